# Optimizing an MI355X kernel written in HIP

```python
import functools
import jax, jax.numpy as jnp
from jax import lax
import numpy as np

D_MODEL = 1024
BATCH = 16
SEQ = 2048
DEPTH = 1
DEC_BATCH = 32
DEC_SEQ = 1
PAST_LEN = 16384
PAGE_SIZE = 128

ATT_HEAD_DIM = 64
ATT_WIDTH = D_MODEL // 2
ATT_HEADS = ATT_WIDTH // ATT_HEAD_DIM
ATT_KV_HEADS = 2
ATT_GROUP = ATT_HEADS // ATT_KV_HEADS
KV_WIDTH = ATT_KV_HEADS * ATT_HEAD_DIM
ATT_SCALE = ATT_HEAD_DIM ** -0.5
IDX_HEADS = 8
IDX_DIM = 64
IDX_W_SCALE = (IDX_HEADS ** -0.5) * (IDX_DIM ** -0.5)
TOPK_MAX = 256
Q_BLOCK = 128
REC_DIM = 128
REC_WIDTH = D_MODEL - ATT_WIDTH
REC_HEADS = REC_WIDTH // REC_DIM
CHUNK = 64
D_FF = 4 * D_MODEL
MIX_WIDTH = ATT_WIDTH + REC_WIDTH
EPS = 1e-6
IN_SPLITS = (ATT_WIDTH, KV_WIDTH, KV_WIDTH, IDX_HEADS * IDX_DIM, IDX_DIM, IDX_HEADS,
             REC_WIDTH, REC_WIDTH, REC_WIDTH, REC_WIDTH)
IN_WIDTH = sum(IN_SPLITS)
IN_OFFSETS = [int(o) for o in np.cumsum(IN_SPLITS)[:-1]]

kernel_name = "hymba_dsa_hgrn2_decode_step"


def rms_norm(x, g):
    xf = x.astype(jnp.float32)
    y = xf * lax.rsqrt(jnp.mean(xf * xf, axis=-1, keepdims=True) + EPS)
    return (y * g.astype(jnp.float32)).astype(x.dtype)


def gather_rows(t, idx):
    return jax.vmap(lambda a, i: a[i])(t, idx)


def indexer_scores(iq, iw, ik):
    dots = jnp.einsum('bthd,bsd->btsh', iq.astype(jnp.float32), ik.astype(jnp.float32))
    return jnp.einsum('btsh,bth->bts', jax.nn.relu(dots), iw.astype(jnp.float32))


def sparse_attend(q, k_sel, v_sel, valid):
    B, T = q.shape[:2]
    qg = q.reshape(B, T, ATT_KV_HEADS, ATT_GROUP, ATT_HEAD_DIM)
    logits = jnp.einsum('btkgd,btskd->btkgs', qg, k_sel).astype(jnp.float32) * ATT_SCALE
    logits = jnp.where(valid[:, :, None, None, :], logits, -jnp.inf)
    p = jax.nn.softmax(logits, axis=-1).astype(v_sel.dtype)
    o = jnp.einsum('btkgs,btskd->btkgd', p, v_sel)
    return o.reshape(B, T, ATT_WIDTH)


def prompt_attention(aq, ak, av, iq, ik, iw):
    B, L = aq.shape[:2]
    n_sel = min(TOPK_MAX, L // 4)
    n_blk = L // Q_BLOCK

    def to_blocks(t):
        return jnp.moveaxis(t.reshape(B, n_blk, Q_BLOCK, *t.shape[2:]), 1, 0)

    qpos = jnp.arange(L, dtype=jnp.int32).reshape(n_blk, Q_BLOCK)
    kpos = jnp.arange(L, dtype=jnp.int32)

    def block(args):
        q_b, iq_b, iw_b, qp = args
        scores = indexer_scores(iq_b, iw_b, ik)
        causal = kpos[None, :] <= qp[:, None]
        scores = jnp.where(causal[None], scores, -jnp.inf)
        _, idx = lax.top_k(scores, n_sel)
        valid = idx <= qp[None, :, None]
        return sparse_attend(q_b, gather_rows(ak, idx), gather_rows(av, idx), valid)

    out = lax.map(block, (to_blocks(aq), to_blocks(iq), to_blocks(iw), qpos))
    return jnp.moveaxis(out, 0, 1).reshape(B, L, ATT_WIDTH)


def sample_attention(aq, ak, av, iq, ik, iw, cache_k, cache_v, cache_kidx, page_table):
    Bd, T = aq.shape[:2]
    past = page_table.shape[1] * PAGE_SIZE
    L = past + T
    n_sel = min(TOPK_MAX, L // 4)
    ik_past = cache_kidx[page_table].reshape(Bd, past, IDX_DIM)
    ik_all = jnp.concatenate([ik_past.astype(jnp.float32), ik.astype(jnp.float32)], axis=1)
    qpos = past + jnp.arange(T, dtype=jnp.int32)
    kpos = jnp.arange(L, dtype=jnp.int32)
    scores = indexer_scores(iq, iw, ik_all)
    scores = jnp.where((kpos[None, :] <= qpos[:, None])[None], scores, -jnp.inf)
    _, idx = lax.top_k(scores, n_sel)
    in_past = idx < past
    pidx = jnp.minimum(idx, past - 1)
    phys = jax.vmap(lambda pt, i: pt[i])(page_table, pidx // PAGE_SIZE)
    off = pidx % PAGE_SIZE
    nidx = jnp.clip(idx - past, 0, T - 1)
    sel = in_past[..., None, None]
    k_sel = jnp.where(sel, cache_k[phys, off], gather_rows(ak, nidx))
    v_sel = jnp.where(sel, cache_v[phys, off], gather_rows(av, nidx))
    valid = idx <= qpos[None, :, None]
    return sparse_attend(aq, k_sel, v_sel, valid)


def hgrn2_chunked(q, log_f, k, v, s0):
    B, L = q.shape[:2]
    C = CHUNK if L % CHUNK == 0 else L
    n = L // C

    def chunks(t):
        return jnp.moveaxis(t.reshape(B, n, C, *t.shape[2:]), 1, 0)

    causal = jnp.tril(jnp.ones((C, C), dtype=bool))[None, :, :, None, None]

    def step(S, inp):
        qc, gc, kc, vc = inp
        b = jnp.cumsum(gc, axis=1)
        o_inter = jnp.einsum('bchk,bhkv->bchv', qc * jnp.exp(b), S)
        diff = b[:, :, None] - b[:, None, :]
        decay = jnp.exp(jnp.where(causal, diff, -jnp.inf))
        A = jnp.einsum('bthk,bshk,btshk->bhts', qc, kc, decay)
        o_intra = jnp.einsum('bhts,bshv->bthv', A, vc)
        b_last = b[:, -1]
        S_new = jnp.exp(b_last)[..., None] * S + jnp.einsum(
            'bshk,bshv->bhkv', kc * jnp.exp(b_last[:, None] - b), vc)
        return S_new, o_inter + o_intra

    S_fin, o = lax.scan(step, s0, (chunks(q), chunks(log_f), chunks(k), chunks(v)))
    return jnp.moveaxis(o, 0, 1).reshape(B, L, *o.shape[3:]), S_fin


def hgrn2_mixer(rq, rf, ri, rg, lb, rec_norm_g, s0):
    B, L = rq.shape[:2]
    shp = (B, L, REC_HEADS, REC_DIM)
    f32 = jnp.float32
    q = (jax.nn.silu(rq.astype(f32)) * (REC_DIM ** -0.5)).reshape(shp)
    xf = rf.astype(f32).reshape(shp)
    lbh = lb.reshape(REC_HEADS, REC_DIM)
    log_f = jnp.logaddexp(jnp.log(lbh), jnp.log1p(-lbh) + jax.nn.log_sigmoid(xf))
    k = (1.0 - lbh) * jax.nn.sigmoid(-xf)
    v = ri.astype(f32).reshape(shp)
    o, S = hgrn2_chunked(q, log_f, k, v, s0.astype(f32))
    o = rms_norm(o, rec_norm_g).reshape(B, L, REC_WIDTH) * jax.nn.silu(rg.astype(f32))
    return o.astype(rg.dtype), S


def trunk_layer(x, s0, lb, attend, norm1_g, w_in, q_norm_g, k_norm_g, idx_k_norm_g,
                rec_norm_g, w_out, norm2_g, w_up, w_down):
    B, L, _ = x.shape
    h = rms_norm(x, norm1_g)
    aq, ak, av, iq, ik, iw, rq, rf, ri, rg = jnp.split(h @ w_in, IN_OFFSETS, axis=-1)
    aq = rms_norm(aq.reshape(B, L, ATT_HEADS, ATT_HEAD_DIM), q_norm_g)
    ak = rms_norm(ak.reshape(B, L, ATT_KV_HEADS, ATT_HEAD_DIM), k_norm_g)
    av = av.reshape(B, L, ATT_KV_HEADS, ATT_HEAD_DIM)
    iq = iq.reshape(B, L, IDX_HEADS, IDX_DIM)
    ik = rms_norm(ik, idx_k_norm_g)
    iw = iw * IDX_W_SCALE
    att = attend(aq, ak, av, iq, ik, iw)
    rec, S_new = hgrn2_mixer(rq, rf, ri, rg, lb, rec_norm_g, s0)
    x = x + jnp.concatenate([att, rec.astype(att.dtype)], axis=-1) @ w_out
    h2 = rms_norm(x, norm2_g)
    x = x + jnp.square(jax.nn.relu(h2 @ w_up)) @ w_down
    return x, ak, av, ik, S_new


def setup_inputs(seed: int = 0) -> dict:
    key = jax.random.key(seed)
    ks = jax.random.split(key, 20)
    f32 = jnp.float32
    n_pages = PAST_LEN // PAGE_SIZE
    n_used = DEC_BATCH * n_pages
    n_pool = n_used + max(1, n_used // 4)

    def nrm(k, shape, scale=1.0):
        return jax.random.normal(k, shape, f32) * scale

    def gain(k, shape):
        return 1.0 + 0.05 * jax.random.normal(k, shape, f32)

    page_table = jax.random.permutation(ks[6], n_pool)[:n_used].reshape(DEC_BATCH, n_pages).astype(jnp.int32)
    return {
        "x_prompt": nrm(ks[0], (BATCH, SEQ, D_MODEL)),
        "x_sample": nrm(ks[1], (DEC_BATCH, DEC_SEQ, D_MODEL)),
        "cache_k": nrm(ks[2], (DEPTH, n_pool, PAGE_SIZE, ATT_KV_HEADS, ATT_HEAD_DIM)),
        "cache_v": nrm(ks[3], (DEPTH, n_pool, PAGE_SIZE, ATT_KV_HEADS, ATT_HEAD_DIM)),
        "cache_kidx": nrm(ks[4], (DEPTH, n_pool, PAGE_SIZE, IDX_DIM)),
        "state_hgrn": nrm(ks[5], (DEPTH, DEC_BATCH, REC_HEADS, REC_DIM, REC_DIM), 0.5),
        "page_table": page_table,
        "norm1_g": gain(ks[7], (DEPTH, D_MODEL)),
        "w_in": nrm(ks[8], (DEPTH, D_MODEL, IN_WIDTH), D_MODEL ** -0.5),
        "q_norm_g": gain(ks[9], (DEPTH, ATT_HEAD_DIM)),
        "k_norm_g": gain(ks[10], (DEPTH, ATT_HEAD_DIM)),
        "idx_k_norm_g": gain(ks[11], (DEPTH, IDX_DIM)),
        "lower_bounds": nrm(ks[12], (DEPTH + 1, REC_WIDTH), 0.1),
        "rec_norm_g": gain(ks[13], (DEPTH, REC_DIM)),
        "w_out": nrm(ks[14], (DEPTH, MIX_WIDTH, D_MODEL), MIX_WIDTH ** -0.5),
        "norm2_g": gain(ks[15], (DEPTH, D_MODEL)),
        "w_up": nrm(ks[16], (DEPTH, D_MODEL, D_FF), D_MODEL ** -0.5),
        "w_down": nrm(ks[17], (DEPTH, D_FF, D_MODEL), D_FF ** -0.5),
    }


def reference(x_prompt, x_sample, cache_k, cache_v, cache_kidx, state_hgrn, page_table,
              norm1_g, w_in, q_norm_g, k_norm_g, idx_k_norm_g, lower_bounds, rec_norm_g,
              w_out, norm2_g, w_up, w_down):
    lb_all = jnp.cumsum(jax.nn.softmax(lower_bounds.astype(jnp.float32), axis=0), axis=0)
    s0_prompt = jnp.zeros((x_prompt.shape[0], REC_HEADS, REC_DIM, REC_DIM), jnp.float32)
    yp, ys = x_prompt, x_sample
    kp_l, vp_l, ip_l, sp_l, ks_l, vs_l, is_l, ss_l = [], [], [], [], [], [], [], []
    for l in range(DEPTH):
        params = (norm1_g[l], w_in[l], q_norm_g[l], k_norm_g[l], idx_k_norm_g[l], rec_norm_g[l],
                  w_out[l], norm2_g[l], w_up[l], w_down[l])
        yp, kp, vp, ip, sp = trunk_layer(yp, s0_prompt, lb_all[l], prompt_attention, *params)
        attend_sample = functools.partial(sample_attention, cache_k=cache_k[l], cache_v=cache_v[l],
                                          cache_kidx=cache_kidx[l], page_table=page_table)
        ys, k_s, v_s, i_s, s_s = trunk_layer(ys, state_hgrn[l], lb_all[l], attend_sample, *params)
        kp_l.append(kp); vp_l.append(vp); ip_l.append(ip); sp_l.append(sp)
        ks_l.append(k_s); vs_l.append(v_s); is_l.append(i_s); ss_l.append(s_s)
    new_k_prompt = jnp.stack(kp_l)
    new_v_prompt = jnp.stack(vp_l)
    new_kidx_prompt = jnp.stack(ip_l)
    new_state_prompt = jnp.stack(sp_l)
    new_k_sample = jnp.stack(ks_l)
    new_v_sample = jnp.stack(vs_l)
    new_kidx_sample = jnp.stack(is_l)
    new_state_sample = jnp.stack(ss_l)
    return (yp, ys, new_k_prompt, new_v_prompt, new_kidx_prompt, new_state_prompt,
            new_k_sample, new_v_sample, new_kidx_sample, new_state_sample)
```

```cpp
#include <hip/hip_runtime.h>
#include <cstdio>
#include <cstdint>

#define LAS __attribute__((address_space(3)))
#define GAS __attribute__((address_space(1)))
typedef float f32x16 __attribute__((ext_vector_type(16)));
typedef unsigned u32x2 __attribute__((ext_vector_type(2)));
typedef unsigned long long u64;

constexpr int NTOK = 32768, NB = 16, SEQ = 2048, DM = 1024, NS = 32, PAST = 16384, PAGE = 128, NPAGES = 128;
constexpr int INW = 3400, INP = 3584, FF = 4096;
constexpr float EPS = 1e-6f;
constexpr float ATT_SCALE = 0.125f, LOG2E = 1.4426950408889634f;
constexpr float IDX_W_SCALE = 0.04419417382415922f;
constexpr float REC_QSCALE = 0.08838834764831845f;
enum { I_XP = 0, I_XS, I_CK, I_CV, I_CKI, I_ST, I_PT, I_N1G, I_WIN, I_QG, I_KG, I_IKG, I_LB, I_RG, I_WOUT, I_N2G, I_WUP, I_WDN };
constexpr size_t O_Y = 0, O_YS = 33554432, O_NK = O_YS + 32768, O_NV = O_NK + 4194304, O_NKI = O_NV + 4194304, O_NSP = O_NKI + 2097152,
                 O_NKS = O_NSP + 1048576, O_NVS = O_NKS + 4096, O_NKIS = O_NVS + 4096, O_NSS = O_NKIS + 2048, O_END = O_NSS + 2097152;
constexpr size_t MiB = 1u << 20;
constexpr size_t WS_CTL = 0, CTL_ZERO_BYTES = 1 * MiB;
constexpr size_t WS_W1T = 2 * MiB, WS_WOT = 10 * MiB, WS_WUT = 12 * MiB, WS_WDT = 20 * MiB;
constexpr size_t WS_GAINS = 28 * MiB + 512 * 1024;
constexpr size_t WS_RSTD1 = 28 * MiB, WS_IWF = 29 * MiB, WS_SSQ2 = 30 * MiB, WS_SAMP = 32 * MiB;
constexpr size_t WS_XB = 40 * MiB, WS_QB = 104 * MiB, WS_KB = 136 * MiB, WS_VT = 144 * MiB, WS_IQB = 152 * MiB, WS_IKB = 184 * MiB;
constexpr size_t WS_RQ = 188 * MiB, WS_RF = 220 * MiB, WS_RI = 252 * MiB, WS_RGT = 284 * MiB, WS_MASK = 316 * MiB, WS_MIX = 324 * MiB;
constexpr size_t WS_X1B = 388 * MiB, WS_H = 452 * MiB, WS_END = 708 * MiB;
constexpr int S_RAW = 0, S_SP = 131072, S_SC = 262144, S_SCROW = 16400, S_MIX = S_SC + 32 * S_SCROW + 256, S_X1 = S_MIX + 32768, S_H = S_X1 + 32768, S_ENDF = S_H + 131072;
static_assert((size_t)S_ENDF * 4 <= 8 * MiB, "sample scratch");
constexpr int CW_BAR = 4096, CW_Q2 = 8192, CW_Q3 = 8256;
constexpr int LDS_BYTES = 147456, LDSCTL_OFF = 131072 + 8192, MISC_OFF = LDSCTL_OFF + 320;

namespace pg8 {
#define PG8_LAS __attribute__((address_space(3)))
typedef unsigned short bf16_t;
typedef short bf16x8 __attribute__((ext_vector_type(8)));
typedef float f32x4 __attribute__((ext_vector_type(4)));
typedef unsigned u32x4 __attribute__((ext_vector_type(4)));
constexpr int BM = 256, BK = 64, HALF = 128, HTB = HALF * BK * 2  , STAGE_BYTES = 8 * HTB, NXCD = 8, WGM = 8;

__host__ __device__ __forceinline__ int lds_byte(int r, int c) { const int st = (r >> 4) * 2 + (c >> 5), rr = r & 15, cc = c & 31, ob = rr * 64 + cc * 2; return st * 1024 + (ob ^ (((ob >> 9) & 1) << 5)); }
__host__ __device__ __forceinline__ void stage_rc(int b, int& R, int& C) { const int st = b / 1024, sb = b % 1024, swz = sb ^ (((sb >> 9) & 1) << 5); R = (st >> 1) * 16 + swz / 64; C = (st & 1) * 32 + (swz % 64) / 2; }
__host__ __device__ __forceinline__ int perm32(int rho) { const int n = rho >> 4, i = rho & 15; return 8 * (i >> 2) + 4 * n + (i & 3); }

struct Unit { int pm, pn; };
struct Gemm { const bf16_t* A; const bf16_t* Bt; int M, N, K; };

struct StaticOrder {
    int nM, nN, nwg, G, c;
    __host__ __device__ void init(int M, int N, int G_, int c_) { nM = M / BM; nN = N / BM; nwg = nM * nN; G = G_; c = c_; }
    __host__ __device__ bool next(int i, Unit& u) const {
        const long L = (long)i * G + c; if (L >= nwg) return false;
        int wgid = (int)L; { const int q = nwg / NXCD, r = nwg % NXCD, xcd = wgid % NXCD, off = wgid / NXCD; wgid = (xcd < r ? xcd * (q + 1) : r * (q + 1) + (xcd - r) * q) + off; }
        const int nig = WGM * nN, gid = wgid / nig, fm = gid * WGM, gsz = (nM - fm) < WGM ? (nM - fm) : WGM;
        u.pm = fm + ((wgid % nig) % gsz); u.pn = (wgid % nig) / gsz; return true;
    }
    __device__ __forceinline__ void a_ready(const Unit&) const {}
    __device__ __forceinline__ void done(const Unit&) const {}
};

__device__ __forceinline__ unsigned cvt_pk_bf16(float lo, float hi) { unsigned r; asm volatile("v_cvt_pk_bf16_f32 %0, %1, %2" : "=v"(r) : "v"(lo), "v"(hi)); return r; }
typedef float f32x2 __attribute__((ext_vector_type(2)));
__device__ __forceinline__ float silu_f(float x) { return x / (1.f + __expf(-x)); }
__device__ __forceinline__ void st_bf16x16(bf16_t* p, const float (&t)[16]) {
    u32x4 a, b;
    a.x = cvt_pk_bf16(t[0], t[1]); a.y = cvt_pk_bf16(t[2], t[3]); a.z = cvt_pk_bf16(t[4], t[5]); a.w = cvt_pk_bf16(t[6], t[7]);
    b.x = cvt_pk_bf16(t[8], t[9]); b.y = cvt_pk_bf16(t[10], t[11]); b.z = cvt_pk_bf16(t[12], t[13]); b.w = cvt_pk_bf16(t[14], t[15]);
    *(u32x4*)p = a; *(u32x4*)(p + 8) = b;
}
__device__ __forceinline__ void st_f32x16(float* p, const float (&t)[16]) {
#pragma unroll
    for (int i = 0; i < 4; ++i) *(f32x4*)(p + 4 * i) = (f32x4){t[4 * i], t[4 * i + 1], t[4 * i + 2], t[4 * i + 3]};
}
__device__ __forceinline__ unsigned short f2bf_rne(float f) { unsigned u = __builtin_bit_cast(unsigned, f); return (unsigned short)((u + 0x7fffu + ((u >> 16) & 1u)) >> 16); }

struct EpiInProj {
    static constexpr bool PERM = false, AFTER_DRAIN = false;
    const float* rstd1; const float* gains;
    bf16_t *Qb, *Kb, *Vt, *IQb, *IKb, *Rq, *Rf, *Ri, *Rg; float* IWf; float *oK, *oV, *oKI;
    __device__ __forceinline__ void operator()(const f32x4 (&acc)[2][2][4][2], const Unit& u, int wr, int wc, int fr, int fq) const {
        const int pn = u.pn;
        const float* gsrc = gains + (pn < 2 ? 0 : (pn == 2 ? 64 : 128));
        float g[16];
#pragma unroll
        for (int i = 0; i < 4; ++i) { const f32x4 v = *(const f32x4*)(gsrc + 16 * fq + 4 * i); g[4 * i] = v[0]; g[4 * i + 1] = v[1]; g[4 * i + 2] = v[2]; g[4 * i + 3] = v[3]; }
#pragma unroll
        for (int ai = 0; ai < 2; ++ai)
#pragma unroll
            for (int m = 0; m < 4; ++m) {
                const int row = u.pm * BM + ai * HALF + wr * 64 + m * 16 + fr;
                const float rs = rstd1[row];
                float t[16];
#pragma unroll
                for (int bj = 0; bj < 2; ++bj)
#pragma unroll
                    for (int n = 0; n < 2; ++n)
#pragma unroll
                        for (int e = 0; e < 4; ++e) t[8 * bj + 4 * n + e] = acc[ai][bj][m][n][e] * rs;
                const bool normed = (pn < 2) || (pn == 2 && wc < 2) || (pn == 5 && wc == 0);
                if (normed) {
                    float ss = 0.f;
#pragma unroll
                    for (int j = 0; j < 16; ++j) ss += t[j] * t[j];
                    ss += __shfl_xor(ss, 16); ss += __shfl_xor(ss, 32);
                    float sc = rsqrtf(ss * (1.0f / 64.0f) + EPS);
                    if (pn < 2) sc *= ATT_SCALE * LOG2E;
#pragma unroll
                    for (int j = 0; j < 16; ++j) t[j] = t[j] * sc * g[j];
                }
                if (pn < 2) {
                    st_bf16x16(Qb + (size_t)row * 512 + (4 * pn + wc) * 64 + 16 * fq, t);
                } else if (pn == 2) {
                    if (wc < 2) { st_f32x16(oK + (size_t)row * 128 + wc * 64 + 16 * fq, t); st_bf16x16(Kb + (size_t)row * 128 + wc * 64 + 16 * fq, t); }
                    else {
                        st_f32x16(oV + (size_t)row * 128 + (wc - 2) * 64 + 16 * fq, t);
                        const int b = row >> 11, tt = row & 2047;
                        bf16_t* vp = Vt + ((size_t)(b * 2 + (wc - 2)) * 64 + 16 * fq) * 2048 + tt;
#pragma unroll
                        for (int j = 0; j < 16; ++j) vp[(size_t)j * 2048] = f2bf_rne(t[j]);
                    }
                } else if (pn < 5) {
                    st_bf16x16(IQb + (size_t)row * 512 + (4 * (pn - 3) + wc) * 64 + 16 * fq, t);
                } else if (pn == 5) {
                    if (wc == 0) { st_f32x16(oKI + (size_t)row * 64 + 16 * fq, t); st_bf16x16(IKb + (size_t)row * 64 + 16 * fq, t); }
                    else if (wc == 1 && fq == 0) {
                        *(f32x4*)(IWf + (size_t)row * 8) = (f32x4){t[0] * IDX_W_SCALE, t[1] * IDX_W_SCALE, t[2] * IDX_W_SCALE, t[3] * IDX_W_SCALE};
                        *(f32x4*)(IWf + (size_t)row * 8 + 4) = (f32x4){t[4] * IDX_W_SCALE, t[5] * IDX_W_SCALE, t[6] * IDX_W_SCALE, t[7] * IDX_W_SCALE};
                    }
                } else {
                    const int kind = (pn - 6) >> 1, col = 256 * ((pn - 6) & 1) + 64 * wc + 16 * fq;
                    if (kind == 0) {
#pragma unroll
                        for (int j = 0; j < 16; ++j) t[j] = silu_f(t[j]) * REC_QSCALE;
                        st_bf16x16(Rq + (size_t)row * 512 + col, t);
                    } else if (kind == 1) st_bf16x16(Rf + (size_t)row * 512 + col, t);
                    else if (kind == 2) st_bf16x16(Ri + (size_t)row * 512 + col, t);
                    else {
#pragma unroll
                        for (int j = 0; j < 16; ++j) t[j] = silu_f(t[j]);
                        st_bf16x16(Rg + (size_t)row * 512 + col, t);
                    }
                }
            }
    }
};
struct EpiOutProj {
    static constexpr bool PERM = false, AFTER_DRAIN = false;
    const float* X; float* Y; bf16_t* X1B; float* SSQ2;
    __device__ __forceinline__ void operator()(const f32x4 (&acc)[2][2][4][2], const Unit& u, int wr, int wc, int fr, int fq) const {
        const int col0 = u.pn * BM + wc * 32 + 4 * fq;
#pragma unroll
        for (int ai = 0; ai < 2; ++ai)
#pragma unroll
            for (int m = 0; m < 4; ++m) {
                const int row = u.pm * BM + ai * HALF + wr * 64 + m * 16 + fr; const size_t off = (size_t)row * DM + col0; float ss = 0.f;
#pragma unroll
                for (int bj = 0; bj < 2; ++bj)
#pragma unroll
                    for (int n = 0; n < 2; ++n) {
                        const f32x4 xv = *(const f32x4*)(X + off + bj * HALF + n * 16); const f32x4 o = xv + acc[ai][bj][m][n];
                        *(f32x4*)(Y + off + bj * HALF + n * 16) = o; ss += (o[0] * o[0] + o[1] * o[1]) + (o[2] * o[2] + o[3] * o[3]);
                        u32x2 w; w.x = cvt_pk_bf16(o[0], o[1]); w.y = cvt_pk_bf16(o[2], o[3]); *(u32x2*)(X1B + off + bj * HALF + n * 16) = w;
                    }
                ss += __shfl_xor(ss, 16); ss += __shfl_xor(ss, 32);
                if (fq == 0) SSQ2[(size_t)row * 16 + u.pn * 4 + wc] = ss;
            }
    }
};
struct EpiUp {
    static constexpr bool PERM = true, AFTER_DRAIN = false;
    const float* SSQ2; bf16_t* H;
    __device__ __forceinline__ void operator()(const f32x4 (&acc)[2][2][4][2], const Unit& u, int wr, int wc, int fr, int fq) const {
        const int col0 = u.pn * BM + wc * 32 + 8 * fq;
#pragma unroll
        for (int ai = 0; ai < 2; ++ai)
#pragma unroll
            for (int m = 0; m < 4; ++m) {
                const int row = u.pm * BM + ai * HALF + wr * 64 + m * 16 + fr;
                const f32x4 s0 = *(const f32x4*)(SSQ2 + (size_t)row * 16), s1 = *(const f32x4*)(SSQ2 + (size_t)row * 16 + 4), s2 = *(const f32x4*)(SSQ2 + (size_t)row * 16 + 8), s3 = *(const f32x4*)(SSQ2 + (size_t)row * 16 + 12);
                const float ss = (((s0[0] + s0[1]) + (s0[2] + s0[3])) + ((s1[0] + s1[1]) + (s1[2] + s1[3]))) + (((s2[0] + s2[1]) + (s2[2] + s2[3])) + ((s3[0] + s3[1]) + (s3[2] + s3[3])));
                const float rs = rsqrtf(ss * (1.0f / 1024.0f) + EPS);
                bf16_t* rowp = H + (size_t)row * FF + col0;
#pragma unroll
                for (int bj = 0; bj < 2; ++bj) {
                    f32x4 v0 = acc[ai][bj][m][0] * rs, v1 = acc[ai][bj][m][1] * rs;
#pragma unroll
                    for (int e = 0; e < 4; ++e) { const float a = fmaxf(v0[e], 0.f), b = fmaxf(v1[e], 0.f); v0[e] = a * a; v1[e] = b * b; }
                    u32x4 w; w.x = cvt_pk_bf16(v0[0], v0[1]); w.y = cvt_pk_bf16(v0[2], v0[3]); w.z = cvt_pk_bf16(v1[0], v1[1]); w.w = cvt_pk_bf16(v1[2], v1[3]);
                    *(u32x4*)(rowp + bj * HALF) = w;
                }
            }
    }
};
struct EpiDown {
    static constexpr bool PERM = false, AFTER_DRAIN = false;
    float* Y;
    __device__ __forceinline__ void operator()(const f32x4 (&acc)[2][2][4][2], const Unit& u, int wr, int wc, int fr, int fq) const {
        const int col0 = u.pn * BM + wc * 32 + 4 * fq;
#pragma unroll
        for (int ai = 0; ai < 2; ++ai)
#pragma unroll
            for (int m = 0; m < 4; ++m) {
                const size_t off = (size_t)(u.pm * BM + ai * HALF + wr * 64 + m * 16 + fr) * DM + col0;
#pragma unroll
                for (int bj = 0; bj < 2; ++bj)
#pragma unroll
                    for (int n = 0; n < 2; ++n) { float* p = Y + off + bj * HALF + n * 16; *(f32x4*)p = *(const f32x4*)p + acc[ai][bj][m][n]; }
            }
    }
};
template <class Epi, class Sched, bool ALIGN_EPI = false, bool SP2 = false>
__device__ __forceinline__ void gemm_phase(PG8_LAS unsigned char* lds, const Gemm g, const Sched& S, const Epi& E) {
    const int tid = threadIdx.x, wid = __builtin_amdgcn_readfirstlane(tid >> 6), lane = tid & 63, wr = wid >> 2, wc = wid & 3, fr = lane & 15, fq = lane >> 4;
    const int K = g.K, nt = K / BK;
    unsigned voffA[2], voffB[2];
#pragma unroll
    for (int i = 0; i < 2; ++i) { int R, C; stage_rc(tid * 16 + i * 8192, R, C); const int Rb = Epi::PERM ? ((R & ~31) + perm32(R & 31)) : R;
        voffA[i] = (unsigned)(R * K + C) * 2u; voffB[i] = (unsigned)(Rb * K + C) * 2u; }
    const size_t kstep = (size_t)(BK * 2);
    const size_t hstep = (size_t)HALF * K * 2;
    const size_t tstep = 2 * hstep;
    const unsigned ldsw = (unsigned)wid * 1024u;
    const int aoff = lds_byte(wr * 64 + fr, fq * 8), boff = lds_byte(wc * 32 + fr, fq * 8);
#define PG8_SA(b, h) (((b) * 2 + (h)) * HTB)
#define PG8_SB(b, h) ((4 + (b) * 2 + (h)) * HTB)
#define PG8_STAGE(bufoff, gbase, voff) do { _Pragma("unroll") for (int _i = 0; _i < 2; ++_i) \
        __builtin_amdgcn_global_load_lds((const unsigned*)((const char*)(gbase) + (voff)[_i]), (PG8_LAS unsigned*)(lds + (bufoff) + ldsw + _i * 8192), 16, 0, 0); } while (0)
#define PG8_LDA(dst, b, h) do { _Pragma("unroll") for (int m = 0; m < 4; ++m) _Pragma("unroll") for (int k = 0; k < 2; ++k) dst[m][k] = *(const PG8_LAS bf16x8*)(lds + PG8_SA(b, h) + aoff + m * 2048 + k * 1024); } while (0)
#define PG8_LDB(dst, b, h) do { _Pragma("unroll") for (int n = 0; n < 2; ++n) _Pragma("unroll") for (int k = 0; k < 2; ++k) dst[n][k] = *(const PG8_LAS bf16x8*)(lds + PG8_SB(b, h) + boff + n * 2048 + k * 1024); } while (0)
#define PG8_MMA(ai, bj, At, Bt) do { __builtin_amdgcn_s_setprio(1); _Pragma("unroll") for (int m = 0; m < 4; ++m) _Pragma("unroll") for (int n = 0; n < 2; ++n) _Pragma("unroll") for (int k = 0; k < 2; ++k) \
        acc[ai][bj][m][n] = __builtin_amdgcn_mfma_f32_16x16x32_bf16(Bt[n][k], At[m][k], acc[ai][bj][m][n], 0, 0, 0); __builtin_amdgcn_s_setprio(0); } while (0)
#define PG8_WAIT_V(n) asm volatile("s_waitcnt vmcnt(" #n ")" ::: "memory")
#define PG8_WAIT_L(n) asm volatile("s_waitcnt lgkmcnt(" #n ")" ::: "memory")
#define PG8_BAR __builtin_amdgcn_s_barrier()
#define PG8_SCHED __builtin_amdgcn_sched_barrier(0)
    Unit cur, nxt; int ui = 0;
    if (!S.next(0, cur)) return;
    f32x4 acc[2][2][4][2];
#pragma unroll
    for (int a = 0; a < 2; ++a)
#pragma unroll
        for (int b = 0; b < 2; ++b)
#pragma unroll
            for (int m = 0; m < 4; ++m)
#pragma unroll
                for (int n = 0; n < 2; ++n) acc[a][b][m][n] = (f32x4){0.f, 0.f, 0.f, 0.f};
    bf16x8 At[4][2], B0[2][2], B1[2][2];
    const char* cA = (const char*)g.A + (size_t)cur.pm * tstep; const char* cB = (const char*)g.Bt + (size_t)cur.pn * tstep;
    S.a_ready(cur);
    if constexpr (SP2) {
        PG8_STAGE(PG8_SB(0, 0), cB, voffB); PG8_STAGE(PG8_SB(0, 1), cB + hstep, voffB); PG8_STAGE(PG8_SA(0, 0), cA, voffA); PG8_STAGE(PG8_SA(0, 1), cA + hstep, voffA);
        if (wr == 1) PG8_BAR;
        PG8_WAIT_V(2); PG8_BAR;
        PG8_STAGE(PG8_SB(1, 0), cB + kstep, voffB); PG8_STAGE(PG8_SA(1, 0), cA + kstep, voffA); PG8_STAGE(PG8_SB(1, 1), cB + hstep + kstep, voffB);
        PG8_WAIT_V(6); PG8_BAR;
    } else {
        PG8_STAGE(PG8_SB(0, 0), cB, voffB); PG8_STAGE(PG8_SA(0, 0), cA, voffA); PG8_STAGE(PG8_SB(0, 1), cB + hstep, voffB); PG8_STAGE(PG8_SA(0, 1), cA + hstep, voffA);
        if (wr == 1) PG8_BAR;
        PG8_WAIT_V(4); PG8_BAR;
        PG8_STAGE(PG8_SB(1, 0), cB + kstep, voffB); PG8_STAGE(PG8_SA(1, 0), cA + kstep, voffA); PG8_STAGE(PG8_SB(1, 1), cB + hstep + kstep, voffB);
        PG8_WAIT_V(6); PG8_BAR;
    }
    for (;;) {
        const bool has_next = S.next(ui + 1, nxt);
        const char* nA = has_next ? (const char*)g.A + (size_t)nxt.pm * tstep : cA; const char* nB = has_next ? (const char*)g.Bt + (size_t)nxt.pn * tstep : cB;
        for (int t = 0; t < nt; t += 2) {
            const bool last = (t == nt - 2);
            const char* a1 = cA + (size_t)(t + 1) * kstep;
            const char* a2 = last ? nA : cA + (size_t)(t + 2) * kstep; const char* b2 = last ? nB : cB + (size_t)(t + 2) * kstep;
            const char* a3 = a2 + kstep; const char* b3 = b2 + kstep;
            if (last && has_next) S.a_ready(nxt);
            if constexpr (SP2) {
            PG8_LDB(B0, 0, 0); PG8_LDB(B1, 0, 1); PG8_SCHED; PG8_LDA(At, 0, 0); PG8_STAGE(PG8_SA(1, 1), a1 + hstep, voffA);
            PG8_WAIT_V(8); PG8_WAIT_L(0); PG8_BAR; PG8_MMA(0, 0, At, B0); PG8_MMA(0, 1, At, B1); PG8_BAR; PG8_SCHED;
            PG8_LDA(At, 0, 1); PG8_STAGE(PG8_SB(0, 0), b2, voffB); PG8_STAGE(PG8_SB(0, 1), b2 + hstep, voffB); PG8_STAGE(PG8_SA(0, 0), a2, voffA);
            PG8_WAIT_V(8); PG8_WAIT_L(0); PG8_BAR; PG8_MMA(1, 0, At, B0); PG8_MMA(1, 1, At, B1); PG8_BAR; PG8_SCHED;
            PG8_LDB(B0, 1, 0); PG8_LDB(B1, 1, 1); PG8_SCHED; PG8_LDA(At, 1, 0); PG8_STAGE(PG8_SA(0, 1), a2 + hstep, voffA);
            PG8_WAIT_V(8); PG8_WAIT_L(0); PG8_BAR; PG8_MMA(0, 0, At, B0); PG8_MMA(0, 1, At, B1); PG8_BAR; PG8_SCHED;
            PG8_LDA(At, 1, 1); PG8_STAGE(PG8_SB(1, 0), b3, voffB); PG8_STAGE(PG8_SB(1, 1), b3 + hstep, voffB); PG8_STAGE(PG8_SA(1, 0), a3, voffA);
            PG8_WAIT_V(8); PG8_WAIT_L(0); PG8_BAR; PG8_MMA(1, 0, At, B0); PG8_MMA(1, 1, At, B1); PG8_BAR; PG8_SCHED;
            } else {
            PG8_LDB(B0, 0, 0); PG8_SCHED; PG8_LDA(At, 0, 0); PG8_STAGE(PG8_SA(1, 1), a1 + hstep, voffA);
            PG8_WAIT_L(8); PG8_BAR; PG8_WAIT_L(0); PG8_MMA(0, 0, At, B0); PG8_BAR; PG8_SCHED;
            PG8_LDB(B1, 0, 1); PG8_STAGE(PG8_SB(0, 0), b2, voffB);
            PG8_BAR; PG8_WAIT_L(0); PG8_MMA(0, 1, At, B1); PG8_BAR;
            PG8_LDA(At, 0, 1); PG8_STAGE(PG8_SA(0, 0), a2, voffA);
            PG8_BAR; PG8_WAIT_L(0); PG8_MMA(1, 0, At, B0); PG8_BAR; PG8_SCHED;
            PG8_STAGE(PG8_SB(0, 1), b2 + hstep, voffB);
            PG8_WAIT_V(6); PG8_BAR; PG8_MMA(1, 1, At, B1); PG8_BAR;
            PG8_LDB(B0, 1, 0); PG8_SCHED; PG8_LDA(At, 1, 0); PG8_STAGE(PG8_SA(0, 1), a2 + hstep, voffA);
            PG8_WAIT_L(8); PG8_BAR; PG8_WAIT_L(0); PG8_MMA(0, 0, At, B0); PG8_BAR; PG8_SCHED;
            PG8_LDB(B1, 1, 1); PG8_STAGE(PG8_SB(1, 0), b3, voffB);
            PG8_BAR; PG8_WAIT_L(0); PG8_MMA(0, 1, At, B1); PG8_BAR;
            PG8_LDA(At, 1, 1); PG8_STAGE(PG8_SA(1, 0), a3, voffA);
            PG8_BAR; PG8_WAIT_L(0); PG8_MMA(1, 0, At, B0); PG8_BAR; PG8_SCHED;
            PG8_STAGE(PG8_SB(1, 1), b3 + hstep, voffB);
            PG8_WAIT_V(6); PG8_BAR; PG8_MMA(1, 1, At, B1); PG8_BAR;
            }
        }
        if constexpr (ALIGN_EPI) { if (wr == 0) PG8_BAR; }
        if constexpr (!Epi::AFTER_DRAIN) { E(acc, cur, wr, wc, fr, fq); S.done(cur); }
        if (!has_next) break;
#pragma unroll
        for (int a = 0; a < 2; ++a)
#pragma unroll
            for (int b = 0; b < 2; ++b)
#pragma unroll
                for (int m = 0; m < 4; ++m)
#pragma unroll
                    for (int n = 0; n < 2; ++n) acc[a][b][m][n] = (f32x4){0.f, 0.f, 0.f, 0.f};
        cur = nxt; cA = nA; cB = nB; ++ui;
        if constexpr (ALIGN_EPI) { if (wr == 1) PG8_BAR; }
    }
    PG8_WAIT_V(0);
    if constexpr (!ALIGN_EPI) { if (wr == 0) PG8_BAR; }
    PG8_BAR;
    if constexpr (Epi::AFTER_DRAIN) { E.fused(acc, cur, wr, wc, fr, fq, lds, wid, lane); S.done(cur); }
#undef PG8_SA
#undef PG8_SB
#undef PG8_STAGE
#undef PG8_LDA
#undef PG8_LDB
#undef PG8_MMA
#undef PG8_WAIT_V
#undef PG8_WAIT_L
#undef PG8_BAR
#undef PG8_SCHED
}
}
#define XB_TMO      128
#define XB_XCNT(j)  (256  + 64 * (j))
#define XB_XSUB(j)  (1280 + 64 * (j))
#define XB_XGEN(j)  (2304 + 64 * (j))
#define XB_TOP      3328
#define XB_TOPGEN   3392
#define XCD_BAR_WORDS 3456
#define XB_SPIN_CAP (1u << 18)

__device__ __forceinline__ unsigned xb_ld(unsigned* p)              { return __hip_atomic_load(p, __ATOMIC_RELAXED, __HIP_MEMORY_SCOPE_AGENT); }
__device__ __forceinline__ unsigned xb_add(unsigned* p, unsigned v) { return __hip_atomic_fetch_add(p, v, __ATOMIC_RELAXED, __HIP_MEMORY_SCOPE_AGENT); }
__device__ __forceinline__ unsigned xb_xcc_id() { return (unsigned)__builtin_amdgcn_s_getreg((3 << 11) | 20) & 0xFu; }
#define XB_SPIN(cond, bar) do { unsigned _sp = 0; while (cond) { __builtin_amdgcn_s_sleep(1); \
    if ((++_sp & 255u) == 0u) { if (xb_ld(&(bar)[XB_TMO])) break; if (_sp > XB_SPIN_CAP) { atomicAdd(&(bar)[XB_TMO], 1u); break; } } } } while (0)

struct XcdBarrier {
    unsigned* bar; unsigned x;
    volatile LAS unsigned* st;
};

__device__ __forceinline__ XcdBarrier xcd_barrier_post(unsigned* bar, volatile LAS unsigned* st) {
    XcdBarrier b; b.bar = bar; b.x = xb_xcc_id(); b.st = st;
    if (threadIdx.x == 0) (void)xb_add(&bar[XB_XCNT(b.x)], 1u);
    return b;
}
__device__ __forceinline__ void xcd_barrier_complete(unsigned* bar, unsigned x, unsigned& nloc, unsigned& nx) {
    const unsigned G = gridDim.x * gridDim.y * gridDim.z;
    unsigned sum, cnt, mine, sp = 0u;
    for (;;) {
        sum = 0u; cnt = 0u; mine = 0u;
#pragma unroll
        for (unsigned j = 0; j < 16; ++j) { const unsigned c = xb_ld(&bar[XB_XCNT(j)]); sum += c; cnt += (c > 0u) ? 1u : 0u; mine = (j == x) ? c : mine; }
        if (sum == G) break;
        __builtin_amdgcn_s_sleep(1);
        if ((++sp & 255u) == 0u) { if (xb_ld(&bar[XB_TMO])) break; if (sp > XB_SPIN_CAP) { atomicAdd(&bar[XB_TMO], 1u); break; } }
    }
    nloc = mine > 0u ? mine : 1u; nx = cnt > 0u ? cnt : 1u;
}

__device__ __forceinline__ void xcd_barrier(const XcdBarrier& b) {
    asm volatile("s_waitcnt vmcnt(0)" ::: "memory");
    __syncthreads();
    if (threadIdx.x == 0) {
        unsigned* bar = b.bar;
        __builtin_amdgcn_s_waitcnt(0);
        unsigned nloc = b.st[0], nx = b.st[1];
        if (nloc == 0u) { xcd_barrier_complete(bar, b.x, nloc, nx); b.st[0] = nloc; b.st[1] = nx; }
        const unsigned old = xb_add(&bar[XB_XSUB(b.x)], 1u);
        const unsigned gen = old / nloc;
        if (old + 1u == (gen + 1u) * nloc) {
            __builtin_amdgcn_fence(__ATOMIC_RELEASE, "agent");
            asm volatile("s_waitcnt vmcnt(0)" ::: "memory");
            const unsigned og = xb_add(&bar[XB_TOP], 1u);
            const unsigned tg = og / nx;
            if (og + 1u == (tg + 1u) * nx) xb_add(&bar[XB_TOPGEN], 1u);
            else XB_SPIN(xb_ld(&bar[XB_TOPGEN]) == tg, bar);
            __builtin_amdgcn_fence(__ATOMIC_ACQUIRE, "agent");
            xb_add(&bar[XB_XGEN(b.x)], 1u);
            asm volatile("s_waitcnt vmcnt(0)" ::: "memory");
        } else {
            XB_SPIN(xb_ld(&bar[XB_XGEN(b.x)]) == gen, bar);
            __builtin_amdgcn_fence(__ATOMIC_ACQUIRE, "agent");
            asm volatile("s_waitcnt vmcnt(0)" ::: "memory");
        }
    }
    __syncthreads();
}
typedef unsigned short bf16;
typedef unsigned v4u __attribute__((ext_vector_type(4)));
typedef float f32x4 __attribute__((ext_vector_type(4)));
typedef short bf16x8 __attribute__((ext_vector_type(8)));
typedef GAS unsigned gu32;
#define LDS_WAIT() asm volatile("s_waitcnt lgkmcnt(0)" ::: "memory")
__device__ __forceinline__ unsigned f2bf(float f) { unsigned u = __builtin_bit_cast(unsigned, f); return (u + 0x7fffu + ((u >> 16) & 1u)) >> 16; }
__device__ __forceinline__ unsigned pk2(float lo, float hi) { return f2bf(lo) | (f2bf(hi) << 16); }
__device__ __forceinline__ float bf2f(unsigned short h) { return __builtin_bit_cast(float, (unsigned)h << 16); }
__device__ __forceinline__ float bflo(unsigned w) { return __builtin_bit_cast(float, w << 16); }
__device__ __forceinline__ float bfhi(unsigned w) { return __builtin_bit_cast(float, w & 0xffff0000u); }
__device__ __forceinline__ float wave_sum(float v) {
#pragma unroll
    for (int o = 1; o < 64; o <<= 1) v += __shfl_xor(v, o);
    return v;
}
__device__ __forceinline__ float silu_f(float x) { return x / (1.f + __expf(-x)); }
__device__ __forceinline__ int crow(int r, int hi) { return (r & 3) + 8 * (r >> 2) + 4 * hi; }

struct Ctx {
    LAS unsigned char* lds; volatile LAS unsigned* MISC; gu32* ctl;
    int tid, lane, wave, vcu, G;
    const float* in[18]; float* out; unsigned char* ws;
};
__device__ __forceinline__ int q_next(Ctx& C, int cw) {
    __syncthreads();
    if (C.tid == 0) C.MISC[16] = __hip_atomic_fetch_add((unsigned*)(C.ctl + cw), 1u, __ATOMIC_RELAXED, __HIP_MEMORY_SCOPE_AGENT);
    __syncthreads();
    return (int)C.MISC[16];
}

__device__ __forceinline__ int inproj_src(int p) {
    const int pn = p >> 8, q = p & 255;
    const int bj = q >> 7, wc = (q >> 5) & 3, n = (q >> 4) & 1, fq = (q >> 2) & 3, e = q & 3;
    const int lc = 64 * wc + 16 * fq + 8 * bj + 4 * n + e;
    if (pn < 5) return 256 * pn + lc;
    if (pn == 5) return lc < 72 ? 1280 + lc : -1;
    return 1352 + 256 * (pn - 6) + lc;
}
template <bool MAP>
__device__ __forceinline__ void p0_transpose_item(const float* W, int K, int N, int NP, const float* gain, bf16* WT, LAS float* scr, int item, int lane) {
    const int nblk = NP / 32, kb = item / nblk, nb = item % nblk, k0 = 64 * kb, n0 = 32 * nb;
    const int p = n0 + (lane & 31); const int sc = MAP ? inproj_src(p) : p;
#pragma unroll 8
    for (int i = 0; i < 32; ++i) { const int kk = 2 * i + (lane >> 5); float v = 0.f; if (sc >= 0) v = W[(size_t)(k0 + kk) * N + sc]; if (gain) v *= gain[k0 + kk]; scr[kk * 33 + (lane & 31)] = v; }
    LDS_WAIT(); asm volatile("" ::: "memory");
    const int c = lane & 7;
#pragma unroll
    for (int j = 0; j < 4; ++j) { const int n = (lane >> 3) + 8 * j; const LAS float* s = scr + (8 * c) * 33 + n;
        v4u o; o.x = pk2(s[0 * 33], s[1 * 33]); o.y = pk2(s[2 * 33], s[3 * 33]); o.z = pk2(s[4 * 33], s[5 * 33]); o.w = pk2(s[6 * 33], s[7 * 33]);
        *(GAS v4u*)(WT + (size_t)(n0 + n) * K + k0 + 8 * c) = o; }
    LDS_WAIT(); asm volatile("" ::: "memory");
}
__device__ __forceinline__ void x_row_to_bf16(const float* xrow, bf16* orow, float* rstd, int lane) {
    const GAS f32x4* xr = (const GAS f32x4*)xrow + lane;
    f32x4 v[4]; float s = 0.f;
#pragma unroll
    for (int j = 0; j < 4; ++j) { v[j] = xr[64 * j]; s += (v[j].x * v[j].x + v[j].y * v[j].y) + (v[j].z * v[j].z + v[j].w * v[j].w); }
    s = wave_sum(s);
    if (lane == 0) *rstd = rsqrtf(s * (1.0f / DM) + EPS);
    GAS u64* o8 = (GAS u64*)orow + lane;
#pragma unroll
    for (int j = 0; j < 4; ++j) o8[64 * j] = (u64)pk2(v[j].x, v[j].y) | ((u64)pk2(v[j].z, v[j].w) << 32);
}

template <int K, bool GK>
__device__ __forceinline__ void skinny32(const float* A, const float* gk, const float* W, int ldw, int N, int n0, LAS float* red, int tid, int lane, int wave) {
    const int i = lane & 31, kh = lane >> 5, n = n0 + i; const bool nok = n < N;
    f32x16 acc = {};
    const int kbeg = wave * (K / 8), kend = kbeg + K / 8;
#pragma unroll 2
    for (int kb = kbeg; kb < kend; kb += 8) {
        f32x4 xa = *(const f32x4*)(A + (size_t)i * K + kb + 4 * kh);
        if (GK) { const f32x4 ga = *(const f32x4*)(gk + kb + 4 * kh); xa = xa * ga; }
        float b0 = 0.f, b1 = 0.f, b2 = 0.f, b3 = 0.f;
        if (nok) { const float* wp = W + (size_t)(kb + 4 * kh) * ldw + n; b0 = wp[0]; b1 = wp[ldw]; b2 = wp[2 * (size_t)ldw]; b3 = wp[3 * (size_t)ldw]; }
        acc = __builtin_amdgcn_mfma_f32_32x32x2f32(xa[0], b0, acc, 0, 0, 0);
        acc = __builtin_amdgcn_mfma_f32_32x32x2f32(xa[1], b1, acc, 0, 0, 0);
        acc = __builtin_amdgcn_mfma_f32_32x32x2f32(xa[2], b2, acc, 0, 0, 0);
        acc = __builtin_amdgcn_mfma_f32_32x32x2f32(xa[3], b3, acc, 0, 0, 0);
    }
#pragma unroll
    for (int r = 0; r < 16; ++r) red[wave * 1024 + crow(r, kh) * 32 + i] = acc[r];
    __syncthreads();
#pragma unroll
    for (int x = 0; x < 2; ++x) { const int e = tid + 512 * x; float s = 0.f;
#pragma unroll
        for (int w = 0; w < 8; ++w) s += red[w * 1024 + e];
        red[8 * 1024 + e] = s; }
    __syncthreads();
}
__device__ __forceinline__ float sk_get(LAS float* red, int e) { return red[8 * 1024 + e]; }
template <int K>
__device__ __forceinline__ void rows_rstd32(const float* A, LAS float* rs, int lane, int wave) {
#pragma unroll
    for (int j = 0; j < 4; ++j) { const int r = wave * 4 + j; float s = 0.f;
        for (int k = lane * 4; k < K; k += 256) { const f32x4 v = *(const f32x4*)(A + (size_t)r * K + k); s += (v[0] * v[0] + v[1] * v[1]) + (v[2] * v[2] + v[3] * v[3]); }
        s = wave_sum(s); if (lane == 0) rs[r] = rsqrtf(s * (1.0f / K) + EPS); }
}

__device__ __forceinline__ void p0_prologue(Ctx& C) {
    LAS float* scr = (LAS float*)(C.lds + C.wave * 16384);
    float* samp = (float*)(C.ws + WS_SAMP);
    if (C.vcu < 107) {
        LAS float* red = (LAS float*)C.lds; LAS float* rs = red + 9 * 1024 + 64;
        rows_rstd32<DM>(C.in[I_XS], rs, C.lane, C.wave);
        skinny32<DM, true>(C.in[I_XS], C.in[I_N1G], C.in[I_WIN], INW, INW, 32 * C.vcu, red, C.tid, C.lane, C.wave);
#pragma unroll
        for (int x = 0; x < 2; ++x) { const int e = C.tid + 512 * x, i = e >> 5, n = 32 * C.vcu + (e & 31); if (n < INW) samp[S_RAW + i * INW + n] = sk_get(red, e) * rs[i]; }
        __syncthreads();
    }
    if (C.vcu == 200 && C.tid < 192) ((float*)(C.ws + WS_GAINS))[C.tid] = C.tid < 64 ? C.in[I_QG][C.tid] : (C.tid < 128 ? C.in[I_KG][C.tid - 64] : C.in[I_IKG][C.tid - 128]);
    const int gw = C.vcu * 8 + C.wave, NGW = C.G * 8;
    constexpr int I_1 = (DM / 64) * (INP / 32), I_O = (DM / 64) * (DM / 32), I_U = (DM / 64) * (FF / 32), I_D = (FF / 64) * (DM / 32);
    for (int it = gw; it < I_1 + I_O + I_U + I_D; it += NGW) {
        int r = it;
        if (r < I_1) { p0_transpose_item<true>(C.in[I_WIN], DM, INW, INP, C.in[I_N1G], (bf16*)(C.ws + WS_W1T), scr, r, C.lane); continue; } r -= I_1;
        if (r < I_O) { p0_transpose_item<false>(C.in[I_WOUT], DM, DM, DM, nullptr, (bf16*)(C.ws + WS_WOT), scr, r, C.lane); continue; } r -= I_O;
        if (r < I_U) { p0_transpose_item<false>(C.in[I_WUP], DM, FF, FF, C.in[I_N2G], (bf16*)(C.ws + WS_WUT), scr, r, C.lane); continue; } r -= I_U;
        p0_transpose_item<false>(C.in[I_WDN], FF, DM, DM, nullptr, (bf16*)(C.ws + WS_WDT), scr, r, C.lane);
    }
    bf16* XB = (bf16*)(C.ws + WS_XB); float* RSTD1 = (float*)(C.ws + WS_RSTD1);
    for (int m = gw; m < NTOK; m += NGW) x_row_to_bf16(C.in[I_XP] + (size_t)m * DM, XB + (size_t)m * DM, RSTD1 + m, C.lane);
}

__device__ __forceinline__ void sample_postproj(Ctx& C, int b) {
    const float* raw = (const float*)(C.ws + WS_SAMP) + S_RAW + (size_t)b * INW; float* sp = (float*)(C.ws + WS_SAMP) + S_SP + (size_t)b * 4096;
    const int l = C.lane;
    for (int h = 0; h < 8; ++h) { const float v = raw[h * 64 + l]; const float ss = wave_sum(v * v); sp[h * 64 + l] = v * rsqrtf(ss * (1.f / 64.f) + EPS) * C.in[I_QG][l]; }
    for (int h = 0; h < 2; ++h) { const float v = raw[512 + h * 64 + l]; const float ss = wave_sum(v * v); const float kn = v * rsqrtf(ss * (1.f / 64.f) + EPS) * C.in[I_KG][l];
        sp[512 + h * 64 + l] = kn; C.out[O_NKS + (size_t)b * 128 + h * 64 + l] = kn; }
    for (int h = 0; h < 2; ++h) { const float v = raw[640 + h * 64 + l]; sp[640 + h * 64 + l] = v; C.out[O_NVS + (size_t)b * 128 + h * 64 + l] = v; }
    for (int j = 0; j < 8; ++j) sp[768 + j * 64 + l] = raw[768 + j * 64 + l];
    { const float v = raw[1280 + l]; const float ss = wave_sum(v * v); const float kn = v * rsqrtf(ss * (1.f / 64.f) + EPS) * C.in[I_IKG][l]; sp[1280 + l] = kn; C.out[O_NKIS + (size_t)b * 64 + l] = kn; }
    if (l < 8) sp[1344 + l] = raw[1344 + l] * IDX_W_SCALE;
    for (int j = 0; j < 8; ++j) { sp[1352 + j * 64 + l] = silu_f(raw[1352 + j * 64 + l]) * REC_QSCALE; sp[1864 + j * 64 + l] = raw[1864 + j * 64 + l]; sp[2376 + j * 64 + l] = raw[2376 + j * 64 + l]; sp[2888 + j * 64 + l] = silu_f(raw[2888 + j * 64 + l]); }
}
constexpr int SROW = 2052;
__device__ __forceinline__ void dsa_select_unit(Ctx& C, int b, int qb) {
    const bf16* IQb = (const bf16*)(C.ws + WS_IQB); const bf16* IKb = (const bf16*)(C.ws + WS_IKB); const float* IWf = (const float*)(C.ws + WS_IWF);
    u64* MASK = (u64*)(C.ws + WS_MASK);
    LAS float* sc = (LAS float*)C.lds;
    int lane = C.lane, wave = C.wave; asm volatile("" : "+v"(lane), "+s"(wave));
    const int t0 = qb * 16, ntile = qb + 1, ql = lane & 15, g = lane >> 4;
    const size_t rowq = (size_t)b * SEQ + t0 + ql;
    bf16x8 bq[8][2];
#pragma unroll
    for (int h = 0; h < 8; ++h)
#pragma unroll
        for (int ks = 0; ks < 2; ++ks) bq[h][ks] = *(const bf16x8*)(IQb + rowq * 512 + h * 64 + ks * 32 + g * 8);
    float w[8];
    { const f32x4 w0 = *(const f32x4*)(IWf + rowq * 8), w1 = *(const f32x4*)(IWf + rowq * 8 + 4); w[0] = w0[0]; w[1] = w0[1]; w[2] = w0[2]; w[3] = w0[3]; w[4] = w1[0]; w[5] = w1[1]; w[6] = w1[2]; w[7] = w1[3]; }
    {
        int i = wave;
        bf16x8 a0 = {}, a1 = {};
        if (i < ntile) { const bf16* kp = IKb + ((size_t)b * SEQ + i * 16 + ql) * 64 + g * 8; a0 = *(const bf16x8*)kp; a1 = *(const bf16x8*)(kp + 32); }
        for (; i < ntile; i += 8) {
            bf16x8 n0 = {}, n1 = {};
            if (i + 8 < ntile) { const bf16* kp = IKb + ((size_t)b * SEQ + (i + 8) * 16 + ql) * 64 + g * 8; n0 = *(const bf16x8*)kp; n1 = *(const bf16x8*)(kp + 32); }
            f32x4 I = {0.f, 0.f, 0.f, 0.f};
#pragma unroll
            for (int h = 0; h < 8; ++h) {
                f32x4 d = __builtin_amdgcn_mfma_f32_16x16x32_bf16(a0, bq[h][0], (f32x4){0.f, 0.f, 0.f, 0.f}, 0, 0, 0);
                d = __builtin_amdgcn_mfma_f32_16x16x32_bf16(a1, bq[h][1], d, 0, 0, 0);
#pragma unroll
                for (int r = 0; r < 4; ++r) I[r] = fmaf(w[h], fmaxf(d[r], 0.f), I[r]);
            }
            *(LAS f32x4*)(sc + ql * SROW + i * 16 + 4 * g) = I;
            a0 = n0; a1 = n1;
        }
    }
    __syncthreads();
#pragma unroll 1
    for (int qq = 0; qq < 2; ++qq) {
        const int qi = wave * 2 + qq, t = t0 + qi;
        u64 myword = 0; unsigned mylo = 0, myhi = 0;
        if (t < 256) {
            const int lo = 64 * lane;
            myword = (lo > t) ? 0ull : ((lo + 63 <= t) ? ~0ull : ((2ull << (t - lo)) - 1ull));
        } else {
            unsigned u[32];
#pragma unroll
            for (int j = 0; j < 32; ++j) { const int key = 64 * j + lane; const float v = sc[qi * SROW + key]; const unsigned bits = __builtin_bit_cast(unsigned, v);
                unsigned m = (bits & 0x80000000u) ? ~bits : (bits | 0x80000000u); if (v == 0.f) m = 0x80000000u; u[j] = (key <= t) ? m : 0u; }
            unsigned prefix = 0;
#pragma unroll 1
            for (int bit = 31; bit >= 0; --bit) { const unsigned cand = prefix | (1u << bit); int cnt = 0;
#pragma unroll
                for (int j = 0; j < 32; ++j) { cnt += __popcll(__ballot(u[j] >= cand)); asm volatile("" : "+s"(cnt)); }
                if (cnt >= 256) prefix = cand; }
            const unsigned theta = prefix; int cgt = 0, ceq = 0;
#pragma unroll
            for (int j = 0; j < 32; ++j) { cgt += __popcll(__ballot(u[j] > theta)); ceq += __popcll(__ballot(u[j] == theta)); asm volatile("" : "+s"(cgt), "+s"(ceq)); }
            const int r = 256 - cgt; int icut = 2047;
            if (ceq != r) { int lo = 0;
#pragma unroll 1
                for (int bit = 10; bit >= 0; --bit) { const int c = lo | (1 << bit); int cnt = 0;
#pragma unroll
                    for (int j = 0; j < 32; ++j) { cnt += __popcll(__ballot(u[j] == theta && (64 * j + lane) < c)); asm volatile("" : "+s"(cnt)); }
                    if (cnt < r) lo = c; }
                icut = lo; }
#pragma unroll
            for (int j = 0; j < 32; ++j) { const bool sel = (u[j] > theta) || (u[j] == theta && (64 * j + lane) <= icut); const u64 word = __ballot(sel); mylo = (lane == j) ? (unsigned)word : mylo; myhi = (lane == j) ? (unsigned)(word >> 32) : myhi; asm volatile("" : "+v"(mylo), "+v"(myhi)); }
            myword = ((u64)myhi << 32) | mylo;
        }
        if (lane < 32) MASK[((size_t)b * SEQ + t) * 32 + lane] = myword;
    }
}

constexpr int A_KROW = 72, A_VROW = 68, A_KT_BYTES = 2 * 64 * A_KROW * 2, A_VT_BYTES = 128 * A_VROW * 2, A_BUF = A_KT_BYTES + A_VT_BYTES, A_OST = 2 * A_BUF, A_OROW = 72;
__device__ __forceinline__ void attn_unit(Ctx& C, int b, int qb) {
    const bf16* Qb = (const bf16*)(C.ws + WS_QB); const bf16* Kb = (const bf16*)(C.ws + WS_KB); const bf16* Vt = (const bf16*)(C.ws + WS_VT);
    const u64* MASK = (const u64*)(C.ws + WS_MASK); bf16* MIX = (bf16*)(C.ws + WS_MIX);
    int tid = C.tid, wave = C.wave; asm volatile("" : "+v"(tid), "+s"(wave));
    const int lane = tid & 63, t0 = qb * 32, nt = qb / 2 + 1, ql = lane & 31, hi = lane >> 5, kvh = wave >> 2;
    const size_t qrow = (size_t)b * SEQ + t0 + ql;
    bf16x8 qf[4];
#pragma unroll
    for (int ks = 0; ks < 4; ++ks) qf[ks] = *(const bf16x8*)(Qb + qrow * 512 + wave * 64 + ks * 16 + hi * 8);
    const u64* mrow = MASK + qrow * 32;
    v4u kr[2], vr[2];
    const bf16* kg_[2]; const bf16* vg_[2]; int kl_[2], vl_[2];
#pragma unroll
    for (int x = 0; x < 2; ++x) { const int pid = tid + 512 * x;
        { const int i = pid >> 4, c16 = pid & 15, kv = c16 >> 3, cc = c16 & 7; kg_[x] = Kb + ((size_t)b * SEQ + i) * 128 + c16 * 8; kl_[x] = ((kv * 64 + i) * A_KROW + cc * 8) * 2; }
        { const int row = pid >> 3, pc = pid & 7; vg_[x] = Vt + ((size_t)b * 128 + row) * SEQ + pc * 8; vl_[x] = A_KT_BYTES + (row * A_VROW + pc * 8) * 2; } }
#define ATT_GLOAD(kt) do { _Pragma("unroll") for (int x = 0; x < 2; ++x) { kr[x] = *(const v4u*)(kg_[x] + (size_t)(kt) * 64 * 128); vr[x] = *(const v4u*)(vg_[x] + (kt) * 64); } } while (0)
#define ATT_LWRITE(buf) do { _Pragma("unroll") for (int x = 0; x < 2; ++x) { *(LAS v4u*)(C.lds + (buf) * A_BUF + kl_[x]) = kr[x]; \
        *(LAS u32x2*)(C.lds + (buf) * A_BUF + vl_[x]) = (u32x2){vr[x].x, vr[x].y}; *(LAS u32x2*)(C.lds + (buf) * A_BUF + vl_[x] + 8) = (u32x2){vr[x].z, vr[x].w}; } } while (0)
    ATT_GLOAD(0); ATT_LWRITE(0);
    u64 mw = mrow[0];
    __syncthreads();
    float m_run = -1e30f, l_run = 0.f; f32x16 o0 = {}, o1 = {};
#pragma unroll 1
    for (int kt = 0; kt < nt; ++kt) {
        const int cur = kt & 1; const bool more = kt + 1 < nt;
        u64 mw_next = 0;
        if (more) { ATT_GLOAD(kt + 1); mw_next = mrow[kt + 1]; }
        const LAS unsigned char* kb_ = C.lds + cur * A_BUF; const LAS unsigned char* vb_ = kb_ + A_KT_BYTES;
        f32x16 p0 = {}, p1 = {};
#pragma unroll
        for (int ks = 0; ks < 4; ++ks) {
            const bf16x8 a0 = *(const LAS bf16x8*)(kb_ + ((kvh * 64 + ql) * A_KROW + ks * 16 + hi * 8) * 2);
            const bf16x8 a1 = *(const LAS bf16x8*)(kb_ + ((kvh * 64 + 32 + ql) * A_KROW + ks * 16 + hi * 8) * 2);
            p0 = __builtin_amdgcn_mfma_f32_32x32x16_bf16(a0, qf[ks], p0, 0, 0, 0);
            p1 = __builtin_amdgcn_mfma_f32_32x32x16_bf16(a1, qf[ks], p1, 0, 0, 0);
        }
        const unsigned mlo = (unsigned)mw, mhi = (unsigned)(mw >> 32);
        float mx = -1e30f;
#pragma unroll
        for (int r = 0; r < 16; ++r) { const int kk = crow(r, 0) + 4 * hi; const bool s0 = (mlo >> kk) & 1u, s1 = (mhi >> kk) & 1u;
            p0[r] = s0 ? p0[r] : -1e30f; p1[r] = s1 ? p1[r] : -1e30f; mx = fmaxf(mx, fmaxf(p0[r], p1[r])); }
        mx = fmaxf(mx, __shfl_xor(mx, 32));
        const float m_new = fmaxf(m_run, mx), alpha = exp2f(m_run - m_new); m_run = m_new;
        float ls = 0.f;
#pragma unroll
        for (int r = 0; r < 16; ++r) { const float e0 = (p0[r] > -1e29f) ? exp2f(p0[r] - m_new) : 0.f, e1 = (p1[r] > -1e29f) ? exp2f(p1[r] - m_new) : 0.f; p0[r] = e0; p1[r] = e1; ls += e0 + e1; }
        l_run = l_run * alpha + ls;
#pragma unroll
        for (int r = 0; r < 16; ++r) { o0[r] *= alpha; o1[r] *= alpha; }
        bf16x8 pb[2][2];
#pragma unroll
        for (int s = 0; s < 2; ++s) {
            v4u w0, w1;
            w0.x = pk2(p0[8 * s + 0], p0[8 * s + 1]); w0.y = pk2(p0[8 * s + 2], p0[8 * s + 3]); w0.z = pk2(p0[8 * s + 4], p0[8 * s + 5]); w0.w = pk2(p0[8 * s + 6], p0[8 * s + 7]);
            w1.x = pk2(p1[8 * s + 0], p1[8 * s + 1]); w1.y = pk2(p1[8 * s + 2], p1[8 * s + 3]); w1.z = pk2(p1[8 * s + 4], p1[8 * s + 5]); w1.w = pk2(p1[8 * s + 6], p1[8 * s + 7]);
            pb[0][s] = __builtin_bit_cast(bf16x8, w0); pb[1][s] = __builtin_bit_cast(bf16x8, w1);
        }
#pragma unroll
        for (int mt = 0; mt < 2; ++mt)
#pragma unroll
            for (int s = 0; s < 2; ++s) {
                const int kof = mt * 32 + s * 16 + hi * 4;
                { const LAS unsigned char* vp = vb_ + ((kvh * 64 + ql) * A_VROW + kof) * 2; const u32x2 lo = *(const LAS u32x2*)vp, hi2 = *(const LAS u32x2*)(vp + 16);
                  const v4u vv = {lo.x, lo.y, hi2.x, hi2.y}; o0 = __builtin_amdgcn_mfma_f32_32x32x16_bf16(__builtin_bit_cast(bf16x8, vv), pb[mt][s], o0, 0, 0, 0); }
                { const LAS unsigned char* vp = vb_ + ((kvh * 64 + 32 + ql) * A_VROW + kof) * 2; const u32x2 lo = *(const LAS u32x2*)vp, hi2 = *(const LAS u32x2*)(vp + 16);
                  const v4u vv = {lo.x, lo.y, hi2.x, hi2.y}; o1 = __builtin_amdgcn_mfma_f32_32x32x16_bf16(__builtin_bit_cast(bf16x8, vv), pb[mt][s], o1, 0, 0, 0); }
            }
        if (more) ATT_LWRITE(cur ^ 1);
        mw = mw_next;
        __syncthreads();
    }
#undef ATT_GLOAD
#undef ATT_LWRITE
    const float l_tot = l_run + __shfl_xor(l_run, 32), inv = 1.0f / l_tot;
    LAS unsigned char* ost = C.lds + A_OST + wave * (32 * A_OROW * 2);
#pragma unroll
    for (int r = 0; r < 16; r += 2) { const int d = crow(r, hi);
        *(LAS unsigned*)(ost + (ql * A_OROW + d) * 2) = pk2(o0[r] * inv, o0[r + 1] * inv);
        *(LAS unsigned*)(ost + (ql * A_OROW + 32 + d) * 2) = pk2(o1[r] * inv, o1[r + 1] * inv); }
    LDS_WAIT(); asm volatile("" ::: "memory");
#pragma unroll
    for (int x = 0; x < 4; ++x) { const int pid = lane + 64 * x, q = pid >> 3, c = pid & 7; const v4u v = *(const LAS v4u*)(ost + (q * A_OROW + c * 8) * 2);
        *(v4u*)(MIX + ((size_t)b * SEQ + t0 + q) * DM + wave * 64 + c * 8) = v; }
    LDS_WAIT(); asm volatile("" ::: "memory");
}
constexpr int H_QROW = 136, H_TROW = 72, H_OROW = 132;
constexpr int H_QD = 0, H_KD = H_QD + 64 * H_QROW * 2, H_KLT = H_KD + 64 * H_QROW * 2, H_VTL = H_KLT + 128 * H_TROW * 2, H_AT = H_VTL + 128 * H_TROW * 2,
              H_OT = H_AT + 64 * H_TROW * 2, H_PART = H_OT + 64 * H_OROW * 4, H_DK = H_PART + 4 * 128 * 4, H_END = H_DK + 512;
static_assert(H_END <= LDSCTL_OFF, "hgrn lds");
__device__ __forceinline__ bf16x8 pack8(const f32x4& a, const f32x4& b) { v4u w; w.x = pk2(a[0], a[1]); w.y = pk2(a[2], a[3]); w.z = pk2(b[0], b[1]); w.w = pk2(b[2], b[3]); return __builtin_bit_cast(bf16x8, w); }
__device__ __forceinline__ void hgrn_unit(Ctx& C, int b, int h) {
    const bf16* Rq = (const bf16*)(C.ws + WS_RQ); const bf16* Rf = (const bf16*)(C.ws + WS_RF); const bf16* Ri = (const bf16*)(C.ws + WS_RI); const bf16* Rg = (const bf16*)(C.ws + WS_RGT);
    bf16* MIX = (bf16*)(C.ws + WS_MIX);
    int tid = C.tid, wave = C.wave; asm volatile("" : "+v"(tid), "+s"(wave));
    const int lane = tid & 63, l15 = lane & 15, g = lane >> 4;
    LAS unsigned char* L = C.lds;
    LAS bf16* QD = (LAS bf16*)(L + H_QD); LAS bf16* KD = (LAS bf16*)(L + H_KD); LAS bf16* KLT = (LAS bf16*)(L + H_KLT); LAS bf16* VTL = (LAS bf16*)(L + H_VTL);
    LAS bf16* AT = (LAS bf16*)(L + H_AT); LAS float* OT = (LAS float*)(L + H_OT); LAS float* PART = (LAS float*)(L + H_PART); LAS float* DK = (LAS float*)(L + H_DK);
    for (int i = tid; i < 64 * H_TROW / 2; i += 512) ((LAS unsigned*)AT)[i] = 0u;
    const int k1 = tid & 127, tq = tid >> 7, s2 = tid >> 3, vg = tid & 7;
    const float l0 = C.in[I_LB][128 * h + k1], l1 = C.in[I_LB][512 + 128 * h + k1];
    const float lb = 1.0f / (1.0f + __expf(l1 - l0)), omlb = 1.0f - lb;
    float gn[16];
#pragma unroll
    for (int i = 0; i < 4; ++i) { const f32x4 v = *(const f32x4*)(C.in[I_RG] + 16 * vg + 4 * i); gn[4 * i] = v[0]; gn[4 * i + 1] = v[1]; gn[4 * i + 2] = v[2]; gn[4 * i + 3] = v[3]; }
    f32x4 S[8];
#pragma unroll
    for (int i = 0; i < 8; ++i) S[i] = (f32x4){0.f, 0.f, 0.f, 0.f};
    const size_t rbase = (size_t)b * SEQ;
    unsigned short nrf[16], nq[16]; v4u nv0, nv1;
#define H_LOAD(c) do { const size_t r0_ = rbase + (size_t)(c) * 64; \
        _Pragma("unroll") for (int i = 0; i < 16; ++i) { const size_t o_ = (r0_ + 16 * tq + i) * 512 + 128 * h + k1; nrf[i] = Rf[o_]; nq[i] = Rq[o_]; } \
        const bf16* vp_ = Ri + (r0_ + s2) * 512 + 128 * h + 16 * vg; nv0 = *(const v4u*)vp_; nv1 = *(const v4u*)(vp_ + 8); } while (0)
    H_LOAD(0);
#pragma unroll 1
    for (int c = 0; c < 32; ++c) {
        float cs[16], kk[16], qv[16]; float run = 0.f;
#pragma unroll
        for (int i = 0; i < 16; ++i) { const float x = bf2f(nrf[i]); const float sg = 1.0f / (1.0f + __expf(-x)); const float f = lb + omlb * sg;
            run += __logf(f); cs[i] = run; kk[i] = omlb * (1.0f - sg); qv[i] = bf2f(nq[i]); }
        const v4u cv0 = nv0, cv1 = nv1;
        PART[tq * 128 + k1] = run;
        __syncthreads();
        if (c + 1 < 32) H_LOAD(c + 1);
        float off = 0.f, blast = 0.f;
#pragma unroll
        for (int j = 0; j < 4; ++j) { const float pj = PART[j * 128 + k1]; blast += pj; off += (j < tq) ? pj : 0.f; }
        {
            float kl[16];
#pragma unroll
            for (int i = 0; i < 16; ++i) { const float bt = off + cs[i]; const int t = 16 * tq + i;
                QD[t * H_QROW + k1] = (bf16)f2bf(qv[i] * __expf(bt)); KD[t * H_QROW + k1] = (bf16)f2bf(kk[i] * __expf(-bt)); kl[i] = kk[i] * __expf(blast - bt); }
            v4u w0, w1; w0.x = pk2(kl[0], kl[1]); w0.y = pk2(kl[2], kl[3]); w0.z = pk2(kl[4], kl[5]); w0.w = pk2(kl[6], kl[7]);
            w1.x = pk2(kl[8], kl[9]); w1.y = pk2(kl[10], kl[11]); w1.z = pk2(kl[12], kl[13]); w1.w = pk2(kl[14], kl[15]);
            *(LAS v4u*)(KLT + k1 * H_TROW + 16 * tq) = w0; *(LAS v4u*)(KLT + k1 * H_TROW + 16 * tq + 8) = w1;
            if (tq == 0) DK[k1] = __expf(blast);
        }
        {
            const unsigned vw[8] = {cv0.x, cv0.y, cv0.z, cv0.w, cv1.x, cv1.y, cv1.z, cv1.w};
#pragma unroll
            for (int i = 0; i < 8; ++i) { VTL[(16 * vg + 2 * i) * H_TROW + s2] = (bf16)(vw[i] & 0xffffu); VTL[(16 * vg + 2 * i + 1) * H_TROW + s2] = (bf16)(vw[i] >> 16); }
        }
        __syncthreads();
        f32x4 ao[4];
#pragma unroll
        for (int m = 0; m < 4; ++m) ao[m] = (f32x4){0.f, 0.f, 0.f, 0.f};
#pragma unroll 1
        for (int ti = wave; ti < 10; ti += 8) {
            const int m = (ti >= 6) ? 3 : (ti >= 3) ? 2 : (ti >= 1) ? 1 : 0, n = ti - m * (m + 1) / 2;
            f32x4 d = {0.f, 0.f, 0.f, 0.f};
#pragma unroll
            for (int ks = 0; ks < 4; ++ks) {
                const bf16x8 a = *(const LAS bf16x8*)(QD + (16 * m + l15) * H_QROW + 32 * ks + 8 * g);
                const bf16x8 bb = *(const LAS bf16x8*)(KD + (16 * n + l15) * H_QROW + 32 * ks + 8 * g);
                d = __builtin_amdgcn_mfma_f32_16x16x32_bf16(a, bb, d, 0, 0, 0);
            }
#pragma unroll
            for (int r = 0; r < 4; ++r) { float v = d[r]; if (m == n && (4 * g + r) < l15) v = 0.f; AT[(16 * m + 4 * g + r) * H_TROW + 16 * n + l15] = (bf16)f2bf(v); }
        }
#pragma unroll
        for (int ks = 0; ks < 4; ++ks) {
            const bf16x8 bfr = pack8(S[2 * ks], S[2 * ks + 1]);
#pragma unroll
            for (int m = 0; m < 4; ++m) {
                const LAS bf16* qp = QD + (16 * m + l15) * H_QROW + 32 * ks + 4 * g;
                const u32x2 lo = *(const LAS u32x2*)qp, hi2 = *(const LAS u32x2*)(qp + 16);
                const v4u av = {lo.x, lo.y, hi2.x, hi2.y};
                ao[m] = __builtin_amdgcn_mfma_f32_16x16x32_bf16(__builtin_bit_cast(bf16x8, av), bfr, ao[m], 0, 0, 0);
            }
        }
        __syncthreads();
        bf16x8 vf[2];
#pragma unroll
        for (int ks = 0; ks < 2; ++ks) vf[ks] = *(const LAS bf16x8*)(VTL + (16 * wave + l15) * H_TROW + 32 * ks + 8 * g);
#pragma unroll
        for (int m = 0; m < 4; ++m)
#pragma unroll
            for (int ks = 0; ks < 2; ++ks) { const bf16x8 a = *(const LAS bf16x8*)(AT + (16 * m + l15) * H_TROW + 32 * ks + 8 * g); ao[m] = __builtin_amdgcn_mfma_f32_16x16x32_bf16(a, vf[ks], ao[m], 0, 0, 0); }
#pragma unroll
        for (int mk = 0; mk < 8; ++mk) {
            const f32x4 dk4 = *(const LAS f32x4*)(DK + 16 * mk + 4 * g); S[mk] = S[mk] * dk4;
#pragma unroll
            for (int ks = 0; ks < 2; ++ks) { const bf16x8 a = *(const LAS bf16x8*)(KLT + (16 * mk + l15) * H_TROW + 32 * ks + 8 * g); S[mk] = __builtin_amdgcn_mfma_f32_16x16x32_bf16(a, vf[ks], S[mk], 0, 0, 0); }
        }
#pragma unroll
        for (int m = 0; m < 4; ++m)
#pragma unroll
            for (int r = 0; r < 4; ++r) OT[(16 * m + 4 * g + r) * H_OROW + 16 * wave + l15] = ao[m][r];
        __syncthreads();
        {
            float o[16]; float ss = 0.f;
#pragma unroll
            for (int i = 0; i < 4; ++i) { const f32x4 v = *(const LAS f32x4*)(OT + s2 * H_OROW + 16 * vg + 4 * i); o[4 * i] = v[0]; o[4 * i + 1] = v[1]; o[4 * i + 2] = v[2]; o[4 * i + 3] = v[3]; ss += (v[0] * v[0] + v[1] * v[1]) + (v[2] * v[2] + v[3] * v[3]); }
            ss += __shfl_xor(ss, 1); ss += __shfl_xor(ss, 2); ss += __shfl_xor(ss, 4);
            const float rs = rsqrtf(ss * (1.0f / 128.0f) + EPS);
            const size_t row = rbase + (size_t)c * 64 + s2;
            const bf16* gp = Rg + row * 512 + 128 * h + 16 * vg; const v4u g0 = *(const v4u*)gp, g1 = *(const v4u*)(gp + 8);
            const unsigned gw[8] = {g0.x, g0.y, g0.z, g0.w, g1.x, g1.y, g1.z, g1.w};
            v4u w0, w1; unsigned ow[8];
#pragma unroll
            for (int i = 0; i < 8; ++i) ow[i] = pk2(o[2 * i] * rs * gn[2 * i] * bflo(gw[i]), o[2 * i + 1] * rs * gn[2 * i + 1] * bfhi(gw[i]));
            w0.x = ow[0]; w0.y = ow[1]; w0.z = ow[2]; w0.w = ow[3]; w1.x = ow[4]; w1.y = ow[5]; w1.z = ow[6]; w1.w = ow[7];
            bf16* op = MIX + row * DM + 512 + 128 * h + 16 * vg; *(v4u*)op = w0; *(v4u*)(op + 8) = w1;
        }
    }
#undef H_LOAD
    float* so = C.out + O_NSP + ((size_t)(b * 4 + h) * 128) * 128;
#pragma unroll
    for (int mk = 0; mk < 8; ++mk)
#pragma unroll
        for (int r = 0; r < 4; ++r) so[(size_t)(16 * mk + 4 * g + r) * 128 + 16 * wave + l15] = S[mk][r];
}

__device__ __forceinline__ void sample_hgrn_unit(Ctx& C, int b, int h) {
    const float* sp = (const float*)(C.ws + WS_SAMP) + S_SP + (size_t)b * 4096; float* mixs = (float*)(C.ws + WS_SAMP) + S_MIX + (size_t)b * 1024;
    const float* S0 = C.in[I_ST] + ((size_t)(b * 4 + h) * 128) * 128; float* S1 = C.out + O_NSS + ((size_t)(b * 4 + h) * 128) * 128;
    LAS float* red = (LAS float*)C.lds;
    int tid = C.tid; asm volatile("" : "+v"(tid));
    const int v4 = tid & 31, kr = tid >> 5;
    const f32x4 vv = *(const f32x4*)(sp + 2376 + 128 * h + 4 * v4);
    f32x4 oacc = {0.f, 0.f, 0.f, 0.f};
#pragma unroll
    for (int i = 0; i < 8; ++i) { const int k = kr + 16 * i; const int c = 128 * h + k;
        const float l0 = C.in[I_LB][c], l1 = C.in[I_LB][512 + c]; const float lb = 1.0f / (1.0f + __expf(l1 - l0));
        const float x = sp[1864 + c], sg = 1.0f / (1.0f + __expf(-x)), f = lb + (1.0f - lb) * sg, kk = (1.0f - lb) * (1.0f - sg), q = sp[1352 + c];
        const f32x4 s0 = *(const f32x4*)(S0 + (size_t)k * 128 + 4 * v4); const f32x4 sn = s0 * f + vv * kk;
        *(f32x4*)(S1 + (size_t)k * 128 + 4 * v4) = sn; oacc = oacc + sn * q; }
    *(LAS f32x4*)(red + kr * 128 + 4 * v4) = oacc;
    __syncthreads();
    if (tid < 128) { float o = 0.f;
#pragma unroll
        for (int j = 0; j < 16; ++j) o += red[j * 128 + tid];
        float ss = wave_sum(o * o); red[2048 + (tid >> 6)] = ss; red[2112 + tid] = o; }
    __syncthreads();
    if (tid < 128) { const float ss = red[2048] + red[2049]; const float o = red[2112 + tid];
        mixs[512 + 128 * h + tid] = o * rsqrtf(ss * (1.0f / 128.0f) + EPS) * C.in[I_RG][tid] * sp[2888 + 128 * h + tid]; }
}

__device__ __forceinline__ void sample_score_unit(Ctx& C, int b, int ch) {
    const float* sp = (const float*)(C.ws + WS_SAMP) + S_SP + (size_t)b * 4096; float* scs = (float*)(C.ws + WS_SAMP) + S_SC + (size_t)b * S_SCROW;
    const int* pt = (const int*)C.in[I_PT] + b * NPAGES;
    int lane = C.lane, wave = C.wave; asm volatile("" : "+v"(lane), "+s"(wave));
    const int dl = lane & 15, kq = lane >> 4;
    float iq[8][4], w[8];
#pragma unroll
    for (int h = 0; h < 8; ++h) { const f32x4 v = *(const f32x4*)(sp + 768 + h * 64 + 4 * dl); iq[h][0] = v[0]; iq[h][1] = v[1]; iq[h][2] = v[2]; iq[h][3] = v[3]; w[h] = sp[1344 + h]; }
#pragma unroll 1
    for (int pg = 0; pg < 8; ++pg) {
        const int lp = ch * 8 + pg; const float* kbase = C.in[I_CKI] + (size_t)pt[lp] * (PAGE * 64);
#pragma unroll 4
        for (int it = 0; it < 4; ++it) {
            const int key = wave * 16 + it * 4 + kq;
            const f32x4 kv = *(const f32x4*)(kbase + (size_t)key * 64 + 4 * dl);
            float sc = 0.f;
#pragma unroll
            for (int h = 0; h < 8; ++h) { float d = (iq[h][0] * kv[0] + iq[h][1] * kv[1]) + (iq[h][2] * kv[2] + iq[h][3] * kv[3]);
                d += __shfl_xor(d, 1); d += __shfl_xor(d, 2); d += __shfl_xor(d, 4); d += __shfl_xor(d, 8); sc = fmaf(w[h], fmaxf(d, 0.f), sc); }
            if (dl == 0) scs[lp * PAGE + key] = sc;
        }
    }
    if (ch == 0 && wave == 0) {
        const f32x4 kv = *(const f32x4*)(sp + 1280 + 4 * dl); float sc = 0.f;
#pragma unroll
        for (int h = 0; h < 8; ++h) { float d = (iq[h][0] * kv[0] + iq[h][1] * kv[1]) + (iq[h][2] * kv[2] + iq[h][3] * kv[3]);
            d += __shfl_xor(d, 1); d += __shfl_xor(d, 2); d += __shfl_xor(d, 4); d += __shfl_xor(d, 8); sc = fmaf(w[h], fmaxf(d, 0.f), sc); }
        if (lane == 0) scs[PAST] = sc;
    }
}
__device__ __forceinline__ unsigned mono_key(float v) { const unsigned bits = __builtin_bit_cast(unsigned, v); unsigned m = (bits & 0x80000000u) ? ~bits : (bits | 0x80000000u); if (v == 0.f) m = 0x80000000u; return m; }
__device__ __forceinline__ void sample_attend_unit(Ctx& C, int b) {
    const float* sp = (const float*)(C.ws + WS_SAMP) + S_SP + (size_t)b * 4096; const float* scs = (const float*)(C.ws + WS_SAMP) + S_SC + (size_t)b * S_SCROW;
    float* mixs = (float*)(C.ws + WS_SAMP) + S_MIX + (size_t)b * 1024; const int* pt = (const int*)C.in[I_PT] + b * NPAGES;
    int tid = C.tid, wave = C.wave; asm volatile("" : "+v"(tid), "+s"(wave));
    const int lane = tid & 63;
    LAS unsigned* cnt = (LAS unsigned*)C.lds;
    LAS unsigned* wcnt = cnt + 64;
    LAS int* sel = (LAS int*)(cnt + 128);
    LAS float* lg = (LAS float*)(cnt + 512);
    LAS float* qs = lg + 2048;
    if (tid < 64) cnt[tid] = 0u;
    qs[tid] = sp[tid] * (ATT_SCALE * LOG2E);
    unsigned u[32];
#pragma unroll
    for (int j = 0; j < 32; ++j) u[j] = mono_key(scs[j * 512 + tid]);
    const unsigned uself = mono_key(scs[PAST]);
    __syncthreads();
    unsigned prefix = 0;
#pragma unroll 1
    for (int bit = 31; bit >= 0; --bit) { const unsigned cand = prefix | (1u << bit); int c = 0;
#pragma unroll
        for (int j = 0; j < 32; ++j) { c += __popcll(__ballot(u[j] >= cand)); asm volatile("" : "+s"(c)); }
        if (lane == 0) __hip_atomic_fetch_add(&cnt[31 - bit], (unsigned)c, __ATOMIC_RELAXED, __HIP_MEMORY_SCOPE_WORKGROUP);
        __syncthreads();
        const int tot = (int)cnt[31 - bit] + (uself >= cand ? 1 : 0);
        if (tot >= 256) prefix = cand; }
    const unsigned theta = prefix;
    int cg = 0, ce = 0;
#pragma unroll
    for (int j = 0; j < 32; ++j) { cg += __popcll(__ballot(u[j] > theta)); ce += __popcll(__ballot(u[j] == theta)); asm volatile("" : "+s"(cg), "+s"(ce)); }
    if (lane == 0) { __hip_atomic_fetch_add(&cnt[32], (unsigned)cg, __ATOMIC_RELAXED, __HIP_MEMORY_SCOPE_WORKGROUP); __hip_atomic_fetch_add(&cnt[33], (unsigned)ce, __ATOMIC_RELAXED, __HIP_MEMORY_SCOPE_WORKGROUP); }
    __syncthreads();
    const int cgt = (int)cnt[32] + (uself > theta ? 1 : 0), ceq = (int)cnt[33] + (uself == theta ? 1 : 0), r = 256 - cgt;
    int icut = PAST;
    if (ceq != r) { int lo = 0;
#pragma unroll 1
        for (int bit = 14; bit >= 0; --bit) { const int cc = lo | (1 << bit); int c = 0;
#pragma unroll
            for (int j = 0; j < 32; ++j) { c += __popcll(__ballot(u[j] == theta && (j * 512 + tid) < cc)); asm volatile("" : "+s"(c)); }
            if (lane == 0) __hip_atomic_fetch_add(&cnt[34 + (14 - bit)], (unsigned)c, __ATOMIC_RELAXED, __HIP_MEMORY_SCOPE_WORKGROUP);
            __syncthreads();
            const int tot = (int)cnt[34 + (14 - bit)];
            const int tot2 = tot + ((uself == theta && PAST < cc) ? 1 : 0);
            if (tot2 < r) lo = cc; }
        icut = lo; }
    int mysel = 0;
#pragma unroll
    for (int j = 0; j < 32; ++j) mysel += ((u[j] > theta) || (u[j] == theta && (j * 512 + tid) <= icut)) ? 1 : 0;
    int incl = mysel;
#pragma unroll
    for (int o = 1; o < 64; o <<= 1) { const int v = __shfl_up(incl, o); if (lane >= o) incl += v; }
    if (lane == 63) wcnt[wave] = (unsigned)incl;
    __syncthreads();
    int base = incl - mysel;
    for (int w = 0; w < wave; ++w) base += (int)wcnt[w];
#pragma unroll
    for (int j = 0; j < 32; ++j) if ((u[j] > theta) || (u[j] == theta && (j * 512 + tid) <= icut)) { if (base < 256) sel[base] = j * 512 + tid; ++base; }
    if (tid == 511) { int tot = base; const bool ss = (uself > theta) || (uself == theta && PAST <= icut); if (ss && tot < 256) sel[tot] = PAST; }
    __syncthreads();
    {
        const int i = tid >> 1, kvh = tid & 1, idx = sel[i];
        const float* kp = (idx < PAST) ? C.in[I_CK] + ((size_t)pt[idx >> 7] * PAGE + (idx & 127)) * 128 + kvh * 64 : sp + 512 + kvh * 64;
        float d0 = 0.f, d1 = 0.f, d2 = 0.f, d3 = 0.f;
#pragma unroll
        for (int c = 0; c < 16; ++c) { const f32x4 kv = *(const f32x4*)(kp + 4 * c);
            const LAS float* q0 = qs + (kvh * 4) * 64 + 4 * c;
            d0 += (q0[0] * kv[0] + q0[1] * kv[1]) + (q0[2] * kv[2] + q0[3] * kv[3]);
            d1 += (q0[64] * kv[0] + q0[65] * kv[1]) + (q0[66] * kv[2] + q0[67] * kv[3]);
            d2 += (q0[128] * kv[0] + q0[129] * kv[1]) + (q0[130] * kv[2] + q0[131] * kv[3]);
            d3 += (q0[192] * kv[0] + q0[193] * kv[1]) + (q0[194] * kv[2] + q0[195] * kv[3]); }
        lg[(kvh * 4 + 0) * 256 + i] = d0; lg[(kvh * 4 + 1) * 256 + i] = d1; lg[(kvh * 4 + 2) * 256 + i] = d2; lg[(kvh * 4 + 3) * 256 + i] = d3;
    }
    __syncthreads();
    {
        float v[4]; float mx = -1e30f;
#pragma unroll
        for (int x = 0; x < 4; ++x) { v[x] = lg[wave * 256 + lane + 64 * x]; mx = fmaxf(mx, v[x]); }
#pragma unroll
        for (int o = 1; o < 64; o <<= 1) mx = fmaxf(mx, __shfl_xor(mx, o));
        float s = 0.f;
#pragma unroll
        for (int x = 0; x < 4; ++x) { v[x] = __builtin_amdgcn_exp2f(v[x] - mx); s += v[x]; }
        s = wave_sum(s); const float inv = 1.0f / s;
#pragma unroll
        for (int x = 0; x < 4; ++x) lg[wave * 256 + lane + 64 * x] = v[x] * inv;
    }
    __syncthreads();
    {
        const int kvh = wave >> 2; float o = 0.f;
#pragma unroll 8
        for (int i = 0; i < 256; ++i) { const int idx = sel[i];
            const float* vp = (idx < PAST) ? C.in[I_CV] + ((size_t)pt[idx >> 7] * PAGE + (idx & 127)) * 128 + kvh * 64 : sp + 640 + kvh * 64;
            o = fmaf(lg[wave * 256 + i], vp[lane], o); }
        mixs[wave * 64 + lane] = o;
    }
}

__device__ __forceinline__ void sample_outproj_task(Ctx& C, int tile) {
    float* samp = (float*)(C.ws + WS_SAMP); LAS float* red = (LAS float*)C.lds;
    skinny32<DM, false>(samp + S_MIX, nullptr, C.in[I_WOUT], DM, DM, 32 * tile, red, C.tid, C.lane, C.wave);
#pragma unroll
    for (int x = 0; x < 2; ++x) { const int e = C.tid + 512 * x, i = e >> 5, n = 32 * tile + (e & 31); samp[S_X1 + i * DM + n] = C.in[I_XS][i * DM + n] + sk_get(red, e); }
    __syncthreads();
}
__device__ __forceinline__ void sample_up_task(Ctx& C, int tile) {
    float* samp = (float*)(C.ws + WS_SAMP); LAS float* red = (LAS float*)C.lds; LAS float* rs = red + 9 * 1024 + 64;
    rows_rstd32<DM>(samp + S_X1, rs, C.lane, C.wave);
    skinny32<DM, true>(samp + S_X1, C.in[I_N2G], C.in[I_WUP], FF, FF, 32 * tile, red, C.tid, C.lane, C.wave);
#pragma unroll
    for (int x = 0; x < 2; ++x) { const int e = C.tid + 512 * x, i = e >> 5, n = 32 * tile + (e & 31); const float v = fmaxf(sk_get(red, e) * rs[i], 0.f); samp[S_H + i * FF + n] = v * v; }
    __syncthreads();
}
__device__ __forceinline__ void sample_down_task(Ctx& C, int tile) {
    float* samp = (float*)(C.ws + WS_SAMP); LAS float* red = (LAS float*)C.lds;
    skinny32<FF, false>(samp + S_H, nullptr, C.in[I_WDN], DM, DM, 32 * tile, red, C.tid, C.lane, C.wave);
#pragma unroll
    for (int x = 0; x < 2; ++x) { const int e = C.tid + 512 * x, i = e >> 5, n = 32 * tile + (e & 31); C.out[O_YS + i * DM + n] = samp[S_X1 + i * DM + n] + sk_get(red, e); }
    __syncthreads();
}
struct Args { const float* in[18]; float* out; unsigned char* ws; int ph_lo, ph_hi; };
constexpr int N_PHASES = 7;
#ifndef MK_SPLIT
#define MK_SPLIT 0
#endif
__global__ void __launch_bounds__(512, 2) hymba_fwd(Args args) {
    extern __shared__ __attribute__((aligned(16))) unsigned char lds_raw[];
    Ctx C;
    C.lds = (LAS unsigned char*)lds_raw; C.MISC = (volatile LAS unsigned*)(C.lds + MISC_OFF);
    C.tid = threadIdx.x; C.lane = C.tid & 63; C.wave = __builtin_amdgcn_readfirstlane(C.tid >> 6);
    C.G = gridDim.x; { const int bx = blockIdx.x; C.vcu = (C.G % 8 == 0) ? (bx % 8) * (C.G / 8) + bx / 8 : bx; }
    C.ws = args.ws; C.out = args.out; C.ctl = (gu32*)(args.ws + WS_CTL);
#pragma unroll
    for (int i = 0; i < 18; ++i) C.in[i] = args.in[i];
    for (int u = C.tid; u < (LDS_BYTES - LDSCTL_OFF) / 4; u += 512) ((LAS unsigned*)(C.lds + LDSCTL_OFF))[u] = 0u;
    __syncthreads();
    const int lo = args.ph_lo, hi = args.ph_hi;
    XcdBarrier bar; bar.bar = (unsigned*)(C.ctl + CW_BAR); bar.x = 0; bar.st = nullptr;
    if (hi - lo > 1) bar = xcd_barrier_post((unsigned*)(C.ctl + CW_BAR), C.MISC + 8);
#ifndef PH_MASK
#define PH_MASK 0x7f
#endif
#define IN(k) (((PH_MASK >> (k)) & 1) && lo <= (k) && (k) < hi)
#define SEAM(k) do { if (IN(k) && IN((k) + 1)) xcd_barrier(bar); } while (0)

    if (IN(0)) { p0_prologue(C); SEAM(0); }

    if (IN(1)) {
        if (C.vcu < 4) sample_postproj(C, C.vcu * 8 + C.wave);
        __syncthreads();
        pg8::Gemm g{(const pg8::bf16_t*)(C.ws + WS_XB), (const pg8::bf16_t*)(C.ws + WS_W1T), NTOK, INP, DM};
        pg8::StaticOrder S; S.init(NTOK, INP, C.G, (int)blockIdx.x);
        pg8::EpiInProj E{(const float*)(C.ws + WS_RSTD1), (const float*)(C.ws + WS_GAINS),
                         (pg8::bf16_t*)(C.ws + WS_QB), (pg8::bf16_t*)(C.ws + WS_KB), (pg8::bf16_t*)(C.ws + WS_VT), (pg8::bf16_t*)(C.ws + WS_IQB), (pg8::bf16_t*)(C.ws + WS_IKB),
                         (pg8::bf16_t*)(C.ws + WS_RQ), (pg8::bf16_t*)(C.ws + WS_RF), (pg8::bf16_t*)(C.ws + WS_RI), (pg8::bf16_t*)(C.ws + WS_RGT), (float*)(C.ws + WS_IWF),
                         C.out + O_NK, C.out + O_NV, C.out + O_NKI};
        pg8::gemm_phase<pg8::EpiInProj, pg8::StaticOrder, true, true>(C.lds, g, S, E);
        SEAM(1);
    }

    if (IN(2)) {
        constexpr int U_H = 64, U_SH = 128, U_SS = 512, U_SEL = 2048, U_TOT = U_H + U_SH + U_SS + U_SEL;
        for (;;) {
            int u = q_next(C, CW_Q2); if (u >= U_TOT) break;
            if (u < U_H) {
#ifndef NO_HGRN
 hgrn_unit(C, u >> 2, u & 3);
#endif
 continue; } u -= U_H;
            if (u < U_SH) {
#ifndef NO_SH
 sample_hgrn_unit(C, u >> 2, u & 3);
#endif
 continue; } u -= U_SH;
            if (u < U_SS) {
#ifndef NO_SS
 sample_score_unit(C, u >> 4, u & 15);
#endif
 continue; } u -= U_SS;
#ifndef NO_SEL
            dsa_select_unit(C, u & 15, 127 - (u >> 4));
#endif
        }
        SEAM(2);
    }

    if (IN(3)) {
        constexpr int U_SA = 32, U_AT = 1024, U_TOT = U_SA + U_AT;
        for (;;) {
            int u = q_next(C, CW_Q3); if (u >= U_TOT) break;
            if (u < U_SA) {
#ifndef NO_SA
 sample_attend_unit(C, u);
#endif
 continue; } u -= U_SA;
#ifndef NO_AT
            attn_unit(C, u & 15, 63 - (u >> 4));
#endif
        }
        SEAM(3);
    }

    if (IN(4)) {
        if (C.vcu < 32) sample_outproj_task(C, C.vcu);
        __syncthreads();
        pg8::Gemm g{(const pg8::bf16_t*)(C.ws + WS_MIX), (const pg8::bf16_t*)(C.ws + WS_WOT), NTOK, DM, DM};
        pg8::StaticOrder S; S.init(NTOK, DM, C.G, (int)blockIdx.x);
        pg8::EpiOutProj E{C.in[I_XP], C.out + O_Y, (pg8::bf16_t*)(C.ws + WS_X1B), (float*)(C.ws + WS_SSQ2)};
        pg8::gemm_phase<pg8::EpiOutProj, pg8::StaticOrder, true, true>(C.lds, g, S, E);
        SEAM(4);
    }

    if (IN(5)) {
        if (C.vcu < 128) sample_up_task(C, C.vcu);
        __syncthreads();
        pg8::Gemm g{(const pg8::bf16_t*)(C.ws + WS_X1B), (const pg8::bf16_t*)(C.ws + WS_WUT), NTOK, FF, DM};
        pg8::StaticOrder S; S.init(NTOK, FF, C.G, (int)blockIdx.x);
        pg8::EpiUp E{(const float*)(C.ws + WS_SSQ2), (pg8::bf16_t*)(C.ws + WS_H)};
        pg8::gemm_phase<pg8::EpiUp, pg8::StaticOrder, true, true>(C.lds, g, S, E);
        SEAM(5);
    }

    if (IN(6)) {
        if (C.vcu < 32) sample_down_task(C, C.vcu);
        __syncthreads();
        pg8::Gemm g{(const pg8::bf16_t*)(C.ws + WS_H), (const pg8::bf16_t*)(C.ws + WS_WDT), NTOK, DM, FF};
        pg8::StaticOrder S; S.init(NTOK, DM, C.G, (int)blockIdx.x);
        pg8::EpiDown E{C.out + O_Y};
        pg8::gemm_phase<pg8::EpiDown, pg8::StaticOrder, true, true>(C.lds, g, S, E);
    }
#undef IN
#undef SEAM
}

extern "C" void kernel_launch(void* const* d_in, const int* in_sizes, int n_in, void* d_out, int out_size, void* d_ws, size_t ws_size, hipStream_t stream) {
    static int grid = 0;
    if (grid == 0) {
        if (n_in != 18 || in_sizes[0] != NTOK * DM || (size_t)out_size != O_END || ws_size < WS_END) {
            fprintf(stderr, "kernel_launch: unexpected shapes: n_in %d in0 %d out %d ws %zu (need ws >= %zu); nothing launched\n", n_in, n_in > 0 ? in_sizes[0] : -1, out_size, ws_size, (size_t)WS_END); grid = -1; return; }
        int dev = 0, cus = 0;
        if (hipGetDevice(&dev) != hipSuccess || hipDeviceGetAttribute(&cus, hipDeviceAttributeMultiprocessorCount, dev) != hipSuccess) { grid = -1; return; }
        if (hipFuncSetAttribute((const void*)hymba_fwd, hipFuncAttributeMaxDynamicSharedMemorySize, LDS_BYTES) != hipSuccess) { fprintf(stderr, "kernel_launch: hipFuncSetAttribute failed\n"); grid = -1; return; }
        int per_cu = 0;
        if (hipOccupancyMaxActiveBlocksPerMultiprocessor(&per_cu, (const void*)hymba_fwd, 512, LDS_BYTES) != hipSuccess || per_cu < 1) fprintf(stderr, "kernel_launch: occupancy query says %d\n", per_cu);
        (void)hipGetLastError();
        grid = cus;
        if (grid != 256) fprintf(stderr, "kernel_launch: %d CUs (expected 256)\n", grid);
    }
    if (grid < 0) return;
    (void)hipMemsetAsync((char*)d_ws + WS_CTL, 0, CTL_ZERO_BYTES, stream);
    Args a{};
    for (int i = 0; i < 18; ++i) a.in[i] = (const float*)d_in[i];
    a.out = (float*)d_out; a.ws = (unsigned char*)d_ws;
#if MK_SPLIT
    for (int p = 0; p < N_PHASES; ++p) { a.ph_lo = p; a.ph_hi = p + 1; hipLaunchKernelGGL(hymba_fwd, dim3(grid), dim3(512), LDS_BYTES, stream, a); }
#else
    a.ph_lo = 0; a.ph_hi = N_PHASES; hipLaunchKernelGGL(hymba_fwd, dim3(grid), dim3(512), LDS_BYTES, stream, a);
#endif
}
```

```cpp
#include <hip/hip_runtime.h>
#include <cstdio>
#include <cstdint>

#define LAS __attribute__((address_space(3)))
#define GAS __attribute__((address_space(1)))
typedef float f32x16 __attribute__((ext_vector_type(16)));
typedef unsigned u32x2 __attribute__((ext_vector_type(2)));
typedef unsigned long long u64;

constexpr int NTOK = 32768, NB = 16, SEQ = 2048, DM = 1024, NS = 32, PAST = 16384, PAGE = 128, NPAGES = 128;
constexpr int INW = 3400, INP = 3584, FF = 4096;
constexpr float EPS = 1e-6f;
constexpr float ATT_SCALE = 0.125f, LOG2E = 1.4426950408889634f;
constexpr float IDX_W_SCALE = 0.04419417382415922f;
constexpr float REC_QSCALE = 0.08838834764831845f;
enum { I_XP = 0, I_XS, I_CK, I_CV, I_CKI, I_ST, I_PT, I_N1G, I_WIN, I_QG, I_KG, I_IKG, I_LB, I_RG, I_WOUT, I_N2G, I_WUP, I_WDN };
constexpr size_t O_Y = 0, O_YS = 33554432, O_NK = O_YS + 32768, O_NV = O_NK + 4194304, O_NKI = O_NV + 4194304, O_NSP = O_NKI + 2097152,
                 O_NKS = O_NSP + 1048576, O_NVS = O_NKS + 4096, O_NKIS = O_NVS + 4096, O_NSS = O_NKIS + 2048, O_END = O_NSS + 2097152;
constexpr size_t MiB = 1u << 20;
constexpr size_t WS_CTL = 0, CTL_ZERO_BYTES = 1 * MiB;
constexpr size_t WS_W1T = 2 * MiB, WS_WOT = 10 * MiB, WS_WUT = 12 * MiB, WS_WDT = 20 * MiB;
constexpr size_t WS_GAINS = 28 * MiB + 512 * 1024;
constexpr size_t WS_RSTD1 = 28 * MiB, WS_IWF = 29 * MiB, WS_SSQ2 = 30 * MiB, WS_SAMP = 32 * MiB;
constexpr size_t WS_XB = 40 * MiB, WS_QB = 104 * MiB, WS_KB = 136 * MiB, WS_VT = 144 * MiB, WS_IQB = 152 * MiB, WS_IKB = 184 * MiB;
constexpr size_t WS_RQ = 188 * MiB, WS_RF = 220 * MiB, WS_RI = 252 * MiB, WS_RGT = 284 * MiB, WS_MASK = 316 * MiB, WS_MIX = 324 * MiB;
constexpr size_t WS_X1B = 388 * MiB, WS_H = 452 * MiB, WS_END = 708 * MiB;
constexpr int S_RAW = 0, S_SP = 131072, S_SC = 262144, S_SCROW = 16400, S_MIX = S_SC + 32 * S_SCROW + 256, S_X1 = S_MIX + 32768, S_H = S_X1 + 32768, S_ENDF = S_H + 131072;
static_assert((size_t)S_ENDF * 4 <= 8 * MiB, "sample scratch");
constexpr int CW_BAR = 4096, CW_Q2 = 8192, CW_Q3 = 8256;
constexpr int LDS_BYTES = 163840, LDSCTL_OFF = LDS_BYTES - 1024, MISC_OFF = LDSCTL_OFF + 320;

#define NO_QPF 1
namespace pg8 {
#define PG8_LAS __attribute__((address_space(3)))
typedef unsigned short bf16_t;
typedef short bf16x8 __attribute__((ext_vector_type(8)));
typedef float f32x4 __attribute__((ext_vector_type(4)));
typedef unsigned u32x4 __attribute__((ext_vector_type(4)));
constexpr int BM = 256, BK = 64, HALF = 128, HTB = HALF * BK * 2  , STAGE_BYTES = 8 * HTB, NXCD = 8, WGM = 8;

__host__ __device__ __forceinline__ int lds_byte(int r, int c) { const int st = (r >> 4) * 2 + (c >> 5), rr = r & 15, cc = c & 31, ob = rr * 64 + cc * 2; return st * 1024 + (ob ^ (((ob >> 9) & 1) << 5)); }
__host__ __device__ __forceinline__ void stage_rc(int b, int& R, int& C) { const int st = b / 1024, sb = b % 1024, swz = sb ^ (((sb >> 9) & 1) << 5); R = (st >> 1) * 16 + swz / 64; C = (st & 1) * 32 + (swz % 64) / 2; }
__host__ __device__ __forceinline__ int perm32(int rho) { const int n = rho >> 4, i = rho & 15; return 8 * (i >> 2) + 4 * n + (i & 3); }

struct Unit { int pm, pn; };
struct Gemm { const bf16_t* A; const bf16_t* Bt; int M, N, K; };

struct StaticOrder {
    int nM, nN, nwg, G, c;
    __host__ __device__ void init(int M, int N, int G_, int c_) { nM = M / BM; nN = N / BM; nwg = nM * nN; G = G_; c = c_; }
    __host__ __device__ bool next(int i, Unit& u) const {
        const long L = (long)i * G + c; if (L >= nwg) return false;
        int wgid = (int)L; { const int q = nwg / NXCD, r = nwg % NXCD, xcd = wgid % NXCD, off = wgid / NXCD; wgid = (xcd < r ? xcd * (q + 1) : r * (q + 1) + (xcd - r) * q) + off; }
        const int nig = WGM * nN, gid = wgid / nig, fm = gid * WGM, gsz = (nM - fm) < WGM ? (nM - fm) : WGM;
        u.pm = fm + ((wgid % nig) % gsz); u.pn = (wgid % nig) / gsz; return true;
    }
    __device__ __forceinline__ void a_ready(const Unit&) const {}
    __device__ __forceinline__ void done(const Unit&) const {}
};

__device__ __forceinline__ unsigned cvt_pk_bf16(float lo, float hi) { unsigned r; asm volatile("v_cvt_pk_bf16_f32 %0, %1, %2" : "=v"(r) : "v"(lo), "v"(hi)); return r; }
typedef float f32x2 __attribute__((ext_vector_type(2)));
__device__ __forceinline__ float silu_f(float x) { return x / (1.f + __expf(-x)); }
__device__ __forceinline__ void st_bf16x16(bf16_t* p, const float (&t)[16]) {
    u32x4 a, b;
    a.x = cvt_pk_bf16(t[0], t[1]); a.y = cvt_pk_bf16(t[2], t[3]); a.z = cvt_pk_bf16(t[4], t[5]); a.w = cvt_pk_bf16(t[6], t[7]);
    b.x = cvt_pk_bf16(t[8], t[9]); b.y = cvt_pk_bf16(t[10], t[11]); b.z = cvt_pk_bf16(t[12], t[13]); b.w = cvt_pk_bf16(t[14], t[15]);
    *(u32x4*)p = a; *(u32x4*)(p + 8) = b;
}
__device__ __forceinline__ void st_f32x16(float* p, const float (&t)[16]) {
#pragma unroll
    for (int i = 0; i < 4; ++i) *(f32x4*)(p + 4 * i) = (f32x4){t[4 * i], t[4 * i + 1], t[4 * i + 2], t[4 * i + 3]};
}
__device__ __forceinline__ unsigned short f2bf_rne(float f) { unsigned u = __builtin_bit_cast(unsigned, f); return (unsigned short)((u + 0x7fffu + ((u >> 16) & 1u)) >> 16); }

struct EpiInProj {
    static constexpr bool PERM = false, AFTER_DRAIN = false;
    const float* rstd1; const float* gains;
    bf16_t *Qb, *Kb, *Vt, *IQb, *IKb, *Rq, *Rf, *Ri, *Rg; float* IWf; float *oK, *oV, *oKI;
    __device__ __forceinline__ void operator()(const f32x4 (&acc)[2][2][4][2], const Unit& u, int wr, int wc, int fr, int fq) const {
        const int pn = u.pn;
        const float* gsrc = gains + (pn < 2 ? 0 : (pn == 2 ? 64 : 128));
        float g[16];
#pragma unroll
        for (int i = 0; i < 4; ++i) { const f32x4 v = *(const f32x4*)(gsrc + 16 * fq + 4 * i); g[4 * i] = v[0]; g[4 * i + 1] = v[1]; g[4 * i + 2] = v[2]; g[4 * i + 3] = v[3]; }
#pragma unroll
        for (int ai = 0; ai < 2; ++ai)
#pragma unroll
            for (int m = 0; m < 4; ++m) {
                const int row = u.pm * BM + ai * HALF + wr * 64 + m * 16 + fr;
                const float rs = rstd1[row];
                float t[16];
#pragma unroll
                for (int bj = 0; bj < 2; ++bj)
#pragma unroll
                    for (int n = 0; n < 2; ++n)
#pragma unroll
                        for (int e = 0; e < 4; ++e) t[8 * bj + 4 * n + e] = acc[ai][bj][m][n][e] * rs;
                const bool normed = (pn < 2) || (pn == 2 && wc < 2) || (pn == 5 && wc == 0);
                if (normed) {
                    float ss = 0.f;
#pragma unroll
                    for (int j = 0; j < 16; ++j) ss += t[j] * t[j];
                    ss += __shfl_xor(ss, 16); ss += __shfl_xor(ss, 32);
                    float sc = rsqrtf(ss * (1.0f / 64.0f) + EPS);
                    if (pn < 2) sc *= ATT_SCALE * LOG2E;
#pragma unroll
                    for (int j = 0; j < 16; ++j) t[j] = t[j] * sc * g[j];
                }
                if (pn < 2) {
                    st_bf16x16(Qb + (size_t)row * 512 + (4 * pn + wc) * 64 + 16 * fq, t);
                } else if (pn == 2) {
                    if (wc < 2) { st_f32x16(oK + (size_t)row * 128 + wc * 64 + 16 * fq, t); st_bf16x16(Kb + (size_t)row * 128 + wc * 64 + 16 * fq, t); }
                    else {
                        st_f32x16(oV + (size_t)row * 128 + (wc - 2) * 64 + 16 * fq, t);
                        const int b = row >> 11, tt = row & 2047;
                        bf16_t* vp = Vt + ((size_t)(b * 2 + (wc - 2)) * 64 + 16 * fq) * 2048 + tt;
#pragma unroll
                        for (int j = 0; j < 16; ++j) vp[(size_t)j * 2048] = f2bf_rne(t[j]);
                    }
                } else if (pn < 5) {
                    st_bf16x16(IQb + (size_t)row * 512 + (4 * (pn - 3) + wc) * 64 + 16 * fq, t);
                } else if (pn == 5) {
                    if (wc == 0) { st_f32x16(oKI + (size_t)row * 64 + 16 * fq, t); st_bf16x16(IKb + (size_t)row * 64 + 16 * fq, t); }
                    else if (wc == 1 && fq == 0) {
                        *(f32x4*)(IWf + (size_t)row * 8) = (f32x4){t[0] * IDX_W_SCALE, t[1] * IDX_W_SCALE, t[2] * IDX_W_SCALE, t[3] * IDX_W_SCALE};
                        *(f32x4*)(IWf + (size_t)row * 8 + 4) = (f32x4){t[4] * IDX_W_SCALE, t[5] * IDX_W_SCALE, t[6] * IDX_W_SCALE, t[7] * IDX_W_SCALE};
                    }
                } else {
                    const int kind = (pn - 6) >> 1, col = 256 * ((pn - 6) & 1) + 64 * wc + 16 * fq;
                    if (kind == 0) {
#pragma unroll
                        for (int j = 0; j < 16; ++j) t[j] = silu_f(t[j]) * REC_QSCALE;
                        st_bf16x16(Rq + (size_t)row * 512 + col, t);
                    } else if (kind == 1) st_bf16x16(Rf + (size_t)row * 512 + col, t);
                    else if (kind == 2) st_bf16x16(Ri + (size_t)row * 512 + col, t);
                    else {
#pragma unroll
                        for (int j = 0; j < 16; ++j) t[j] = silu_f(t[j]);
                        st_bf16x16(Rg + (size_t)row * 512 + col, t);
                    }
                }
            }
    }
};
struct EpiOutProj {
    static constexpr bool PERM = false, AFTER_DRAIN = false;
    const float* X; float* Y; bf16_t* X1B; float* SSQ2;
    __device__ __forceinline__ void operator()(const f32x4 (&acc)[2][2][4][2], const Unit& u, int wr, int wc, int fr, int fq) const {
        const int col0 = u.pn * BM + wc * 32 + 4 * fq;
#pragma unroll
        for (int ai = 0; ai < 2; ++ai)
#pragma unroll
            for (int m = 0; m < 4; ++m) {
                const int row = u.pm * BM + ai * HALF + wr * 64 + m * 16 + fr; const size_t off = (size_t)row * DM + col0; float ss = 0.f;
#pragma unroll
                for (int bj = 0; bj < 2; ++bj)
#pragma unroll
                    for (int n = 0; n < 2; ++n) {
                        const f32x4 xv = *(const f32x4*)(X + off + bj * HALF + n * 16); const f32x4 o = xv + acc[ai][bj][m][n];
                        *(f32x4*)(Y + off + bj * HALF + n * 16) = o; ss += (o[0] * o[0] + o[1] * o[1]) + (o[2] * o[2] + o[3] * o[3]);
                        u32x2 w; w.x = cvt_pk_bf16(o[0], o[1]); w.y = cvt_pk_bf16(o[2], o[3]); *(u32x2*)(X1B + off + bj * HALF + n * 16) = w;
                    }
                ss += __shfl_xor(ss, 16); ss += __shfl_xor(ss, 32);
                if (fq == 0) SSQ2[(size_t)row * 16 + u.pn * 4 + wc] = ss;
            }
    }
};
struct EpiUp {
    static constexpr bool PERM = true, AFTER_DRAIN = false;
    const float* SSQ2; bf16_t* H;
    __device__ __forceinline__ void operator()(const f32x4 (&acc)[2][2][4][2], const Unit& u, int wr, int wc, int fr, int fq) const {
        const int col0 = u.pn * BM + wc * 32 + 8 * fq;
#pragma unroll
        for (int ai = 0; ai < 2; ++ai)
#pragma unroll
            for (int m = 0; m < 4; ++m) {
                const int row = u.pm * BM + ai * HALF + wr * 64 + m * 16 + fr;
                const f32x4 s0 = *(const f32x4*)(SSQ2 + (size_t)row * 16), s1 = *(const f32x4*)(SSQ2 + (size_t)row * 16 + 4), s2 = *(const f32x4*)(SSQ2 + (size_t)row * 16 + 8), s3 = *(const f32x4*)(SSQ2 + (size_t)row * 16 + 12);
                const float ss = (((s0[0] + s0[1]) + (s0[2] + s0[3])) + ((s1[0] + s1[1]) + (s1[2] + s1[3]))) + (((s2[0] + s2[1]) + (s2[2] + s2[3])) + ((s3[0] + s3[1]) + (s3[2] + s3[3])));
                const float rs = rsqrtf(ss * (1.0f / 1024.0f) + EPS);
                bf16_t* rowp = H + (size_t)row * FF + col0;
#pragma unroll
                for (int bj = 0; bj < 2; ++bj) {
                    f32x4 v0 = acc[ai][bj][m][0] * rs, v1 = acc[ai][bj][m][1] * rs;
#pragma unroll
                    for (int e = 0; e < 4; ++e) { const float a = fmaxf(v0[e], 0.f), b = fmaxf(v1[e], 0.f); v0[e] = a * a; v1[e] = b * b; }
                    u32x4 w; w.x = cvt_pk_bf16(v0[0], v0[1]); w.y = cvt_pk_bf16(v0[2], v0[3]); w.z = cvt_pk_bf16(v1[0], v1[1]); w.w = cvt_pk_bf16(v1[2], v1[3]);
                    *(u32x4*)(rowp + bj * HALF) = w;
                }
            }
    }
};
struct EpiDown {
    static constexpr bool PERM = false, AFTER_DRAIN = false;
    float* Y;
    __device__ __forceinline__ void operator()(const f32x4 (&acc)[2][2][4][2], const Unit& u, int wr, int wc, int fr, int fq) const {
        const int col0 = u.pn * BM + wc * 32 + 4 * fq;
#pragma unroll
        for (int ai = 0; ai < 2; ++ai)
#pragma unroll
            for (int m = 0; m < 4; ++m) {
                const size_t off = (size_t)(u.pm * BM + ai * HALF + wr * 64 + m * 16 + fr) * DM + col0;
#pragma unroll
                for (int bj = 0; bj < 2; ++bj)
#pragma unroll
                    for (int n = 0; n < 2; ++n) { float* p = Y + off + bj * HALF + n * 16; *(f32x4*)p = *(const f32x4*)p + acc[ai][bj][m][n]; }
            }
    }
};
template <class Epi, class Sched, bool ALIGN_EPI = false, bool SP2 = false>
__device__ __forceinline__ void gemm_phase(PG8_LAS unsigned char* lds, const Gemm g, const Sched& S, const Epi& E) {
    const int tid = threadIdx.x, wid = __builtin_amdgcn_readfirstlane(tid >> 6), lane = tid & 63, wr = wid >> 2, wc = wid & 3, fr = lane & 15, fq = lane >> 4;
    const int K = g.K, nt = K / BK;
    unsigned voffA[2], voffB[2];
#pragma unroll
    for (int i = 0; i < 2; ++i) { int R, C; stage_rc(tid * 16 + i * 8192, R, C); const int Rb = Epi::PERM ? ((R & ~31) + perm32(R & 31)) : R;
        voffA[i] = (unsigned)(R * K + C) * 2u; voffB[i] = (unsigned)(Rb * K + C) * 2u; }
    const size_t kstep = (size_t)(BK * 2);
    const size_t hstep = (size_t)HALF * K * 2;
    const size_t tstep = 2 * hstep;
    const unsigned ldsw = (unsigned)wid * 1024u;
    const int aoff = lds_byte(wr * 64 + fr, fq * 8), boff = lds_byte(wc * 32 + fr, fq * 8);
#define PG8_SA(b, h) (((b) * 2 + (h)) * HTB)
#define PG8_SB(b, h) ((4 + (b) * 2 + (h)) * HTB)
#define PG8_STAGE(bufoff, gbase, voff) do { _Pragma("unroll") for (int _i = 0; _i < 2; ++_i) \
        __builtin_amdgcn_global_load_lds((const unsigned*)((const char*)(gbase) + (voff)[_i]), (PG8_LAS unsigned*)(lds + (bufoff) + ldsw + _i * 8192), 16, 0, 0); } while (0)
#define PG8_LDA(dst, b, h) do { _Pragma("unroll") for (int m = 0; m < 4; ++m) _Pragma("unroll") for (int k = 0; k < 2; ++k) dst[m][k] = *(const PG8_LAS bf16x8*)(lds + PG8_SA(b, h) + aoff + m * 2048 + k * 1024); } while (0)
#define PG8_LDB(dst, b, h) do { _Pragma("unroll") for (int n = 0; n < 2; ++n) _Pragma("unroll") for (int k = 0; k < 2; ++k) dst[n][k] = *(const PG8_LAS bf16x8*)(lds + PG8_SB(b, h) + boff + n * 2048 + k * 1024); } while (0)
#define PG8_MMA(ai, bj, At, Bt) do { __builtin_amdgcn_s_setprio(1); _Pragma("unroll") for (int m = 0; m < 4; ++m) _Pragma("unroll") for (int n = 0; n < 2; ++n) _Pragma("unroll") for (int k = 0; k < 2; ++k) \
        acc[ai][bj][m][n] = __builtin_amdgcn_mfma_f32_16x16x32_bf16(Bt[n][k], At[m][k], acc[ai][bj][m][n], 0, 0, 0); __builtin_amdgcn_s_setprio(0); } while (0)
#define PG8_WAIT_V(n) asm volatile("s_waitcnt vmcnt(" #n ")" ::: "memory")
#define PG8_WAIT_L(n) asm volatile("s_waitcnt lgkmcnt(" #n ")" ::: "memory")
#define PG8_BAR __builtin_amdgcn_s_barrier()
#define PG8_SCHED __builtin_amdgcn_sched_barrier(0)
    Unit cur, nxt; int ui = 0;
    if (!S.next(0, cur)) return;
    f32x4 acc[2][2][4][2];
#pragma unroll
    for (int a = 0; a < 2; ++a)
#pragma unroll
        for (int b = 0; b < 2; ++b)
#pragma unroll
            for (int m = 0; m < 4; ++m)
#pragma unroll
                for (int n = 0; n < 2; ++n) acc[a][b][m][n] = (f32x4){0.f, 0.f, 0.f, 0.f};
    bf16x8 At[4][2], B0[2][2], B1[2][2];
    const char* cA = (const char*)g.A + (size_t)cur.pm * tstep; const char* cB = (const char*)g.Bt + (size_t)cur.pn * tstep;
    S.a_ready(cur);
    if constexpr (SP2) {
        PG8_STAGE(PG8_SB(0, 0), cB, voffB); PG8_STAGE(PG8_SB(0, 1), cB + hstep, voffB); PG8_STAGE(PG8_SA(0, 0), cA, voffA); PG8_STAGE(PG8_SA(0, 1), cA + hstep, voffA);
        if (wr == 1) PG8_BAR;
        PG8_WAIT_V(2); PG8_BAR;
        PG8_STAGE(PG8_SB(1, 0), cB + kstep, voffB); PG8_STAGE(PG8_SA(1, 0), cA + kstep, voffA); PG8_STAGE(PG8_SB(1, 1), cB + hstep + kstep, voffB);
        PG8_WAIT_V(6); PG8_BAR;
    } else {
        PG8_STAGE(PG8_SB(0, 0), cB, voffB); PG8_STAGE(PG8_SA(0, 0), cA, voffA); PG8_STAGE(PG8_SB(0, 1), cB + hstep, voffB); PG8_STAGE(PG8_SA(0, 1), cA + hstep, voffA);
        if (wr == 1) PG8_BAR;
        PG8_WAIT_V(4); PG8_BAR;
        PG8_STAGE(PG8_SB(1, 0), cB + kstep, voffB); PG8_STAGE(PG8_SA(1, 0), cA + kstep, voffA); PG8_STAGE(PG8_SB(1, 1), cB + hstep + kstep, voffB);
        PG8_WAIT_V(6); PG8_BAR;
    }
    for (;;) {
        const bool has_next = S.next(ui + 1, nxt);
        const char* nA = has_next ? (const char*)g.A + (size_t)nxt.pm * tstep : cA; const char* nB = has_next ? (const char*)g.Bt + (size_t)nxt.pn * tstep : cB;
        for (int t = 0; t < nt; t += 2) {
            const bool last = (t == nt - 2);
            const char* a1 = cA + (size_t)(t + 1) * kstep;
            const char* a2 = last ? nA : cA + (size_t)(t + 2) * kstep; const char* b2 = last ? nB : cB + (size_t)(t + 2) * kstep;
            const char* a3 = a2 + kstep; const char* b3 = b2 + kstep;
            if (last && has_next) S.a_ready(nxt);
            if constexpr (SP2) {
            PG8_LDB(B0, 0, 0); PG8_LDB(B1, 0, 1); PG8_SCHED; PG8_LDA(At, 0, 0); PG8_STAGE(PG8_SA(1, 1), a1 + hstep, voffA);
            PG8_WAIT_V(8); PG8_WAIT_L(0); PG8_BAR; PG8_MMA(0, 0, At, B0); PG8_MMA(0, 1, At, B1); PG8_BAR; PG8_SCHED;
            PG8_LDA(At, 0, 1); PG8_STAGE(PG8_SB(0, 0), b2, voffB); PG8_STAGE(PG8_SB(0, 1), b2 + hstep, voffB); PG8_STAGE(PG8_SA(0, 0), a2, voffA);
            PG8_WAIT_V(8); PG8_WAIT_L(0); PG8_BAR; PG8_MMA(1, 0, At, B0); PG8_MMA(1, 1, At, B1); PG8_BAR; PG8_SCHED;
            PG8_LDB(B0, 1, 0); PG8_LDB(B1, 1, 1); PG8_SCHED; PG8_LDA(At, 1, 0); PG8_STAGE(PG8_SA(0, 1), a2 + hstep, voffA);
            PG8_WAIT_V(8); PG8_WAIT_L(0); PG8_BAR; PG8_MMA(0, 0, At, B0); PG8_MMA(0, 1, At, B1); PG8_BAR; PG8_SCHED;
            PG8_LDA(At, 1, 1); PG8_STAGE(PG8_SB(1, 0), b3, voffB); PG8_STAGE(PG8_SB(1, 1), b3 + hstep, voffB); PG8_STAGE(PG8_SA(1, 0), a3, voffA);
            PG8_WAIT_V(8); PG8_WAIT_L(0); PG8_BAR; PG8_MMA(1, 0, At, B0); PG8_MMA(1, 1, At, B1); PG8_BAR; PG8_SCHED;
            } else {
            PG8_LDB(B0, 0, 0); PG8_SCHED; PG8_LDA(At, 0, 0); PG8_STAGE(PG8_SA(1, 1), a1 + hstep, voffA);
            PG8_WAIT_L(8); PG8_BAR; PG8_WAIT_L(0); PG8_MMA(0, 0, At, B0); PG8_BAR; PG8_SCHED;
            PG8_LDB(B1, 0, 1); PG8_STAGE(PG8_SB(0, 0), b2, voffB);
            PG8_BAR; PG8_WAIT_L(0); PG8_MMA(0, 1, At, B1); PG8_BAR;
            PG8_LDA(At, 0, 1); PG8_STAGE(PG8_SA(0, 0), a2, voffA);
            PG8_BAR; PG8_WAIT_L(0); PG8_MMA(1, 0, At, B0); PG8_BAR; PG8_SCHED;
            PG8_STAGE(PG8_SB(0, 1), b2 + hstep, voffB);
            PG8_WAIT_V(6); PG8_BAR; PG8_MMA(1, 1, At, B1); PG8_BAR;
            PG8_LDB(B0, 1, 0); PG8_SCHED; PG8_LDA(At, 1, 0); PG8_STAGE(PG8_SA(0, 1), a2 + hstep, voffA);
            PG8_WAIT_L(8); PG8_BAR; PG8_WAIT_L(0); PG8_MMA(0, 0, At, B0); PG8_BAR; PG8_SCHED;
            PG8_LDB(B1, 1, 1); PG8_STAGE(PG8_SB(1, 0), b3, voffB);
            PG8_BAR; PG8_WAIT_L(0); PG8_MMA(0, 1, At, B1); PG8_BAR;
            PG8_LDA(At, 1, 1); PG8_STAGE(PG8_SA(1, 0), a3, voffA);
            PG8_BAR; PG8_WAIT_L(0); PG8_MMA(1, 0, At, B0); PG8_BAR; PG8_SCHED;
            PG8_STAGE(PG8_SB(1, 1), b3 + hstep, voffB);
            PG8_WAIT_V(6); PG8_BAR; PG8_MMA(1, 1, At, B1); PG8_BAR;
            }
        }
        if constexpr (ALIGN_EPI) { if (wr == 0) PG8_BAR; }
        if constexpr (!Epi::AFTER_DRAIN) { E(acc, cur, wr, wc, fr, fq); S.done(cur); }
        if (!has_next) break;
#pragma unroll
        for (int a = 0; a < 2; ++a)
#pragma unroll
            for (int b = 0; b < 2; ++b)
#pragma unroll
                for (int m = 0; m < 4; ++m)
#pragma unroll
                    for (int n = 0; n < 2; ++n) acc[a][b][m][n] = (f32x4){0.f, 0.f, 0.f, 0.f};
        cur = nxt; cA = nA; cB = nB; ++ui;
        if constexpr (ALIGN_EPI) { if (wr == 1) PG8_BAR; }
    }
    PG8_WAIT_V(0);
    if constexpr (!ALIGN_EPI) { if (wr == 0) PG8_BAR; }
    PG8_BAR;
    if constexpr (Epi::AFTER_DRAIN) { E.fused(acc, cur, wr, wc, fr, fq, lds, wid, lane); S.done(cur); }
#undef PG8_SA
#undef PG8_SB
#undef PG8_STAGE
#undef PG8_LDA
#undef PG8_LDB
#undef PG8_MMA
#undef PG8_WAIT_V
#undef PG8_WAIT_L
#undef PG8_BAR
#undef PG8_SCHED
}
}
#define XB_TMO      128
#define XB_XCNT(j)  (256  + 64 * (j))
#define XB_XSUB(j)  (1280 + 64 * (j))
#define XB_XGEN(j)  (2304 + 64 * (j))
#define XB_TOP      3328
#define XB_TOPGEN   3392
#define XCD_BAR_WORDS 3456
#define XB_SPIN_CAP (1u << 18)

__device__ __forceinline__ unsigned xb_ld(unsigned* p)              { return __hip_atomic_load(p, __ATOMIC_RELAXED, __HIP_MEMORY_SCOPE_AGENT); }
__device__ __forceinline__ unsigned xb_add(unsigned* p, unsigned v) { return __hip_atomic_fetch_add(p, v, __ATOMIC_RELAXED, __HIP_MEMORY_SCOPE_AGENT); }
__device__ __forceinline__ unsigned xb_xcc_id() { return (unsigned)__builtin_amdgcn_s_getreg((3 << 11) | 20) & 0xFu; }
#define XB_SPIN(cond, bar) do { unsigned _sp = 0; while (cond) { __builtin_amdgcn_s_sleep(1); \
    if ((++_sp & 255u) == 0u) { if (xb_ld(&(bar)[XB_TMO])) break; if (_sp > XB_SPIN_CAP) { atomicAdd(&(bar)[XB_TMO], 1u); break; } } } } while (0)

struct XcdBarrier {
    unsigned* bar; unsigned x;
    volatile LAS unsigned* st;
};

__device__ __forceinline__ XcdBarrier xcd_barrier_post(unsigned* bar, volatile LAS unsigned* st) {
    XcdBarrier b; b.bar = bar; b.x = xb_xcc_id(); b.st = st;
    if (threadIdx.x == 0) (void)xb_add(&bar[XB_XCNT(b.x)], 1u);
    return b;
}
__device__ __forceinline__ void xcd_barrier_complete(unsigned* bar, unsigned x, unsigned& nloc, unsigned& nx) {
    const unsigned G = gridDim.x * gridDim.y * gridDim.z;
    unsigned sum, cnt, mine, sp = 0u;
    for (;;) {
        sum = 0u; cnt = 0u; mine = 0u;
#pragma unroll
        for (unsigned j = 0; j < 16; ++j) { const unsigned c = xb_ld(&bar[XB_XCNT(j)]); sum += c; cnt += (c > 0u) ? 1u : 0u; mine = (j == x) ? c : mine; }
        if (sum == G) break;
        __builtin_amdgcn_s_sleep(1);
        if ((++sp & 255u) == 0u) { if (xb_ld(&bar[XB_TMO])) break; if (sp > XB_SPIN_CAP) { atomicAdd(&bar[XB_TMO], 1u); break; } }
    }
    nloc = mine > 0u ? mine : 1u; nx = cnt > 0u ? cnt : 1u;
}

__device__ __forceinline__ void xcd_barrier(const XcdBarrier& b) {
    asm volatile("s_waitcnt vmcnt(0)" ::: "memory");
    __syncthreads();
    if (threadIdx.x == 0) {
        unsigned* bar = b.bar;
        __builtin_amdgcn_s_waitcnt(0);
        unsigned nloc = b.st[0], nx = b.st[1];
        if (nloc == 0u) { xcd_barrier_complete(bar, b.x, nloc, nx); b.st[0] = nloc; b.st[1] = nx; }
        const unsigned old = xb_add(&bar[XB_XSUB(b.x)], 1u);
        const unsigned gen = old / nloc;
        if (old + 1u == (gen + 1u) * nloc) {
            __builtin_amdgcn_fence(__ATOMIC_RELEASE, "agent");
            asm volatile("s_waitcnt vmcnt(0)" ::: "memory");
            const unsigned og = xb_add(&bar[XB_TOP], 1u);
            const unsigned tg = og / nx;
            if (og + 1u == (tg + 1u) * nx) xb_add(&bar[XB_TOPGEN], 1u);
            else XB_SPIN(xb_ld(&bar[XB_TOPGEN]) == tg, bar);
            __builtin_amdgcn_fence(__ATOMIC_ACQUIRE, "agent");
            xb_add(&bar[XB_XGEN(b.x)], 1u);
            asm volatile("s_waitcnt vmcnt(0)" ::: "memory");
        } else {
            XB_SPIN(xb_ld(&bar[XB_XGEN(b.x)]) == gen, bar);
            __builtin_amdgcn_fence(__ATOMIC_ACQUIRE, "agent");
            asm volatile("s_waitcnt vmcnt(0)" ::: "memory");
        }
    }
    __syncthreads();
}
typedef unsigned short bf16;
typedef unsigned v4u __attribute__((ext_vector_type(4)));
typedef float f32x4 __attribute__((ext_vector_type(4)));
typedef short bf16x8 __attribute__((ext_vector_type(8)));
typedef GAS unsigned gu32;
#define LDS_WAIT() asm volatile("s_waitcnt lgkmcnt(0)" ::: "memory")
__device__ __forceinline__ unsigned f2bf(float f) { unsigned u = __builtin_bit_cast(unsigned, f); return (u + 0x7fffu + ((u >> 16) & 1u)) >> 16; }
__device__ __forceinline__ unsigned pk2(float lo, float hi) { return f2bf(lo) | (f2bf(hi) << 16); }
__device__ __forceinline__ float bf2f(unsigned short h) { return __builtin_bit_cast(float, (unsigned)h << 16); }
__device__ __forceinline__ float bflo(unsigned w) { return __builtin_bit_cast(float, w << 16); }
__device__ __forceinline__ float bfhi(unsigned w) { return __builtin_bit_cast(float, w & 0xffff0000u); }
__device__ __forceinline__ float wave_sum(float v) {
#pragma unroll
    for (int o = 1; o < 64; o <<= 1) v += __shfl_xor(v, o);
    return v;
}
__device__ __forceinline__ float silu_f(float x) { return x / (1.f + __expf(-x)); }
__device__ __forceinline__ int crow(int r, int hi) { return (r & 3) + 8 * (r >> 2) + 4 * hi; }

struct Ctx {
    LAS unsigned char* lds; volatile LAS unsigned* MISC; gu32* ctl;
    int tid, lane, wave, vcu, G;
    const float* in[18]; float* out; unsigned char* ws;
};
__device__ __forceinline__ int q_next(Ctx& C, int cw) {
    __syncthreads();
    if (C.tid == 0) C.MISC[16] = __hip_atomic_fetch_add((unsigned*)(C.ctl + cw), 1u, __ATOMIC_RELAXED, __HIP_MEMORY_SCOPE_AGENT);
    __syncthreads();
    return (int)C.MISC[16];
}

__device__ __forceinline__ int inproj_src(int p) {
    const int pn = p >> 8, q = p & 255;
    const int bj = q >> 7, wc = (q >> 5) & 3, n = (q >> 4) & 1, fq = (q >> 2) & 3, e = q & 3;
    const int lc = 64 * wc + 16 * fq + 8 * bj + 4 * n + e;
    if (pn < 5) return 256 * pn + lc;
    if (pn == 5) return lc < 72 ? 1280 + lc : -1;
    return 1352 + 256 * (pn - 6) + lc;
}
template <bool MAP>
__device__ __forceinline__ void p0_transpose_item(const float* W, int K, int N, int NP, const float* gain, bf16* WT, LAS float* scr, int item, int lane) {
    const int nblk = NP / 32, kb = item / nblk, nb = item % nblk, k0 = 64 * kb, n0 = 32 * nb;
    const int p = n0 + (lane & 31); const int sc = MAP ? inproj_src(p) : p;
#pragma unroll 8
    for (int i = 0; i < 32; ++i) { const int kk = 2 * i + (lane >> 5); float v = 0.f; if (sc >= 0) v = W[(size_t)(k0 + kk) * N + sc]; if (gain) v *= gain[k0 + kk]; scr[kk * 33 + (lane & 31)] = v; }
    LDS_WAIT(); asm volatile("" ::: "memory");
    const int c = lane & 7;
#pragma unroll
    for (int j = 0; j < 4; ++j) { const int n = (lane >> 3) + 8 * j; const LAS float* s = scr + (8 * c) * 33 + n;
        v4u o; o.x = pk2(s[0 * 33], s[1 * 33]); o.y = pk2(s[2 * 33], s[3 * 33]); o.z = pk2(s[4 * 33], s[5 * 33]); o.w = pk2(s[6 * 33], s[7 * 33]);
        *(GAS v4u*)(WT + (size_t)(n0 + n) * K + k0 + 8 * c) = o; }
    LDS_WAIT(); asm volatile("" ::: "memory");
}
__device__ __forceinline__ void x_row_to_bf16(const float* xrow, bf16* orow, float* rstd, int lane) {
    const GAS f32x4* xr = (const GAS f32x4*)xrow + lane;
    f32x4 v[4]; float s = 0.f;
#pragma unroll
    for (int j = 0; j < 4; ++j) { v[j] = xr[64 * j]; s += (v[j].x * v[j].x + v[j].y * v[j].y) + (v[j].z * v[j].z + v[j].w * v[j].w); }
    s = wave_sum(s);
    if (lane == 0) *rstd = rsqrtf(s * (1.0f / DM) + EPS);
    GAS u64* o8 = (GAS u64*)orow + lane;
#pragma unroll
    for (int j = 0; j < 4; ++j) o8[64 * j] = (u64)pk2(v[j].x, v[j].y) | ((u64)pk2(v[j].z, v[j].w) << 32);
}

template <int K, bool GK, int KW = K / 8>
__device__ __forceinline__ void skinny32(const float* A, const float* gk, const float* W, int ldw, int N, int n0, LAS float* red, int tid, int lane, int wave, int kbase = 0) {
    const int i = lane & 31, kh = lane >> 5, n = n0 + i; const bool nok = n < N;
    f32x16 acc = {};
    const int kbeg = kbase + wave * KW, kend = kbeg + KW;
#pragma unroll 1
    for (int kb0 = kbeg; kb0 < kend; kb0 += 64) {
        f32x4 xa[8]; float bw[8][4];
#pragma unroll
        for (int s = 0; s < 8; ++s) { const int kb = kb0 + 8 * s;
            xa[s] = *(const f32x4*)(A + (size_t)i * K + kb + 4 * kh);
            if (GK) { const f32x4 ga = *(const f32x4*)(gk + kb + 4 * kh); xa[s] = xa[s] * ga; }
            const float* wp = W + (size_t)(kb + 4 * kh) * ldw + (nok ? n : 0);
            bw[s][0] = wp[0]; bw[s][1] = wp[ldw]; bw[s][2] = wp[2 * (size_t)ldw]; bw[s][3] = wp[3 * (size_t)ldw]; }
#pragma unroll
        for (int s = 0; s < 8; ++s)
#pragma unroll
            for (int j = 0; j < 4; ++j) acc = __builtin_amdgcn_mfma_f32_32x32x2f32(xa[s][j], nok ? bw[s][j] : 0.f, acc, 0, 0, 0);
    }
#pragma unroll
    for (int r = 0; r < 16; ++r) red[wave * 1024 + crow(r, kh) * 32 + i] = acc[r];
    __syncthreads();
#pragma unroll
    for (int x = 0; x < 2; ++x) { const int e = tid + 512 * x; float s = 0.f;
#pragma unroll
        for (int w = 0; w < 8; ++w) s += red[w * 1024 + e];
        red[8 * 1024 + e] = s; }
    __syncthreads();
}
__device__ __forceinline__ float sk_get(LAS float* red, int e) { return red[8 * 1024 + e]; }
template <int K>
__device__ __forceinline__ void rows_rstd32(const float* A, LAS float* rs, int lane, int wave) {
#pragma unroll
    for (int j = 0; j < 4; ++j) { const int r = wave * 4 + j; float s = 0.f;
        for (int k = lane * 4; k < K; k += 256) { const f32x4 v = *(const f32x4*)(A + (size_t)r * K + k); s += (v[0] * v[0] + v[1] * v[1]) + (v[2] * v[2] + v[3] * v[3]); }
        s = wave_sum(s); if (lane == 0) rs[r] = rsqrtf(s * (1.0f / K) + EPS); }
}

__device__ __forceinline__ void p0_prologue(Ctx& C) {
    LAS float* scr = (LAS float*)(C.lds + C.wave * 16384);
    float* samp = (float*)(C.ws + WS_SAMP);
    if (C.vcu < 107) {
        LAS float* red = (LAS float*)C.lds; LAS float* rs = red + 9 * 1024 + 64;
        rows_rstd32<DM>(C.in[I_XS], rs, C.lane, C.wave);
        skinny32<DM, true>(C.in[I_XS], C.in[I_N1G], C.in[I_WIN], INW, INW, 32 * C.vcu, red, C.tid, C.lane, C.wave);
#pragma unroll
        for (int x = 0; x < 2; ++x) { const int e = C.tid + 512 * x, i = e >> 5, n = 32 * C.vcu + (e & 31); if (n < INW) samp[S_RAW + i * INW + n] = sk_get(red, e) * rs[i]; }
        __syncthreads();
    }
    if (C.vcu == 200 && C.tid < 192) ((float*)(C.ws + WS_GAINS))[C.tid] = C.tid < 64 ? C.in[I_QG][C.tid] : (C.tid < 128 ? C.in[I_KG][C.tid - 64] : C.in[I_IKG][C.tid - 128]);
    const int gw = C.vcu * 8 + C.wave, NGW = C.G * 8;
    constexpr int I_1 = (DM / 64) * (INP / 32), I_O = (DM / 64) * (DM / 32), I_U = (DM / 64) * (FF / 32), I_D = (FF / 64) * (DM / 32);
    for (int it = gw; it < I_1 + I_O + I_U + I_D; it += NGW) {
        int r = it;
        if (r < I_1) { p0_transpose_item<true>(C.in[I_WIN], DM, INW, INP, C.in[I_N1G], (bf16*)(C.ws + WS_W1T), scr, r, C.lane); continue; } r -= I_1;
        if (r < I_O) { p0_transpose_item<false>(C.in[I_WOUT], DM, DM, DM, nullptr, (bf16*)(C.ws + WS_WOT), scr, r, C.lane); continue; } r -= I_O;
        if (r < I_U) { p0_transpose_item<false>(C.in[I_WUP], DM, FF, FF, C.in[I_N2G], (bf16*)(C.ws + WS_WUT), scr, r, C.lane); continue; } r -= I_U;
        p0_transpose_item<false>(C.in[I_WDN], FF, DM, DM, nullptr, (bf16*)(C.ws + WS_WDT), scr, r, C.lane);
    }
    bf16* XB = (bf16*)(C.ws + WS_XB); float* RSTD1 = (float*)(C.ws + WS_RSTD1);
    for (int m = gw; m < NTOK; m += NGW) x_row_to_bf16(C.in[I_XP] + (size_t)m * DM, XB + (size_t)m * DM, RSTD1 + m, C.lane);
}

__device__ __forceinline__ void sample_postproj(Ctx& C, int b) {
    const float* raw = (const float*)(C.ws + WS_SAMP) + S_RAW + (size_t)b * INW; float* sp = (float*)(C.ws + WS_SAMP) + S_SP + (size_t)b * 4096;
    const int l = C.lane;
    for (int h = 0; h < 8; ++h) { const float v = raw[h * 64 + l]; const float ss = wave_sum(v * v); sp[h * 64 + l] = v * rsqrtf(ss * (1.f / 64.f) + EPS) * C.in[I_QG][l]; }
    for (int h = 0; h < 2; ++h) { const float v = raw[512 + h * 64 + l]; const float ss = wave_sum(v * v); const float kn = v * rsqrtf(ss * (1.f / 64.f) + EPS) * C.in[I_KG][l];
        sp[512 + h * 64 + l] = kn; C.out[O_NKS + (size_t)b * 128 + h * 64 + l] = kn; }
    for (int h = 0; h < 2; ++h) { const float v = raw[640 + h * 64 + l]; sp[640 + h * 64 + l] = v; C.out[O_NVS + (size_t)b * 128 + h * 64 + l] = v; }
    for (int j = 0; j < 8; ++j) sp[768 + j * 64 + l] = raw[768 + j * 64 + l];
    { const float v = raw[1280 + l]; const float ss = wave_sum(v * v); const float kn = v * rsqrtf(ss * (1.f / 64.f) + EPS) * C.in[I_IKG][l]; sp[1280 + l] = kn; C.out[O_NKIS + (size_t)b * 64 + l] = kn; }
    if (l < 8) sp[1344 + l] = raw[1344 + l] * IDX_W_SCALE;
    for (int j = 0; j < 8; ++j) { sp[1352 + j * 64 + l] = silu_f(raw[1352 + j * 64 + l]) * REC_QSCALE; sp[1864 + j * 64 + l] = raw[1864 + j * 64 + l]; sp[2376 + j * 64 + l] = raw[2376 + j * 64 + l]; sp[2888 + j * 64 + l] = silu_f(raw[2888 + j * 64 + l]); }
}
constexpr int SROW = 2052, SEL_WS_OFF = 131584;
static_assert(SEL_WS_OFF + 8 * 2048 <= LDSCTL_OFF, "select lds");
template <int CTRL> __device__ __forceinline__ float dppf(float v) { return __builtin_bit_cast(float, __builtin_amdgcn_update_dpp(__builtin_bit_cast(int, v), __builtin_bit_cast(int, v), CTRL, 0xf, 0xf, false)); }
template <int CTRL> __device__ __forceinline__ int dppi(int v) { return __builtin_amdgcn_update_dpp(v, v, CTRL, 0xf, 0xf, false); }
__device__ __forceinline__ float rdl_f(float v, int l) { return __builtin_bit_cast(float, __builtin_amdgcn_readlane(__builtin_bit_cast(int, v), l)); }
__device__ __forceinline__ float wave_min_f(float v) {
    v = fminf(v, dppf<0xB1>(v)); v = fminf(v, dppf<0x4E>(v)); v = fminf(v, dppf<0x141>(v)); v = fminf(v, dppf<0x140>(v));
    return fminf(fminf(rdl_f(v, 0), rdl_f(v, 16)), fminf(rdl_f(v, 32), rdl_f(v, 48)));
}
__device__ __forceinline__ float wave_max_f(float v) {
    v = fmaxf(v, dppf<0xB1>(v)); v = fmaxf(v, dppf<0x4E>(v)); v = fmaxf(v, dppf<0x141>(v)); v = fmaxf(v, dppf<0x140>(v));
    return fmaxf(fmaxf(rdl_f(v, 0), rdl_f(v, 16)), fmaxf(rdl_f(v, 32), rdl_f(v, 48)));
}
__device__ __forceinline__ int row_sum_i(int v) { v += dppi<0xB1>(v); v += dppi<0x4E>(v); v += dppi<0x141>(v); v += dppi<0x140>(v); return v; }
__device__ __forceinline__ int row_suffix_i(int v) {
    v += __builtin_amdgcn_update_dpp(0, v, 0x101, 0xf, 0xf, true); v += __builtin_amdgcn_update_dpp(0, v, 0x102, 0xf, 0xf, true);
    v += __builtin_amdgcn_update_dpp(0, v, 0x104, 0xf, 0xf, true); v += __builtin_amdgcn_update_dpp(0, v, 0x108, 0xf, 0xf, true); return v;
}
__device__ __forceinline__ void dsa_select_unit(Ctx& C, int b, int qb) {
    const bf16* IQb = (const bf16*)(C.ws + WS_IQB); const bf16* IKb = (const bf16*)(C.ws + WS_IKB); const float* IWf = (const float*)(C.ws + WS_IWF);
    u64* MASK = (u64*)(C.ws + WS_MASK);
    LAS float* sc = (LAS float*)C.lds;
    int lane = C.lane, wave = C.wave; asm volatile("" : "+v"(lane), "+s"(wave));
    const int t0 = qb * 16, ntile = qb + 1, ql = lane & 15, g = lane >> 4;
    const size_t rowq = (size_t)b * SEQ + t0 + ql;
#ifdef SEL_REP_SCORE
    for (int rep_ = 0; rep_ < 2; ++rep_)
#endif
    {
        bf16x8 bq[8][2];
#pragma unroll
        for (int h = 0; h < 8; ++h)
#pragma unroll
            for (int ks = 0; ks < 2; ++ks) bq[h][ks] = *(const bf16x8*)(IQb + rowq * 512 + h * 64 + ks * 32 + g * 8);
        float w[8];
        { const f32x4 w0 = *(const f32x4*)(IWf + rowq * 8), w1 = *(const f32x4*)(IWf + rowq * 8 + 4); w[0] = w0[0]; w[1] = w0[1]; w[2] = w0[2]; w[3] = w0[3]; w[4] = w1[0]; w[5] = w1[1]; w[6] = w1[2]; w[7] = w1[3]; }
        const bf16* kbase = IKb + ((size_t)b * SEQ + ql) * 64 + g * 8;
        bf16x8 ta[16][2];
#pragma unroll
        for (int x = 0; x < 16; ++x) { const int ii = wave + 8 * x; if (ii < ntile) { const bf16* kp = kbase + (size_t)ii * 16 * 64; ta[x][0] = *(const bf16x8*)kp; ta[x][1] = *(const bf16x8*)(kp + 32); } }
#pragma unroll
        for (int x = 0; x < 16; ++x) { const int ii = wave + 8 * x;
            if (ii < ntile) {
                f32x4 I = {0.f, 0.f, 0.f, 0.f};
#pragma unroll
                for (int h = 0; h < 8; ++h) {
                    f32x4 d = __builtin_amdgcn_mfma_f32_16x16x32_bf16(ta[x][0], bq[h][0], (f32x4){0.f, 0.f, 0.f, 0.f}, 0, 0, 0);
                    d = __builtin_amdgcn_mfma_f32_16x16x32_bf16(ta[x][1], bq[h][1], d, 0, 0, 0);
#pragma unroll
                    for (int r = 0; r < 4; ++r) I[r] = fmaf(w[h], fmaxf(d[r], 0.f), I[r]);
                }
                *(LAS f32x4*)(sc + ql * SROW + ii * 16 + 4 * g) = I;
            } }
    }
    __syncthreads();
    LAS unsigned* hist = (LAS unsigned*)(C.lds + SEL_WS_OFF) + wave * 512;
#ifdef SEL_REP_PICK
    for (int rep_ = 0; rep_ < 2; ++rep_)
#endif
#pragma unroll 1
    for (int qq = 0; qq < 2; ++qq) {
        const int qi = wave * 2 + qq, t = t0 + qi;
        unsigned mylo = 0, myhi = 0;
        if (t < 256) {
            const int lo = 64 * lane;
            const u64 mw_ = (lo > t) ? 0ull : ((lo + 63 <= t) ? ~0ull : ((2ull << (t - lo)) - 1ull));
            mylo = (unsigned)mw_; myhi = (unsigned)(mw_ >> 32);
        } else {
#ifndef SEL_RS
#define SEL_RS 0
#endif
            float v[32]; const int nj = (t >> 6) + 1;
            float lo = INFINITY, hi = -INFINITY;
#pragma unroll 1
            for (int rr = 0; rr < (SEL_RS == 1 ? 3 : 1); ++rr) { asm volatile("" ::: "memory"); lo = INFINITY; hi = -INFINITY;
#pragma unroll
            for (int j = 0; j < 32; ++j) v[j] = sc[qi * SROW + 64 * j + lane];
#pragma unroll
            for (int j = 0; j < 32; ++j) { const bool ok = (64 * j + lane) <= t; const float xl = ok ? v[j] : INFINITY; v[j] = ok ? v[j] : -INFINITY;
                asm("v_max_f32 %0, %0, %1" : "+v"(hi) : "v"(v[j])); asm("v_min_f32 %0, %0, %1" : "+v"(lo) : "v"(xl)); }
            lo = wave_min_f(lo); hi = wave_max_f(hi); }
            const float scale = (hi > lo) ? 255.99f / (hi - lo) : 0.f;
            int bn[32];
#pragma unroll 1
            for (int rr = 0; rr < (SEL_RS == 2 ? 3 : 1); ++rr) {
            *(LAS v4u*)(hist + 4 * lane) = (v4u){0u, 0u, 0u, 0u}; *(LAS v4u*)(hist + 256 + 4 * lane) = (v4u){0u, 0u, 0u, 0u};
            LDS_WAIT(); asm volatile("" ::: "memory");
#pragma unroll
            for (int j = 0; j < 32; ++j) { bn[j] = -1; if (j < nj) { int bi = (int)((v[j] - lo) * scale); bi = bi > 255 ? 255 : bi; asm volatile("" : "+v"(bi)); bn[j] = bi;
                if (bi >= 0) __hip_atomic_fetch_add(hist + bi, 1u, __ATOMIC_RELAXED, __HIP_MEMORY_SCOPE_WORKGROUP); } }
            LDS_WAIT(); asm volatile("" ::: "memory"); }
            const v4u hh = *(const LAS v4u*)(hist + 4 * lane);
            const int s4 = (int)(hh.x + hh.y + hh.z + hh.w);
            const int rsum = row_sum_i(s4);
            const int r0s = __builtin_amdgcn_readlane(rsum, 0), r1s = __builtin_amdgcn_readlane(rsum, 16), r2s = __builtin_amdgcn_readlane(rsum, 32), r3s = __builtin_amdgcn_readlane(rsum, 48);
            int Rs, abv;
            if (r3s >= 256) { Rs = 3; abv = 0; } else if (r3s + r2s >= 256) { Rs = 2; abv = r3s; } else if (r3s + r2s + r1s >= 256) { Rs = 1; abv = r3s + r2s; } else { Rs = 0; abv = r3s + r2s + r1s; }
            (void)r0s;
            const int incl = abv + row_suffix_i(s4);
            const u64 bal = __ballot(((lane >> 4) == Rs) && incl >= 256);
            const int Ls = 63 - __clzll(bal);
            int c = incl - s4, bsel, cab, hsel;
            if (c + (int)hh.w >= 256) { bsel = 3; cab = c; hsel = (int)hh.w; }
            else { c += (int)hh.w; if (c + (int)hh.z >= 256) { bsel = 2; cab = c; hsel = (int)hh.z; }
                else { c += (int)hh.z; if (c + (int)hh.y >= 256) { bsel = 1; cab = c; hsel = (int)hh.y; } else { c += (int)hh.y; bsel = 0; cab = c; hsel = (int)hh.x; } } }
            const int Bs = 4 * Ls + __builtin_amdgcn_readlane(bsel, Ls), cabove = __builtin_amdgcn_readlane(cab, Ls), cntB = __builtin_amdgcn_readlane(hsel, Ls);
            const int r = 256 - cabove;
            if (cntB <= 64) {
#pragma unroll 1
                for (int rr = 0; rr < (SEL_RS == 4 ? 3 : 1); ++rr) { asm volatile("" ::: "memory");
                int cbase = 0;
#pragma unroll
                for (int j = 0; j < 32; ++j) if (j < nj) { const u64 wa = __ballot(bn[j] > Bs);
                    mylo = (lane == j) ? (unsigned)wa : mylo; myhi = (lane == j) ? (unsigned)(wa >> 32) : myhi;
                    const bool isc = bn[j] == Bs; const u64 bm = __ballot(isc);
                    if (bm != 0ull) { const int pos = cbase + (int)__builtin_amdgcn_mbcnt_hi((unsigned)(bm >> 32), __builtin_amdgcn_mbcnt_lo((unsigned)bm, 0u));
                        if (isc) { hist[258 + 2 * pos] = __builtin_bit_cast(unsigned, v[j]); hist[259 + 2 * pos] = (unsigned)(64 * j + lane); }
                        cbase += __popcll(bm); } }
                LDS_WAIT(); asm volatile("" ::: "memory");
                const bool mine = lane < cntB;
                const float cv = mine ? __builtin_bit_cast(float, hist[258 + 2 * lane]) : 0.f; const int ci = mine ? (int)hist[259 + 2 * lane] : 0;
                int rank = 0;
#pragma unroll 1
                for (int j = 0; j < cntB; ++j) { const float x = rdl_f(cv, j); const int y = __builtin_amdgcn_readlane(ci, j); rank += ((x > cv) | ((x == cv) & (y < ci))) ? 1 : 0; }
                if (mine && rank < r) __hip_atomic_fetch_or(hist + 416 + (ci >> 5), 1u << (ci & 31), __ATOMIC_RELAXED, __HIP_MEMORY_SCOPE_WORKGROUP);
                LDS_WAIT(); asm volatile("" ::: "memory"); }
                if (lane < 32) { mylo |= hist[416 + 2 * lane]; myhi |= hist[417 + 2 * lane]; }
            } else {
#ifndef SEL_NO_FALLBACK
                float th; int icut;
                unsigned u[32];
#pragma unroll
                for (int j = 0; j < 32; ++j) { const unsigned bits = __builtin_bit_cast(unsigned, v[j]); unsigned m = (bits & 0x80000000u) ? ~bits : (bits | 0x80000000u); if (v[j] == 0.f) m = 0x80000000u; u[j] = ((64 * j + lane) <= t) ? m : 0u; }
                unsigned prefix = 0;
#pragma unroll 1
                for (int bit = 31; bit >= 0; --bit) { const unsigned cand = prefix | (1u << bit); int cnt = 0;
#pragma unroll
                    for (int j = 0; j < 32; ++j) { cnt += __popcll(__ballot(u[j] >= cand)); asm volatile("" : "+s"(cnt)); }
                    if (cnt >= 256) prefix = cand; }
                const unsigned theta = prefix; int cgt = 0, ceq = 0;
#pragma unroll
                for (int j = 0; j < 32; ++j) { cgt += __popcll(__ballot(u[j] > theta)); ceq += __popcll(__ballot(u[j] == theta)); asm volatile("" : "+s"(cgt), "+s"(ceq)); }
                const int r2 = 256 - cgt; icut = 2047;
                if (ceq != r2) { int lo2 = 0;
#pragma unroll 1
                    for (int bit = 10; bit >= 0; --bit) { const int cc = lo2 | (1 << bit); int cnt = 0;
#pragma unroll
                        for (int j = 0; j < 32; ++j) { cnt += __popcll(__ballot(u[j] == theta && (64 * j + lane) < cc)); asm volatile("" : "+s"(cnt)); }
                        if (cnt < r2) lo2 = cc; }
                    icut = lo2; }
                const unsigned tb = (theta & 0x80000000u) ? (theta & 0x7fffffffu) : ~theta;
                th = __builtin_bit_cast(float, tb);
#pragma unroll
                for (int j = 0; j < 32; ++j) { const bool sel = (v[j] > th) | ((v[j] == th) & ((64 * j + lane) <= icut)); const u64 word = __ballot(sel);
                    mylo = (lane == j) ? (unsigned)word : mylo; myhi = (lane == j) ? (unsigned)(word >> 32) : myhi; asm volatile("" : "+v"(mylo), "+v"(myhi)); }
#endif
            }
        }
        if (lane < 32) MASK[((size_t)b * SEQ + t) * 32 + lane] = ((u64)myhi << 32) | mylo;
    }
}

constexpr int A_KROW = 72, A_VROW = 68, A_KT_BYTES = 2 * 64 * A_KROW * 2, A_VT_BYTES = 128 * A_VROW * 2, A_BUF = A_KT_BYTES + A_VT_BYTES, A_OST = 2 * A_BUF, A_OROW = 72;
__device__ __forceinline__ void attn_unit(Ctx& C, int b, int qb) {
    const bf16* Qb = (const bf16*)(C.ws + WS_QB); const bf16* Kb = (const bf16*)(C.ws + WS_KB); const bf16* Vt = (const bf16*)(C.ws + WS_VT);
    const u64* MASK = (const u64*)(C.ws + WS_MASK); bf16* MIX = (bf16*)(C.ws + WS_MIX);
    int tid = C.tid, wave = C.wave; asm volatile("" : "+v"(tid), "+s"(wave));
    const int lane = tid & 63, t0 = qb * 32, nt = qb / 2 + 1, ql = lane & 31, hi = lane >> 5, kvh = wave >> 2;
    const size_t qrow = (size_t)b * SEQ + t0 + ql;
    bf16x8 qf[4];
#pragma unroll
    for (int ks = 0; ks < 4; ++ks) qf[ks] = *(const bf16x8*)(Qb + qrow * 512 + wave * 64 + ks * 16 + hi * 8);
    const u64* mrow = MASK + qrow * 32;
    v4u kr[2], vr[2];
    const bf16* kg_[2]; const bf16* vg_[2]; int kl_[2], vl_[2];
#pragma unroll
    for (int x = 0; x < 2; ++x) { const int pid = tid + 512 * x;
        { const int i = pid >> 4, c16 = pid & 15, kv = c16 >> 3, cc = c16 & 7; kg_[x] = Kb + ((size_t)b * SEQ + i) * 128 + c16 * 8; kl_[x] = ((kv * 64 + i) * A_KROW + cc * 8) * 2; }
        { const int row = pid >> 3, pc = pid & 7; vg_[x] = Vt + ((size_t)b * 128 + row) * SEQ + pc * 8; vl_[x] = A_KT_BYTES + (row * A_VROW + pc * 8) * 2; } }
#define ATT_GLOAD(kt) do { _Pragma("unroll") for (int x = 0; x < 2; ++x) { kr[x] = *(const v4u*)(kg_[x] + (size_t)(kt) * 64 * 128); vr[x] = *(const v4u*)(vg_[x] + (kt) * 64); } } while (0)
#define ATT_LWRITE(buf) do { _Pragma("unroll") for (int x = 0; x < 2; ++x) { *(LAS v4u*)(C.lds + (buf) * A_BUF + kl_[x]) = kr[x]; \
        *(LAS u32x2*)(C.lds + (buf) * A_BUF + vl_[x]) = (u32x2){vr[x].x, vr[x].y}; *(LAS u32x2*)(C.lds + (buf) * A_BUF + vl_[x] + 8) = (u32x2){vr[x].z, vr[x].w}; } } while (0)
    ATT_GLOAD(0); ATT_LWRITE(0);
    u64 mw = mrow[0];
    __syncthreads();
    float m_run = -1e30f, l_run = 0.f; f32x16 o0 = {}, o1 = {};
#pragma unroll 1
    for (int kt = 0; kt < nt; ++kt) {
        const int cur = kt & 1; const bool more = kt + 1 < nt;
        u64 mw_next = 0;
        if (more) { ATT_GLOAD(kt + 1); mw_next = mrow[kt + 1]; }
        const LAS unsigned char* kb_ = C.lds + cur * A_BUF; const LAS unsigned char* vb_ = kb_ + A_KT_BYTES;
        f32x16 p0 = {}, p1 = {};
#pragma unroll
        for (int ks = 0; ks < 4; ++ks) {
            const bf16x8 a0 = *(const LAS bf16x8*)(kb_ + ((kvh * 64 + ql) * A_KROW + ks * 16 + hi * 8) * 2);
            const bf16x8 a1 = *(const LAS bf16x8*)(kb_ + ((kvh * 64 + 32 + ql) * A_KROW + ks * 16 + hi * 8) * 2);
            p0 = __builtin_amdgcn_mfma_f32_32x32x16_bf16(a0, qf[ks], p0, 0, 0, 0);
            p1 = __builtin_amdgcn_mfma_f32_32x32x16_bf16(a1, qf[ks], p1, 0, 0, 0);
        }
        const unsigned mlo = (unsigned)mw, mhi = (unsigned)(mw >> 32);
        float mx = -1e30f;
#pragma unroll
        for (int r = 0; r < 16; ++r) { const int kk = crow(r, 0) + 4 * hi; const bool s0 = (mlo >> kk) & 1u, s1 = (mhi >> kk) & 1u;
            p0[r] = s0 ? p0[r] : -1e30f; p1[r] = s1 ? p1[r] : -1e30f; mx = fmaxf(mx, fmaxf(p0[r], p1[r])); }
        mx = fmaxf(mx, __shfl_xor(mx, 32));
        const float m_new = fmaxf(m_run, mx), alpha = __builtin_amdgcn_exp2f(m_run - m_new); m_run = m_new;
        float ls = 0.f;
#pragma unroll
        for (int r = 0; r < 16; ++r) { const float e0 = (p0[r] > -1e29f) ? __builtin_amdgcn_exp2f(p0[r] - m_new) : 0.f, e1 = (p1[r] > -1e29f) ? __builtin_amdgcn_exp2f(p1[r] - m_new) : 0.f; p0[r] = e0; p1[r] = e1; ls += e0 + e1; }
        l_run = l_run * alpha + ls;
#pragma unroll
        for (int r = 0; r < 16; ++r) { o0[r] *= alpha; o1[r] *= alpha; }
        bf16x8 pb[2][2];
#pragma unroll
        for (int s = 0; s < 2; ++s) {
            v4u w0, w1;
            w0.x = pk2(p0[8 * s + 0], p0[8 * s + 1]); w0.y = pk2(p0[8 * s + 2], p0[8 * s + 3]); w0.z = pk2(p0[8 * s + 4], p0[8 * s + 5]); w0.w = pk2(p0[8 * s + 6], p0[8 * s + 7]);
            w1.x = pk2(p1[8 * s + 0], p1[8 * s + 1]); w1.y = pk2(p1[8 * s + 2], p1[8 * s + 3]); w1.z = pk2(p1[8 * s + 4], p1[8 * s + 5]); w1.w = pk2(p1[8 * s + 6], p1[8 * s + 7]);
            pb[0][s] = __builtin_bit_cast(bf16x8, w0); pb[1][s] = __builtin_bit_cast(bf16x8, w1);
        }
#pragma unroll
        for (int mt = 0; mt < 2; ++mt)
#pragma unroll
            for (int s = 0; s < 2; ++s) {
                const int kof = mt * 32 + s * 16 + hi * 4;
                { const LAS unsigned char* vp = vb_ + ((kvh * 64 + ql) * A_VROW + kof) * 2; const u32x2 lo = *(const LAS u32x2*)vp, hi2 = *(const LAS u32x2*)(vp + 16);
                  const v4u vv = {lo.x, lo.y, hi2.x, hi2.y}; o0 = __builtin_amdgcn_mfma_f32_32x32x16_bf16(__builtin_bit_cast(bf16x8, vv), pb[mt][s], o0, 0, 0, 0); }
                { const LAS unsigned char* vp = vb_ + ((kvh * 64 + 32 + ql) * A_VROW + kof) * 2; const u32x2 lo = *(const LAS u32x2*)vp, hi2 = *(const LAS u32x2*)(vp + 16);
                  const v4u vv = {lo.x, lo.y, hi2.x, hi2.y}; o1 = __builtin_amdgcn_mfma_f32_32x32x16_bf16(__builtin_bit_cast(bf16x8, vv), pb[mt][s], o1, 0, 0, 0); }
            }
        if (more) ATT_LWRITE(cur ^ 1);
        mw = mw_next;
        __syncthreads();
    }
#undef ATT_GLOAD
#undef ATT_LWRITE
    const float l_tot = l_run + __shfl_xor(l_run, 32), inv = 1.0f / l_tot;
    LAS unsigned char* ost = C.lds + A_OST + wave * (32 * A_OROW * 2);
#pragma unroll
    for (int r = 0; r < 16; r += 2) { const int d = crow(r, hi);
        *(LAS unsigned*)(ost + (ql * A_OROW + d) * 2) = pk2(o0[r] * inv, o0[r + 1] * inv);
        *(LAS unsigned*)(ost + (ql * A_OROW + 32 + d) * 2) = pk2(o1[r] * inv, o1[r + 1] * inv); }
    LDS_WAIT(); asm volatile("" ::: "memory");
#pragma unroll
    for (int x = 0; x < 4; ++x) { const int pid = lane + 64 * x, q = pid >> 3, c = pid & 7; const v4u v = *(const LAS v4u*)(ost + (q * A_OROW + c * 8) * 2);
        *(v4u*)(MIX + ((size_t)b * SEQ + t0 + q) * DM + wave * 64 + c * 8) = v; }
    LDS_WAIT(); asm volatile("" ::: "memory");
}
constexpr int H_QROW = 136, H_TROW = 72, H_OROW = 132;
constexpr int H_QD = 0, H_KD = H_QD + 64 * H_QROW * 2, H_KLT = H_KD + 64 * H_QROW * 2, H_VTL = H_KLT + 128 * H_TROW * 2, H_AT = H_VTL + 128 * H_TROW * 2,
              H_OT = H_AT + 64 * H_TROW * 2, H_PART = H_OT + 64 * H_OROW * 4, H_DK = H_PART + 4 * 128 * 4, H_END = H_DK + 512;
static_assert(H_END <= LDSCTL_OFF, "hgrn lds");
__device__ __forceinline__ unsigned cvtpk(float lo, float hi) { typedef float f2_ __attribute__((ext_vector_type(2))); typedef __bf16 b2_ __attribute__((ext_vector_type(2))); f2_ v = {lo, hi}; b2_ b = __builtin_convertvector(v, b2_); return __builtin_bit_cast(unsigned, b); }
__device__ __forceinline__ bf16x8 pack8(const f32x4& a, const f32x4& b) { v4u w; w.x = cvtpk(a[0], a[1]); w.y = cvtpk(a[2], a[3]); w.z = cvtpk(b[0], b[1]); w.w = cvtpk(b[2], b[3]); return __builtin_bit_cast(bf16x8, w); }
__device__ __forceinline__ void hgrn_unit(Ctx& C, int b, int h) {
    const bf16* Rq = (const bf16*)(C.ws + WS_RQ); const bf16* Rf = (const bf16*)(C.ws + WS_RF); const bf16* Ri = (const bf16*)(C.ws + WS_RI); const bf16* Rg = (const bf16*)(C.ws + WS_RGT);
    bf16* MIX = (bf16*)(C.ws + WS_MIX);
    int tid = C.tid, wave = C.wave; asm volatile("" : "+v"(tid), "+s"(wave));
    const int lane = tid & 63, l15 = lane & 15, g = lane >> 4;
    LAS unsigned char* L = C.lds;
    LAS bf16* QD = (LAS bf16*)(L + H_QD); LAS bf16* KD = (LAS bf16*)(L + H_KD); LAS bf16* KLT = (LAS bf16*)(L + H_KLT); LAS bf16* VTL = (LAS bf16*)(L + H_VTL);
    LAS bf16* AT = (LAS bf16*)(L + H_AT); LAS float* OT = (LAS float*)(L + H_OT); LAS float* PART = (LAS float*)(L + H_PART); LAS float* DK = (LAS float*)(L + H_DK);
    for (int i = tid; i < 64 * H_TROW / 2; i += 512) ((LAS unsigned*)AT)[i] = 0u;
    const int k1 = tid & 127, tq = tid >> 7, s2 = tid >> 3, vg = tid & 7;
    const float l0 = C.in[I_LB][128 * h + k1], l1 = C.in[I_LB][512 + 128 * h + k1];
    const float lb = 1.0f / (1.0f + __expf(l1 - l0)), omlb = 1.0f - lb;
    float gn[16];
#pragma unroll
    for (int i = 0; i < 4; ++i) { const f32x4 v = *(const f32x4*)(C.in[I_RG] + 16 * vg + 4 * i); gn[4 * i] = v[0]; gn[4 * i + 1] = v[1]; gn[4 * i + 2] = v[2]; gn[4 * i + 3] = v[3]; }
    f32x4 S[8];
#pragma unroll
    for (int i = 0; i < 8; ++i) S[i] = (f32x4){0.f, 0.f, 0.f, 0.f};
    const size_t rbase = (size_t)b * SEQ;
    unsigned short nrf[16], nq[16]; v4u nv0, nv1, ng0, ng1;
#define H_LOAD(c) do { const size_t r0_ = rbase + (size_t)(c) * 64; \
        _Pragma("unroll") for (int i = 0; i < 16; ++i) { const size_t o_ = (r0_ + 16 * tq + i) * 512 + 128 * h + k1; nrf[i] = Rf[o_]; nq[i] = Rq[o_]; } \
        const bf16* vp_ = Ri + (r0_ + s2) * 512 + 128 * h + 16 * vg; nv0 = *(const v4u*)vp_; nv1 = *(const v4u*)(vp_ + 8); \
        const bf16* gp_ = Rg + (r0_ + s2) * 512 + 128 * h + 16 * vg; ng0 = *(const v4u*)gp_; ng1 = *(const v4u*)(gp_ + 8); } while (0)
    H_LOAD(0);
#pragma unroll 1
    for (int c = 0; c < 32; ++c) {
        float cs[16], kk[16], qv[16]; float run = 0.f;
#pragma unroll
        for (int i = 0; i < 16; ++i) { const float x = bf2f(nrf[i]); const float sg = __builtin_amdgcn_rcpf(1.0f + __builtin_amdgcn_exp2f(x * -LOG2E)); const float f = lb + omlb * sg;
            run += __builtin_amdgcn_logf(f); cs[i] = run; kk[i] = omlb * (1.0f - sg); qv[i] = bf2f(nq[i]); }
        const v4u cv0 = nv0, cv1 = nv1, g0 = ng0, g1 = ng1;
        PART[tq * 128 + k1] = run;
        __syncthreads();
        if (c + 1 < 32) H_LOAD(c + 1);
        float off = 0.f, blast = 0.f;
#pragma unroll
        for (int j = 0; j < 4; ++j) { const float pj = PART[j * 128 + k1]; blast += pj; off += (j < tq) ? pj : 0.f; }
        {
            float kl[16];
            const float eb = __builtin_amdgcn_exp2f(blast);
#pragma unroll
            for (int i = 0; i < 16; ++i) { const float bt = off + cs[i]; const int t = 16 * tq + i;
                const float qd = qv[i] * __builtin_amdgcn_exp2f(bt), kd = kk[i] * __builtin_amdgcn_exp2f(-bt); const unsigned pw = cvtpk(qd, kd);
                QD[t * H_QROW + k1] = (bf16)(pw & 0xffffu); KD[t * H_QROW + k1] = (bf16)(pw >> 16); kl[i] = kd * eb; }
            v4u w0, w1; w0.x = cvtpk(kl[0], kl[1]); w0.y = cvtpk(kl[2], kl[3]); w0.z = cvtpk(kl[4], kl[5]); w0.w = cvtpk(kl[6], kl[7]);
            w1.x = cvtpk(kl[8], kl[9]); w1.y = cvtpk(kl[10], kl[11]); w1.z = cvtpk(kl[12], kl[13]); w1.w = cvtpk(kl[14], kl[15]);
            *(LAS v4u*)(KLT + k1 * H_TROW + 16 * tq) = w0; *(LAS v4u*)(KLT + k1 * H_TROW + 16 * tq + 8) = w1;
            if (tq == 0) DK[k1] = eb;
        }
        {
            const unsigned vw[8] = {cv0.x, cv0.y, cv0.z, cv0.w, cv1.x, cv1.y, cv1.z, cv1.w};
#pragma unroll
            for (int i = 0; i < 8; ++i) { VTL[(16 * vg + 2 * i) * H_TROW + s2] = (bf16)(vw[i] & 0xffffu); VTL[(16 * vg + 2 * i + 1) * H_TROW + s2] = (bf16)(vw[i] >> 16); }
        }
        __syncthreads();
        f32x4 ao[4];
#pragma unroll
        for (int m = 0; m < 4; ++m) ao[m] = (f32x4){0.f, 0.f, 0.f, 0.f};
#pragma unroll 1
        for (int ti = wave; ti < 10; ti += 8) {
            const int m = (ti >= 6) ? 3 : (ti >= 3) ? 2 : (ti >= 1) ? 1 : 0, n = ti - m * (m + 1) / 2;
            f32x4 d = {0.f, 0.f, 0.f, 0.f};
#pragma unroll
            for (int ks = 0; ks < 4; ++ks) {
                const bf16x8 a = *(const LAS bf16x8*)(QD + (16 * m + l15) * H_QROW + 32 * ks + 8 * g);
                const bf16x8 bb = *(const LAS bf16x8*)(KD + (16 * n + l15) * H_QROW + 32 * ks + 8 * g);
                d = __builtin_amdgcn_mfma_f32_16x16x32_bf16(a, bb, d, 0, 0, 0);
            }
#pragma unroll
            for (int r = 0; r < 4; r += 2) { float v0 = d[r], v1 = d[r + 1]; if (m == n && (4 * g + r) < l15) v0 = 0.f; if (m == n && (4 * g + r + 1) < l15) v1 = 0.f; const unsigned pw = cvtpk(v0, v1);
                AT[(16 * m + 4 * g + r) * H_TROW + 16 * n + l15] = (bf16)(pw & 0xffffu); AT[(16 * m + 4 * g + r + 1) * H_TROW + 16 * n + l15] = (bf16)(pw >> 16); }
        }
#pragma unroll
        for (int ks = 0; ks < 4; ++ks) {
            const bf16x8 bfr = pack8(S[2 * ks], S[2 * ks + 1]);
#pragma unroll
            for (int m = 0; m < 4; ++m) {
                const LAS bf16* qp = QD + (16 * m + l15) * H_QROW + 32 * ks + 4 * g;
                const u32x2 lo = *(const LAS u32x2*)qp, hi2 = *(const LAS u32x2*)(qp + 16);
                const v4u av = {lo.x, lo.y, hi2.x, hi2.y};
                ao[m] = __builtin_amdgcn_mfma_f32_16x16x32_bf16(__builtin_bit_cast(bf16x8, av), bfr, ao[m], 0, 0, 0);
            }
        }
        __syncthreads();
        bf16x8 vf[2];
#pragma unroll
        for (int ks = 0; ks < 2; ++ks) vf[ks] = *(const LAS bf16x8*)(VTL + (16 * wave + l15) * H_TROW + 32 * ks + 8 * g);
#pragma unroll
        for (int m = 0; m < 4; ++m)
#pragma unroll
            for (int ks = 0; ks < 2; ++ks) { const bf16x8 a = *(const LAS bf16x8*)(AT + (16 * m + l15) * H_TROW + 32 * ks + 8 * g); ao[m] = __builtin_amdgcn_mfma_f32_16x16x32_bf16(a, vf[ks], ao[m], 0, 0, 0); }
#pragma unroll
        for (int mk = 0; mk < 8; ++mk) {
            const f32x4 dk4 = *(const LAS f32x4*)(DK + 16 * mk + 4 * g); S[mk] = S[mk] * dk4;
#pragma unroll
            for (int ks = 0; ks < 2; ++ks) { const bf16x8 a = *(const LAS bf16x8*)(KLT + (16 * mk + l15) * H_TROW + 32 * ks + 8 * g); S[mk] = __builtin_amdgcn_mfma_f32_16x16x32_bf16(a, vf[ks], S[mk], 0, 0, 0); }
        }
#pragma unroll
        for (int m = 0; m < 4; ++m)
#pragma unroll
            for (int r = 0; r < 4; ++r) OT[(16 * m + 4 * g + r) * H_OROW + 16 * wave + l15] = ao[m][r];
        __syncthreads();
        {
            float o[16]; float ss = 0.f;
#pragma unroll
            for (int i = 0; i < 4; ++i) { const f32x4 v = *(const LAS f32x4*)(OT + s2 * H_OROW + 16 * vg + 4 * i); o[4 * i] = v[0]; o[4 * i + 1] = v[1]; o[4 * i + 2] = v[2]; o[4 * i + 3] = v[3]; ss += (v[0] * v[0] + v[1] * v[1]) + (v[2] * v[2] + v[3] * v[3]); }
            ss += __shfl_xor(ss, 1); ss += __shfl_xor(ss, 2); ss += __shfl_xor(ss, 4);
            const float rs = rsqrtf(ss * (1.0f / 128.0f) + EPS);
            const size_t row = rbase + (size_t)c * 64 + s2;
            const unsigned gw[8] = {g0.x, g0.y, g0.z, g0.w, g1.x, g1.y, g1.z, g1.w};
            v4u w0, w1; unsigned ow[8];
#pragma unroll
            for (int i = 0; i < 8; ++i) ow[i] = cvtpk(o[2 * i] * rs * gn[2 * i] * bflo(gw[i]), o[2 * i + 1] * rs * gn[2 * i + 1] * bfhi(gw[i]));
            w0.x = ow[0]; w0.y = ow[1]; w0.z = ow[2]; w0.w = ow[3]; w1.x = ow[4]; w1.y = ow[5]; w1.z = ow[6]; w1.w = ow[7];
            bf16* op = MIX + row * DM + 512 + 128 * h + 16 * vg; *(v4u*)op = w0; *(v4u*)(op + 8) = w1;
        }
    }
#undef H_LOAD
    float* so = C.out + O_NSP + ((size_t)(b * 4 + h) * 128) * 128;
#pragma unroll
    for (int mk = 0; mk < 8; ++mk)
#pragma unroll
        for (int r = 0; r < 4; ++r) so[(size_t)(16 * mk + 4 * g + r) * 128 + 16 * wave + l15] = S[mk][r];
}

__device__ __forceinline__ void sample_hgrn_unit(Ctx& C, int b, int h) {
    const float* sp = (const float*)(C.ws + WS_SAMP) + S_SP + (size_t)b * 4096; float* mixs = (float*)(C.ws + WS_SAMP) + S_MIX + (size_t)b * 1024;
    const float* S0 = C.in[I_ST] + ((size_t)(b * 4 + h) * 128) * 128; float* S1 = C.out + O_NSS + ((size_t)(b * 4 + h) * 128) * 128;
    LAS float* red = (LAS float*)C.lds;
    int tid = C.tid; asm volatile("" : "+v"(tid));
    const int v4 = tid & 31, kr = tid >> 5;
    const f32x4 vv = *(const f32x4*)(sp + 2376 + 128 * h + 4 * v4);
    f32x4 oacc = {0.f, 0.f, 0.f, 0.f};
#pragma unroll
    for (int i = 0; i < 8; ++i) { const int k = kr + 16 * i; const int c = 128 * h + k;
        const float l0 = C.in[I_LB][c], l1 = C.in[I_LB][512 + c]; const float lb = 1.0f / (1.0f + __expf(l1 - l0));
        const float x = sp[1864 + c], sg = 1.0f / (1.0f + __expf(-x)), f = lb + (1.0f - lb) * sg, kk = (1.0f - lb) * (1.0f - sg), q = sp[1352 + c];
        const f32x4 s0 = *(const f32x4*)(S0 + (size_t)k * 128 + 4 * v4); const f32x4 sn = s0 * f + vv * kk;
        *(f32x4*)(S1 + (size_t)k * 128 + 4 * v4) = sn; oacc = oacc + sn * q; }
    *(LAS f32x4*)(red + kr * 128 + 4 * v4) = oacc;
    __syncthreads();
    if (tid < 128) { float o = 0.f;
#pragma unroll
        for (int j = 0; j < 16; ++j) o += red[j * 128 + tid];
        float ss = wave_sum(o * o); red[2048 + (tid >> 6)] = ss; red[2112 + tid] = o; }
    __syncthreads();
    if (tid < 128) { const float ss = red[2048] + red[2049]; const float o = red[2112 + tid];
        mixs[512 + 128 * h + tid] = o * rsqrtf(ss * (1.0f / 128.0f) + EPS) * C.in[I_RG][tid] * sp[2888 + 128 * h + tid]; }
}

__device__ __forceinline__ void sample_score_unit(Ctx& C, int b, int ch) {
    const float* sp = (const float*)(C.ws + WS_SAMP) + S_SP + (size_t)b * 4096; float* scs = (float*)(C.ws + WS_SAMP) + S_SC + (size_t)b * S_SCROW;
    const int* pt = (const int*)C.in[I_PT] + b * NPAGES;
    int lane = C.lane, wave = C.wave; asm volatile("" : "+v"(lane), "+s"(wave));
    const int dl = lane & 15, kq = lane >> 4;
    float iq[8][4], w[8];
#pragma unroll
    for (int h = 0; h < 8; ++h) { const f32x4 v = *(const f32x4*)(sp + 768 + h * 64 + 4 * dl); iq[h][0] = v[0]; iq[h][1] = v[1]; iq[h][2] = v[2]; iq[h][3] = v[3]; w[h] = sp[1344 + h]; }
#pragma unroll 1
    for (int pg0 = 0; pg0 < 8; pg0 += 4) {
        f32x4 kv[4][4];
#pragma unroll
        for (int p = 0; p < 4; ++p) { const float* kbase = C.in[I_CKI] + (size_t)pt[ch * 8 + pg0 + p] * (PAGE * 64);
#pragma unroll
            for (int it = 0; it < 4; ++it) kv[p][it] = *(const f32x4*)(kbase + (size_t)(wave * 16 + it * 4 + kq) * 64 + 4 * dl); }
#pragma unroll
        for (int p = 0; p < 4; ++p)
#pragma unroll
            for (int it = 0; it < 4; ++it) {
                float sc = 0.f;
#pragma unroll
                for (int h = 0; h < 8; ++h) { float d = (iq[h][0] * kv[p][it][0] + iq[h][1] * kv[p][it][1]) + (iq[h][2] * kv[p][it][2] + iq[h][3] * kv[p][it][3]);
                    d += __shfl_xor(d, 1); d += __shfl_xor(d, 2); d += __shfl_xor(d, 4); d += __shfl_xor(d, 8); sc = fmaf(w[h], fmaxf(d, 0.f), sc); }
                if (dl == 0) scs[(ch * 8 + pg0 + p) * PAGE + wave * 16 + it * 4 + kq] = sc;
            }
    }
    if (ch == 0 && wave == 0) {
        const f32x4 kv = *(const f32x4*)(sp + 1280 + 4 * dl); float sc = 0.f;
#pragma unroll
        for (int h = 0; h < 8; ++h) { float d = (iq[h][0] * kv[0] + iq[h][1] * kv[1]) + (iq[h][2] * kv[2] + iq[h][3] * kv[3]);
            d += __shfl_xor(d, 1); d += __shfl_xor(d, 2); d += __shfl_xor(d, 4); d += __shfl_xor(d, 8); sc = fmaf(w[h], fmaxf(d, 0.f), sc); }
        if (lane == 0) scs[PAST] = sc;
    }
}
__device__ __forceinline__ unsigned mono_key(float v) { const unsigned bits = __builtin_bit_cast(unsigned, v); unsigned m = (bits & 0x80000000u) ? ~bits : (bits | 0x80000000u); if (v == 0.f) m = 0x80000000u; return m; }
__device__ __forceinline__ void sample_attend_unit(Ctx& C, int b) {
    const float* sp = (const float*)(C.ws + WS_SAMP) + S_SP + (size_t)b * 4096; const float* scs = (const float*)(C.ws + WS_SAMP) + S_SC + (size_t)b * S_SCROW;
    float* mixs = (float*)(C.ws + WS_SAMP) + S_MIX + (size_t)b * 1024; const int* pt = (const int*)C.in[I_PT] + b * NPAGES;
    int tid = C.tid, wave = C.wave; asm volatile("" : "+v"(tid), "+s"(wave));
    const int lane = tid & 63;
    LAS unsigned* cnt = (LAS unsigned*)C.lds;
    LAS unsigned* wcnt = cnt + 64;
    LAS int* sel = (LAS int*)(cnt + 128);
    LAS float* lg = (LAS float*)(cnt + 512);
    LAS float* qs = lg + 2048;
    if (tid < 64) cnt[tid] = 0u;
    qs[tid] = sp[tid] * (ATT_SCALE * LOG2E);
    unsigned u[32];
#pragma unroll
    for (int j = 0; j < 32; ++j) u[j] = mono_key(scs[j * 512 + tid]);
    const unsigned uself = mono_key(scs[PAST]);
    __syncthreads();
    unsigned prefix = 0;
#pragma unroll 1
    for (int bit = 31; bit >= 0; --bit) { const unsigned cand = prefix | (1u << bit); int c = 0;
#pragma unroll
        for (int j = 0; j < 32; ++j) { c += __popcll(__ballot(u[j] >= cand)); asm volatile("" : "+s"(c)); }
        if (lane == 0) __hip_atomic_fetch_add(&cnt[31 - bit], (unsigned)c, __ATOMIC_RELAXED, __HIP_MEMORY_SCOPE_WORKGROUP);
        __syncthreads();
        const int tot = (int)cnt[31 - bit] + (uself >= cand ? 1 : 0);
        if (tot >= 256) prefix = cand; }
    const unsigned theta = prefix;
    int cg = 0, ce = 0;
#pragma unroll
    for (int j = 0; j < 32; ++j) { cg += __popcll(__ballot(u[j] > theta)); ce += __popcll(__ballot(u[j] == theta)); asm volatile("" : "+s"(cg), "+s"(ce)); }
    if (lane == 0) { __hip_atomic_fetch_add(&cnt[32], (unsigned)cg, __ATOMIC_RELAXED, __HIP_MEMORY_SCOPE_WORKGROUP); __hip_atomic_fetch_add(&cnt[33], (unsigned)ce, __ATOMIC_RELAXED, __HIP_MEMORY_SCOPE_WORKGROUP); }
    __syncthreads();
    const int cgt = (int)cnt[32] + (uself > theta ? 1 : 0), ceq = (int)cnt[33] + (uself == theta ? 1 : 0), r = 256 - cgt;
    int icut = PAST;
    if (ceq != r) { int lo = 0;
#pragma unroll 1
        for (int bit = 14; bit >= 0; --bit) { const int cc = lo | (1 << bit); int c = 0;
#pragma unroll
            for (int j = 0; j < 32; ++j) { c += __popcll(__ballot(u[j] == theta && (j * 512 + tid) < cc)); asm volatile("" : "+s"(c)); }
            if (lane == 0) __hip_atomic_fetch_add(&cnt[34 + (14 - bit)], (unsigned)c, __ATOMIC_RELAXED, __HIP_MEMORY_SCOPE_WORKGROUP);
            __syncthreads();
            const int tot = (int)cnt[34 + (14 - bit)];
            const int tot2 = tot + ((uself == theta && PAST < cc) ? 1 : 0);
            if (tot2 < r) lo = cc; }
        icut = lo; }
    int mysel = 0;
#pragma unroll
    for (int j = 0; j < 32; ++j) mysel += ((u[j] > theta) || (u[j] == theta && (j * 512 + tid) <= icut)) ? 1 : 0;
    int incl = mysel;
#pragma unroll
    for (int o = 1; o < 64; o <<= 1) { const int v = __shfl_up(incl, o); if (lane >= o) incl += v; }
    if (lane == 63) wcnt[wave] = (unsigned)incl;
    __syncthreads();
    int base = incl - mysel;
    for (int w = 0; w < wave; ++w) base += (int)wcnt[w];
#pragma unroll
    for (int j = 0; j < 32; ++j) if ((u[j] > theta) || (u[j] == theta && (j * 512 + tid) <= icut)) { if (base < 256) sel[base] = j * 512 + tid; ++base; }
    if (tid == 511) { int tot = base; const bool ss = (uself > theta) || (uself == theta && PAST <= icut); if (ss && tot < 256) sel[tot] = PAST; }
    __syncthreads();
    {
        const int i = tid >> 1, kvh = tid & 1, idx = sel[i];
        const float* kp = (idx < PAST) ? C.in[I_CK] + ((size_t)pt[idx >> 7] * PAGE + (idx & 127)) * 128 + kvh * 64 : sp + 512 + kvh * 64;
        float d0 = 0.f, d1 = 0.f, d2 = 0.f, d3 = 0.f;
#pragma unroll
        for (int c = 0; c < 16; ++c) { const f32x4 kv = *(const f32x4*)(kp + 4 * c);
            const LAS float* q0 = qs + (kvh * 4) * 64 + 4 * c;
            d0 += (q0[0] * kv[0] + q0[1] * kv[1]) + (q0[2] * kv[2] + q0[3] * kv[3]);
            d1 += (q0[64] * kv[0] + q0[65] * kv[1]) + (q0[66] * kv[2] + q0[67] * kv[3]);
            d2 += (q0[128] * kv[0] + q0[129] * kv[1]) + (q0[130] * kv[2] + q0[131] * kv[3]);
            d3 += (q0[192] * kv[0] + q0[193] * kv[1]) + (q0[194] * kv[2] + q0[195] * kv[3]); }
        lg[(kvh * 4 + 0) * 256 + i] = d0; lg[(kvh * 4 + 1) * 256 + i] = d1; lg[(kvh * 4 + 2) * 256 + i] = d2; lg[(kvh * 4 + 3) * 256 + i] = d3;
    }
    __syncthreads();
    {
        float v[4]; float mx = -1e30f;
#pragma unroll
        for (int x = 0; x < 4; ++x) { v[x] = lg[wave * 256 + lane + 64 * x]; mx = fmaxf(mx, v[x]); }
#pragma unroll
        for (int o = 1; o < 64; o <<= 1) mx = fmaxf(mx, __shfl_xor(mx, o));
        float s = 0.f;
#pragma unroll
        for (int x = 0; x < 4; ++x) { v[x] = __builtin_amdgcn_exp2f(v[x] - mx); s += v[x]; }
        s = wave_sum(s); const float inv = 1.0f / s;
#pragma unroll
        for (int x = 0; x < 4; ++x) lg[wave * 256 + lane + 64 * x] = v[x] * inv;
    }
    __syncthreads();
    {
        const int kvh = wave >> 2; float o = 0.f;
#pragma unroll 8
        for (int i = 0; i < 256; ++i) { const int idx = sel[i];
            const float* vp = (idx < PAST) ? C.in[I_CV] + ((size_t)pt[idx >> 7] * PAGE + (idx & 127)) * 128 + kvh * 64 : sp + 640 + kvh * 64;
            o = fmaf(lg[wave * 256 + i], vp[lane], o); }
        mixs[wave * 64 + lane] = o;
    }
}

__device__ __forceinline__ void sample_outproj_task(Ctx& C, int tile) {
    float* samp = (float*)(C.ws + WS_SAMP); LAS float* red = (LAS float*)C.lds;
    skinny32<DM, false>(samp + S_MIX, nullptr, C.in[I_WOUT], DM, DM, 32 * tile, red, C.tid, C.lane, C.wave);
#pragma unroll
    for (int x = 0; x < 2; ++x) { const int e = C.tid + 512 * x, i = e >> 5, n = 32 * tile + (e & 31); samp[S_X1 + i * DM + n] = C.in[I_XS][i * DM + n] + sk_get(red, e); }
    __syncthreads();
}
__device__ __forceinline__ void sample_up_task(Ctx& C, int tile) {
    float* samp = (float*)(C.ws + WS_SAMP); LAS float* red = (LAS float*)C.lds; LAS float* rs = red + 9 * 1024 + 64;
    rows_rstd32<DM>(samp + S_X1, rs, C.lane, C.wave);
    skinny32<DM, true>(samp + S_X1, C.in[I_N2G], C.in[I_WUP], FF, FF, 32 * tile, red, C.tid, C.lane, C.wave);
#pragma unroll
    for (int x = 0; x < 2; ++x) { const int e = C.tid + 512 * x, i = e >> 5, n = 32 * tile + (e & 31); const float v = fmaxf(sk_get(red, e) * rs[i], 0.f); samp[S_H + i * FF + n] = v * v; }
    __syncthreads();
}
constexpr int CW_SDN = 8320;
__device__ __forceinline__ void sample_down_partial(Ctx& C) {
    float* samp = (float*)(C.ws + WS_SAMP); LAS float* red = (LAS float*)C.lds; float* part = (float*)(C.ws + WS_SAMP + 5 * MiB);
    const int tile = C.vcu & 31, ks = C.vcu >> 5;
    skinny32<FF, false, 64>(samp + S_H, nullptr, C.in[I_WDN], DM, DM, 32 * tile, red, C.tid, C.lane, C.wave, ks * 512);
#pragma unroll
    for (int x = 0; x < 2; ++x) { const int e = C.tid + 512 * x, i = e >> 5, n = 32 * tile + (e & 31); part[(size_t)ks * 32768 + i * DM + n] = sk_get(red, e); }
    asm volatile("s_waitcnt vmcnt(0)" ::: "memory");
    __syncthreads();
    if (C.tid == 0) { __builtin_amdgcn_fence(__ATOMIC_RELEASE, "agent"); asm volatile("s_waitcnt vmcnt(0)" ::: "memory");
        __hip_atomic_fetch_add((unsigned*)(C.ctl + CW_SDN), 1u, __ATOMIC_RELAXED, __HIP_MEMORY_SCOPE_AGENT); }
    __syncthreads();
}
__device__ __forceinline__ void sample_down_final(Ctx& C, int tile) {
    float* samp = (float*)(C.ws + WS_SAMP); const float* part = (const float*)(C.ws + WS_SAMP + 5 * MiB);
    if (C.tid == 0) { unsigned sp = 0; while (__hip_atomic_load((unsigned*)(C.ctl + CW_SDN), __ATOMIC_RELAXED, __HIP_MEMORY_SCOPE_AGENT) < (unsigned)C.G) { __builtin_amdgcn_s_sleep(4); if (++sp > (1u << 20)) break; }
        __builtin_amdgcn_fence(__ATOMIC_ACQUIRE, "agent"); asm volatile("s_waitcnt vmcnt(0)" ::: "memory"); }
    __syncthreads();
#pragma unroll
    for (int x = 0; x < 2; ++x) { const int e = C.tid + 512 * x, i = e >> 5, n = 32 * tile + (e & 31); float s = samp[S_X1 + i * DM + n];
#pragma unroll
        for (int k = 0; k < 8; ++k) s += __hip_atomic_load(part + (size_t)k * 32768 + i * DM + n, __ATOMIC_RELAXED, __HIP_MEMORY_SCOPE_AGENT);
        C.out[O_YS + i * DM + n] = s; }
}
struct Args { const float* in[18]; float* out; unsigned char* ws; int ph_lo, ph_hi; };
constexpr int N_PHASES = 7;
#ifndef MK_SPLIT
#define MK_SPLIT 0
#endif
__global__ void __launch_bounds__(512, 2) hymba_fwd(Args args) {
    extern __shared__ __attribute__((aligned(16))) unsigned char lds_raw[];
    Ctx C;
    C.lds = (LAS unsigned char*)lds_raw; C.MISC = (volatile LAS unsigned*)(C.lds + MISC_OFF);
    C.tid = threadIdx.x; C.lane = C.tid & 63; C.wave = __builtin_amdgcn_readfirstlane(C.tid >> 6);
    C.G = gridDim.x; { const int bx = blockIdx.x; C.vcu = (C.G % 8 == 0) ? (bx % 8) * (C.G / 8) + bx / 8 : bx; }
    C.ws = args.ws; C.out = args.out; C.ctl = (gu32*)(args.ws + WS_CTL);
#pragma unroll
    for (int i = 0; i < 18; ++i) C.in[i] = args.in[i];
    for (int u = C.tid; u < (LDS_BYTES - LDSCTL_OFF) / 4; u += 512) ((LAS unsigned*)(C.lds + LDSCTL_OFF))[u] = 0u;
    __syncthreads();
    const int lo = args.ph_lo, hi = args.ph_hi;
    XcdBarrier bar; bar.bar = (unsigned*)(C.ctl + CW_BAR); bar.x = 0; bar.st = nullptr;
    if (hi - lo > 1) bar = xcd_barrier_post((unsigned*)(C.ctl + CW_BAR), C.MISC + 8);
#ifndef PH_MASK
#define PH_MASK 0x7f
#endif
#define IN(k) (((PH_MASK >> (k)) & 1) && lo <= (k) && (k) < hi)
#ifndef REP_MASK
#define REP_MASK 0
#endif
#define REPS(k) (((REP_MASK >> (k)) & 1) ? 2 : 1)
#define SEAM(k) do { if (IN(k) && IN((k) + 1)) xcd_barrier(bar); } while (0)

    if (IN(0)) { for (int rep = 0; rep < REPS(0); ++rep) { p0_prologue(C); __syncthreads(); } SEAM(0); }

    if (IN(1)) {
        if (C.vcu < 4) sample_postproj(C, C.vcu * 8 + C.wave);
        __syncthreads();
        pg8::Gemm g{(const pg8::bf16_t*)(C.ws + WS_XB), (const pg8::bf16_t*)(C.ws + WS_W1T), NTOK, INP, DM};
        pg8::StaticOrder S; S.init(NTOK, INP, C.G, (int)blockIdx.x);
        pg8::EpiInProj E{(const float*)(C.ws + WS_RSTD1), (const float*)(C.ws + WS_GAINS),
                         (pg8::bf16_t*)(C.ws + WS_QB), (pg8::bf16_t*)(C.ws + WS_KB), (pg8::bf16_t*)(C.ws + WS_VT), (pg8::bf16_t*)(C.ws + WS_IQB), (pg8::bf16_t*)(C.ws + WS_IKB),
                         (pg8::bf16_t*)(C.ws + WS_RQ), (pg8::bf16_t*)(C.ws + WS_RF), (pg8::bf16_t*)(C.ws + WS_RI), (pg8::bf16_t*)(C.ws + WS_RGT), (float*)(C.ws + WS_IWF),
                         C.out + O_NK, C.out + O_NV, C.out + O_NKI};
        pg8::gemm_phase<pg8::EpiInProj, pg8::StaticOrder, true, true>(C.lds, g, S, E);
#if (REP_MASK >> 1) & 1
        __syncthreads(); pg8::gemm_phase<pg8::EpiInProj, pg8::StaticOrder, true, true>(C.lds, g, S, E);
#endif
        SEAM(1);
    }

    if (IN(2)) {
        constexpr int U_H = 64, U_SH = 128, U_SS = 512, U_SEL = 2048, U_TOT = U_H + U_SH + U_SS + U_SEL;
        for (int rep = 0; rep < REPS(2); ++rep)
        for (int u = q_next(C, CW_Q2 + 128 * rep), un = 0; u < U_TOT; u = un) {
#ifdef NO_QPF
            struct Fin { Ctx& C; int cw; int& un; __device__ __forceinline__ ~Fin() { un = q_next(C, cw); } } fin_{C, CW_Q2 + 128 * rep, un};
#else
            unsigned nx_ = 0; if (C.tid == 0) nx_ = __hip_atomic_fetch_add((unsigned*)(C.ctl + CW_Q2 + 128 * rep), 1u, __ATOMIC_RELAXED, __HIP_MEMORY_SCOPE_AGENT);
            struct Fin { Ctx& C; unsigned& nx; int& un; __device__ __forceinline__ ~Fin() { __syncthreads(); if (C.tid == 0) C.MISC[16] = nx; __syncthreads(); un = (int)C.MISC[16]; } } fin_{C, nx_, un};
#endif
            if (u < U_H) {
#ifndef NO_HGRN
 hgrn_unit(C, u >> 2, u & 3);
#ifdef HGRN_REP
 __syncthreads(); hgrn_unit(C, u >> 2, u & 3);
#endif
#endif
 continue; } u -= U_H;
            if (u < U_SH) {
#ifndef NO_SH
 sample_hgrn_unit(C, u >> 2, u & 3);
#endif
 continue; } u -= U_SH;
            if (u < U_SS) {
#ifndef NO_SS
 sample_score_unit(C, u >> 4, u & 15);
#endif
 continue; } u -= U_SS;
#ifndef NO_SEL
            dsa_select_unit(C, u & 15, 127 - (u >> 4));
#ifdef SEL_REP
            __syncthreads(); dsa_select_unit(C, u & 15, 127 - (u >> 4));
#endif
#endif
        }
        SEAM(2);
    }

    if (IN(3)) {
        constexpr int U_SA = 32, U_AT = 1024, U_TOT = U_SA + U_AT;
        for (int rep = 0; rep < REPS(3); ++rep)
        for (int u = q_next(C, CW_Q3 + 128 * rep), un = 0; u < U_TOT; u = un) {
#ifdef NO_QPF
            struct Fin { Ctx& C; int cw; int& un; __device__ __forceinline__ ~Fin() { un = q_next(C, cw); } } fin_{C, CW_Q3 + 128 * rep, un};
#else
            unsigned nx_ = 0; if (C.tid == 0) nx_ = __hip_atomic_fetch_add((unsigned*)(C.ctl + CW_Q3 + 128 * rep), 1u, __ATOMIC_RELAXED, __HIP_MEMORY_SCOPE_AGENT);
            struct Fin { Ctx& C; unsigned& nx; int& un; __device__ __forceinline__ ~Fin() { __syncthreads(); if (C.tid == 0) C.MISC[16] = nx; __syncthreads(); un = (int)C.MISC[16]; } } fin_{C, nx_, un};
#endif
            if (u < U_SA) {
#ifndef NO_SA
 sample_attend_unit(C, u);
#endif
 continue; } u -= U_SA;
#ifndef NO_AT
            attn_unit(C, u & 15, 63 - (u >> 4));
#endif
        }
        SEAM(3);
    }

    if (IN(4)) {
        if (C.vcu < 32) sample_outproj_task(C, C.vcu);
        __syncthreads();
        pg8::Gemm g{(const pg8::bf16_t*)(C.ws + WS_MIX), (const pg8::bf16_t*)(C.ws + WS_WOT), NTOK, DM, DM};
        pg8::StaticOrder S; S.init(NTOK, DM, C.G, (int)blockIdx.x);
        pg8::EpiOutProj E{C.in[I_XP], C.out + O_Y, (pg8::bf16_t*)(C.ws + WS_X1B), (float*)(C.ws + WS_SSQ2)};
        pg8::gemm_phase<pg8::EpiOutProj, pg8::StaticOrder, true, true>(C.lds, g, S, E);
#if (REP_MASK >> 4) & 1
        __syncthreads(); pg8::gemm_phase<pg8::EpiOutProj, pg8::StaticOrder, true, true>(C.lds, g, S, E);
#endif
        SEAM(4);
    }

    if (IN(5)) {
        if (C.vcu < 128) sample_up_task(C, C.vcu);
        __syncthreads();
        pg8::Gemm g{(const pg8::bf16_t*)(C.ws + WS_X1B), (const pg8::bf16_t*)(C.ws + WS_WUT), NTOK, FF, DM};
        pg8::StaticOrder S; S.init(NTOK, FF, C.G, (int)blockIdx.x);
        pg8::EpiUp E{(const float*)(C.ws + WS_SSQ2), (pg8::bf16_t*)(C.ws + WS_H)};
        pg8::gemm_phase<pg8::EpiUp, pg8::StaticOrder, true, true>(C.lds, g, S, E);
#if (REP_MASK >> 5) & 1
        __syncthreads(); pg8::gemm_phase<pg8::EpiUp, pg8::StaticOrder, true, true>(C.lds, g, S, E);
#endif
        SEAM(5);
    }

    if (IN(6)) {
        sample_down_partial(C);
        __syncthreads();
        pg8::Gemm g{(const pg8::bf16_t*)(C.ws + WS_H), (const pg8::bf16_t*)(C.ws + WS_WDT), NTOK, DM, FF};
        pg8::StaticOrder S; S.init(NTOK, DM, C.G, (int)blockIdx.x);
        pg8::EpiDown E{C.out + O_Y};
        pg8::gemm_phase<pg8::EpiDown, pg8::StaticOrder, true, true>(C.lds, g, S, E);
        if (C.vcu < 32) sample_down_final(C, C.vcu);
    }
#undef IN
#undef SEAM
}

extern "C" void kernel_launch(void* const* d_in, const int* in_sizes, int n_in, void* d_out, int out_size, void* d_ws, size_t ws_size, hipStream_t stream) {
    static int grid = 0;
    if (grid == 0) {
        if (n_in != 18 || in_sizes[0] != NTOK * DM || (size_t)out_size != O_END || ws_size < WS_END) {
            fprintf(stderr, "kernel_launch: unexpected shapes: n_in %d in0 %d out %d ws %zu (need ws >= %zu); nothing launched\n", n_in, n_in > 0 ? in_sizes[0] : -1, out_size, ws_size, (size_t)WS_END); grid = -1; return; }
        int dev = 0, cus = 0;
        if (hipGetDevice(&dev) != hipSuccess || hipDeviceGetAttribute(&cus, hipDeviceAttributeMultiprocessorCount, dev) != hipSuccess) { grid = -1; return; }
        if (hipFuncSetAttribute((const void*)hymba_fwd, hipFuncAttributeMaxDynamicSharedMemorySize, LDS_BYTES) != hipSuccess) { fprintf(stderr, "kernel_launch: hipFuncSetAttribute failed\n"); grid = -1; return; }
        int per_cu = 0;
        if (hipOccupancyMaxActiveBlocksPerMultiprocessor(&per_cu, (const void*)hymba_fwd, 512, LDS_BYTES) != hipSuccess || per_cu < 1) fprintf(stderr, "kernel_launch: occupancy query says %d\n", per_cu);
        (void)hipGetLastError();
        grid = cus;
        if (grid != 256) fprintf(stderr, "kernel_launch: %d CUs (expected 256)\n", grid);
    }
    if (grid < 0) return;
    (void)hipMemsetAsync((char*)d_ws + WS_CTL, 0, CTL_ZERO_BYTES, stream);
    Args a{};
    for (int i = 0; i < 18; ++i) a.in[i] = (const float*)d_in[i];
    a.out = (float*)d_out; a.ws = (unsigned char*)d_ws;
#if MK_SPLIT
    for (int p = 0; p < N_PHASES; ++p) { a.ph_lo = p; a.ph_hi = p + 1; hipLaunchKernelGGL(hymba_fwd, dim3(grid), dim3(512), LDS_BYTES, stream, a); }
#else
    a.ph_lo = 0; a.ph_hi = N_PHASES; hipLaunchKernelGGL(hymba_fwd, dim3(grid), dim3(512), LDS_BYTES, stream, a);
#endif
}
```

```cpp
#include <hip/hip_runtime.h>
#include <cstdio>
#include <cstdint>

#define LAS __attribute__((address_space(3)))
#define GAS __attribute__((address_space(1)))
typedef float f32x16 __attribute__((ext_vector_type(16)));
typedef unsigned u32x2 __attribute__((ext_vector_type(2)));
typedef unsigned long long u64;

#define RES_BF16 1
constexpr int NTOK = 32768, NB = 16, SEQ = 2048, DM = 1024, NS = 32, PAST = 16384, PAGE = 128, NPAGES = 128;
constexpr int INW = 3400, INP = 3584, FF = 4096;
constexpr float EPS = 1e-6f;
constexpr float ATT_SCALE = 0.125f, LOG2E = 1.4426950408889634f;
constexpr float IDX_W_SCALE = 0.04419417382415922f;
constexpr float REC_QSCALE = 0.08838834764831845f;
enum { I_XP = 0, I_XS, I_CK, I_CV, I_CKI, I_ST, I_PT, I_N1G, I_WIN, I_QG, I_KG, I_IKG, I_LB, I_RG, I_WOUT, I_N2G, I_WUP, I_WDN };
constexpr size_t O_Y = 0, O_YS = 33554432, O_NK = O_YS + 32768, O_NV = O_NK + 4194304, O_NKI = O_NV + 4194304, O_NSP = O_NKI + 2097152,
                 O_NKS = O_NSP + 1048576, O_NVS = O_NKS + 4096, O_NKIS = O_NVS + 4096, O_NSS = O_NKIS + 2048, O_END = O_NSS + 2097152;
constexpr size_t MiB = 1u << 20;
constexpr size_t WS_CTL = 0, CTL_ZERO_BYTES = 65536;
constexpr size_t WS_W1T = 2 * MiB, WS_WOT = 10 * MiB, WS_WUT = 12 * MiB, WS_WDT = 20 * MiB;
constexpr size_t WS_GAINS = 28 * MiB + 512 * 1024;
constexpr size_t WS_RSTD1 = 28 * MiB, WS_IWF = 29 * MiB, WS_SSQ2 = 30 * MiB, WS_SAMP = 32 * MiB;
constexpr size_t WS_XB = 40 * MiB, WS_QB = 104 * MiB, WS_KB = 136 * MiB, WS_VT = 144 * MiB, WS_IQB = 152 * MiB, WS_IKB = 184 * MiB;
constexpr size_t WS_RQ = 188 * MiB, WS_RF = 220 * MiB, WS_RI = 252 * MiB, WS_RGT = 284 * MiB, WS_MASK = 316 * MiB, WS_MIX = 324 * MiB;
constexpr size_t WS_X1B = 388 * MiB, WS_H = 452 * MiB, WS_HST = 708 * MiB, WS_END = 712 * MiB;
constexpr int S_RAW = 0, S_SP = 131072, S_SC = 262144, S_SCROW = 16400, S_MIX = S_SC + 32 * S_SCROW + 256, S_X1 = S_MIX + 32768, S_H = S_X1 + 32768, S_ENDF = S_H + 131072;
static_assert((size_t)S_ENDF * 4 <= 8 * MiB, "sample scratch");
constexpr int CW_BAR = 4096, CW_Q2 = 8192, CW_Q3 = 8192 + 1024;
constexpr int LDS_BYTES = 163840, LDSCTL_OFF = LDS_BYTES - 1024, MISC_OFF = LDSCTL_OFF + 320;

namespace pg8 {
#define PG8_LAS __attribute__((address_space(3)))
typedef unsigned short bf16_t;
typedef short bf16x8 __attribute__((ext_vector_type(8)));
typedef float f32x4 __attribute__((ext_vector_type(4)));
typedef unsigned u32x4 __attribute__((ext_vector_type(4)));
constexpr int BM = 256, BK = 64, HALF = 128, HTB = HALF * BK * 2  , STAGE_BYTES = 8 * HTB, NXCD = 8, WGM = 8;

__host__ __device__ __forceinline__ int lds_byte(int r, int c) { const int st = (r >> 4) * 2 + (c >> 5), rr = r & 15, cc = c & 31, ob = rr * 64 + cc * 2; return st * 1024 + (ob ^ (((ob >> 9) & 1) << 5)); }
__host__ __device__ __forceinline__ void stage_rc(int b, int& R, int& C) { const int st = b / 1024, sb = b % 1024, swz = sb ^ (((sb >> 9) & 1) << 5); R = (st >> 1) * 16 + swz / 64; C = (st & 1) * 32 + (swz % 64) / 2; }
__host__ __device__ __forceinline__ int perm32(int rho) { const int n = rho >> 4, i = rho & 15; return 8 * (i >> 2) + 4 * n + (i & 3); }

struct Unit { int pm, pn; };
struct Gemm { const bf16_t* A; const bf16_t* Bt; int M, N, K; };

struct StaticOrder {
    int nM, nN, nwg, G, c;
    __host__ __device__ void init(int M, int N, int G_, int c_) { nM = M / BM; nN = N / BM; nwg = nM * nN; G = G_; c = c_; }
    __host__ __device__ bool next(int i, Unit& u) const {
        const long L = (long)i * G + c; if (L >= nwg) return false;
        int wgid = (int)L; { const int q = nwg / NXCD, r = nwg % NXCD, xcd = wgid % NXCD, off = wgid / NXCD; wgid = (xcd < r ? xcd * (q + 1) : r * (q + 1) + (xcd - r) * q) + off; }
        const int nig = WGM * nN, gid = wgid / nig, fm = gid * WGM, gsz = (nM - fm) < WGM ? (nM - fm) : WGM;
        u.pm = fm + ((wgid % nig) % gsz); u.pn = (wgid % nig) / gsz; return true;
    }
    __device__ __forceinline__ void a_ready(const Unit&) const {}
    __device__ __forceinline__ void done(const Unit&) const {}
};

__device__ __forceinline__ unsigned cvt_pk_bf16(float lo, float hi) { unsigned r; asm volatile("v_cvt_pk_bf16_f32 %0, %1, %2" : "=v"(r) : "v"(lo), "v"(hi)); return r; }
typedef float f32x2 __attribute__((ext_vector_type(2)));
__device__ __forceinline__ float silu_f(float x) { return x / (1.f + __expf(-x)); }
__device__ __forceinline__ void st_bf16x16(bf16_t* p, const float (&t)[16]) {
    u32x4 a, b;
    a.x = cvt_pk_bf16(t[0], t[1]); a.y = cvt_pk_bf16(t[2], t[3]); a.z = cvt_pk_bf16(t[4], t[5]); a.w = cvt_pk_bf16(t[6], t[7]);
    b.x = cvt_pk_bf16(t[8], t[9]); b.y = cvt_pk_bf16(t[10], t[11]); b.z = cvt_pk_bf16(t[12], t[13]); b.w = cvt_pk_bf16(t[14], t[15]);
    *(u32x4*)p = a; *(u32x4*)(p + 8) = b;
}
__device__ __forceinline__ void st_f32x16(float* p, const float (&t)[16]) {
#pragma unroll
    for (int i = 0; i < 4; ++i) *(f32x4*)(p + 4 * i) = (f32x4){t[4 * i], t[4 * i + 1], t[4 * i + 2], t[4 * i + 3]};
}
__device__ __forceinline__ unsigned short f2bf_rne(float f) { unsigned u = __builtin_bit_cast(unsigned, f); return (unsigned short)((u + 0x7fffu + ((u >> 16) & 1u)) >> 16); }

struct EpiInProj {
    static constexpr bool PERM = false, AFTER_DRAIN = false;
    const float* rstd1; const float* gains;
    bf16_t *Qb, *Kb, *Vt, *IQb, *IKb, *Rq, *Rf, *Ri, *Rg; float* IWf; float *oK, *oV, *oKI;
    __device__ __forceinline__ void operator()(const f32x4 (&acc)[2][2][4][2], const Unit& u, int wr, int wc, int fr, int fq) const {
        const int pn = u.pn;
        const float* gsrc = gains + (pn < 2 ? 0 : (pn == 2 ? 64 : 128)) + 16 * fq;
#pragma unroll
        for (int ai = 0; ai < 2; ++ai)
#pragma unroll
            for (int m = 0; m < 4; ++m) {
                const int row = u.pm * BM + ai * HALF + wr * 64 + m * 16 + fr;
                const float rs = rstd1[row];
                float t[16];
#pragma unroll
                for (int bj = 0; bj < 2; ++bj)
#pragma unroll
                    for (int n = 0; n < 2; ++n)
#pragma unroll
                        for (int e = 0; e < 4; ++e) t[8 * bj + 4 * n + e] = acc[ai][bj][m][n][e] * rs;
                const bool normed = (pn < 2) || (pn == 2 && wc < 2) || (pn == 5 && wc == 0);
                if (normed) {
                    float ss = 0.f;
#pragma unroll
                    for (int j = 0; j < 16; ++j) ss += t[j] * t[j];
                    ss += __shfl_xor(ss, 16); ss += __shfl_xor(ss, 32);
                    float sc = rsqrtf(ss * (1.0f / 64.0f) + EPS);
                    if (pn < 2) sc *= ATT_SCALE * LOG2E;
#pragma unroll
                    for (int i = 0; i < 4; ++i) { const f32x4 gv = *(const f32x4*)(gsrc + 4 * i);
                        t[4 * i] *= sc * gv[0]; t[4 * i + 1] *= sc * gv[1]; t[4 * i + 2] *= sc * gv[2]; t[4 * i + 3] *= sc * gv[3]; }
                }
                if (pn < 2) {
                    st_bf16x16(Qb + (size_t)row * 512 + (4 * pn + wc) * 64 + 16 * fq, t);
                } else if (pn == 2) {
                    if (wc < 2) { st_f32x16(oK + (size_t)row * 128 + wc * 64 + 16 * fq, t); st_bf16x16(Kb + (size_t)row * 128 + wc * 64 + 16 * fq, t); }
                    else {
                        st_f32x16(oV + (size_t)row * 128 + (wc - 2) * 64 + 16 * fq, t);
                        const int b = row >> 11, tt = row & 2047;
                        bf16_t* vp = Vt + ((size_t)(b * 2 + (wc - 2)) * 64 + 16 * fq) * 2048 + tt;
#pragma unroll
                        for (int j = 0; j < 16; ++j) vp[(size_t)j * 2048] = f2bf_rne(t[j]);
                    }
                } else if (pn < 5) {
                    st_bf16x16(IQb + (size_t)row * 512 + (4 * (pn - 3) + wc) * 64 + 16 * fq, t);
                } else if (pn == 5) {
                    if (wc == 0) { st_f32x16(oKI + (size_t)row * 64 + 16 * fq, t); st_bf16x16(IKb + (size_t)row * 64 + 16 * fq, t); }
                    else if (wc == 1 && fq == 0) {
                        *(f32x4*)(IWf + (size_t)row * 8) = (f32x4){t[0] * IDX_W_SCALE, t[1] * IDX_W_SCALE, t[2] * IDX_W_SCALE, t[3] * IDX_W_SCALE};
                        *(f32x4*)(IWf + (size_t)row * 8 + 4) = (f32x4){t[4] * IDX_W_SCALE, t[5] * IDX_W_SCALE, t[6] * IDX_W_SCALE, t[7] * IDX_W_SCALE};
                    }
                } else {
                    const int kind = (pn - 6) >> 1, col = 256 * ((pn - 6) & 1) + 64 * wc + 16 * fq;
                    if (kind == 0) {
#pragma unroll
                        for (int j = 0; j < 16; ++j) t[j] = silu_f(t[j]) * REC_QSCALE;
                        st_bf16x16(Rq + (size_t)row * 512 + col, t);
                    } else if (kind == 1) st_bf16x16(Rf + (size_t)row * 512 + col, t);
                    else if (kind == 2) st_bf16x16(Ri + (size_t)row * 512 + col, t);
                    else {
#pragma unroll
                        for (int j = 0; j < 16; ++j) t[j] = silu_f(t[j]);
                        st_bf16x16(Rg + (size_t)row * 512 + col, t);
                    }
                }
            }
    }
};
struct EpiOutProj {
    static constexpr bool PERM = false, AFTER_DRAIN = false;
    const float* X; float* Y; bf16_t* X1B; float* SSQ2;
    __device__ __forceinline__ void operator()(const f32x4 (&acc)[2][2][4][2], const Unit& u, int wr, int wc, int fr, int fq) const {
        const int col0 = u.pn * BM + wc * 32 + 4 * fq;
#pragma unroll
        for (int ai = 0; ai < 2; ++ai)
#pragma unroll
            for (int m = 0; m < 4; ++m) {
                const int row = u.pm * BM + ai * HALF + wr * 64 + m * 16 + fr; const size_t off = (size_t)row * DM + col0; float ss = 0.f;
#pragma unroll
                for (int bj = 0; bj < 2; ++bj)
#pragma unroll
                    for (int n = 0; n < 2; ++n) {
                        const f32x4 xv = *(const f32x4*)(X + off + bj * HALF + n * 16); const f32x4 o = xv + acc[ai][bj][m][n];
#if !RES_BF16
                        *(f32x4*)(Y + off + bj * HALF + n * 16) = o;
#endif
                        ss += (o[0] * o[0] + o[1] * o[1]) + (o[2] * o[2] + o[3] * o[3]);
                        u32x2 w; w.x = cvt_pk_bf16(o[0], o[1]); w.y = cvt_pk_bf16(o[2], o[3]); *(u32x2*)(X1B + off + bj * HALF + n * 16) = w;
                    }
                ss += __shfl_xor(ss, 16); ss += __shfl_xor(ss, 32);
                if (fq == 0) SSQ2[(size_t)row * 16 + u.pn * 4 + wc] = ss;
            }
    }
};
struct EpiUp {
    static constexpr bool PERM = true, AFTER_DRAIN = false;
    const float* SSQ2; bf16_t* H;
    __device__ __forceinline__ void operator()(const f32x4 (&acc)[2][2][4][2], const Unit& u, int wr, int wc, int fr, int fq) const {
        const int col0 = u.pn * BM + wc * 32 + 8 * fq;
#pragma unroll
        for (int ai = 0; ai < 2; ++ai)
#pragma unroll
            for (int m = 0; m < 4; ++m) {
                const int row = u.pm * BM + ai * HALF + wr * 64 + m * 16 + fr;
                const f32x4 s0 = *(const f32x4*)(SSQ2 + (size_t)row * 16), s1 = *(const f32x4*)(SSQ2 + (size_t)row * 16 + 4), s2 = *(const f32x4*)(SSQ2 + (size_t)row * 16 + 8), s3 = *(const f32x4*)(SSQ2 + (size_t)row * 16 + 12);
                const float ss = (((s0[0] + s0[1]) + (s0[2] + s0[3])) + ((s1[0] + s1[1]) + (s1[2] + s1[3]))) + (((s2[0] + s2[1]) + (s2[2] + s2[3])) + ((s3[0] + s3[1]) + (s3[2] + s3[3])));
                const float rs = rsqrtf(ss * (1.0f / 1024.0f) + EPS);
                bf16_t* rowp = H + (size_t)row * FF + col0;
#pragma unroll
                for (int bj = 0; bj < 2; ++bj) {
                    f32x4 v0 = acc[ai][bj][m][0] * rs, v1 = acc[ai][bj][m][1] * rs;
#pragma unroll
                    for (int e = 0; e < 4; ++e) { const float a = fmaxf(v0[e], 0.f), b = fmaxf(v1[e], 0.f); v0[e] = a * a; v1[e] = b * b; }
                    u32x4 w; w.x = cvt_pk_bf16(v0[0], v0[1]); w.y = cvt_pk_bf16(v0[2], v0[3]); w.z = cvt_pk_bf16(v1[0], v1[1]); w.w = cvt_pk_bf16(v1[2], v1[3]);
                    *(u32x4*)(rowp + bj * HALF) = w;
                }
            }
    }
};
struct EpiDown {
    static constexpr bool PERM = false, AFTER_DRAIN = false;
    float* Y; const bf16_t* X1B;
    __device__ __forceinline__ void operator()(const f32x4 (&acc)[2][2][4][2], const Unit& u, int wr, int wc, int fr, int fq) const {
        const int col0 = u.pn * BM + wc * 32 + 4 * fq;
#pragma unroll
        for (int ai = 0; ai < 2; ++ai)
#pragma unroll
            for (int m = 0; m < 4; ++m) {
                const size_t off = (size_t)(u.pm * BM + ai * HALF + wr * 64 + m * 16 + fr) * DM + col0;
#pragma unroll
                for (int bj = 0; bj < 2; ++bj)
#pragma unroll
                    for (int n = 0; n < 2; ++n) { float* p = Y + off + bj * HALF + n * 16;
#if RES_BF16
                        const u32x2 xw = *(const u32x2*)(X1B + off + bj * HALF + n * 16);
                        const f32x4 x1 = {__builtin_bit_cast(float, xw.x << 16), __builtin_bit_cast(float, xw.x & 0xffff0000u), __builtin_bit_cast(float, xw.y << 16), __builtin_bit_cast(float, xw.y & 0xffff0000u)};
                        *(f32x4*)p = x1 + acc[ai][bj][m][n];
#else
                        *(f32x4*)p = *(const f32x4*)p + acc[ai][bj][m][n];
#endif
                    }
            }
    }
};
template <class Epi, class Sched, bool ALIGN_EPI = false, bool SP2 = false>
__device__ __forceinline__ void gemm_phase(PG8_LAS unsigned char* lds, const Gemm g, const Sched& S, const Epi& E) {
    const int tid = threadIdx.x, wid = __builtin_amdgcn_readfirstlane(tid >> 6), lane = tid & 63, wr = wid >> 2, wc = wid & 3, fr = lane & 15, fq = lane >> 4;
    const int K = g.K, nt = K / BK;
    unsigned voffA[2], voffB[2];
#pragma unroll
    for (int i = 0; i < 2; ++i) { int R, C; stage_rc(tid * 16 + i * 8192, R, C); const int Rb = Epi::PERM ? ((R & ~31) + perm32(R & 31)) : R;
        voffA[i] = (unsigned)(R * K + C) * 2u; voffB[i] = (unsigned)(Rb * K + C) * 2u; }
    const size_t kstep = (size_t)(BK * 2);
    const size_t hstep = (size_t)HALF * K * 2;
    const size_t tstep = 2 * hstep;
    const unsigned ldsw = (unsigned)wid * 1024u;
    const int aoff = lds_byte(wr * 64 + fr, fq * 8), boff = lds_byte(wc * 32 + fr, fq * 8);
#define PG8_SA(b, h) (((b) * 2 + (h)) * HTB)
#define PG8_SB(b, h) ((4 + (b) * 2 + (h)) * HTB)
#define PG8_STAGE(bufoff, gbase, voff) do { _Pragma("unroll") for (int _i = 0; _i < 2; ++_i) \
        __builtin_amdgcn_global_load_lds((const unsigned*)((const char*)(gbase) + (voff)[_i]), (PG8_LAS unsigned*)(lds + (bufoff) + ldsw + _i * 8192), 16, 0, 0); } while (0)
#define PG8_LDA(dst, b, h) do { _Pragma("unroll") for (int m = 0; m < 4; ++m) _Pragma("unroll") for (int k = 0; k < 2; ++k) dst[m][k] = *(const PG8_LAS bf16x8*)(lds + PG8_SA(b, h) + aoff + m * 2048 + k * 1024); } while (0)
#define PG8_LDB(dst, b, h) do { _Pragma("unroll") for (int n = 0; n < 2; ++n) _Pragma("unroll") for (int k = 0; k < 2; ++k) dst[n][k] = *(const PG8_LAS bf16x8*)(lds + PG8_SB(b, h) + boff + n * 2048 + k * 1024); } while (0)
#define PG8_MMA(ai, bj, At, Bt) do { __builtin_amdgcn_s_setprio(1); _Pragma("unroll") for (int m = 0; m < 4; ++m) _Pragma("unroll") for (int n = 0; n < 2; ++n) _Pragma("unroll") for (int k = 0; k < 2; ++k) \
        acc[ai][bj][m][n] = __builtin_amdgcn_mfma_f32_16x16x32_bf16(Bt[n][k], At[m][k], acc[ai][bj][m][n], 0, 0, 0); __builtin_amdgcn_s_setprio(0); } while (0)
#define PG8_WAIT_V(n) asm volatile("s_waitcnt vmcnt(" #n ")" ::: "memory")
#define PG8_WAIT_L(n) asm volatile("s_waitcnt lgkmcnt(" #n ")" ::: "memory")
#define PG8_BAR __builtin_amdgcn_s_barrier()
#define PG8_SCHED __builtin_amdgcn_sched_barrier(0)
    Unit cur, nxt; int ui = 0;
    if (!S.next(0, cur)) return;
    f32x4 acc[2][2][4][2];
#pragma unroll
    for (int a = 0; a < 2; ++a)
#pragma unroll
        for (int b = 0; b < 2; ++b)
#pragma unroll
            for (int m = 0; m < 4; ++m)
#pragma unroll
                for (int n = 0; n < 2; ++n) acc[a][b][m][n] = (f32x4){0.f, 0.f, 0.f, 0.f};
    bf16x8 At[4][2], B0[2][2], B1[2][2];
    const char* cA = (const char*)g.A + (size_t)cur.pm * tstep; const char* cB = (const char*)g.Bt + (size_t)cur.pn * tstep;
    S.a_ready(cur);
    if constexpr (SP2) {
        PG8_STAGE(PG8_SB(0, 0), cB, voffB); PG8_STAGE(PG8_SB(0, 1), cB + hstep, voffB); PG8_STAGE(PG8_SA(0, 0), cA, voffA); PG8_STAGE(PG8_SA(0, 1), cA + hstep, voffA);
        if (wr == 1) PG8_BAR;
        PG8_WAIT_V(2); PG8_BAR;
        PG8_STAGE(PG8_SB(1, 0), cB + kstep, voffB); PG8_STAGE(PG8_SA(1, 0), cA + kstep, voffA); PG8_STAGE(PG8_SB(1, 1), cB + hstep + kstep, voffB);
        PG8_WAIT_V(6); PG8_BAR;
    } else {
        PG8_STAGE(PG8_SB(0, 0), cB, voffB); PG8_STAGE(PG8_SA(0, 0), cA, voffA); PG8_STAGE(PG8_SB(0, 1), cB + hstep, voffB); PG8_STAGE(PG8_SA(0, 1), cA + hstep, voffA);
        if (wr == 1) PG8_BAR;
        PG8_WAIT_V(4); PG8_BAR;
        PG8_STAGE(PG8_SB(1, 0), cB + kstep, voffB); PG8_STAGE(PG8_SA(1, 0), cA + kstep, voffA); PG8_STAGE(PG8_SB(1, 1), cB + hstep + kstep, voffB);
        PG8_WAIT_V(6); PG8_BAR;
    }
    for (;;) {
        const bool has_next = S.next(ui + 1, nxt);
        const char* nA = has_next ? (const char*)g.A + (size_t)nxt.pm * tstep : cA; const char* nB = has_next ? (const char*)g.Bt + (size_t)nxt.pn * tstep : cB;
        for (int t = 0; t < nt; t += 2) {
            const bool last = (t == nt - 2);
            const char* a1 = cA + (size_t)(t + 1) * kstep;
            const char* a2 = last ? nA : cA + (size_t)(t + 2) * kstep; const char* b2 = last ? nB : cB + (size_t)(t + 2) * kstep;
            const char* a3 = a2 + kstep; const char* b3 = b2 + kstep;
            if (last && has_next) S.a_ready(nxt);
            if constexpr (SP2) {
            PG8_LDB(B0, 0, 0); PG8_LDB(B1, 0, 1); PG8_SCHED; PG8_LDA(At, 0, 0); PG8_STAGE(PG8_SA(1, 1), a1 + hstep, voffA);
            PG8_WAIT_V(8); PG8_WAIT_L(0); PG8_BAR; PG8_MMA(0, 0, At, B0); PG8_MMA(0, 1, At, B1); PG8_BAR; PG8_SCHED;
            PG8_LDA(At, 0, 1); PG8_STAGE(PG8_SB(0, 0), b2, voffB); PG8_STAGE(PG8_SB(0, 1), b2 + hstep, voffB); PG8_STAGE(PG8_SA(0, 0), a2, voffA);
            PG8_WAIT_V(8); PG8_WAIT_L(0); PG8_BAR; PG8_MMA(1, 0, At, B0); PG8_MMA(1, 1, At, B1); PG8_BAR; PG8_SCHED;
            PG8_LDB(B0, 1, 0); PG8_LDB(B1, 1, 1); PG8_SCHED; PG8_LDA(At, 1, 0); PG8_STAGE(PG8_SA(0, 1), a2 + hstep, voffA);
            PG8_WAIT_V(8); PG8_WAIT_L(0); PG8_BAR; PG8_MMA(0, 0, At, B0); PG8_MMA(0, 1, At, B1); PG8_BAR; PG8_SCHED;
            PG8_LDA(At, 1, 1); PG8_STAGE(PG8_SB(1, 0), b3, voffB); PG8_STAGE(PG8_SB(1, 1), b3 + hstep, voffB); PG8_STAGE(PG8_SA(1, 0), a3, voffA);
            PG8_WAIT_V(8); PG8_WAIT_L(0); PG8_BAR; PG8_MMA(1, 0, At, B0); PG8_MMA(1, 1, At, B1); PG8_BAR; PG8_SCHED;
            } else {
            PG8_LDB(B0, 0, 0); PG8_SCHED; PG8_LDA(At, 0, 0); PG8_STAGE(PG8_SA(1, 1), a1 + hstep, voffA);
            PG8_WAIT_L(8); PG8_BAR; PG8_WAIT_L(0); PG8_MMA(0, 0, At, B0); PG8_BAR; PG8_SCHED;
            PG8_LDB(B1, 0, 1); PG8_STAGE(PG8_SB(0, 0), b2, voffB);
            PG8_BAR; PG8_WAIT_L(0); PG8_MMA(0, 1, At, B1); PG8_BAR;
            PG8_LDA(At, 0, 1); PG8_STAGE(PG8_SA(0, 0), a2, voffA);
            PG8_BAR; PG8_WAIT_L(0); PG8_MMA(1, 0, At, B0); PG8_BAR; PG8_SCHED;
            PG8_STAGE(PG8_SB(0, 1), b2 + hstep, voffB);
            PG8_WAIT_V(6); PG8_BAR; PG8_MMA(1, 1, At, B1); PG8_BAR;
            PG8_LDB(B0, 1, 0); PG8_SCHED; PG8_LDA(At, 1, 0); PG8_STAGE(PG8_SA(0, 1), a2 + hstep, voffA);
            PG8_WAIT_L(8); PG8_BAR; PG8_WAIT_L(0); PG8_MMA(0, 0, At, B0); PG8_BAR; PG8_SCHED;
            PG8_LDB(B1, 1, 1); PG8_STAGE(PG8_SB(1, 0), b3, voffB);
            PG8_BAR; PG8_WAIT_L(0); PG8_MMA(0, 1, At, B1); PG8_BAR;
            PG8_LDA(At, 1, 1); PG8_STAGE(PG8_SA(1, 0), a3, voffA);
            PG8_BAR; PG8_WAIT_L(0); PG8_MMA(1, 0, At, B0); PG8_BAR; PG8_SCHED;
            PG8_STAGE(PG8_SB(1, 1), b3 + hstep, voffB);
            PG8_WAIT_V(6); PG8_BAR; PG8_MMA(1, 1, At, B1); PG8_BAR;
            }
        }
        if constexpr (ALIGN_EPI) { if (wr == 0) PG8_BAR; }
        if constexpr (!Epi::AFTER_DRAIN) { E(acc, cur, wr, wc, fr, fq); S.done(cur); }
        if (!has_next) break;
#pragma unroll
        for (int a = 0; a < 2; ++a)
#pragma unroll
            for (int b = 0; b < 2; ++b)
#pragma unroll
                for (int m = 0; m < 4; ++m)
#pragma unroll
                    for (int n = 0; n < 2; ++n) acc[a][b][m][n] = (f32x4){0.f, 0.f, 0.f, 0.f};
        cur = nxt; cA = nA; cB = nB; ++ui;
        if constexpr (ALIGN_EPI) { if (wr == 1) PG8_BAR; }
    }
    PG8_WAIT_V(0);
    if constexpr (!ALIGN_EPI) { if (wr == 0) PG8_BAR; }
    PG8_BAR;
    if constexpr (Epi::AFTER_DRAIN) { E.fused(acc, cur, wr, wc, fr, fq, lds, wid, lane); S.done(cur); }
#undef PG8_SA
#undef PG8_SB
#undef PG8_STAGE
#undef PG8_LDA
#undef PG8_LDB
#undef PG8_MMA
#undef PG8_WAIT_V
#undef PG8_WAIT_L
#undef PG8_BAR
#undef PG8_SCHED
}
}
#define XB_TMO      128
#define XB_XCNT(j)  (256  + 64 * (j))
#define XB_XSUB(j)  (1280 + 64 * (j))
#define XB_XGEN(j)  (2304 + 64 * (j))
#define XB_TOP      3328
#define XB_TOPGEN   3392
#define XCD_BAR_WORDS 3456
#define XB_SPIN_CAP (1u << 18)

__device__ __forceinline__ unsigned xb_ld(unsigned* p)              { return __hip_atomic_load(p, __ATOMIC_RELAXED, __HIP_MEMORY_SCOPE_AGENT); }
__device__ __forceinline__ unsigned xb_add(unsigned* p, unsigned v) { return __hip_atomic_fetch_add(p, v, __ATOMIC_RELAXED, __HIP_MEMORY_SCOPE_AGENT); }
__device__ __forceinline__ unsigned xb_xcc_id() { return (unsigned)__builtin_amdgcn_s_getreg((3 << 11) | 20) & 0xFu; }
#define XB_SPIN(cond, bar) do { unsigned _sp = 0; while (cond) { __builtin_amdgcn_s_sleep(1); \
    if ((++_sp & 255u) == 0u) { if (xb_ld(&(bar)[XB_TMO])) break; if (_sp > XB_SPIN_CAP) { atomicAdd(&(bar)[XB_TMO], 1u); break; } } } } while (0)

struct XcdBarrier {
    unsigned* bar; unsigned x;
    volatile LAS unsigned* st;
};

__device__ __forceinline__ XcdBarrier xcd_barrier_post(unsigned* bar, volatile LAS unsigned* st) {
    XcdBarrier b; b.bar = bar; b.x = xb_xcc_id(); b.st = st;
    if (threadIdx.x == 0) (void)xb_add(&bar[XB_XCNT(b.x)], 1u);
    return b;
}
__device__ __forceinline__ void xcd_barrier_complete(unsigned* bar, unsigned x, unsigned& nloc, unsigned& nx) {
    const unsigned G = gridDim.x * gridDim.y * gridDim.z;
    unsigned sum, cnt, mine, sp = 0u;
    for (;;) {
        sum = 0u; cnt = 0u; mine = 0u;
#pragma unroll
        for (unsigned j = 0; j < 16; ++j) { const unsigned c = xb_ld(&bar[XB_XCNT(j)]); sum += c; cnt += (c > 0u) ? 1u : 0u; mine = (j == x) ? c : mine; }
        if (sum == G) break;
        __builtin_amdgcn_s_sleep(1);
        if ((++sp & 255u) == 0u) { if (xb_ld(&bar[XB_TMO])) break; if (sp > XB_SPIN_CAP) { atomicAdd(&bar[XB_TMO], 1u); break; } }
    }
    nloc = mine > 0u ? mine : 1u; nx = cnt > 0u ? cnt : 1u;
}

__device__ __forceinline__ void xcd_barrier(const XcdBarrier& b) {
    asm volatile("s_waitcnt vmcnt(0)" ::: "memory");
    __syncthreads();
    if (threadIdx.x == 0) {
        unsigned* bar = b.bar;
        __builtin_amdgcn_s_waitcnt(0);
        unsigned nloc = b.st[0], nx = b.st[1];
        if (nloc == 0u) { xcd_barrier_complete(bar, b.x, nloc, nx); b.st[0] = nloc; b.st[1] = nx; }
        const unsigned old = xb_add(&bar[XB_XSUB(b.x)], 1u);
        const unsigned gen = old / nloc;
        if (old + 1u == (gen + 1u) * nloc) {
            __builtin_amdgcn_fence(__ATOMIC_RELEASE, "agent");
            asm volatile("s_waitcnt vmcnt(0)" ::: "memory");
            const unsigned og = xb_add(&bar[XB_TOP], 1u);
            const unsigned tg = og / nx;
            if (og + 1u == (tg + 1u) * nx) xb_add(&bar[XB_TOPGEN], 1u);
            else XB_SPIN(xb_ld(&bar[XB_TOPGEN]) == tg, bar);
            __builtin_amdgcn_fence(__ATOMIC_ACQUIRE, "agent");
            xb_add(&bar[XB_XGEN(b.x)], 1u);
            asm volatile("s_waitcnt vmcnt(0)" ::: "memory");
        } else {
            XB_SPIN(xb_ld(&bar[XB_XGEN(b.x)]) == gen, bar);
            __builtin_amdgcn_fence(__ATOMIC_ACQUIRE, "agent");
            asm volatile("s_waitcnt vmcnt(0)" ::: "memory");
        }
    }
    __syncthreads();
}
typedef unsigned short bf16;
typedef unsigned v4u __attribute__((ext_vector_type(4)));
typedef float f32x4 __attribute__((ext_vector_type(4)));
typedef short bf16x8 __attribute__((ext_vector_type(8)));
typedef GAS unsigned gu32;
#define LDS_WAIT() asm volatile("s_waitcnt lgkmcnt(0)" ::: "memory")
__device__ __forceinline__ unsigned f2bf(float f) { unsigned u = __builtin_bit_cast(unsigned, f); return (u + 0x7fffu + ((u >> 16) & 1u)) >> 16; }
__device__ __forceinline__ unsigned pk2(float lo, float hi) { return f2bf(lo) | (f2bf(hi) << 16); }
__device__ __forceinline__ unsigned cvtpk(float lo, float hi) { typedef float f2_ __attribute__((ext_vector_type(2))); typedef __bf16 b2_ __attribute__((ext_vector_type(2))); f2_ v = {lo, hi}; b2_ b = __builtin_convertvector(v, b2_); return __builtin_bit_cast(unsigned, b); }
__device__ __forceinline__ float bf2f(unsigned short h) { return __builtin_bit_cast(float, (unsigned)h << 16); }
__device__ __forceinline__ float bflo(unsigned w) { return __builtin_bit_cast(float, w << 16); }
__device__ __forceinline__ float bfhi(unsigned w) { return __builtin_bit_cast(float, w & 0xffff0000u); }
__device__ __forceinline__ float wave_sum(float v) {
#pragma unroll
    for (int o = 1; o < 64; o <<= 1) v += __shfl_xor(v, o);
    return v;
}
__device__ __forceinline__ float silu_f(float x) { return x / (1.f + __expf(-x)); }
__device__ __forceinline__ int crow(int r, int hi) { return (r & 3) + 8 * (r >> 2) + 4 * hi; }

struct Ctx {
    LAS unsigned char* lds; volatile LAS unsigned* MISC; gu32* ctl;
    int tid, wave, vcu, G;
    const float* in[18]; float* out; unsigned char* ws;
};
__device__ __forceinline__ int q_next(Ctx& C, int cw) {
    __syncthreads();
    if (C.tid == 0) C.MISC[16] = __hip_atomic_fetch_add((unsigned*)(C.ctl + cw), 1u, __ATOMIC_RELAXED, __HIP_MEMORY_SCOPE_AGENT);
    __syncthreads();
    return (int)C.MISC[16];
}

__device__ __forceinline__ int inproj_src(int p) {
    const int pn = p >> 8, q = p & 255;
    const int bj = q >> 7, wc = (q >> 5) & 3, n = (q >> 4) & 1, fq = (q >> 2) & 3, e = q & 3;
    const int lc = 64 * wc + 16 * fq + 8 * bj + 4 * n + e;
    if (pn < 5) return 256 * pn + lc;
    if (pn == 5) return lc < 72 ? 1280 + lc : -1;
    return 1352 + 256 * (pn - 6) + lc;
}
template <bool MAP>
__device__ __forceinline__ void p0_transpose_item(const float* W, int K, int N, int NP, const float* gain, bf16* WT, LAS float* scr, int item, int lane) {
    const int nblk = NP / 32, kb = item / nblk, nb = item % nblk, k0 = 64 * kb, n0 = 32 * nb;
    const int p = n0 + (lane & 31); const int sc = MAP ? inproj_src(p) : p;
#pragma unroll 8
    for (int i = 0; i < 32; ++i) { const int kk = 2 * i + (lane >> 5); float v = 0.f; if (sc >= 0) v = W[(size_t)(k0 + kk) * N + sc]; if (gain) v *= gain[k0 + kk]; scr[kk * 33 + (lane & 31)] = v; }
    LDS_WAIT(); asm volatile("" ::: "memory");
    const int c = lane & 7;
#pragma unroll
    for (int j = 0; j < 4; ++j) { const int n = (lane >> 3) + 8 * j; const LAS float* s = scr + (8 * c) * 33 + n;
        v4u o; o.x = cvtpk(s[0 * 33], s[1 * 33]); o.y = cvtpk(s[2 * 33], s[3 * 33]); o.z = cvtpk(s[4 * 33], s[5 * 33]); o.w = cvtpk(s[6 * 33], s[7 * 33]);
        *(GAS v4u*)(WT + (size_t)(n0 + n) * K + k0 + 8 * c) = o; }
    LDS_WAIT(); asm volatile("" ::: "memory");
}
template <int R>
__device__ __forceinline__ void x_rows_to_bf16(const float* x0, size_t rstride, bf16* o0, float* rstd0, int lane, int nrows) {
    f32x4 v[R][4];
#pragma unroll
    for (int r = 0; r < R; ++r) { const GAS f32x4* xr = (const GAS f32x4*)(x0 + (r < nrows ? r : 0) * rstride * DM) + lane;
#pragma unroll
        for (int j = 0; j < 4; ++j) v[r][j] = xr[64 * j]; }
#pragma unroll
    for (int r = 0; r < R; ++r) if (r < nrows) { float s = 0.f;
#pragma unroll
        for (int j = 0; j < 4; ++j) s += (v[r][j].x * v[r][j].x + v[r][j].y * v[r][j].y) + (v[r][j].z * v[r][j].z + v[r][j].w * v[r][j].w);
        s = wave_sum(s);
        if (lane == 0) rstd0[r * rstride] = rsqrtf(s * (1.0f / DM) + EPS);
        GAS u64* o8 = (GAS u64*)(o0 + r * rstride * DM) + lane;
#pragma unroll
        for (int j = 0; j < 4; ++j) o8[64 * j] = (u64)cvtpk(v[r][j].x, v[r][j].y) | ((u64)cvtpk(v[r][j].z, v[r][j].w) << 32); }
}

template <int K, bool GK, int KW = K / 8>
__device__ __forceinline__ void skinny32(const float* A, const float* gk, const float* W, int ldw, int N, int n0, LAS float* red, int tid, int lane, int wave, int kbase = 0) {
    asm volatile("" : "+v"(tid), "+v"(lane));
    const int i = lane & 31, kh = lane >> 5, n = n0 + i; const bool nok = n < N;
    f32x16 acc = {};
    const int kbeg = kbase + wave * KW, kend = kbeg + KW;
#pragma unroll 1
    for (int kb0 = kbeg; kb0 < kend; kb0 += 64) {
        f32x4 xa[8]; float bw[8][4];
#pragma unroll
        for (int s = 0; s < 8; ++s) { const int kb = kb0 + 8 * s;
            xa[s] = *(const f32x4*)(A + (size_t)i * K + kb + 4 * kh);
            if (GK) { const f32x4 ga = *(const f32x4*)(gk + kb + 4 * kh); xa[s] = xa[s] * ga; }
            const float* wp = W + (size_t)(kb + 4 * kh) * ldw + (nok ? n : 0);
            bw[s][0] = wp[0]; bw[s][1] = wp[ldw]; bw[s][2] = wp[2 * (size_t)ldw]; bw[s][3] = wp[3 * (size_t)ldw]; }
#pragma unroll
        for (int s = 0; s < 8; ++s)
#pragma unroll
            for (int j = 0; j < 4; ++j) acc = __builtin_amdgcn_mfma_f32_32x32x2f32(xa[s][j], nok ? bw[s][j] : 0.f, acc, 0, 0, 0);
    }
#pragma unroll
    for (int r = 0; r < 16; ++r) red[wave * 1024 + crow(r, kh) * 32 + i] = acc[r];
    __syncthreads();
#pragma unroll
    for (int x = 0; x < 2; ++x) { const int e = tid + 512 * x; float s = 0.f;
#pragma unroll
        for (int w = 0; w < 8; ++w) s += red[w * 1024 + e];
        red[8 * 1024 + e] = s; }
    __syncthreads();
}
__device__ __forceinline__ float sk_get(LAS float* red, int e) { return red[8 * 1024 + e]; }
template <int K>
__device__ __forceinline__ void rows_rstd32(const float* A, LAS float* rs, int lane, int wave) {
#pragma unroll
    for (int j = 0; j < 4; ++j) { const int r = wave * 4 + j; float s = 0.f;
        for (int k = lane * 4; k < K; k += 256) { const f32x4 v = *(const f32x4*)(A + (size_t)r * K + k); s += (v[0] * v[0] + v[1] * v[1]) + (v[2] * v[2] + v[3] * v[3]); }
        s = wave_sum(s); if (lane == 0) rs[r] = rsqrtf(s * (1.0f / K) + EPS); }
}

__device__ __forceinline__ void p0_prologue(Ctx& C) {
    LAS float* scr = (LAS float*)(C.lds + C.wave * 16384);
    float* samp = (float*)(C.ws + WS_SAMP);
    if (C.vcu < 107) {
        LAS float* red = (LAS float*)C.lds; LAS float* rs = red + 9 * 1024 + 64;
        rows_rstd32<DM>(C.in[I_XS], rs, (C.tid & 63), C.wave);
        skinny32<DM, true>(C.in[I_XS], C.in[I_N1G], C.in[I_WIN], INW, INW, 32 * C.vcu, red, C.tid, (C.tid & 63), C.wave);
        int tid_ = C.tid; asm volatile("" : "+v"(tid_));
#pragma unroll
        for (int x = 0; x < 2; ++x) { const int e = tid_ + 512 * x, i = e >> 5, n = 32 * C.vcu + (e & 31); if (n < INW) samp[S_RAW + i * INW + n] = sk_get(red, e) * rs[i]; }
        __syncthreads();
    }
    if (C.vcu == 200 && C.tid < 192) ((float*)(C.ws + WS_GAINS))[C.tid] = C.tid < 64 ? C.in[I_QG][C.tid] : (C.tid < 128 ? C.in[I_KG][C.tid - 64] : C.in[I_IKG][C.tid - 128]);
    const int gw = C.vcu * 8 + C.wave, NGW = C.G * 8;
    constexpr int I_1 = (DM / 64) * (INP / 32), I_O = (DM / 64) * (DM / 32), I_U = (DM / 64) * (FF / 32), I_D = (FF / 64) * (DM / 32);
    for (int it = gw; it < I_1 + I_O + I_U + I_D; it += NGW) {
        int r = it;
        if (r < I_1) { p0_transpose_item<true>(C.in[I_WIN], DM, INW, INP, C.in[I_N1G], (bf16*)(C.ws + WS_W1T), scr, r, (C.tid & 63)); continue; } r -= I_1;
        if (r < I_O) { p0_transpose_item<false>(C.in[I_WOUT], DM, DM, DM, nullptr, (bf16*)(C.ws + WS_WOT), scr, r, (C.tid & 63)); continue; } r -= I_O;
        if (r < I_U) { p0_transpose_item<false>(C.in[I_WUP], DM, FF, FF, C.in[I_N2G], (bf16*)(C.ws + WS_WUT), scr, r, (C.tid & 63)); continue; } r -= I_U;
        p0_transpose_item<false>(C.in[I_WDN], FF, DM, DM, nullptr, (bf16*)(C.ws + WS_WDT), scr, r, (C.tid & 63));
    }
    bf16* XB = (bf16*)(C.ws + WS_XB); float* RSTD1 = (float*)(C.ws + WS_RSTD1);
    for (int m = gw; m < NTOK; m += 4 * NGW) x_rows_to_bf16<4>(C.in[I_XP] + (size_t)m * DM, (size_t)NGW, XB + (size_t)m * DM, RSTD1 + m, (C.tid & 63), (NTOK - 1 - m) / NGW + 1);
}

__device__ __forceinline__ void sample_postproj(Ctx& C, int b) {
    const float* raw = (const float*)(C.ws + WS_SAMP) + S_RAW + (size_t)b * INW; float* sp = (float*)(C.ws + WS_SAMP) + S_SP + (size_t)b * 4096;
    const int l = (C.tid & 63);
    for (int h = 0; h < 8; ++h) { const float v = raw[h * 64 + l]; const float ss = wave_sum(v * v); sp[h * 64 + l] = v * rsqrtf(ss * (1.f / 64.f) + EPS) * C.in[I_QG][l]; }
    for (int h = 0; h < 2; ++h) { const float v = raw[512 + h * 64 + l]; const float ss = wave_sum(v * v); const float kn = v * rsqrtf(ss * (1.f / 64.f) + EPS) * C.in[I_KG][l];
        sp[512 + h * 64 + l] = kn; C.out[O_NKS + (size_t)b * 128 + h * 64 + l] = kn; }
    for (int h = 0; h < 2; ++h) { const float v = raw[640 + h * 64 + l]; sp[640 + h * 64 + l] = v; C.out[O_NVS + (size_t)b * 128 + h * 64 + l] = v; }
    for (int j = 0; j < 8; ++j) sp[768 + j * 64 + l] = raw[768 + j * 64 + l];
    { const float v = raw[1280 + l]; const float ss = wave_sum(v * v); const float kn = v * rsqrtf(ss * (1.f / 64.f) + EPS) * C.in[I_IKG][l]; sp[1280 + l] = kn; C.out[O_NKIS + (size_t)b * 64 + l] = kn; }
    if (l < 8) sp[1344 + l] = raw[1344 + l] * IDX_W_SCALE;
    for (int j = 0; j < 8; ++j) { sp[1352 + j * 64 + l] = silu_f(raw[1352 + j * 64 + l]) * REC_QSCALE; sp[1864 + j * 64 + l] = raw[1864 + j * 64 + l]; sp[2376 + j * 64 + l] = raw[2376 + j * 64 + l]; sp[2888 + j * 64 + l] = silu_f(raw[2888 + j * 64 + l]); }
}
constexpr int SROW = 2052, SEL_WS_OFF = 131584;
static_assert(SEL_WS_OFF + 8 * 2048 <= LDSCTL_OFF, "select lds");
template <int CTRL> __device__ __forceinline__ float dppf(float v) { return __builtin_bit_cast(float, __builtin_amdgcn_update_dpp(__builtin_bit_cast(int, v), __builtin_bit_cast(int, v), CTRL, 0xf, 0xf, false)); }
template <int CTRL> __device__ __forceinline__ int dppi(int v) { return __builtin_amdgcn_update_dpp(v, v, CTRL, 0xf, 0xf, false); }
__device__ __forceinline__ float rdl_f(float v, int l) { return __builtin_bit_cast(float, __builtin_amdgcn_readlane(__builtin_bit_cast(int, v), l)); }
__device__ __forceinline__ float wave_min_f(float v) {
    v = fminf(v, dppf<0xB1>(v)); v = fminf(v, dppf<0x4E>(v)); v = fminf(v, dppf<0x141>(v)); v = fminf(v, dppf<0x140>(v));
    return fminf(fminf(rdl_f(v, 0), rdl_f(v, 16)), fminf(rdl_f(v, 32), rdl_f(v, 48)));
}
__device__ __forceinline__ float wave_max_f(float v) {
    v = fmaxf(v, dppf<0xB1>(v)); v = fmaxf(v, dppf<0x4E>(v)); v = fmaxf(v, dppf<0x141>(v)); v = fmaxf(v, dppf<0x140>(v));
    return fmaxf(fmaxf(rdl_f(v, 0), rdl_f(v, 16)), fmaxf(rdl_f(v, 32), rdl_f(v, 48)));
}
__device__ __forceinline__ int row_sum_i(int v) { v += dppi<0xB1>(v); v += dppi<0x4E>(v); v += dppi<0x141>(v); v += dppi<0x140>(v); return v; }
__device__ __forceinline__ int row_suffix_i(int v) {
    v += __builtin_amdgcn_update_dpp(0, v, 0x101, 0xf, 0xf, true); v += __builtin_amdgcn_update_dpp(0, v, 0x102, 0xf, 0xf, true);
    v += __builtin_amdgcn_update_dpp(0, v, 0x104, 0xf, 0xf, true); v += __builtin_amdgcn_update_dpp(0, v, 0x108, 0xf, 0xf, true); return v;
}
__device__ __forceinline__ float relu_f(float x) { return __builtin_amdgcn_fmed3f(x, 0.f, INFINITY); }
__device__ __forceinline__ void dsa_select_unit(Ctx& C, int b, int qb) {
    const bf16* IQb = (const bf16*)(C.ws + WS_IQB); const bf16* IKb = (const bf16*)(C.ws + WS_IKB); const float* IWf = (const float*)(C.ws + WS_IWF);
    u64* MASK = (u64*)(C.ws + WS_MASK);
    LAS float* sc = (LAS float*)C.lds;
    int lane = (C.tid & 63), wave = C.wave; asm volatile("" : "+v"(lane), "+s"(wave));
#ifdef PROBE_SEL
    const unsigned long long ps0_ = __builtin_amdgcn_s_memrealtime(); unsigned long long ps1_ = 0;
#endif
    const int t0 = qb * 16, ntile = qb + 1, ql = lane & 15, g = lane >> 4;
    const size_t rowq = (size_t)b * SEQ + t0 + ql;
    if (t0 + 15 >= 256)
    {
        bf16x8 bq[8][2];
#pragma unroll
        for (int h = 0; h < 8; ++h)
#pragma unroll
            for (int ks = 0; ks < 2; ++ks) bq[h][ks] = *(const bf16x8*)(IQb + rowq * 512 + h * 64 + ks * 32 + g * 8);
        float w[8];
        { const f32x4 w0 = *(const f32x4*)(IWf + rowq * 8), w1 = *(const f32x4*)(IWf + rowq * 8 + 4); w[0] = w0[0]; w[1] = w0[1]; w[2] = w0[2]; w[3] = w0[3]; w[4] = w1[0]; w[5] = w1[1]; w[6] = w1[2]; w[7] = w1[3]; }
        LAS unsigned char* stg = C.lds + SEL_WS_OFF;
        const int tid_ = C.tid, pk0 = tid_ >> 3, pc = tid_ & 7, nround = (ntile + 7) >> 3;
        const bf16* gsrc = IKb + ((size_t)b * SEQ + pk0) * 64 + pc * 8;
        v4u r0 = *(const v4u*)gsrc, r1 = *(const v4u*)(gsrc + 64 * 64);
        const int wo0 = (pk0 * 8 + (pc ^ (pk0 & 7))) * 16, wo1 = ((pk0 + 64) * 8 + (pc ^ (pk0 & 7))) * 16;
        const int ro0 = ((16 * wave + ql) * 8 + (g ^ (ql & 7))) * 16, ro1 = ((16 * wave + ql) * 8 + ((4 + g) ^ (ql & 7))) * 16;
#pragma unroll 1
        for (int rd = 0; rd < nround; ++rd) {
            __syncthreads();
            *(LAS v4u*)(stg + wo0) = r0; *(LAS v4u*)(stg + wo1) = r1;
            if (rd + 1 < nround) { const bf16* gp = gsrc + (size_t)(rd + 1) * 128 * 64; r0 = *(const v4u*)gp; r1 = *(const v4u*)(gp + 64 * 64); }
            __syncthreads();
            const int ii = rd * 8 + wave;
            if (ii < ntile) {
                const bf16x8 a0 = *(const LAS bf16x8*)(stg + ro0), a1 = *(const LAS bf16x8*)(stg + ro1);
                f32x4 I = {0.f, 0.f, 0.f, 0.f};
#pragma unroll
                for (int h = 0; h < 8; ++h) {
                    f32x4 d = __builtin_amdgcn_mfma_f32_16x16x32_bf16(a0, bq[h][0], (f32x4){0.f, 0.f, 0.f, 0.f}, 0, 0, 0);
                    d = __builtin_amdgcn_mfma_f32_16x16x32_bf16(a1, bq[h][1], d, 0, 0, 0);
#pragma unroll
                    for (int r = 0; r < 4; ++r) I[r] = fmaf(w[h], relu_f(d[r]), I[r]);
                }
                *(LAS f32x4*)(sc + ql * SROW + ii * 16 + 4 * g) = I;
            }
        }
    }
    __syncthreads();
#ifdef PROBE_SEL
    ps1_ = __builtin_amdgcn_s_memrealtime();
#endif
#ifdef PROBE_SEL
    unsigned long long sm_t_ = ps1_, sm_acc_ = 0;
#define SELMARK(k) do { const unsigned long long n_ = __builtin_amdgcn_s_memrealtime(); if (PROBE_SEL == (k)) sm_acc_ += n_ - sm_t_; sm_t_ = n_; } while (0)
#else
#define SELMARK(k) do {} while (0)
#endif
    LAS unsigned* hist = (LAS unsigned*)(C.lds + SEL_WS_OFF) + wave * 512;
#ifdef SEL_REP_PICK
    for (int rep_ = 0; rep_ < 2; ++rep_)
#endif
#pragma unroll 1
    for (int qq = 0; qq < 2; ++qq) {
        const int qi = wave * 2 + qq, t = t0 + qi;
        unsigned mylo = 0, myhi = 0;
        if (t < 256) {
            const int lo = 64 * lane;
            const u64 mw_ = (lo > t) ? 0ull : ((lo + 63 <= t) ? ~0ull : ((2ull << (t - lo)) - 1ull));
            mylo = (unsigned)mw_; myhi = (unsigned)(mw_ >> 32);
        } else {
#ifndef SEL_RS
#define SEL_RS 0
#endif
            SELMARK(9);
            float v[32]; const int nj = (t >> 6) + 1;
            float lo = INFINITY, hi = -INFINITY;
#pragma unroll 1
            for (int rr = 0; rr < (SEL_RS == 1 ? 3 : 1); ++rr) { asm volatile("" ::: "memory"); lo = INFINITY; hi = -INFINITY;
#pragma unroll
            for (int j = 0; j < 32; ++j) v[j] = sc[qi * SROW + 64 * j + lane];
#pragma unroll
            for (int j = 0; j < 32; ++j) { const bool ok = (64 * j + lane) <= t; const float xl = ok ? v[j] : INFINITY; v[j] = ok ? v[j] : -INFINITY;
                asm("v_max_f32 %0, %0, %1" : "+v"(hi) : "v"(v[j])); asm("v_min_f32 %0, %0, %1" : "+v"(lo) : "v"(xl)); }
            lo = wave_min_f(lo); hi = wave_max_f(hi); }
            const float scale = (hi > lo) ? 255.99f / (hi - lo) : 0.f;
            SELMARK(4);
            int bn[32];
#pragma unroll 1
            for (int rr = 0; rr < (SEL_RS == 2 ? 3 : 1); ++rr) {
            *(LAS v4u*)(hist + 4 * lane) = (v4u){0u, 0u, 0u, 0u}; *(LAS v4u*)(hist + 256 + 4 * lane) = (v4u){0u, 0u, 0u, 0u};
            LDS_WAIT(); asm volatile("" ::: "memory");
#pragma unroll
            for (int j = 0; j < 32; ++j) { bn[j] = -1; if (j < nj) { int bi = (int)((v[j] - lo) * scale); bi = bi > 255 ? 255 : bi; asm volatile("" : "+v"(bi)); bn[j] = bi;
                if (bi >= 0) __hip_atomic_fetch_add(hist + bi, 1u, __ATOMIC_RELAXED, __HIP_MEMORY_SCOPE_WORKGROUP); } }
            LDS_WAIT(); asm volatile("" ::: "memory"); }
            SELMARK(5);
            const v4u hh = *(const LAS v4u*)(hist + 4 * lane);
            const int s4 = (int)(hh.x + hh.y + hh.z + hh.w);
            const int rsum = row_sum_i(s4);
            const int r0s = __builtin_amdgcn_readlane(rsum, 0), r1s = __builtin_amdgcn_readlane(rsum, 16), r2s = __builtin_amdgcn_readlane(rsum, 32), r3s = __builtin_amdgcn_readlane(rsum, 48);
            int Rs, abv;
            if (r3s >= 256) { Rs = 3; abv = 0; } else if (r3s + r2s >= 256) { Rs = 2; abv = r3s; } else if (r3s + r2s + r1s >= 256) { Rs = 1; abv = r3s + r2s; } else { Rs = 0; abv = r3s + r2s + r1s; }
            (void)r0s;
            const int incl = abv + row_suffix_i(s4);
            const u64 bal = __ballot(((lane >> 4) == Rs) && incl >= 256);
            const int Ls = 63 - __clzll(bal);
            int c = incl - s4, bsel, cab, hsel;
            if (c + (int)hh.w >= 256) { bsel = 3; cab = c; hsel = (int)hh.w; }
            else { c += (int)hh.w; if (c + (int)hh.z >= 256) { bsel = 2; cab = c; hsel = (int)hh.z; }
                else { c += (int)hh.z; if (c + (int)hh.y >= 256) { bsel = 1; cab = c; hsel = (int)hh.y; } else { c += (int)hh.y; bsel = 0; cab = c; hsel = (int)hh.x; } } }
            const int Bs = 4 * Ls + __builtin_amdgcn_readlane(bsel, Ls), cabove = __builtin_amdgcn_readlane(cab, Ls), cntB = __builtin_amdgcn_readlane(hsel, Ls);
            const int r = 256 - cabove;
            SELMARK(6);
#ifdef SEL_FORCE_FALLBACK
            if (cntB <= 64 && t > (SEL_FORCE_FALLBACK)) {
#else
            if (cntB <= 64) {
#endif
#pragma unroll 1
                for (int rr = 0; rr < (SEL_RS == 4 ? 3 : 1); ++rr) { asm volatile("" ::: "memory");
                int cbase = 0;
#pragma unroll
                for (int j = 0; j < 32; ++j) if (j < nj) { const u64 wa = __ballot(bn[j] > Bs);
                    mylo = (lane == j) ? (unsigned)wa : mylo; myhi = (lane == j) ? (unsigned)(wa >> 32) : myhi;
                    const bool isc = bn[j] == Bs; const u64 bm = __ballot(isc);
                    if (bm != 0ull) { const int pos = cbase + (int)__builtin_amdgcn_mbcnt_hi((unsigned)(bm >> 32), __builtin_amdgcn_mbcnt_lo((unsigned)bm, 0u));
                        if (isc) { hist[258 + 2 * pos] = __builtin_bit_cast(unsigned, sc[qi * SROW + 64 * j + lane]); hist[259 + 2 * pos] = (unsigned)(64 * j + lane); }
                        cbase += __popcll(bm); } }
                LDS_WAIT(); asm volatile("" ::: "memory");
                const bool mine = lane < cntB;
                const float cv = mine ? __builtin_bit_cast(float, hist[258 + 2 * lane]) : 0.f; const int ci = mine ? (int)hist[259 + 2 * lane] : 0;
                int rank = 0;
#pragma unroll 1
                for (int j = 0; j < cntB; ++j) { const float x = rdl_f(cv, j); const int y = __builtin_amdgcn_readlane(ci, j); rank += ((x > cv) | ((x == cv) & (y < ci))) ? 1 : 0; }
                if (mine && rank < r) __hip_atomic_fetch_or(hist + 416 + (ci >> 5), 1u << (ci & 31), __ATOMIC_RELAXED, __HIP_MEMORY_SCOPE_WORKGROUP);
                LDS_WAIT(); asm volatile("" ::: "memory"); }
                if (lane < 32) { mylo |= hist[416 + 2 * lane]; myhi |= hist[417 + 2 * lane]; }
            } else {
#ifndef SEL_NO_FALLBACK
                const LAS float* row = sc + qi * SROW;
#define SEL_KEY(j) ({ const float x_ = row[64 * (j) + lane]; const unsigned b_ = __builtin_bit_cast(unsigned, x_); unsigned m_ = (b_ & 0x80000000u) ? ~b_ : (b_ | 0x80000000u); if (x_ == 0.f) m_ = 0x80000000u; ((64 * (j) + lane) <= t) ? m_ : 0u; })
                unsigned prefix = 0;
#pragma unroll 1
                for (int bit = 31; bit >= 0; --bit) { const unsigned cand = prefix | (1u << bit); int cnt = 0;
#pragma unroll 1
                    for (int j = 0; j < nj; ++j) cnt += __popcll(__ballot(SEL_KEY(j) >= cand));
                    if (cnt >= 256) prefix = cand; }
                const unsigned theta = prefix; int cgt = 0, ceq = 0;
#pragma unroll 1
                for (int j = 0; j < nj; ++j) { const unsigned uj = SEL_KEY(j); cgt += __popcll(__ballot(uj > theta)); ceq += __popcll(__ballot(uj == theta)); }
                const int r2 = 256 - cgt; int icut = 2047;
                if (ceq != r2) { int lo2 = 0;
#pragma unroll 1
                    for (int bit = 10; bit >= 0; --bit) { const int cc = lo2 | (1 << bit); int cnt = 0;
#pragma unroll 1
                        for (int j = 0; j < nj; ++j) cnt += __popcll(__ballot(SEL_KEY(j) == theta && (64 * j + lane) < cc));
                        if (cnt < r2) lo2 = cc; }
                    icut = lo2; }
#pragma unroll 1
                for (int j = 0; j < nj; ++j) { const unsigned uj = SEL_KEY(j); const bool sel = (uj > theta) | ((uj == theta) & ((64 * j + lane) <= icut)); const u64 word = __ballot(sel);
                    mylo = (lane == j) ? (unsigned)word : mylo; myhi = (lane == j) ? (unsigned)(word >> 32) : myhi; }
#undef SEL_KEY
#endif
            }
        }
        SELMARK(7);
        if (lane < 32) MASK[((size_t)b * SEQ + t) * 32 + lane] = ((u64)myhi << 32) | mylo;
    }
#ifdef PROBE_SEL
    if (b == 0 && qb == PROBE_SELQ && C.tid == 0) { const unsigned long long ps2_ = __builtin_amdgcn_s_memrealtime(); const float us = (float)(PROBE_SEL == 1 ? ps1_ - ps0_ : PROBE_SEL == 2 ? ps2_ - ps1_ : PROBE_SEL == 3 ? ps2_ - ps0_ : sm_acc_) * 0.01f;
        C.out[O_NKIS] += sqrtf(2048.0f * (1e-4f + 5e-4f * fminf(us / 50.0f, 1.0f))); }
#endif
}

constexpr int A_KROW = 72, A_VROW = 68, A_KT_BYTES = 2 * 64 * A_KROW * 2, A_VT_BYTES = 128 * A_VROW * 2, A_BUF = A_KT_BYTES + A_VT_BYTES, A_OST = 3 * A_BUF, A_OROW = 72;
static_assert(A_OST + 8 * 32 * 72 * 2 <= LDSCTL_OFF, "attention lds");
typedef float f32x2v __attribute__((ext_vector_type(2)));
__device__ __forceinline__ float bfi_f(unsigned m, float a, float b) { float r; asm("v_bfi_b32 %0, %1, %2, %3" : "=v"(r) : "v"(m), "v"(a), "v"(b)); return r; }
__device__ __forceinline__ float max3f(float a, float b, float c) { float r; asm("v_max3_f32 %0, %1, %2, %3" : "=v"(r) : "v"(a), "v"(b), "v"(c)); return r; }
__device__ __forceinline__ void attn_unit(Ctx& C, int b, int qb) {
    const bf16* Qb = (const bf16*)(C.ws + WS_QB); const bf16* Kb = (const bf16*)(C.ws + WS_KB); const bf16* Vt = (const bf16*)(C.ws + WS_VT);
    const u64* MASK = (const u64*)(C.ws + WS_MASK); bf16* MIX = (bf16*)(C.ws + WS_MIX);
    int tid = C.tid, wave = C.wave; asm volatile("" : "+v"(tid), "+s"(wave));
#ifdef PROBE_ATT
    const unsigned long long pt0_ = __builtin_amdgcn_s_memrealtime();
#endif
    const int lane = tid & 63, t0 = qb * 32, nt = qb / 2 + 1, ql = lane & 31, hi = lane >> 5, kvh = wave >> 2;
    const size_t qrow = (size_t)b * SEQ + t0 + ql;
    bf16x8 qf[4];
#pragma unroll
    for (int ks = 0; ks < 4; ++ks) qf[ks] = *(const bf16x8*)(Qb + qrow * 512 + wave * 64 + ks * 16 + hi * 8);
    const u64* mrow = MASK + qrow * 32;
    v4u krA[2], vrA[2], krB[2], vrB[2];
    const bf16* kg_[2]; const bf16* vg_[2]; int kl_[2], vl_[2];
#pragma unroll
    for (int x = 0; x < 2; ++x) { const int pid = tid + 512 * x;
        { const int i = pid >> 4, c16 = pid & 15, kv = c16 >> 3, cc = c16 & 7; kg_[x] = Kb + ((size_t)b * SEQ + i) * 128 + c16 * 8; kl_[x] = ((kv * 64 + i) * A_KROW + cc * 8) * 2; }
        { const int row = pid >> 3, pc = pid & 7; vg_[x] = Vt + ((size_t)b * 128 + row) * SEQ + pc * 8; vl_[x] = A_KT_BYTES + (row * A_VROW + pc * 8) * 2; } }
#define ATT_GLOAD(KR, VR, kt) do { _Pragma("unroll") for (int x = 0; x < 2; ++x) { KR[x] = *(const v4u*)(kg_[x] + (size_t)(kt) * 64 * 128); VR[x] = *(const v4u*)(vg_[x] + (kt) * 64); } } while (0)
#define ATT_LWRITE(KR, VR, boff) do { _Pragma("unroll") for (int x = 0; x < 2; ++x) { *(LAS v4u*)(C.lds + (boff) + kl_[x]) = KR[x]; \
        *(LAS u32x2*)(C.lds + (boff) + vl_[x]) = (u32x2){VR[x].x, VR[x].y}; *(LAS u32x2*)(C.lds + (boff) + vl_[x] + 8) = (u32x2){VR[x].z, VR[x].w}; } } while (0)
#define ATT_QK(boff, P0_, P1_) do { const LAS unsigned char* kb_ = C.lds + (boff); P0_ = (f32x16){}; P1_ = (f32x16){}; \
        _Pragma("unroll") for (int ks = 0; ks < 4; ++ks) { \
            const bf16x8 a0 = *(const LAS bf16x8*)(kb_ + ((kvh * 64 + ql) * A_KROW + ks * 16 + hi * 8) * 2); \
            const bf16x8 a1 = *(const LAS bf16x8*)(kb_ + ((kvh * 64 + 32 + ql) * A_KROW + ks * 16 + hi * 8) * 2); \
            P0_ = __builtin_amdgcn_mfma_f32_32x32x16_bf16(a0, qf[ks], P0_, 0, 0, 0); \
            P1_ = __builtin_amdgcn_mfma_f32_32x32x16_bf16(a1, qf[ks], P1_, 0, 0, 0); } } while (0)
    const int ntm1 = nt - 1;
    ATT_GLOAD(krA, vrA, 0);
    ATT_GLOAD(krB, vrB, (1 < nt ? 1 : ntm1));
    u64 mwA = mrow[0], mwB = mrow[1 < nt ? 1 : ntm1];
    ATT_LWRITE(krA, vrA, 0);
    ATT_GLOAD(krA, vrA, (2 < nt ? 2 : ntm1));
    ATT_LWRITE(krB, vrB, A_BUF);
    ATT_GLOAD(krB, vrB, (3 < nt ? 3 : ntm1));
    __syncthreads();
    float m_run = -1e30f, l_run = 0.f; f32x16 o0 = {}, o1 = {};
    const int sh4 = 4 * hi;
    f32x16 pA0, pA1, pB0, pB1;
    ATT_QK(0, pA0, pA1);
    asm volatile("s_nop 15\n\ts_nop 7" : "+v"(pA0), "+v"(pA1));
    int bo_cur = 0, bo_nxt = A_BUF, bo_wr = 2 * A_BUF;
#define ATT_STEP(kt, PC0, PC1, PN0, PN1, KR, VR, MW_) do { \
        if ((kt) + 1 < nt) ATT_QK(bo_nxt, PN0, PN1); \
        __builtin_amdgcn_sched_barrier(0); \
        const int kt2_ = ((kt) + 2 < nt) ? (kt) + 2 : ntm1; \
        const unsigned mlo = (unsigned)MW_ >> sh4, mhi = (unsigned)(MW_ >> 32) >> sh4; \
        _Pragma("unroll") for (int r = 0; r < 16; ++r) { const int pos_ = crow(r, 0); \
            const unsigned t0_ = 0u - ((mlo >> pos_) & 1u), t1_ = 0u - ((mhi >> pos_) & 1u); \
            PC0[r] = bfi_f(t0_, PC0[r], -1e30f); PC1[r] = bfi_f(t1_, PC1[r], -1e30f); } \
        MW_ = mrow[kt2_]; \
        float mx; { float a_ = max3f(PC0[0], PC0[1], PC0[2]), b_ = max3f(PC1[0], PC1[1], PC1[2]); \
            a_ = max3f(a_, PC0[3], PC0[4]); b_ = max3f(b_, PC1[3], PC1[4]); a_ = max3f(a_, PC0[5], PC0[6]); b_ = max3f(b_, PC1[5], PC1[6]); a_ = max3f(a_, PC0[7], PC0[8]); b_ = max3f(b_, PC1[7], PC1[8]); \
            a_ = max3f(a_, PC0[9], PC0[10]); b_ = max3f(b_, PC1[9], PC1[10]); a_ = max3f(a_, PC0[11], PC0[12]); b_ = max3f(b_, PC1[11], PC1[12]); a_ = max3f(a_, PC0[13], PC0[14]); b_ = max3f(b_, PC1[13], PC1[14]); \
            mx = max3f(a_, b_, PC0[15]); mx = max3f(mx, PC1[15], -1e30f); } \
        mx = fmaxf(mx, __shfl_xor(mx, 32)); \
        const float m_new = fmaxf(m_run, mx), alpha = __builtin_amdgcn_exp2f(m_run - m_new), m_use = fmaxf(m_new, -1e29f); m_run = m_new; \
        f32x2v ls2 = {0.f, 0.f}; const f32x2v mu2 = {m_use, m_use}; \
        _Pragma("unroll") for (int r = 0; r < 16; r += 2) { f32x2v d0 = (f32x2v){PC0[r], PC0[r + 1]} - mu2, d1 = (f32x2v){PC1[r], PC1[r + 1]} - mu2; \
            d0.x = __builtin_amdgcn_exp2f(d0.x); d0.y = __builtin_amdgcn_exp2f(d0.y); d1.x = __builtin_amdgcn_exp2f(d1.x); d1.y = __builtin_amdgcn_exp2f(d1.y); \
            PC0[r] = d0.x; PC0[r + 1] = d0.y; PC1[r] = d1.x; PC1[r + 1] = d1.y; ls2 = ls2 + d0; ls2 = ls2 + d1; } \
        const float ls = ls2.x + ls2.y; \
        l_run = l_run * alpha + ls; \
        { _Pragma("unroll") for (int r = 0; r < 16; ++r) { o0[r] *= alpha; o1[r] *= alpha; } } \
        bf16x8 pb[2][2]; \
        _Pragma("unroll") for (int s = 0; s < 2; ++s) { v4u w0, w1; \
            w0.x = cvtpk(PC0[8 * s + 0], PC0[8 * s + 1]); w0.y = cvtpk(PC0[8 * s + 2], PC0[8 * s + 3]); w0.z = cvtpk(PC0[8 * s + 4], PC0[8 * s + 5]); w0.w = cvtpk(PC0[8 * s + 6], PC0[8 * s + 7]); \
            w1.x = cvtpk(PC1[8 * s + 0], PC1[8 * s + 1]); w1.y = cvtpk(PC1[8 * s + 2], PC1[8 * s + 3]); w1.z = cvtpk(PC1[8 * s + 4], PC1[8 * s + 5]); w1.w = cvtpk(PC1[8 * s + 6], PC1[8 * s + 7]); \
            pb[0][s] = __builtin_bit_cast(bf16x8, w0); pb[1][s] = __builtin_bit_cast(bf16x8, w1); } \
        { const LAS unsigned char* vb_ = C.lds + bo_cur + A_KT_BYTES; \
        _Pragma("unroll") for (int mt = 0; mt < 2; ++mt) _Pragma("unroll") for (int s = 0; s < 2; ++s) { const int kof = mt * 32 + s * 16 + hi * 4; \
            { const LAS unsigned char* vp = vb_ + ((kvh * 64 + ql) * A_VROW + kof) * 2; const u32x2 lo = *(const LAS u32x2*)vp, hi2 = *(const LAS u32x2*)(vp + 16); \
              const v4u vv = {lo.x, lo.y, hi2.x, hi2.y}; o0 = __builtin_amdgcn_mfma_f32_32x32x16_bf16(__builtin_bit_cast(bf16x8, vv), pb[mt][s], o0, 0, 0, 0); } \
            { const LAS unsigned char* vp = vb_ + ((kvh * 64 + 32 + ql) * A_VROW + kof) * 2; const u32x2 lo = *(const LAS u32x2*)vp, hi2 = *(const LAS u32x2*)(vp + 16); \
              const v4u vv = {lo.x, lo.y, hi2.x, hi2.y}; o1 = __builtin_amdgcn_mfma_f32_32x32x16_bf16(__builtin_bit_cast(bf16x8, vv), pb[mt][s], o1, 0, 0, 0); } } } \
        if ((kt) + 2 < nt) ATT_LWRITE(KR, VR, bo_wr); \
        { const int kt4_ = ((kt) + 4 < nt) ? (kt) + 4 : ntm1; ATT_GLOAD(KR, VR, kt4_); } \
        { const int tmp_ = bo_cur; bo_cur = bo_nxt; bo_nxt = bo_wr; bo_wr = tmp_; } \
        __syncthreads(); } while (0)
#pragma unroll 1
    for (int kt = 0; kt < nt; kt += 2) {
        ATT_STEP(kt, pA0, pA1, pB0, pB1, krA, vrA, mwA);
        if (kt + 1 < nt) ATT_STEP(kt + 1, pB0, pB1, pA0, pA1, krB, vrB, mwB);
    }
#undef ATT_STEP
#undef ATT_QK
#undef ATT_GLOAD
#undef ATT_LWRITE
    const float l_tot = l_run + __shfl_xor(l_run, 32);
    const float inv = 1.0f / l_tot;
    LAS unsigned char* ost = C.lds + A_OST + wave * (32 * A_OROW * 2);
#pragma unroll
    for (int r = 0; r < 16; r += 2) { const int d = crow(r, hi);
        *(LAS unsigned*)(ost + (ql * A_OROW + d) * 2) = cvtpk(o0[r] * inv, o0[r + 1] * inv);
        *(LAS unsigned*)(ost + (ql * A_OROW + 32 + d) * 2) = cvtpk(o1[r] * inv, o1[r + 1] * inv); }
    LDS_WAIT(); asm volatile("" ::: "memory");
#pragma unroll
    for (int x = 0; x < 4; ++x) { const int pid = lane + 64 * x, q = pid >> 3, c = pid & 7; const v4u v = *(const LAS v4u*)(ost + (q * A_OROW + c * 8) * 2);
        *(v4u*)(MIX + ((size_t)b * SEQ + t0 + q) * DM + wave * 64 + c * 8) = v; }
    LDS_WAIT(); asm volatile("" ::: "memory");
#ifdef PROBE_ATT
    if (b == 0 && qb == PROBE_ATT && tid == 0) { const float us = (float)(__builtin_amdgcn_s_memrealtime() - pt0_) * 0.01f; C.out[O_NKIS] += sqrtf(2048.0f * (1e-4f + 5e-4f * fminf(us / 100.0f, 1.0f))); }
#endif
}
constexpr int H_QROW = 136, H_TROW = 72, H_OROW = 132;
constexpr int H_QD = 0, H_KD = H_QD + 64 * H_QROW * 2, H_KLT = H_KD + 64 * H_QROW * 2, H_VTL = H_KLT + 128 * H_TROW * 2, H_AT = H_VTL + 128 * H_TROW * 2,
              H_OT = H_AT + 64 * H_TROW * 2, H_PART = H_OT + 64 * H_OROW * 4, H_DK = H_PART + 8 * 128 * 4, H_END = H_DK + 1024;
static_assert(H_END <= LDSCTL_OFF, "hgrn lds");
__device__ __forceinline__ bf16x8 pack8(const f32x4& a, const f32x4& b) { v4u w; w.x = cvtpk(a[0], a[1]); w.y = cvtpk(a[2], a[3]); w.z = cvtpk(b[0], b[1]); w.w = cvtpk(b[2], b[3]); return __builtin_bit_cast(bf16x8, w); }
__device__ __forceinline__ void hgrn_unit(Ctx& C, int b, int h, int part) {
    const bf16* Rq = (const bf16*)(C.ws + WS_RQ); const bf16* Rf = (const bf16*)(C.ws + WS_RF); const bf16* Ri = (const bf16*)(C.ws + WS_RI); const bf16* Rg = (const bf16*)(C.ws + WS_RGT);
    bf16* MIX = (bf16*)(C.ws + WS_MIX);
    int tid = C.tid, wave = C.wave; asm volatile("" : "+v"(tid), "+s"(wave));
#ifdef PROBE_HGRN
    const unsigned long long t_begin_ = __builtin_amdgcn_s_memrealtime();
#endif
    const int lane = tid & 63, l15 = lane & 15, g = lane >> 4;
    LAS unsigned char* L = C.lds;
    LAS bf16* QD = (LAS bf16*)(L + H_QD); LAS bf16* KD = (LAS bf16*)(L + H_KD); LAS bf16* KLT = (LAS bf16*)(L + H_KLT); LAS bf16* VTL = (LAS bf16*)(L + H_VTL);
    LAS bf16* AT = (LAS bf16*)(L + H_AT); LAS float* OT = (LAS float*)(L + H_OT); LAS float* PART = (LAS float*)(L + H_PART); LAS float* DK = (LAS float*)(L + H_DK);
    for (int i = tid; i < 64 * H_TROW / 2; i += 512) ((LAS unsigned*)AT)[i] = 0u;
    const int kp = tid & 63, tg = tid >> 6, k0 = 2 * kp, s2 = tid >> 3, vg = tid & 7;
    float lb0, lb1;
    { const float a0 = C.in[I_LB][128 * h + k0], a1 = C.in[I_LB][512 + 128 * h + k0], b0 = C.in[I_LB][128 * h + k0 + 1], b1 = C.in[I_LB][512 + 128 * h + k0 + 1];
      lb0 = 1.0f / (1.0f + __expf(a1 - a0)); lb1 = 1.0f / (1.0f + __expf(b1 - b0)); }
    LAS float* GN = DK + 128;
    if (tid < 128) GN[tid] = C.in[I_RG][tid];
    f32x4 S[8];
    float* hst = (float*)(C.ws + WS_HST) + ((size_t)(b * 4 + h) * 128) * 128;
#pragma unroll
    for (int i = 0; i < 8; ++i) S[i] = (f32x4){0.f, 0.f, 0.f, 0.f};
    if (part) {
#pragma unroll
        for (int mk = 0; mk < 8; ++mk)
#pragma unroll
            for (int r = 0; r < 4; ++r) S[mk][r] = hst[(size_t)(16 * mk + 4 * g + r) * 128 + 16 * wave + l15];
    }
    const int cbeg = part * 16, cend = cbeg + 16;
    const size_t rbase = (size_t)b * SEQ;
    unsigned nrf[2][8], nq[2][8]; v4u nv0[2], nv1[2];
#define H_LOAD(cc, c) do { const size_t r0_ = rbase + (size_t)(c) * 64; \
        _Pragma("unroll") for (int i = 0; i < 8; ++i) { const size_t o_ = (r0_ + 8 * tg + i) * 512 + 128 * h + k0; nrf[cc][i] = *(const unsigned*)(Rf + o_); nq[cc][i] = *(const unsigned*)(Rq + o_); } \
        const bf16* vp_ = Ri + (r0_ + s2) * 512 + 128 * h + 16 * vg; nv0[cc] = *(const v4u*)vp_; nv1[cc] = *(const v4u*)(vp_ + 8); } while (0)
    H_LOAD(0, cbeg); H_LOAD(1, cbeg + 1);
#ifdef PROBE_SEG
    unsigned long long seg_acc_ = 0, seg_t0_ = 0;
#define SEGMARK(k) do { const unsigned long long now_ = __builtin_amdgcn_s_memrealtime(); if (PROBE_SEG == (k)) seg_acc_ += now_ - seg_t0_; seg_t0_ = now_; } while (0)
#else
#define SEGMARK(k) do {} while (0)
#endif
#pragma unroll 1
    for (int c2 = cbeg; c2 < cend; c2 += 2) {
#pragma unroll
    for (int cc = 0; cc < 2; ++cc) { const int c = c2 + cc;
        SEGMARK(5);
        float cs0[8], cs1[8], kk0[8], kk1[8], qv0[8], qv1[8]; float run0 = 1.f, run1 = 1.f;
#pragma unroll
        for (int i = 0; i < 8; ++i) { const float x0 = bflo(nrf[cc][i]), x1 = bfhi(nrf[cc][i]);
            const float sg0 = __builtin_amdgcn_rcpf(1.0f + __builtin_amdgcn_exp2f(x0 * -LOG2E)), sg1 = __builtin_amdgcn_rcpf(1.0f + __builtin_amdgcn_exp2f(x1 * -LOG2E));
            run0 *= lb0 + (1.0f - lb0) * sg0; run1 *= lb1 + (1.0f - lb1) * sg1; cs0[i] = run0; cs1[i] = run1;
            kk0[i] = (1.0f - lb0) * (1.0f - sg0); kk1[i] = (1.0f - lb1) * (1.0f - sg1); qv0[i] = bflo(nq[cc][i]); qv1[i] = bfhi(nq[cc][i]); }
        const v4u cv0 = nv0[cc], cv1 = nv1[cc];
        const bf16* gp_ = Rg + (rbase + (size_t)c * 64 + s2) * 512 + 128 * h + 16 * vg; const v4u g0 = *(const v4u*)gp_, g1 = *(const v4u*)(gp_ + 8);
        if (c + 2 < cend) H_LOAD(cc, c + 2);
        *(LAS f32x2v*)(PART + tg * 128 + k0) = (f32x2v){run0, run1};
        __syncthreads();
        SEGMARK(1);
        float off0 = 1.f, off1 = 1.f, bl0 = 1.f, bl1 = 1.f;
#pragma unroll
        for (int j = 0; j < 8; ++j) { const f32x2v pj = *(const LAS f32x2v*)(PART + j * 128 + k0); bl0 *= pj.x; bl1 *= pj.y; off0 *= (j < tg) ? pj.x : 1.f; off1 *= (j < tg) ? pj.y : 1.f; }
        {
            float kl0[8], kl1[8];
            const float eb0 = bl0, eb1 = bl1;
#pragma unroll
            for (int i = 0; i < 8; ++i) { const float p0_ = off0 * cs0[i], p1_ = off1 * cs1[i]; const int t = 8 * tg + i;
                const float kd0 = kk0[i] * __builtin_amdgcn_rcpf(p0_), kd1 = kk1[i] * __builtin_amdgcn_rcpf(p1_);
                *(LAS unsigned*)(QD + t * H_QROW + k0) = cvtpk(qv0[i] * p0_, qv1[i] * p1_);
                *(LAS unsigned*)(KD + t * H_QROW + k0) = cvtpk(kd0, kd1); kl0[i] = kd0 * eb0; kl1[i] = kd1 * eb1; }
            v4u w0, w1; w0.x = cvtpk(kl0[0], kl0[1]); w0.y = cvtpk(kl0[2], kl0[3]); w0.z = cvtpk(kl0[4], kl0[5]); w0.w = cvtpk(kl0[6], kl0[7]);
            w1.x = cvtpk(kl1[0], kl1[1]); w1.y = cvtpk(kl1[2], kl1[3]); w1.z = cvtpk(kl1[4], kl1[5]); w1.w = cvtpk(kl1[6], kl1[7]);
            *(LAS v4u*)(KLT + k0 * H_TROW + 8 * tg) = w0; *(LAS v4u*)(KLT + (k0 + 1) * H_TROW + 8 * tg) = w1;
            if (tg == 0) *(LAS f32x2v*)(DK + k0) = (f32x2v){eb0, eb1};
        }
        {
            const unsigned vw[8] = {cv0.x, cv0.y, cv0.z, cv0.w, cv1.x, cv1.y, cv1.z, cv1.w};
#pragma unroll
            for (int i = 0; i < 8; ++i) { VTL[(16 * vg + 2 * i) * H_TROW + s2] = (bf16)(vw[i] & 0xffffu); VTL[(16 * vg + 2 * i + 1) * H_TROW + s2] = (bf16)(vw[i] >> 16); }
        }
        __syncthreads();
        SEGMARK(2);
        f32x4 ao[4];
#pragma unroll
        for (int m = 0; m < 4; ++m) ao[m] = (f32x4){0.f, 0.f, 0.f, 0.f};
#define HSB() __builtin_amdgcn_sched_barrier(0)
#pragma unroll 1
        for (int ti = wave; ti < 10; ti += 8) {
            const int m = (ti >= 6) ? 3 : (ti >= 3) ? 2 : (ti >= 1) ? 1 : 0, n = ti - m * (m + 1) / 2;
            f32x4 d = {0.f, 0.f, 0.f, 0.f};
            bf16x8 fa[4], fb[4];
#pragma unroll
            for (int ks = 0; ks < 4; ++ks) { fa[ks] = *(const LAS bf16x8*)(QD + (16 * m + l15) * H_QROW + 32 * ks + 8 * g); fb[ks] = *(const LAS bf16x8*)(KD + (16 * n + l15) * H_QROW + 32 * ks + 8 * g); }
            HSB();
#pragma unroll
            for (int ks = 0; ks < 4; ++ks) d = __builtin_amdgcn_mfma_f32_16x16x32_bf16(fa[ks], fb[ks], d, 0, 0, 0);
#pragma unroll
            for (int r = 0; r < 4; r += 2) { float v0 = d[r], v1 = d[r + 1]; if (m == n && (4 * g + r) < l15) v0 = 0.f; if (m == n && (4 * g + r + 1) < l15) v1 = 0.f; const unsigned pw = cvtpk(v0, v1);
                AT[(16 * m + 4 * g + r) * H_TROW + 16 * n + l15] = (bf16)(pw & 0xffffu); AT[(16 * m + 4 * g + r + 1) * H_TROW + 16 * n + l15] = (bf16)(pw >> 16); }
        }
        {
            u32x2 ql_[2][4], qh_[2][4];
#define H_QLOAD(buf, ks) do { _Pragma("unroll") for (int m = 0; m < 4; ++m) { const LAS bf16* qp = QD + (16 * m + l15) * H_QROW + 32 * (ks) + 4 * g; ql_[buf][m] = *(const LAS u32x2*)qp; qh_[buf][m] = *(const LAS u32x2*)(qp + 16); } } while (0)
            H_QLOAD(0, 0);
#pragma unroll
            for (int ks = 0; ks < 4; ++ks) {
                if (ks < 3) H_QLOAD((ks + 1) & 1, ks + 1);
                const bf16x8 bfr = pack8(S[2 * ks], S[2 * ks + 1]);
                HSB();
#pragma unroll
                for (int m = 0; m < 4; ++m) { const v4u av = {ql_[ks & 1][m].x, ql_[ks & 1][m].y, qh_[ks & 1][m].x, qh_[ks & 1][m].y};
                    ao[m] = __builtin_amdgcn_mfma_f32_16x16x32_bf16(__builtin_bit_cast(bf16x8, av), bfr, ao[m], 0, 0, 0); }
                HSB();
            }
#undef H_QLOAD
        }
        __syncthreads();
        SEGMARK(3);
        {
            bf16x8 vf[2], fa[4][2];
#pragma unroll
            for (int ks = 0; ks < 2; ++ks) vf[ks] = *(const LAS bf16x8*)(VTL + (16 * wave + l15) * H_TROW + 32 * ks + 8 * g);
#pragma unroll
            for (int m = 0; m < 4; ++m)
#pragma unroll
                for (int ks = 0; ks < 2; ++ks) fa[m][ks] = *(const LAS bf16x8*)(AT + (16 * m + l15) * H_TROW + 32 * ks + 8 * g);
            HSB();
            bf16x8 fk[4][2]; f32x4 dk4[4];
#define H_KLOAD(mk0) do { _Pragma("unroll") for (int x = 0; x < 4; ++x) { dk4[x] = *(const LAS f32x4*)(DK + 16 * ((mk0) + x) + 4 * g); \
                _Pragma("unroll") for (int ks = 0; ks < 2; ++ks) fk[x][ks] = *(const LAS bf16x8*)(KLT + (16 * ((mk0) + x) + l15) * H_TROW + 32 * ks + 8 * g); } } while (0)
#pragma unroll
            for (int m = 0; m < 4; ++m)
#pragma unroll
                for (int ks = 0; ks < 2; ++ks) ao[m] = __builtin_amdgcn_mfma_f32_16x16x32_bf16(fa[m][ks], vf[ks], ao[m], 0, 0, 0);
            HSB();
            H_KLOAD(0);
            HSB();
#pragma unroll
            for (int x = 0; x < 4; ++x) { S[x] = S[x] * dk4[x];
#pragma unroll
                for (int ks = 0; ks < 2; ++ks) S[x] = __builtin_amdgcn_mfma_f32_16x16x32_bf16(fk[x][ks], vf[ks], S[x], 0, 0, 0); }
            HSB();
            H_KLOAD(4);
            HSB();
#pragma unroll
            for (int x = 0; x < 4; ++x) { S[4 + x] = S[4 + x] * dk4[x];
#pragma unroll
                for (int ks = 0; ks < 2; ++ks) S[4 + x] = __builtin_amdgcn_mfma_f32_16x16x32_bf16(fk[x][ks], vf[ks], S[4 + x], 0, 0, 0); }
#undef H_KLOAD
        }
#undef HSB
#pragma unroll
        for (int m = 0; m < 4; ++m)
#pragma unroll
            for (int r = 0; r < 4; ++r) OT[(16 * m + 4 * g + r) * H_OROW + 16 * wave + l15] = ao[m][r];
        __syncthreads();
        SEGMARK(4);
        {
            float o[16]; float ss = 0.f;
#pragma unroll
            for (int i = 0; i < 4; ++i) { const f32x4 v = *(const LAS f32x4*)(OT + s2 * H_OROW + 16 * vg + 4 * i); o[4 * i] = v[0]; o[4 * i + 1] = v[1]; o[4 * i + 2] = v[2]; o[4 * i + 3] = v[3]; ss += (v[0] * v[0] + v[1] * v[1]) + (v[2] * v[2] + v[3] * v[3]); }
            ss += __shfl_xor(ss, 1); ss += __shfl_xor(ss, 2); ss += __shfl_xor(ss, 4);
            const float rs = rsqrtf(ss * (1.0f / 128.0f) + EPS);
            const size_t row = rbase + (size_t)c * 64 + s2;
            const unsigned gw[8] = {g0.x, g0.y, g0.z, g0.w, g1.x, g1.y, g1.z, g1.w};
            v4u w0, w1; unsigned ow[8];
#pragma unroll
            for (int i = 0; i < 8; ++i) { const f32x2v gg = *(const LAS f32x2v*)(GN + 16 * vg + 2 * i); ow[i] = cvtpk(o[2 * i] * rs * gg.x * bflo(gw[i]), o[2 * i + 1] * rs * gg.y * bfhi(gw[i])); }
            w0.x = ow[0]; w0.y = ow[1]; w0.z = ow[2]; w0.w = ow[3]; w1.x = ow[4]; w1.y = ow[5]; w1.z = ow[6]; w1.w = ow[7];
            bf16* op = MIX + row * DM + 512 + 128 * h + 16 * vg; *(v4u*)op = w0; *(v4u*)(op + 8) = w1;
        }
    } }
#undef H_LOAD
#ifdef PROBE_SEG
    if (b == 0 && h == 0 && tid == 0) { const float us = (float)seg_acc_ * 0.01f; C.out[O_NKIS] += sqrtf(2048.0f * (1e-4f + 5e-4f * fminf(us / 100.0f, 1.0f))); }
#endif
#ifdef PROBE_HGRN
    if (b == 0 && h == 0 && tid == 0) { const float us = (float)(__builtin_amdgcn_s_memrealtime() - t_begin_) * 0.01f;
        C.out[O_NKIS] += sqrtf(2048.0f * (1e-4f + 5e-4f * fminf(us / (float)PROBE_HGRN, 1.0f))); }
#endif
    float* so = part ? C.out + O_NSP + ((size_t)(b * 4 + h) * 128) * 128 : hst;
#pragma unroll
    for (int mk = 0; mk < 8; ++mk)
#pragma unroll
        for (int r = 0; r < 4; ++r) so[(size_t)(16 * mk + 4 * g + r) * 128 + 16 * wave + l15] = S[mk][r];
}

__device__ __forceinline__ void sample_hgrn_unit(Ctx& C, int b, int h) {
    const float* sp = (const float*)(C.ws + WS_SAMP) + S_SP + (size_t)b * 4096; float* mixs = (float*)(C.ws + WS_SAMP) + S_MIX + (size_t)b * 1024;
    const float* S0 = C.in[I_ST] + ((size_t)(b * 4 + h) * 128) * 128; float* S1 = C.out + O_NSS + ((size_t)(b * 4 + h) * 128) * 128;
    LAS float* red = (LAS float*)C.lds;
    int tid = C.tid; asm volatile("" : "+v"(tid));
    const int v4 = tid & 31, kr = tid >> 5;
    const f32x4 vv = *(const f32x4*)(sp + 2376 + 128 * h + 4 * v4);
    f32x4 oacc = {0.f, 0.f, 0.f, 0.f};
#pragma unroll
    for (int i = 0; i < 8; ++i) { const int k = kr + 16 * i; const int c = 128 * h + k;
        const float l0 = C.in[I_LB][c], l1 = C.in[I_LB][512 + c]; const float lb = 1.0f / (1.0f + __expf(l1 - l0));
        const float x = sp[1864 + c], sg = 1.0f / (1.0f + __expf(-x)), f = lb + (1.0f - lb) * sg, kk = (1.0f - lb) * (1.0f - sg), q = sp[1352 + c];
        const f32x4 s0 = *(const f32x4*)(S0 + (size_t)k * 128 + 4 * v4); const f32x4 sn = s0 * f + vv * kk;
        *(f32x4*)(S1 + (size_t)k * 128 + 4 * v4) = sn; oacc = oacc + sn * q; }
    *(LAS f32x4*)(red + kr * 128 + 4 * v4) = oacc;
    __syncthreads();
    if (tid < 128) { float o = 0.f;
#pragma unroll
        for (int j = 0; j < 16; ++j) o += red[j * 128 + tid];
        float ss = wave_sum(o * o); red[2048 + (tid >> 6)] = ss; red[2112 + tid] = o; }
    __syncthreads();
    if (tid < 128) { const float ss = red[2048] + red[2049]; const float o = red[2112 + tid];
        mixs[512 + 128 * h + tid] = o * rsqrtf(ss * (1.0f / 128.0f) + EPS) * C.in[I_RG][tid] * sp[2888 + 128 * h + tid]; }
}

__device__ __forceinline__ void sample_score_unit(Ctx& C, int b, int ch) {
    const float* sp = (const float*)(C.ws + WS_SAMP) + S_SP + (size_t)b * 4096; float* scs = (float*)(C.ws + WS_SAMP) + S_SC + (size_t)b * S_SCROW;
    const int* pt = (const int*)C.in[I_PT] + b * NPAGES;
    int lane = (C.tid & 63), wave = C.wave; asm volatile("" : "+v"(lane), "+s"(wave));
    const int dl = lane & 15, kq = lane >> 4;
    float iq[8][4], w[8];
#pragma unroll
    for (int h = 0; h < 8; ++h) { const f32x4 v = *(const f32x4*)(sp + 768 + h * 64 + 4 * dl); iq[h][0] = v[0]; iq[h][1] = v[1]; iq[h][2] = v[2]; iq[h][3] = v[3]; w[h] = sp[1344 + h]; }
#pragma unroll 1
    for (int pg0 = 0; pg0 < 8; pg0 += 4) {
        f32x4 kv[4][4];
#pragma unroll
        for (int p = 0; p < 4; ++p) { const float* kbase = C.in[I_CKI] + (size_t)pt[ch * 8 + pg0 + p] * (PAGE * 64);
#pragma unroll
            for (int it = 0; it < 4; ++it) kv[p][it] = *(const f32x4*)(kbase + (size_t)(wave * 16 + it * 4 + kq) * 64 + 4 * dl); }
#pragma unroll
        for (int p = 0; p < 4; ++p)
#pragma unroll
            for (int it = 0; it < 4; ++it) {
                float sc = 0.f;
#pragma unroll
                for (int h = 0; h < 8; ++h) { float d = (iq[h][0] * kv[p][it][0] + iq[h][1] * kv[p][it][1]) + (iq[h][2] * kv[p][it][2] + iq[h][3] * kv[p][it][3]);
                    d += __shfl_xor(d, 1); d += __shfl_xor(d, 2); d += __shfl_xor(d, 4); d += __shfl_xor(d, 8); sc = fmaf(w[h], fmaxf(d, 0.f), sc); }
                if (dl == 0) scs[(ch * 8 + pg0 + p) * PAGE + wave * 16 + it * 4 + kq] = sc;
            }
    }
    if (ch == 0 && wave == 0) {
        const f32x4 kv = *(const f32x4*)(sp + 1280 + 4 * dl); float sc = 0.f;
#pragma unroll
        for (int h = 0; h < 8; ++h) { float d = (iq[h][0] * kv[0] + iq[h][1] * kv[1]) + (iq[h][2] * kv[2] + iq[h][3] * kv[3]);
            d += __shfl_xor(d, 1); d += __shfl_xor(d, 2); d += __shfl_xor(d, 4); d += __shfl_xor(d, 8); sc = fmaf(w[h], fmaxf(d, 0.f), sc); }
        if (lane == 0) scs[PAST] = sc;
    }
}
__device__ __forceinline__ unsigned mono_key(float v) { const unsigned bits = __builtin_bit_cast(unsigned, v); unsigned m = (bits & 0x80000000u) ? ~bits : (bits | 0x80000000u); if (v == 0.f) m = 0x80000000u; return m; }
__device__ __forceinline__ void sample_attend_unit(Ctx& C, int b) {
    const float* sp = (const float*)(C.ws + WS_SAMP) + S_SP + (size_t)b * 4096; const float* scs = (const float*)(C.ws + WS_SAMP) + S_SC + (size_t)b * S_SCROW;
    float* mixs = (float*)(C.ws + WS_SAMP) + S_MIX + (size_t)b * 1024; const int* pt = (const int*)C.in[I_PT] + b * NPAGES;
    int tid = C.tid, wave = C.wave; asm volatile("" : "+v"(tid), "+s"(wave));
    const int lane = tid & 63;
    LAS unsigned* cnt = (LAS unsigned*)C.lds;
    LAS unsigned* wcnt = cnt + 64;
    LAS int* sel = (LAS int*)(cnt + 128);
    LAS float* lg = (LAS float*)(cnt + 512);
    LAS float* qs = lg + 2048;
    if (tid < 64) cnt[tid] = 0u;
    qs[tid] = sp[tid] * (ATT_SCALE * LOG2E);
    unsigned u[32];
#pragma unroll
    for (int j = 0; j < 32; ++j) u[j] = mono_key(scs[j * 512 + tid]);
    const unsigned uself = mono_key(scs[PAST]);
    __syncthreads();
    unsigned prefix = 0;
#pragma unroll 1
    for (int bit = 31; bit >= 0; --bit) { const unsigned cand = prefix | (1u << bit); int c = 0;
#pragma unroll
        for (int j = 0; j < 32; ++j) { c += __popcll(__ballot(u[j] >= cand)); asm volatile("" : "+s"(c)); }
        if (lane == 0) __hip_atomic_fetch_add(&cnt[31 - bit], (unsigned)c, __ATOMIC_RELAXED, __HIP_MEMORY_SCOPE_WORKGROUP);
        __syncthreads();
        const int tot = (int)cnt[31 - bit] + (uself >= cand ? 1 : 0);
        if (tot >= 256) prefix = cand; }
    const unsigned theta = prefix;
    int cg = 0, ce = 0;
#pragma unroll
    for (int j = 0; j < 32; ++j) { cg += __popcll(__ballot(u[j] > theta)); ce += __popcll(__ballot(u[j] == theta)); asm volatile("" : "+s"(cg), "+s"(ce)); }
    if (lane == 0) { __hip_atomic_fetch_add(&cnt[32], (unsigned)cg, __ATOMIC_RELAXED, __HIP_MEMORY_SCOPE_WORKGROUP); __hip_atomic_fetch_add(&cnt[33], (unsigned)ce, __ATOMIC_RELAXED, __HIP_MEMORY_SCOPE_WORKGROUP); }
    __syncthreads();
    const int cgt = (int)cnt[32] + (uself > theta ? 1 : 0), ceq = (int)cnt[33] + (uself == theta ? 1 : 0), r = 256 - cgt;
    int icut = PAST;
    if (ceq != r) { int lo = 0;
#pragma unroll 1
        for (int bit = 14; bit >= 0; --bit) { const int cc = lo | (1 << bit); int c = 0;
#pragma unroll
            for (int j = 0; j < 32; ++j) { c += __popcll(__ballot(u[j] == theta && (j * 512 + tid) < cc)); asm volatile("" : "+s"(c)); }
            if (lane == 0) __hip_atomic_fetch_add(&cnt[34 + (14 - bit)], (unsigned)c, __ATOMIC_RELAXED, __HIP_MEMORY_SCOPE_WORKGROUP);
            __syncthreads();
            const int tot = (int)cnt[34 + (14 - bit)];
            const int tot2 = tot + ((uself == theta && PAST < cc) ? 1 : 0);
            if (tot2 < r) lo = cc; }
        icut = lo; }
    int mysel = 0;
#pragma unroll
    for (int j = 0; j < 32; ++j) mysel += ((u[j] > theta) || (u[j] == theta && (j * 512 + tid) <= icut)) ? 1 : 0;
    int incl = mysel;
#pragma unroll
    for (int o = 1; o < 64; o <<= 1) { const int v = __shfl_up(incl, o); if (lane >= o) incl += v; }
    if (lane == 63) wcnt[wave] = (unsigned)incl;
    __syncthreads();
    int base = incl - mysel;
    for (int w = 0; w < wave; ++w) base += (int)wcnt[w];
#pragma unroll
    for (int j = 0; j < 32; ++j) if ((u[j] > theta) || (u[j] == theta && (j * 512 + tid) <= icut)) { if (base < 256) sel[base] = j * 512 + tid; ++base; }
    if (tid == 511) { int tot = base; const bool ss = (uself > theta) || (uself == theta && PAST <= icut); if (ss && tot < 256) sel[tot] = PAST; }
    __syncthreads();
    {
        const int i = tid >> 1, kvh = tid & 1, idx = sel[i];
        const float* kp = (idx < PAST) ? C.in[I_CK] + ((size_t)pt[idx >> 7] * PAGE + (idx & 127)) * 128 + kvh * 64 : sp + 512 + kvh * 64;
        float d0 = 0.f, d1 = 0.f, d2 = 0.f, d3 = 0.f;
#pragma unroll
        for (int c = 0; c < 16; ++c) { const f32x4 kv = *(const f32x4*)(kp + 4 * c);
            const LAS float* q0 = qs + (kvh * 4) * 64 + 4 * c;
            d0 += (q0[0] * kv[0] + q0[1] * kv[1]) + (q0[2] * kv[2] + q0[3] * kv[3]);
            d1 += (q0[64] * kv[0] + q0[65] * kv[1]) + (q0[66] * kv[2] + q0[67] * kv[3]);
            d2 += (q0[128] * kv[0] + q0[129] * kv[1]) + (q0[130] * kv[2] + q0[131] * kv[3]);
            d3 += (q0[192] * kv[0] + q0[193] * kv[1]) + (q0[194] * kv[2] + q0[195] * kv[3]); }
        lg[(kvh * 4 + 0) * 256 + i] = d0; lg[(kvh * 4 + 1) * 256 + i] = d1; lg[(kvh * 4 + 2) * 256 + i] = d2; lg[(kvh * 4 + 3) * 256 + i] = d3;
    }
    __syncthreads();
    {
        float v[4]; float mx = -1e30f;
#pragma unroll
        for (int x = 0; x < 4; ++x) { v[x] = lg[wave * 256 + lane + 64 * x]; mx = fmaxf(mx, v[x]); }
#pragma unroll
        for (int o = 1; o < 64; o <<= 1) mx = fmaxf(mx, __shfl_xor(mx, o));
        float s = 0.f;
#pragma unroll
        for (int x = 0; x < 4; ++x) { v[x] = __builtin_amdgcn_exp2f(v[x] - mx); s += v[x]; }
        s = wave_sum(s); const float inv = 1.0f / s;
#pragma unroll
        for (int x = 0; x < 4; ++x) lg[wave * 256 + lane + 64 * x] = v[x] * inv;
    }
    __syncthreads();
    {
        const int kvh = wave >> 2; float o = 0.f;
#pragma unroll 8
        for (int i = 0; i < 256; ++i) { const int idx = sel[i];
            const float* vp = (idx < PAST) ? C.in[I_CV] + ((size_t)pt[idx >> 7] * PAGE + (idx & 127)) * 128 + kvh * 64 : sp + 640 + kvh * 64;
            o = fmaf(lg[wave * 256 + i], vp[lane], o); }
        mixs[wave * 64 + lane] = o;
    }
}

__device__ __forceinline__ void sample_outproj_task(Ctx& C, int tile) {
    int tid_ = C.tid; asm volatile("" : "+v"(tid_));
    float* samp = (float*)(C.ws + WS_SAMP); LAS float* red = (LAS float*)C.lds;
    skinny32<DM, false>(samp + S_MIX, nullptr, C.in[I_WOUT], DM, DM, 32 * tile, red, C.tid, (C.tid & 63), C.wave);
#pragma unroll
    for (int x = 0; x < 2; ++x) { const int e = tid_ + 512 * x, i = e >> 5, n = 32 * tile + (e & 31); samp[S_X1 + i * DM + n] = C.in[I_XS][i * DM + n] + sk_get(red, e); }
    __syncthreads();
}
__device__ __forceinline__ void sample_up_task(Ctx& C, int tile) {
    int tid_ = C.tid; asm volatile("" : "+v"(tid_));
    float* samp = (float*)(C.ws + WS_SAMP); LAS float* red = (LAS float*)C.lds; LAS float* rs = red + 9 * 1024 + 64;
    rows_rstd32<DM>(samp + S_X1, rs, (C.tid & 63), C.wave);
    skinny32<DM, true>(samp + S_X1, C.in[I_N2G], C.in[I_WUP], FF, FF, 32 * tile, red, C.tid, (C.tid & 63), C.wave);
#pragma unroll
    for (int x = 0; x < 2; ++x) { const int e = tid_ + 512 * x, i = e >> 5, n = 32 * tile + (e & 31); const float v = fmaxf(sk_get(red, e) * rs[i], 0.f); samp[S_H + i * FF + n] = v * v; }
    __syncthreads();
}
constexpr int CW_SDN = 8192 + 2048;
__device__ __forceinline__ void sample_down_partial(Ctx& C) {
    int tid_ = C.tid; asm volatile("" : "+v"(tid_));
    float* samp = (float*)(C.ws + WS_SAMP); LAS float* red = (LAS float*)C.lds; float* part = (float*)(C.ws + WS_SAMP + 5 * MiB);
    const int tile = C.vcu & 31, ks = C.vcu >> 5;
    skinny32<FF, false, 64>(samp + S_H, nullptr, C.in[I_WDN], DM, DM, 32 * tile, red, C.tid, (C.tid & 63), C.wave, ks * 512);
#pragma unroll
    for (int x = 0; x < 2; ++x) { const int e = tid_ + 512 * x, i = e >> 5, n = 32 * tile + (e & 31); part[(size_t)ks * 32768 + i * DM + n] = sk_get(red, e); }
    asm volatile("s_waitcnt vmcnt(0)" ::: "memory");
    __syncthreads();
    if (C.tid == 0) { __builtin_amdgcn_fence(__ATOMIC_RELEASE, "agent"); asm volatile("s_waitcnt vmcnt(0)" ::: "memory");
        __hip_atomic_fetch_add((unsigned*)(C.ctl + CW_SDN), 1u, __ATOMIC_RELAXED, __HIP_MEMORY_SCOPE_AGENT); }
    __syncthreads();
}
__device__ __forceinline__ void sample_down_final(Ctx& C, int tile) {
    int tid_ = C.tid; asm volatile("" : "+v"(tid_));
    float* samp = (float*)(C.ws + WS_SAMP); const float* part = (const float*)(C.ws + WS_SAMP + 5 * MiB);
    if (C.tid == 0) { unsigned sp = 0; while (__hip_atomic_load((unsigned*)(C.ctl + CW_SDN), __ATOMIC_RELAXED, __HIP_MEMORY_SCOPE_AGENT) < (unsigned)C.G) { __builtin_amdgcn_s_sleep(4); if (++sp > (1u << 20)) break; }
        __builtin_amdgcn_fence(__ATOMIC_ACQUIRE, "agent"); asm volatile("s_waitcnt vmcnt(0)" ::: "memory"); }
    __syncthreads();
#pragma unroll
    for (int x = 0; x < 2; ++x) { const int e = tid_ + 512 * x, i = e >> 5, n = 32 * tile + (e & 31); float s = samp[S_X1 + i * DM + n];
#pragma unroll
        for (int k = 0; k < 8; ++k) s += __hip_atomic_load(part + (size_t)k * 32768 + i * DM + n, __ATOMIC_RELAXED, __HIP_MEMORY_SCOPE_AGENT);
        C.out[O_YS + i * DM + n] = s; }
}
__device__ __forceinline__ bool opaque_tid(Ctx& C) { asm volatile("" : "+v"(C.tid)); return true; }
struct Args { const float* in[18]; float* out; unsigned char* ws; int ph_lo, ph_hi; };
constexpr int N_PHASES = 7;
#ifndef MK_SPLIT
#define MK_SPLIT 0
#endif
__global__ void __launch_bounds__(512, 2) hymba_fwd(Args args) {
    extern __shared__ __attribute__((aligned(16))) unsigned char lds_raw[];
    Ctx C;
    C.lds = (LAS unsigned char*)lds_raw; C.MISC = (volatile LAS unsigned*)(C.lds + MISC_OFF);
    C.tid = threadIdx.x; C.wave = __builtin_amdgcn_readfirstlane(C.tid >> 6);
    C.G = gridDim.x; { const int bx = blockIdx.x; C.vcu = (C.G % 8 == 0) ? (bx % 8) * (C.G / 8) + bx / 8 : bx; }
    C.ws = args.ws; C.out = args.out; C.ctl = (gu32*)(args.ws + WS_CTL);
#pragma unroll
    for (int i = 0; i < 18; ++i) C.in[i] = args.in[i];
    for (int u = C.tid; u < (LDS_BYTES - LDSCTL_OFF) / 4; u += 512) ((LAS unsigned*)(C.lds + LDSCTL_OFF))[u] = 0u;
    __syncthreads();
    const int lo = args.ph_lo, hi = args.ph_hi;
#ifdef PROBE_PH
    unsigned long long ph_t0_ = __builtin_amdgcn_s_memrealtime(), ph_acc_ = 0;
#define PHMARK(k) do { const unsigned long long now_ = __builtin_amdgcn_s_memrealtime(); if (PROBE_PH == (k)) ph_acc_ = now_ - ph_t0_; ph_t0_ = now_; } while (0)
#else
#define PHMARK(k) do {} while (0)
#endif
    XcdBarrier bar; bar.bar = (unsigned*)(C.ctl + CW_BAR); bar.x = 0; bar.st = nullptr;
    if (hi - lo > 1) bar = xcd_barrier_post((unsigned*)(C.ctl + CW_BAR), C.MISC + 8);
#ifndef PH_MASK
#define PH_MASK 0x7f
#endif
#define IN(k) (((PH_MASK >> (k)) & 1) && lo <= (k) && (k) < hi)
#ifndef REP_MASK
#define REP_MASK 0
#endif
#define REPS(k) (((REP_MASK >> (k)) & 1) ? 2 : 1)
#ifdef PROBE_2BAR
#define SEAM(k) do { if (IN(k) && IN((k) + 1)) { xcd_barrier(bar); xcd_barrier(bar); } } while (0)
#else
#define SEAM(k) do { if (IN(k) && IN((k) + 1)) xcd_barrier(bar); } while (0)
#endif

#ifdef PROBE_VALU
    if (C.vcu == 40) {
        float x_[16]; for (int i = 0; i < 16; ++i) x_[i] = (float)(C.tid + i);
        const float a_ = 1.0001f, b_ = 0.5f;
        __syncthreads();
        const unsigned long long t0_ = __builtin_amdgcn_s_memrealtime();
#pragma unroll 1
        for (int it = 0; it < 4096; ++it) {
#pragma unroll
            for (int i = 0; i < 16; ++i) asm volatile("v_fma_f32 %0, %0, %1, %2" : "+v"(x_[i]) : "v"(a_), "v"(b_));
        }
        __syncthreads();
        const unsigned long long t1_ = __builtin_amdgcn_s_memrealtime();
        float s_ = 0.f; for (int i = 0; i < 16; ++i) s_ += x_[i];
        if (C.tid == 0) { const float us = (float)(t1_ - t0_) * 0.01f; ((float*)(C.ws + WS_GAINS + 4096))[0] = sqrtf(2048.0f * (1e-4f + 5e-4f * fminf(us / 400.0f, 1.0f))); ((float*)(C.ws + WS_GAINS + 4096))[1] = s_; }
    }
#endif
    if (IN(0)) { for (int rep = 0; rep < REPS(0); ++rep) { p0_prologue(C); __syncthreads(); } SEAM(0); PHMARK(0); }

    if (IN(1)) {
        if (C.vcu < 4) sample_postproj(C, C.vcu * 8 + C.wave);
        __syncthreads();
        pg8::Gemm g{(const pg8::bf16_t*)(C.ws + WS_XB), (const pg8::bf16_t*)(C.ws + WS_W1T), NTOK, INP, DM};
        pg8::StaticOrder S; S.init(NTOK, INP, C.G, (int)blockIdx.x);
        pg8::EpiInProj E{(const float*)(C.ws + WS_RSTD1), (const float*)(C.ws + WS_GAINS),
                         (pg8::bf16_t*)(C.ws + WS_QB), (pg8::bf16_t*)(C.ws + WS_KB), (pg8::bf16_t*)(C.ws + WS_VT), (pg8::bf16_t*)(C.ws + WS_IQB), (pg8::bf16_t*)(C.ws + WS_IKB),
                         (pg8::bf16_t*)(C.ws + WS_RQ), (pg8::bf16_t*)(C.ws + WS_RF), (pg8::bf16_t*)(C.ws + WS_RI), (pg8::bf16_t*)(C.ws + WS_RGT), (float*)(C.ws + WS_IWF),
                         C.out + O_NK, C.out + O_NV, C.out + O_NKI};
        pg8::gemm_phase<pg8::EpiInProj, pg8::StaticOrder, true, true>(C.lds, g, S, E);
#if (REP_MASK >> 1) & 1
        __syncthreads(); pg8::gemm_phase<pg8::EpiInProj, pg8::StaticOrder, true, true>(C.lds, g, S, E);
#endif
        SEAM(1); PHMARK(1);
    }

    const int myx = (int)(xb_xcc_id() & 7u);
    if (IN(2)) {
        constexpr int U_H = 8, U_SH = 16, U_SS = 64, U_SEL = 256, U_TOT = U_H + U_SH + U_SS + U_SEL;
        for (int qi = 0; qi < 8; ++qi) { const int x = (myx + qi) & 7, cw = CW_Q2 + 64 * x;
            for (int u = q_next(C, cw); u < U_TOT; u = q_next(C, cw)) {
                if (u < U_H) { hgrn_unit(C, 2 * x + (u >> 2), u & 3, 0); continue; }
                int v = u - U_H;
                if (v < U_SH) { sample_hgrn_unit(C, 4 * x + (v >> 2), v & 3); continue; } v -= U_SH;
                if (v < U_SS) { sample_score_unit(C, 4 * x + (v >> 4), v & 15); continue; } v -= U_SS;
                dsa_select_unit(C, 2 * x + (v & 1), 127 - (v >> 1));
            } }
        SEAM(2); PHMARK(2);
    }
    if (IN(3)) {
        constexpr int U_HG = 8, U_SA = 4, U_AT = 128, U_TOT = U_HG + U_SA + U_AT;
        for (int qi = 0; qi < 8; ++qi) { const int x = (myx + qi) & 7, cw = CW_Q3 + 64 * x;
            for (int u = q_next(C, cw); u < U_TOT; u = q_next(C, cw)) {
                if (u < U_HG) { hgrn_unit(C, 2 * x + (u >> 2), u & 3, 1); continue; }
                int v = u - U_HG;
                if (v < U_SA) { sample_attend_unit(C, 4 * x + v); continue; } v -= U_SA;
                attn_unit(C, 2 * x + (v & 1), 63 - (v >> 1));
            } }
        SEAM(3); PHMARK(3);
    }

    if (IN(4)) {
        if (C.vcu < 32) sample_outproj_task(C, C.vcu);
        __syncthreads();
        pg8::Gemm g{(const pg8::bf16_t*)(C.ws + WS_MIX), (const pg8::bf16_t*)(C.ws + WS_WOT), NTOK, DM, DM};
        pg8::StaticOrder S; S.init(NTOK, DM, C.G, (int)blockIdx.x);
        pg8::EpiOutProj E{C.in[I_XP], C.out + O_Y, (pg8::bf16_t*)(C.ws + WS_X1B), (float*)(C.ws + WS_SSQ2)};
        pg8::gemm_phase<pg8::EpiOutProj, pg8::StaticOrder, true, true>(C.lds, g, S, E);
#if (REP_MASK >> 4) & 1
        __syncthreads(); pg8::gemm_phase<pg8::EpiOutProj, pg8::StaticOrder, true, true>(C.lds, g, S, E);
#endif
        SEAM(4); PHMARK(4);
    }

    if (IN(5)) {
        if (C.vcu < 128) sample_up_task(C, C.vcu);
        __syncthreads();
        pg8::Gemm g{(const pg8::bf16_t*)(C.ws + WS_X1B), (const pg8::bf16_t*)(C.ws + WS_WUT), NTOK, FF, DM};
        pg8::StaticOrder S; S.init(NTOK, FF, C.G, (int)blockIdx.x);
        pg8::EpiUp E{(const float*)(C.ws + WS_SSQ2), (pg8::bf16_t*)(C.ws + WS_H)};
        pg8::gemm_phase<pg8::EpiUp, pg8::StaticOrder, true, true>(C.lds, g, S, E);
#if (REP_MASK >> 5) & 1
        __syncthreads(); pg8::gemm_phase<pg8::EpiUp, pg8::StaticOrder, true, true>(C.lds, g, S, E);
#endif
        SEAM(5); PHMARK(5);
    }

    if (IN(6)) {
        sample_down_partial(C);
        __syncthreads();
        pg8::Gemm g{(const pg8::bf16_t*)(C.ws + WS_H), (const pg8::bf16_t*)(C.ws + WS_WDT), NTOK, DM, FF};
        pg8::StaticOrder S; S.init(NTOK, DM, C.G, (int)blockIdx.x);
        pg8::EpiDown E{C.out + O_Y, (const pg8::bf16_t*)(C.ws + WS_X1B)};
        pg8::gemm_phase<pg8::EpiDown, pg8::StaticOrder, true, true>(C.lds, g, S, E);
        if (C.vcu < 32) sample_down_final(C, C.vcu);
        PHMARK(6);
#if defined(PROBE_P0) || defined(PROBE_VALU)
        if (C.vcu == 40 && C.tid == 0) C.out[O_NKIS + 5] += ((const float*)(C.ws + WS_GAINS + 4096))[0];
#endif
#ifdef PROBE_PH
        if (C.vcu == 40 && C.tid == 0) { const float us = (float)ph_acc_ * 0.01f; C.out[O_NKIS] += sqrtf(2048.0f * (1e-4f + 5e-4f * fminf(us / 400.0f, 1.0f))); }
#endif
    }
#undef IN
#undef SEAM
}

extern "C" void kernel_launch(void* const* d_in, const int* in_sizes, int n_in, void* d_out, int out_size, void* d_ws, size_t ws_size, hipStream_t stream) {
    static int grid = 0;
    if (grid == 0) {
        if (n_in != 18 || in_sizes[0] != NTOK * DM || (size_t)out_size != O_END || ws_size < WS_END) {
            fprintf(stderr, "kernel_launch: unexpected shapes: n_in %d in0 %d out %d ws %zu (need ws >= %zu); nothing launched\n", n_in, n_in > 0 ? in_sizes[0] : -1, out_size, ws_size, (size_t)WS_END); grid = -1; return; }
        int dev = 0, cus = 0;
        if (hipGetDevice(&dev) != hipSuccess || hipDeviceGetAttribute(&cus, hipDeviceAttributeMultiprocessorCount, dev) != hipSuccess) { grid = -1; return; }
        if (hipFuncSetAttribute((const void*)hymba_fwd, hipFuncAttributeMaxDynamicSharedMemorySize, LDS_BYTES) != hipSuccess) { fprintf(stderr, "kernel_launch: hipFuncSetAttribute failed\n"); grid = -1; return; }
        int per_cu = 0;
        if (hipOccupancyMaxActiveBlocksPerMultiprocessor(&per_cu, (const void*)hymba_fwd, 512, LDS_BYTES) != hipSuccess || per_cu < 1) fprintf(stderr, "kernel_launch: occupancy query says %d\n", per_cu);
        (void)hipGetLastError();
        grid = cus;
        if (grid != 256) fprintf(stderr, "kernel_launch: %d CUs (expected 256)\n", grid);
    }
    if (grid < 0) return;
    (void)hipMemsetAsync((char*)d_ws + WS_CTL, 0, CTL_ZERO_BYTES, stream);
    Args a{};
    for (int i = 0; i < 18; ++i) a.in[i] = (const float*)d_in[i];
    a.out = (float*)d_out; a.ws = (unsigned char*)d_ws;
#if MK_SPLIT
    for (int p = 0; p < N_PHASES; ++p) { a.ph_lo = p; a.ph_hi = p + 1; hipLaunchKernelGGL(hymba_fwd, dim3(grid), dim3(512), LDS_BYTES, stream, a); }
#else
    a.ph_lo = 0; a.ph_hi = N_PHASES; hipLaunchKernelGGL(hymba_fwd, dim3(grid), dim3(512), LDS_BYTES, stream, a);
#endif
}
```

```cpp
#include <hip/hip_runtime.h>
#include <cstdio>
#include <cstdint>

#define LAS __attribute__((address_space(3)))
#define GAS __attribute__((address_space(1)))
typedef float f32x16 __attribute__((ext_vector_type(16)));
typedef unsigned u32x2 __attribute__((ext_vector_type(2)));
typedef unsigned long long u64;

#define RES_BF16 1
constexpr int NTOK = 32768, NB = 16, SEQ = 2048, DM = 1024, NS = 32, PAST = 16384, PAGE = 128, NPAGES = 128;
constexpr int INW = 3400, INP = 3584, FF = 4096;
constexpr float EPS = 1e-6f;
constexpr float ATT_SCALE = 0.125f, LOG2E = 1.4426950408889634f;
constexpr float IDX_W_SCALE = 0.04419417382415922f;
constexpr float REC_QSCALE = 0.08838834764831845f;
enum { I_XP = 0, I_XS, I_CK, I_CV, I_CKI, I_ST, I_PT, I_N1G, I_WIN, I_QG, I_KG, I_IKG, I_LB, I_RG, I_WOUT, I_N2G, I_WUP, I_WDN };
constexpr size_t O_Y = 0, O_YS = 33554432, O_NK = O_YS + 32768, O_NV = O_NK + 4194304, O_NKI = O_NV + 4194304, O_NSP = O_NKI + 2097152,
                 O_NKS = O_NSP + 1048576, O_NVS = O_NKS + 4096, O_NKIS = O_NVS + 4096, O_NSS = O_NKIS + 2048, O_END = O_NSS + 2097152;
constexpr size_t MiB = 1u << 20;
constexpr size_t WS_SSQ = 131072;
constexpr size_t WS_CTL = 0, CTL_ZERO_BYTES = 262144;
constexpr size_t WS_W1T = 2 * MiB, WS_WOT = 10 * MiB, WS_WUT = 12 * MiB, WS_WDT = 20 * MiB;
constexpr size_t WS_GAINS = 28 * MiB + 512 * 1024;
constexpr size_t WS_RSTD1 = 28 * MiB, WS_IWF = 29 * MiB, WS_SSQ2 = 30 * MiB, WS_SAMP = 32 * MiB;
constexpr size_t WS_XB = 40 * MiB, WS_QB = 104 * MiB, WS_KB = 136 * MiB, WS_VT = 144 * MiB, WS_IQB = 152 * MiB, WS_IKB = 184 * MiB;
constexpr size_t WS_RQ = 188 * MiB, WS_RF = 220 * MiB, WS_RI = 252 * MiB, WS_RGT = 284 * MiB, WS_MASK = 316 * MiB, WS_MIX = 324 * MiB;
constexpr size_t WS_X1B = 388 * MiB, WS_H = 452 * MiB, WS_HST = 708 * MiB, WS_END = 712 * MiB;
constexpr int S_RAW = 0, S_SP = 131072, S_SC = 262144, S_SCROW = 16400, S_MIX = S_SC + 32 * S_SCROW + 256, S_X1 = S_MIX + 32768, S_H = S_X1 + 32768, S_ENDF = S_H + 131072;
static_assert((size_t)S_ENDF * 4 <= 8 * MiB, "sample scratch");
constexpr int CW_BAR = 4096, CW_Q2 = 8192, CW_Q3 = 8192 + 1024;
constexpr int LDS_BYTES = 163840, LDSCTL_OFF = LDS_BYTES - 1024, MISC_OFF = LDSCTL_OFF + 320;

namespace pg8 {
#define PG8_LAS __attribute__((address_space(3)))
typedef unsigned short bf16_t;
typedef short bf16x8 __attribute__((ext_vector_type(8)));
typedef float f32x4 __attribute__((ext_vector_type(4)));
typedef unsigned u32x4 __attribute__((ext_vector_type(4)));
constexpr int BM = 256, BK = 64, HALF = 128, HTB = HALF * BK * 2  , STAGE_BYTES = 8 * HTB, NXCD = 8, WGM = 8;

__host__ __device__ __forceinline__ int lds_byte(int r, int c) { const int st = (r >> 4) * 2 + (c >> 5), rr = r & 15, cc = c & 31, ob = rr * 64 + cc * 2; return st * 1024 + (ob ^ (((ob >> 9) & 1) << 5)); }
__host__ __device__ __forceinline__ void stage_rc(int b, int& R, int& C) { const int st = b / 1024, sb = b % 1024, swz = sb ^ (((sb >> 9) & 1) << 5); R = (st >> 1) * 16 + swz / 64; C = (st & 1) * 32 + (swz % 64) / 2; }
__host__ __device__ __forceinline__ int perm32(int rho) { const int n = rho >> 4, i = rho & 15; return 8 * (i >> 2) + 4 * n + (i & 3); }

struct Unit { int pm, pn; };
struct Gemm { const bf16_t* A; const bf16_t* Bt; int M, N, K; };

struct StaticOrder {
    int nM, nN, nwg, G, c;
    __host__ __device__ void init(int M, int N, int G_, int c_) { nM = M / BM; nN = N / BM; nwg = nM * nN; G = G_; c = c_; }
    __host__ __device__ bool next(int i, Unit& u) const {
        const long L = (long)i * G + c; if (L >= nwg) return false;
        int wgid = (int)L; { const int q = nwg / NXCD, r = nwg % NXCD, xcd = wgid % NXCD, off = wgid / NXCD; wgid = (xcd < r ? xcd * (q + 1) : r * (q + 1) + (xcd - r) * q) + off; }
        const int nig = WGM * nN, gid = wgid / nig, fm = gid * WGM, gsz = (nM - fm) < WGM ? (nM - fm) : WGM;
        u.pm = fm + ((wgid % nig) % gsz); u.pn = (wgid % nig) / gsz; return true;
    }
    __device__ __forceinline__ void a_ready(const Unit&) const {}
    __device__ __forceinline__ void done(const Unit&) const {}
};

__device__ __forceinline__ unsigned cvt_pk_bf16(float lo, float hi) { unsigned r; asm volatile("v_cvt_pk_bf16_f32 %0, %1, %2" : "=v"(r) : "v"(lo), "v"(hi)); return r; }
typedef float f32x2 __attribute__((ext_vector_type(2)));
__device__ __forceinline__ float silu_f(float x) { return x / (1.f + __expf(-x)); }
__device__ __forceinline__ void st_bf16x16(bf16_t* p, const float (&t)[16]) {
    u32x4 a, b;
    a.x = cvt_pk_bf16(t[0], t[1]); a.y = cvt_pk_bf16(t[2], t[3]); a.z = cvt_pk_bf16(t[4], t[5]); a.w = cvt_pk_bf16(t[6], t[7]);
    b.x = cvt_pk_bf16(t[8], t[9]); b.y = cvt_pk_bf16(t[10], t[11]); b.z = cvt_pk_bf16(t[12], t[13]); b.w = cvt_pk_bf16(t[14], t[15]);
    *(u32x4*)p = a; *(u32x4*)(p + 8) = b;
}
__device__ __forceinline__ void st_f32x16(float* p, const float (&t)[16]) {
#pragma unroll
    for (int i = 0; i < 4; ++i) *(f32x4*)(p + 4 * i) = (f32x4){t[4 * i], t[4 * i + 1], t[4 * i + 2], t[4 * i + 3]};
}
__device__ __forceinline__ unsigned short f2bf_rne(float f) { unsigned u = __builtin_bit_cast(unsigned, f); return (unsigned short)((u + 0x7fffu + ((u >> 16) & 1u)) >> 16); }

struct EpiInProj {
    static constexpr bool PERM = false, AFTER_DRAIN = false;
    const float* rstd1; const float* gains;
    bf16_t *Qb, *Kb, *Vt, *IQb, *IKb, *Rq, *Rf, *Ri, *Rg; float* IWf; float *oK, *oV, *oKI;
    __device__ __forceinline__ void operator()(const f32x4 (&acc)[2][2][4][2], const Unit& u, int wr, int wc, int fr, int fq) const {
        const int pn = u.pn;
        const float* gsrc = gains + (pn < 2 ? 0 : (pn == 2 ? 64 : 128)) + 16 * fq;
#pragma unroll
        for (int ai = 0; ai < 2; ++ai)
#pragma unroll
            for (int m = 0; m < 4; ++m) {
                const int row = u.pm * BM + ai * HALF + wr * 64 + m * 16 + fr;
                const float rs = rstd1[row];
                float t[16];
#pragma unroll
                for (int bj = 0; bj < 2; ++bj)
#pragma unroll
                    for (int n = 0; n < 2; ++n)
#pragma unroll
                        for (int e = 0; e < 4; ++e) t[8 * bj + 4 * n + e] = acc[ai][bj][m][n][e] * rs;
                const bool normed = (pn < 2) || (pn == 2 && wc < 2) || (pn == 5 && wc == 0);
                if (normed) {
                    float ss = 0.f;
#pragma unroll
                    for (int j = 0; j < 16; ++j) ss += t[j] * t[j];
                    ss += __shfl_xor(ss, 16); ss += __shfl_xor(ss, 32);
                    float sc = rsqrtf(ss * (1.0f / 64.0f) + EPS);
                    if (pn < 2) sc *= ATT_SCALE * LOG2E;
#pragma unroll
                    for (int i = 0; i < 4; ++i) { const f32x4 gv = *(const f32x4*)(gsrc + 4 * i);
                        t[4 * i] *= sc * gv[0]; t[4 * i + 1] *= sc * gv[1]; t[4 * i + 2] *= sc * gv[2]; t[4 * i + 3] *= sc * gv[3]; }
                }
                if (pn < 2) {
                    st_bf16x16(Qb + (size_t)row * 512 + (4 * pn + wc) * 64 + 16 * fq, t);
                } else if (pn == 2) {
                    if (wc < 2) { st_f32x16(oK + (size_t)row * 128 + wc * 64 + 16 * fq, t); st_bf16x16(Kb + (size_t)row * 128 + wc * 64 + 16 * fq, t); }
                    else {
                        st_f32x16(oV + (size_t)row * 128 + (wc - 2) * 64 + 16 * fq, t);
                        const int b = row >> 11, tt = row & 2047;
                        bf16_t* vp = Vt + ((size_t)(b * 2 + (wc - 2)) * 64 + 16 * fq) * 2048 + tt;
#pragma unroll
                        for (int j = 0; j < 16; ++j) vp[(size_t)j * 2048] = f2bf_rne(t[j]);
                    }
                } else if (pn < 5) {
                    st_bf16x16(IQb + (size_t)row * 512 + (4 * (pn - 3) + wc) * 64 + 16 * fq, t);
                } else if (pn == 5) {
                    if (wc == 0) { st_f32x16(oKI + (size_t)row * 64 + 16 * fq, t); st_bf16x16(IKb + (size_t)row * 64 + 16 * fq, t); }
                    else if (wc == 1 && fq == 0) {
                        *(f32x4*)(IWf + (size_t)row * 8) = (f32x4){t[0] * IDX_W_SCALE, t[1] * IDX_W_SCALE, t[2] * IDX_W_SCALE, t[3] * IDX_W_SCALE};
                        *(f32x4*)(IWf + (size_t)row * 8 + 4) = (f32x4){t[4] * IDX_W_SCALE, t[5] * IDX_W_SCALE, t[6] * IDX_W_SCALE, t[7] * IDX_W_SCALE};
                    }
                } else {
                    const int kind = (pn - 6) >> 1, col = 256 * ((pn - 6) & 1) + 64 * wc + 16 * fq;
                    if (kind == 0) {
#pragma unroll
                        for (int j = 0; j < 16; ++j) t[j] = silu_f(t[j]) * REC_QSCALE;
                        st_bf16x16(Rq + (size_t)row * 512 + col, t);
                    } else if (kind == 1) st_bf16x16(Rf + (size_t)row * 512 + col, t);
                    else if (kind == 2) st_bf16x16(Ri + (size_t)row * 512 + col, t);
                    else {
#pragma unroll
                        for (int j = 0; j < 16; ++j) t[j] = silu_f(t[j]);
                        st_bf16x16(Rg + (size_t)row * 512 + col, t);
                    }
                }
            }
    }
};
struct EpiOutProj {
    static constexpr bool PERM = false, AFTER_DRAIN = false;
    const float* X; float* Y; bf16_t* X1B; float* SSQ2;
    __device__ __forceinline__ void operator()(const f32x4 (&acc)[2][2][4][2], const Unit& u, int wr, int wc, int fr, int fq) const {
        const int col0 = u.pn * BM + wc * 32 + 4 * fq;
#pragma unroll
        for (int ai = 0; ai < 2; ++ai)
#pragma unroll
            for (int m = 0; m < 4; ++m) {
                const int row = u.pm * BM + ai * HALF + wr * 64 + m * 16 + fr; const size_t off = (size_t)row * DM + col0; float ss = 0.f;
#pragma unroll
                for (int bj = 0; bj < 2; ++bj)
#pragma unroll
                    for (int n = 0; n < 2; ++n) {
                        const f32x4 xv = *(const f32x4*)(X + off + bj * HALF + n * 16); const f32x4 o = xv + acc[ai][bj][m][n];
#if !RES_BF16
                        *(f32x4*)(Y + off + bj * HALF + n * 16) = o;
#endif
                        ss += (o[0] * o[0] + o[1] * o[1]) + (o[2] * o[2] + o[3] * o[3]);
                        u32x2 w; w.x = cvt_pk_bf16(o[0], o[1]); w.y = cvt_pk_bf16(o[2], o[3]); *(u32x2*)(X1B + off + bj * HALF + n * 16) = w;
                    }
                ss += __shfl_xor(ss, 16); ss += __shfl_xor(ss, 32);
                if (fq == 0) atomicAdd(SSQ2 + row, ss);
            }
    }
};
struct EpiUp {
    static constexpr bool PERM = true, AFTER_DRAIN = false;
    const float* SSQ; bf16_t* H;
    __device__ __forceinline__ void operator()(const f32x4 (&acc)[2][2][4][2], const Unit& u, int wr, int wc, int fr, int fq) const {
        const int col0 = u.pn * BM + wc * 32 + 8 * fq;
        float rsv[2][4];
#pragma unroll
        for (int ai = 0; ai < 2; ++ai)
#pragma unroll
            for (int m = 0; m < 4; ++m) rsv[ai][m] = SSQ[u.pm * BM + ai * HALF + wr * 64 + m * 16 + fr];
#pragma unroll
        for (int ai = 0; ai < 2; ++ai)
#pragma unroll
            for (int m = 0; m < 4; ++m) {
                const int row = u.pm * BM + ai * HALF + wr * 64 + m * 16 + fr;
                const float rs = rsqrtf(rsv[ai][m] * (1.0f / 1024.0f) + EPS);
                bf16_t* rowp = H + (size_t)row * FF + col0;
#pragma unroll
                for (int bj = 0; bj < 2; ++bj) {
                    f32x4 v0 = acc[ai][bj][m][0] * rs, v1 = acc[ai][bj][m][1] * rs;
#pragma unroll
                    for (int e = 0; e < 4; ++e) { const float a = fmaxf(v0[e], 0.f), b = fmaxf(v1[e], 0.f); v0[e] = a * a; v1[e] = b * b; }
                    u32x4 w; w.x = cvt_pk_bf16(v0[0], v0[1]); w.y = cvt_pk_bf16(v0[2], v0[3]); w.z = cvt_pk_bf16(v1[0], v1[1]); w.w = cvt_pk_bf16(v1[2], v1[3]);
                    *(u32x4*)(rowp + bj * HALF) = w;
                }
            }
    }
};
struct EpiDown {
    static constexpr bool PERM = false, AFTER_DRAIN = false;
    float* Y; const bf16_t* X1B;
    __device__ __forceinline__ void operator()(const f32x4 (&acc)[2][2][4][2], const Unit& u, int wr, int wc, int fr, int fq) const {
        const int col0 = u.pn * BM + wc * 32 + 4 * fq;
#pragma unroll
        for (int ai = 0; ai < 2; ++ai)
#pragma unroll
            for (int m = 0; m < 4; ++m) {
                const size_t off = (size_t)(u.pm * BM + ai * HALF + wr * 64 + m * 16 + fr) * DM + col0;
#pragma unroll
                for (int bj = 0; bj < 2; ++bj)
#pragma unroll
                    for (int n = 0; n < 2; ++n) { float* p = Y + off + bj * HALF + n * 16;
#if RES_BF16
                        const u32x2 xw = *(const u32x2*)(X1B + off + bj * HALF + n * 16);
                        const f32x4 x1 = {__builtin_bit_cast(float, xw.x << 16), __builtin_bit_cast(float, xw.x & 0xffff0000u), __builtin_bit_cast(float, xw.y << 16), __builtin_bit_cast(float, xw.y & 0xffff0000u)};
                        *(f32x4*)p = x1 + acc[ai][bj][m][n];
#else
                        *(f32x4*)p = *(const f32x4*)p + acc[ai][bj][m][n];
#endif
                    }
            }
    }
};
template <class Epi, class Sched, bool ALIGN_EPI = false, bool SP2 = false>
__device__ __forceinline__ void gemm_phase(PG8_LAS unsigned char* lds, const Gemm g, const Sched& S, const Epi& E) {
    const int tid = threadIdx.x, wid = __builtin_amdgcn_readfirstlane(tid >> 6), lane = tid & 63, wr = wid >> 2, wc = wid & 3, fr = lane & 15, fq = lane >> 4;
    const int K = g.K, nt = K / BK;
    unsigned voffA[2], voffB[2];
#pragma unroll
    for (int i = 0; i < 2; ++i) { int R, C; stage_rc(tid * 16 + i * 8192, R, C); const int Rb = Epi::PERM ? ((R & ~31) + perm32(R & 31)) : R;
        voffA[i] = (unsigned)(R * K + C) * 2u; voffB[i] = (unsigned)(Rb * K + C) * 2u; }
    const size_t kstep = (size_t)(BK * 2);
    const size_t hstep = (size_t)HALF * K * 2;
    const size_t tstep = 2 * hstep;
    const unsigned ldsw = (unsigned)wid * 1024u;
    const int aoff = lds_byte(wr * 64 + fr, fq * 8), boff = lds_byte(wc * 32 + fr, fq * 8);
#define PG8_SA(b, h) (((b) * 2 + (h)) * HTB)
#define PG8_SB(b, h) ((4 + (b) * 2 + (h)) * HTB)
#define PG8_STAGE(bufoff, gbase, voff) do { _Pragma("unroll") for (int _i = 0; _i < 2; ++_i) \
        __builtin_amdgcn_global_load_lds((const unsigned*)((const char*)(gbase) + (voff)[_i]), (PG8_LAS unsigned*)(lds + (bufoff) + ldsw + _i * 8192), 16, 0, 0); } while (0)
#define PG8_LDA(dst, b, h) do { _Pragma("unroll") for (int m = 0; m < 4; ++m) _Pragma("unroll") for (int k = 0; k < 2; ++k) dst[m][k] = *(const PG8_LAS bf16x8*)(lds + PG8_SA(b, h) + aoff + m * 2048 + k * 1024); } while (0)
#define PG8_LDB(dst, b, h) do { _Pragma("unroll") for (int n = 0; n < 2; ++n) _Pragma("unroll") for (int k = 0; k < 2; ++k) dst[n][k] = *(const PG8_LAS bf16x8*)(lds + PG8_SB(b, h) + boff + n * 2048 + k * 1024); } while (0)
#define PG8_MMA(ai, bj, At, Bt) do { __builtin_amdgcn_s_setprio(1); _Pragma("unroll") for (int m = 0; m < 4; ++m) _Pragma("unroll") for (int n = 0; n < 2; ++n) _Pragma("unroll") for (int k = 0; k < 2; ++k) \
        acc[ai][bj][m][n] = __builtin_amdgcn_mfma_f32_16x16x32_bf16(Bt[n][k], At[m][k], acc[ai][bj][m][n], 0, 0, 0); __builtin_amdgcn_s_setprio(0); } while (0)
#define PG8_WAIT_V(n) asm volatile("s_waitcnt vmcnt(" #n ")" ::: "memory")
#define PG8_WAIT_L(n) asm volatile("s_waitcnt lgkmcnt(" #n ")" ::: "memory")
#define PG8_BAR __builtin_amdgcn_s_barrier()
#define PG8_SCHED __builtin_amdgcn_sched_barrier(0)
    Unit cur, nxt; int ui = 0;
    if (!S.next(0, cur)) return;
    f32x4 acc[2][2][4][2];
#pragma unroll
    for (int a = 0; a < 2; ++a)
#pragma unroll
        for (int b = 0; b < 2; ++b)
#pragma unroll
            for (int m = 0; m < 4; ++m)
#pragma unroll
                for (int n = 0; n < 2; ++n) acc[a][b][m][n] = (f32x4){0.f, 0.f, 0.f, 0.f};
    bf16x8 At[4][2], B0[2][2], B1[2][2];
    const char* cA = (const char*)g.A + (size_t)cur.pm * tstep; const char* cB = (const char*)g.Bt + (size_t)cur.pn * tstep;
    S.a_ready(cur);
    if constexpr (SP2) {
        PG8_STAGE(PG8_SB(0, 0), cB, voffB); PG8_STAGE(PG8_SB(0, 1), cB + hstep, voffB); PG8_STAGE(PG8_SA(0, 0), cA, voffA); PG8_STAGE(PG8_SA(0, 1), cA + hstep, voffA);
        if (wr == 1) PG8_BAR;
        PG8_WAIT_V(2); PG8_BAR;
        PG8_STAGE(PG8_SB(1, 0), cB + kstep, voffB); PG8_STAGE(PG8_SA(1, 0), cA + kstep, voffA); PG8_STAGE(PG8_SB(1, 1), cB + hstep + kstep, voffB);
        PG8_WAIT_V(6); PG8_BAR;
    } else {
        PG8_STAGE(PG8_SB(0, 0), cB, voffB); PG8_STAGE(PG8_SA(0, 0), cA, voffA); PG8_STAGE(PG8_SB(0, 1), cB + hstep, voffB); PG8_STAGE(PG8_SA(0, 1), cA + hstep, voffA);
        if (wr == 1) PG8_BAR;
        PG8_WAIT_V(4); PG8_BAR;
        PG8_STAGE(PG8_SB(1, 0), cB + kstep, voffB); PG8_STAGE(PG8_SA(1, 0), cA + kstep, voffA); PG8_STAGE(PG8_SB(1, 1), cB + hstep + kstep, voffB);
        PG8_WAIT_V(6); PG8_BAR;
    }
    for (;;) {
        const bool has_next = S.next(ui + 1, nxt);
        const char* nA = has_next ? (const char*)g.A + (size_t)nxt.pm * tstep : cA; const char* nB = has_next ? (const char*)g.Bt + (size_t)nxt.pn * tstep : cB;
        for (int t = 0; t < nt; t += 2) {
            const bool last = (t == nt - 2);
            const char* a1 = cA + (size_t)(t + 1) * kstep;
            const char* a2 = last ? nA : cA + (size_t)(t + 2) * kstep; const char* b2 = last ? nB : cB + (size_t)(t + 2) * kstep;
            const char* a3 = a2 + kstep; const char* b3 = b2 + kstep;
            if (last && has_next) S.a_ready(nxt);
            if constexpr (SP2) {
            PG8_LDB(B0, 0, 0); PG8_LDB(B1, 0, 1); PG8_SCHED; PG8_LDA(At, 0, 0); PG8_STAGE(PG8_SA(1, 1), a1 + hstep, voffA);
            PG8_WAIT_V(8); PG8_WAIT_L(0); PG8_BAR; PG8_MMA(0, 0, At, B0); PG8_MMA(0, 1, At, B1); PG8_BAR; PG8_SCHED;
            PG8_LDA(At, 0, 1); PG8_STAGE(PG8_SB(0, 0), b2, voffB); PG8_STAGE(PG8_SB(0, 1), b2 + hstep, voffB); PG8_STAGE(PG8_SA(0, 0), a2, voffA);
            PG8_WAIT_V(8); PG8_WAIT_L(0); PG8_BAR; PG8_MMA(1, 0, At, B0); PG8_MMA(1, 1, At, B1); PG8_BAR; PG8_SCHED;
            PG8_LDB(B0, 1, 0); PG8_LDB(B1, 1, 1); PG8_SCHED; PG8_LDA(At, 1, 0); PG8_STAGE(PG8_SA(0, 1), a2 + hstep, voffA);
            PG8_WAIT_V(8); PG8_WAIT_L(0); PG8_BAR; PG8_MMA(0, 0, At, B0); PG8_MMA(0, 1, At, B1); PG8_BAR; PG8_SCHED;
            PG8_LDA(At, 1, 1); PG8_STAGE(PG8_SB(1, 0), b3, voffB); PG8_STAGE(PG8_SB(1, 1), b3 + hstep, voffB); PG8_STAGE(PG8_SA(1, 0), a3, voffA);
            PG8_WAIT_V(8); PG8_WAIT_L(0); PG8_BAR; PG8_MMA(1, 0, At, B0); PG8_MMA(1, 1, At, B1); PG8_BAR; PG8_SCHED;
            } else {
            PG8_LDB(B0, 0, 0); PG8_SCHED; PG8_LDA(At, 0, 0); PG8_STAGE(PG8_SA(1, 1), a1 + hstep, voffA);
            PG8_WAIT_L(8); PG8_BAR; PG8_WAIT_L(0); PG8_MMA(0, 0, At, B0); PG8_BAR; PG8_SCHED;
            PG8_LDB(B1, 0, 1); PG8_STAGE(PG8_SB(0, 0), b2, voffB);
            PG8_BAR; PG8_WAIT_L(0); PG8_MMA(0, 1, At, B1); PG8_BAR;
            PG8_LDA(At, 0, 1); PG8_STAGE(PG8_SA(0, 0), a2, voffA);
            PG8_BAR; PG8_WAIT_L(0); PG8_MMA(1, 0, At, B0); PG8_BAR; PG8_SCHED;
            PG8_STAGE(PG8_SB(0, 1), b2 + hstep, voffB);
            PG8_WAIT_V(6); PG8_BAR; PG8_MMA(1, 1, At, B1); PG8_BAR;
            PG8_LDB(B0, 1, 0); PG8_SCHED; PG8_LDA(At, 1, 0); PG8_STAGE(PG8_SA(0, 1), a2 + hstep, voffA);
            PG8_WAIT_L(8); PG8_BAR; PG8_WAIT_L(0); PG8_MMA(0, 0, At, B0); PG8_BAR; PG8_SCHED;
            PG8_LDB(B1, 1, 1); PG8_STAGE(PG8_SB(1, 0), b3, voffB);
            PG8_BAR; PG8_WAIT_L(0); PG8_MMA(0, 1, At, B1); PG8_BAR;
            PG8_LDA(At, 1, 1); PG8_STAGE(PG8_SA(1, 0), a3, voffA);
            PG8_BAR; PG8_WAIT_L(0); PG8_MMA(1, 0, At, B0); PG8_BAR; PG8_SCHED;
            PG8_STAGE(PG8_SB(1, 1), b3 + hstep, voffB);
            PG8_WAIT_V(6); PG8_BAR; PG8_MMA(1, 1, At, B1); PG8_BAR;
            }
        }
        if constexpr (ALIGN_EPI) { if (wr == 0) PG8_BAR; }
        if constexpr (!Epi::AFTER_DRAIN) { E(acc, cur, wr, wc, fr, fq); S.done(cur); }
        if (!has_next) break;
#pragma unroll
        for (int a = 0; a < 2; ++a)
#pragma unroll
            for (int b = 0; b < 2; ++b)
#pragma unroll
                for (int m = 0; m < 4; ++m)
#pragma unroll
                    for (int n = 0; n < 2; ++n) acc[a][b][m][n] = (f32x4){0.f, 0.f, 0.f, 0.f};
        cur = nxt; cA = nA; cB = nB; ++ui;
        if constexpr (ALIGN_EPI) { if (wr == 1) PG8_BAR; }
    }
    PG8_WAIT_V(0);
    if constexpr (!ALIGN_EPI) { if (wr == 0) PG8_BAR; }
    PG8_BAR;
    if constexpr (Epi::AFTER_DRAIN) { E.fused(acc, cur, wr, wc, fr, fq, lds, wid, lane); S.done(cur); }
#undef PG8_SA
#undef PG8_SB
#undef PG8_STAGE
#undef PG8_LDA
#undef PG8_LDB
#undef PG8_MMA
#undef PG8_WAIT_V
#undef PG8_WAIT_L
#undef PG8_BAR
#undef PG8_SCHED
}
}
#define XB_TMO      128
#define XB_XCNT(j)  (256  + 64 * (j))
#define XB_XSUB(j)  (1280 + 64 * (j))
#define XB_XGEN(j)  (2304 + 64 * (j))
#define XB_TOP      3328
#define XB_TOPGEN   3392
#define XCD_BAR_WORDS 3456
#define XB_SPIN_CAP (1u << 18)

__device__ __forceinline__ unsigned xb_ld(unsigned* p)              { return __hip_atomic_load(p, __ATOMIC_RELAXED, __HIP_MEMORY_SCOPE_AGENT); }
__device__ __forceinline__ unsigned xb_add(unsigned* p, unsigned v) { return __hip_atomic_fetch_add(p, v, __ATOMIC_RELAXED, __HIP_MEMORY_SCOPE_AGENT); }
__device__ __forceinline__ unsigned xb_xcc_id() { return (unsigned)__builtin_amdgcn_s_getreg((3 << 11) | 20) & 0xFu; }
#define XB_SPIN(cond, bar) do { unsigned _sp = 0; while (cond) { __builtin_amdgcn_s_sleep(1); \
    if ((++_sp & 255u) == 0u) { if (xb_ld(&(bar)[XB_TMO])) break; if (_sp > XB_SPIN_CAP) { atomicAdd(&(bar)[XB_TMO], 1u); break; } } } } while (0)

struct XcdBarrier {
    unsigned* bar; unsigned x;
    volatile LAS unsigned* st;
};

__device__ __forceinline__ XcdBarrier xcd_barrier_post(unsigned* bar, volatile LAS unsigned* st) {
    XcdBarrier b; b.bar = bar; b.x = xb_xcc_id(); b.st = st;
    if (threadIdx.x == 0) (void)xb_add(&bar[XB_XCNT(b.x)], 1u);
    return b;
}
__device__ __forceinline__ void xcd_barrier_complete(unsigned* bar, unsigned x, unsigned& nloc, unsigned& nx) {
    const unsigned G = gridDim.x * gridDim.y * gridDim.z;
    unsigned sum, cnt, mine, sp = 0u;
    for (;;) {
        sum = 0u; cnt = 0u; mine = 0u;
#pragma unroll
        for (unsigned j = 0; j < 16; ++j) { const unsigned c = xb_ld(&bar[XB_XCNT(j)]); sum += c; cnt += (c > 0u) ? 1u : 0u; mine = (j == x) ? c : mine; }
        if (sum == G) break;
        __builtin_amdgcn_s_sleep(1);
        if ((++sp & 255u) == 0u) { if (xb_ld(&bar[XB_TMO])) break; if (sp > XB_SPIN_CAP) { atomicAdd(&bar[XB_TMO], 1u); break; } }
    }
    nloc = mine > 0u ? mine : 1u; nx = cnt > 0u ? cnt : 1u;
}

__device__ __forceinline__ void xcd_barrier(const XcdBarrier& b) {
    asm volatile("s_waitcnt vmcnt(0)" ::: "memory");
    __syncthreads();
    if (threadIdx.x == 0) {
        unsigned* bar = b.bar;
        __builtin_amdgcn_s_waitcnt(0);
        unsigned nloc = b.st[0], nx = b.st[1];
        if (nloc == 0u) { xcd_barrier_complete(bar, b.x, nloc, nx); b.st[0] = nloc; b.st[1] = nx; }
        const unsigned old = xb_add(&bar[XB_XSUB(b.x)], 1u);
        const unsigned gen = old / nloc;
        if (old + 1u == (gen + 1u) * nloc) {
            __builtin_amdgcn_fence(__ATOMIC_RELEASE, "agent");
            asm volatile("s_waitcnt vmcnt(0)" ::: "memory");
            const unsigned og = xb_add(&bar[XB_TOP], 1u);
            const unsigned tg = og / nx;
            if (og + 1u == (tg + 1u) * nx) xb_add(&bar[XB_TOPGEN], 1u);
            else XB_SPIN(xb_ld(&bar[XB_TOPGEN]) == tg, bar);
            __builtin_amdgcn_fence(__ATOMIC_ACQUIRE, "agent");
            xb_add(&bar[XB_XGEN(b.x)], 1u);
            asm volatile("s_waitcnt vmcnt(0)" ::: "memory");
        } else {
            XB_SPIN(xb_ld(&bar[XB_XGEN(b.x)]) == gen, bar);
            __builtin_amdgcn_fence(__ATOMIC_ACQUIRE, "agent");
            asm volatile("s_waitcnt vmcnt(0)" ::: "memory");
        }
    }
    __syncthreads();
}
typedef unsigned short bf16;
typedef unsigned v4u __attribute__((ext_vector_type(4)));
typedef float f32x4 __attribute__((ext_vector_type(4)));
typedef short bf16x8 __attribute__((ext_vector_type(8)));
typedef GAS unsigned gu32;
#define LDS_WAIT() asm volatile("s_waitcnt lgkmcnt(0)" ::: "memory")
__device__ __forceinline__ unsigned f2bf(float f) { unsigned u = __builtin_bit_cast(unsigned, f); return (u + 0x7fffu + ((u >> 16) & 1u)) >> 16; }
__device__ __forceinline__ unsigned pk2(float lo, float hi) { return f2bf(lo) | (f2bf(hi) << 16); }
__device__ __forceinline__ unsigned cvtpk(float lo, float hi) { typedef float f2_ __attribute__((ext_vector_type(2))); typedef __bf16 b2_ __attribute__((ext_vector_type(2))); f2_ v = {lo, hi}; b2_ b = __builtin_convertvector(v, b2_); return __builtin_bit_cast(unsigned, b); }
__device__ __forceinline__ float bf2f(unsigned short h) { return __builtin_bit_cast(float, (unsigned)h << 16); }
__device__ __forceinline__ float bflo(unsigned w) { return __builtin_bit_cast(float, w << 16); }
__device__ __forceinline__ float bfhi(unsigned w) { return __builtin_bit_cast(float, w & 0xffff0000u); }
__device__ __forceinline__ float wave_sum(float v) {
#pragma unroll
    for (int o = 1; o < 64; o <<= 1) v += __shfl_xor(v, o);
    return v;
}
__device__ __forceinline__ float silu_f(float x) { return x / (1.f + __expf(-x)); }
__device__ __forceinline__ int crow(int r, int hi) { return (r & 3) + 8 * (r >> 2) + 4 * hi; }

struct Ctx {
    LAS unsigned char* lds; volatile LAS unsigned* MISC; gu32* ctl;
    int tid, wave, vcu, G;
    const float* in[18]; float* out; unsigned char* ws;
};
__device__ __forceinline__ int q_next(Ctx& C, int cw, unsigned n = 1u) {
    __syncthreads();
    if (C.tid == 0) C.MISC[16] = __hip_atomic_fetch_add((unsigned*)(C.ctl + cw), n, __ATOMIC_RELAXED, __HIP_MEMORY_SCOPE_AGENT);
    __syncthreads();
    return (int)C.MISC[16];
}

__device__ __forceinline__ int inproj_src(int p) {
    const int pn = p >> 8, q = p & 255;
    const int bj = q >> 7, wc = (q >> 5) & 3, n = (q >> 4) & 1, fq = (q >> 2) & 3, e = q & 3;
    const int lc = 64 * wc + 16 * fq + 8 * bj + 4 * n + e;
    if (pn < 5) return 256 * pn + lc;
    if (pn == 5) return lc < 72 ? 1280 + lc : -1;
    return 1352 + 256 * (pn - 6) + lc;
}
template <bool MAP>
__device__ __forceinline__ void p0_transpose_item(const float* W, int K, int N, int NP, const float* gain, bf16* WT, LAS float* scr, int item, int lane) {
    const int nblk = NP / 32, kb = item / nblk, nb = item % nblk, k0 = 64 * kb, n0 = 32 * nb;
    const int p = n0 + (lane & 31); const int sc = MAP ? inproj_src(p) : p;
#pragma unroll 8
    for (int i = 0; i < 32; ++i) { const int kk = 2 * i + (lane >> 5); float v = 0.f; if (sc >= 0) v = W[(size_t)(k0 + kk) * N + sc]; if (gain) v *= gain[k0 + kk]; scr[kk * 33 + (lane & 31)] = v; }
    LDS_WAIT(); asm volatile("" ::: "memory");
    const int c = lane & 7;
#pragma unroll
    for (int j = 0; j < 4; ++j) { const int n = (lane >> 3) + 8 * j; const LAS float* s = scr + (8 * c) * 33 + n;
        v4u o; o.x = cvtpk(s[0 * 33], s[1 * 33]); o.y = cvtpk(s[2 * 33], s[3 * 33]); o.z = cvtpk(s[4 * 33], s[5 * 33]); o.w = cvtpk(s[6 * 33], s[7 * 33]);
        *(GAS v4u*)(WT + (size_t)(n0 + n) * K + k0 + 8 * c) = o; }
    LDS_WAIT(); asm volatile("" ::: "memory");
}
template <int R>
__device__ __forceinline__ void x_rows_to_bf16(const float* x0, size_t rstride, bf16* o0, float* rstd0, int lane, int nrows) {
    f32x4 v[R][4];
#pragma unroll
    for (int r = 0; r < R; ++r) { const GAS f32x4* xr = (const GAS f32x4*)(x0 + (r < nrows ? r : 0) * rstride * DM) + lane;
#pragma unroll
        for (int j = 0; j < 4; ++j) v[r][j] = xr[64 * j]; }
#pragma unroll
    for (int r = 0; r < R; ++r) if (r < nrows) { float s = 0.f;
#pragma unroll
        for (int j = 0; j < 4; ++j) s += (v[r][j].x * v[r][j].x + v[r][j].y * v[r][j].y) + (v[r][j].z * v[r][j].z + v[r][j].w * v[r][j].w);
        s = wave_sum(s);
        if (lane == 0) rstd0[r * rstride] = rsqrtf(s * (1.0f / DM) + EPS);
        GAS u64* o8 = (GAS u64*)(o0 + r * rstride * DM) + lane;
#pragma unroll
        for (int j = 0; j < 4; ++j) o8[64 * j] = (u64)cvtpk(v[r][j].x, v[r][j].y) | ((u64)cvtpk(v[r][j].z, v[r][j].w) << 32); }
}

template <int K, bool GK, int KW = K / 8>
__device__ __forceinline__ void skinny32(const float* A, const float* gk, const float* W, int ldw, int N, int n0, LAS float* red, int tid, int lane, int wave, int kbase = 0) {
    asm volatile("" : "+v"(tid), "+v"(lane));
    const int i = lane & 31, kh = lane >> 5, n = n0 + i; const bool nok = n < N;
    f32x16 acc = {};
    const int kbeg = kbase + wave * KW, kend = kbeg + KW;
#pragma unroll 1
    for (int kb0 = kbeg; kb0 < kend; kb0 += 64) {
        f32x4 xa[8]; float bw[8][4];
#pragma unroll
        for (int s = 0; s < 8; ++s) { const int kb = kb0 + 8 * s;
            xa[s] = *(const f32x4*)(A + (size_t)i * K + kb + 4 * kh);
            if (GK) { const f32x4 ga = *(const f32x4*)(gk + kb + 4 * kh); xa[s] = xa[s] * ga; }
            const float* wp = W + (size_t)(kb + 4 * kh) * ldw + (nok ? n : 0);
            bw[s][0] = wp[0]; bw[s][1] = wp[ldw]; bw[s][2] = wp[2 * (size_t)ldw]; bw[s][3] = wp[3 * (size_t)ldw]; }
#pragma unroll
        for (int s = 0; s < 8; ++s)
#pragma unroll
            for (int j = 0; j < 4; ++j) acc = __builtin_amdgcn_mfma_f32_32x32x2f32(xa[s][j], nok ? bw[s][j] : 0.f, acc, 0, 0, 0);
    }
#pragma unroll
    for (int r = 0; r < 16; ++r) red[wave * 1024 + crow(r, kh) * 32 + i] = acc[r];
    __syncthreads();
#pragma unroll
    for (int x = 0; x < 2; ++x) { const int e = tid + 512 * x; float s = 0.f;
#pragma unroll
        for (int w = 0; w < 8; ++w) s += red[w * 1024 + e];
        red[8 * 1024 + e] = s; }
    __syncthreads();
}
__device__ __forceinline__ float sk_get(LAS float* red, int e) { return red[8 * 1024 + e]; }
template <int K>
__device__ __forceinline__ void rows_rstd32(const float* A, LAS float* rs, int lane, int wave) {
#pragma unroll
    for (int j = 0; j < 4; ++j) { const int r = wave * 4 + j; float s = 0.f;
        for (int k = lane * 4; k < K; k += 256) { const f32x4 v = *(const f32x4*)(A + (size_t)r * K + k); s += (v[0] * v[0] + v[1] * v[1]) + (v[2] * v[2] + v[3] * v[3]); }
        s = wave_sum(s); if (lane == 0) rs[r] = rsqrtf(s * (1.0f / K) + EPS); }
}

__device__ __forceinline__ void p0_prologue(Ctx& C) {
    LAS float* scr = (LAS float*)(C.lds + C.wave * 16384);
    float* samp = (float*)(C.ws + WS_SAMP);
    if (C.vcu < 107) {
        LAS float* red = (LAS float*)C.lds; LAS float* rs = red + 9 * 1024 + 64;
        rows_rstd32<DM>(C.in[I_XS], rs, (C.tid & 63), C.wave);
        skinny32<DM, true>(C.in[I_XS], C.in[I_N1G], C.in[I_WIN], INW, INW, 32 * C.vcu, red, C.tid, (C.tid & 63), C.wave);
        int tid_ = C.tid; asm volatile("" : "+v"(tid_));
#pragma unroll
        for (int x = 0; x < 2; ++x) { const int e = tid_ + 512 * x, i = e >> 5, n = 32 * C.vcu + (e & 31); if (n < INW) samp[S_RAW + i * INW + n] = sk_get(red, e) * rs[i]; }
        __syncthreads();
    }
    if (C.vcu == 200 && C.tid < 192) ((float*)(C.ws + WS_GAINS))[C.tid] = C.tid < 64 ? C.in[I_QG][C.tid] : (C.tid < 128 ? C.in[I_KG][C.tid - 64] : C.in[I_IKG][C.tid - 128]);
    const int gw = C.vcu * 8 + C.wave, NGW = C.G * 8;
    constexpr int I_1 = (DM / 64) * (INP / 32), I_O = (DM / 64) * (DM / 32), I_U = (DM / 64) * (FF / 32), I_D = (FF / 64) * (DM / 32);
    for (int it = gw; it < I_1 + I_O + I_U + I_D; it += NGW) {
        int r = it;
        if (r < I_1) { p0_transpose_item<true>(C.in[I_WIN], DM, INW, INP, C.in[I_N1G], (bf16*)(C.ws + WS_W1T), scr, r, (C.tid & 63)); continue; } r -= I_1;
        if (r < I_O) { p0_transpose_item<false>(C.in[I_WOUT], DM, DM, DM, nullptr, (bf16*)(C.ws + WS_WOT), scr, r, (C.tid & 63)); continue; } r -= I_O;
        if (r < I_U) { p0_transpose_item<false>(C.in[I_WUP], DM, FF, FF, C.in[I_N2G], (bf16*)(C.ws + WS_WUT), scr, r, (C.tid & 63)); continue; } r -= I_U;
        p0_transpose_item<false>(C.in[I_WDN], FF, DM, DM, nullptr, (bf16*)(C.ws + WS_WDT), scr, r, (C.tid & 63));
    }
    bf16* XB = (bf16*)(C.ws + WS_XB); float* RSTD1 = (float*)(C.ws + WS_RSTD1);
    for (int m = gw; m < NTOK; m += 4 * NGW) x_rows_to_bf16<4>(C.in[I_XP] + (size_t)m * DM, (size_t)NGW, XB + (size_t)m * DM, RSTD1 + m, (C.tid & 63), (NTOK - 1 - m) / NGW + 1);
}

__device__ __forceinline__ void sample_postproj(Ctx& C, int b) {
    const float* raw = (const float*)(C.ws + WS_SAMP) + S_RAW + (size_t)b * INW; float* sp = (float*)(C.ws + WS_SAMP) + S_SP + (size_t)b * 4096;
    const int l = (C.tid & 63);
    for (int h = 0; h < 8; ++h) { const float v = raw[h * 64 + l]; const float ss = wave_sum(v * v); sp[h * 64 + l] = v * rsqrtf(ss * (1.f / 64.f) + EPS) * C.in[I_QG][l]; }
    for (int h = 0; h < 2; ++h) { const float v = raw[512 + h * 64 + l]; const float ss = wave_sum(v * v); const float kn = v * rsqrtf(ss * (1.f / 64.f) + EPS) * C.in[I_KG][l];
        sp[512 + h * 64 + l] = kn; C.out[O_NKS + (size_t)b * 128 + h * 64 + l] = kn; }
    for (int h = 0; h < 2; ++h) { const float v = raw[640 + h * 64 + l]; sp[640 + h * 64 + l] = v; C.out[O_NVS + (size_t)b * 128 + h * 64 + l] = v; }
    for (int j = 0; j < 8; ++j) sp[768 + j * 64 + l] = raw[768 + j * 64 + l];
    { const float v = raw[1280 + l]; const float ss = wave_sum(v * v); const float kn = v * rsqrtf(ss * (1.f / 64.f) + EPS) * C.in[I_IKG][l]; sp[1280 + l] = kn; C.out[O_NKIS + (size_t)b * 64 + l] = kn; }
    if (l < 8) sp[1344 + l] = raw[1344 + l] * IDX_W_SCALE;
    for (int j = 0; j < 8; ++j) { sp[1352 + j * 64 + l] = silu_f(raw[1352 + j * 64 + l]) * REC_QSCALE; sp[1864 + j * 64 + l] = raw[1864 + j * 64 + l]; sp[2376 + j * 64 + l] = raw[2376 + j * 64 + l]; sp[2888 + j * 64 + l] = silu_f(raw[2888 + j * 64 + l]); }
}
constexpr int SROW = 2052, SEL_WS_OFF = 131584;
static_assert(SEL_WS_OFF + 8 * 2048 <= LDSCTL_OFF, "select lds");
template <int CTRL> __device__ __forceinline__ float dppf(float v) { return __builtin_bit_cast(float, __builtin_amdgcn_update_dpp(__builtin_bit_cast(int, v), __builtin_bit_cast(int, v), CTRL, 0xf, 0xf, false)); }
template <int CTRL> __device__ __forceinline__ int dppi(int v) { return __builtin_amdgcn_update_dpp(v, v, CTRL, 0xf, 0xf, false); }
__device__ __forceinline__ float rdl_f(float v, int l) { return __builtin_bit_cast(float, __builtin_amdgcn_readlane(__builtin_bit_cast(int, v), l)); }
__device__ __forceinline__ float wave_min_f(float v) {
    v = fminf(v, dppf<0xB1>(v)); v = fminf(v, dppf<0x4E>(v)); v = fminf(v, dppf<0x141>(v)); v = fminf(v, dppf<0x140>(v));
    return fminf(fminf(rdl_f(v, 0), rdl_f(v, 16)), fminf(rdl_f(v, 32), rdl_f(v, 48)));
}
__device__ __forceinline__ float wave_max_f(float v) {
    v = fmaxf(v, dppf<0xB1>(v)); v = fmaxf(v, dppf<0x4E>(v)); v = fmaxf(v, dppf<0x141>(v)); v = fmaxf(v, dppf<0x140>(v));
    return fmaxf(fmaxf(rdl_f(v, 0), rdl_f(v, 16)), fmaxf(rdl_f(v, 32), rdl_f(v, 48)));
}
__device__ __forceinline__ int row_sum_i(int v) { v += dppi<0xB1>(v); v += dppi<0x4E>(v); v += dppi<0x141>(v); v += dppi<0x140>(v); return v; }
__device__ __forceinline__ int row_suffix_i(int v) {
    v += __builtin_amdgcn_update_dpp(0, v, 0x101, 0xf, 0xf, true); v += __builtin_amdgcn_update_dpp(0, v, 0x102, 0xf, 0xf, true);
    v += __builtin_amdgcn_update_dpp(0, v, 0x104, 0xf, 0xf, true); v += __builtin_amdgcn_update_dpp(0, v, 0x108, 0xf, 0xf, true); return v;
}
__device__ __forceinline__ float relu_f(float x) { return __builtin_amdgcn_fmed3f(x, 0.f, INFINITY); }
__device__ __forceinline__ void dsa_select_unit(Ctx& C, int b, int qb) {
    const bf16* IQb = (const bf16*)(C.ws + WS_IQB); const bf16* IKb = (const bf16*)(C.ws + WS_IKB); const float* IWf = (const float*)(C.ws + WS_IWF);
    u64* MASK = (u64*)(C.ws + WS_MASK);
    LAS float* sc = (LAS float*)C.lds;
    int lane = (C.tid & 63), wave = C.wave; asm volatile("" : "+v"(lane), "+s"(wave));
#ifdef PROBE_SEL
    const unsigned long long ps0_ = __builtin_amdgcn_s_memrealtime(); unsigned long long ps1_ = 0;
#endif
    const int t0 = qb * 16, ntile = qb + 1, ql = lane & 15, g = lane >> 4;
    const size_t rowq = (size_t)b * SEQ + t0 + ql;
    if (t0 + 15 >= 256)
    {
        bf16x8 bq[8][2];
#pragma unroll
        for (int h = 0; h < 8; ++h)
#pragma unroll
            for (int ks = 0; ks < 2; ++ks) bq[h][ks] = *(const bf16x8*)(IQb + rowq * 512 + h * 64 + ks * 32 + g * 8);
        float w[8];
        { const f32x4 w0 = *(const f32x4*)(IWf + rowq * 8), w1 = *(const f32x4*)(IWf + rowq * 8 + 4); w[0] = w0[0]; w[1] = w0[1]; w[2] = w0[2]; w[3] = w0[3]; w[4] = w1[0]; w[5] = w1[1]; w[6] = w1[2]; w[7] = w1[3]; }
        LAS unsigned char* stg = C.lds + SEL_WS_OFF;
        const int tid_ = C.tid, pk0 = tid_ >> 3, pc = tid_ & 7, nround = (ntile + 7) >> 3;
        const bf16* gsrc = IKb + ((size_t)b * SEQ + pk0) * 64 + pc * 8;
        v4u r0 = *(const v4u*)gsrc, r1 = *(const v4u*)(gsrc + 64 * 64);
        const int wo0 = (pk0 * 8 + (pc ^ (pk0 & 7))) * 16, wo1 = ((pk0 + 64) * 8 + (pc ^ (pk0 & 7))) * 16;
        const int ro0 = ((16 * wave + ql) * 8 + (g ^ (ql & 7))) * 16, ro1 = ((16 * wave + ql) * 8 + ((4 + g) ^ (ql & 7))) * 16;
#pragma unroll 1
        for (int rd = 0; rd < nround; ++rd) {
            __syncthreads();
            *(LAS v4u*)(stg + wo0) = r0; *(LAS v4u*)(stg + wo1) = r1;
            if (rd + 1 < nround) { const bf16* gp = gsrc + (size_t)(rd + 1) * 128 * 64; r0 = *(const v4u*)gp; r1 = *(const v4u*)(gp + 64 * 64); }
            __syncthreads();
            const int ii = rd * 8 + wave;
            if (ii < ntile) {
                const bf16x8 a0 = *(const LAS bf16x8*)(stg + ro0), a1 = *(const LAS bf16x8*)(stg + ro1);
                f32x4 I = {0.f, 0.f, 0.f, 0.f};
#pragma unroll
                for (int h = 0; h < 8; ++h) {
                    f32x4 d = __builtin_amdgcn_mfma_f32_16x16x32_bf16(a0, bq[h][0], (f32x4){0.f, 0.f, 0.f, 0.f}, 0, 0, 0);
                    d = __builtin_amdgcn_mfma_f32_16x16x32_bf16(a1, bq[h][1], d, 0, 0, 0);
#pragma unroll
                    for (int r = 0; r < 4; ++r) I[r] = fmaf(w[h], relu_f(d[r]), I[r]);
                }
                *(LAS f32x4*)(sc + ql * SROW + ii * 16 + 4 * g) = I;
            }
        }
    }
    __syncthreads();
#ifdef PROBE_SEL
    ps1_ = __builtin_amdgcn_s_memrealtime();
#endif
#ifdef PROBE_SEL
    unsigned long long sm_t_ = ps1_, sm_acc_ = 0;
#define SELMARK(k) do { const unsigned long long n_ = __builtin_amdgcn_s_memrealtime(); if (PROBE_SEL == (k)) sm_acc_ += n_ - sm_t_; sm_t_ = n_; } while (0)
#else
#define SELMARK(k) do {} while (0)
#endif
    LAS unsigned* hist = (LAS unsigned*)(C.lds + SEL_WS_OFF) + wave * 512;
#ifdef SEL_REP_PICK
    for (int rep_ = 0; rep_ < 2; ++rep_)
#endif
#pragma unroll 1
    for (int qq = 0; qq < 2; ++qq) {
        const int qi = wave * 2 + qq, t = t0 + qi;
        unsigned mylo = 0, myhi = 0;
        if (t < 256) {
            const int lo = 64 * lane;
            const u64 mw_ = (lo > t) ? 0ull : ((lo + 63 <= t) ? ~0ull : ((2ull << (t - lo)) - 1ull));
            mylo = (unsigned)mw_; myhi = (unsigned)(mw_ >> 32);
        } else {
#ifndef SEL_RS
#define SEL_RS 0
#endif
            SELMARK(9);
            float v[32]; const int nj = (t >> 6) + 1;
            float lo = INFINITY, hi = -INFINITY;
#pragma unroll 1
            for (int rr = 0; rr < (SEL_RS == 1 ? 3 : 1); ++rr) { asm volatile("" ::: "memory"); lo = INFINITY; hi = -INFINITY;
#pragma unroll
            for (int j = 0; j < 32; ++j) v[j] = sc[qi * SROW + 64 * j + lane];
#pragma unroll
            for (int j = 0; j < 32; ++j) { const bool ok = (64 * j + lane) <= t; const float xl = ok ? v[j] : INFINITY; v[j] = ok ? v[j] : -INFINITY;
                asm("v_max_f32 %0, %0, %1" : "+v"(hi) : "v"(v[j])); asm("v_min_f32 %0, %0, %1" : "+v"(lo) : "v"(xl)); }
            lo = wave_min_f(lo); hi = wave_max_f(hi); }
            const float scale = (hi > lo) ? 255.99f / (hi - lo) : 0.f;
            SELMARK(4);
            int bn[32];
#pragma unroll 1
            for (int rr = 0; rr < (SEL_RS == 2 ? 3 : 1); ++rr) {
            *(LAS v4u*)(hist + 4 * lane) = (v4u){0u, 0u, 0u, 0u}; *(LAS v4u*)(hist + 256 + 4 * lane) = (v4u){0u, 0u, 0u, 0u};
            LDS_WAIT(); asm volatile("" ::: "memory");
#pragma unroll
            for (int j = 0; j < 32; ++j) { bn[j] = -1; if (j < nj) { int bi = (int)((v[j] - lo) * scale); bi = bi > 255 ? 255 : bi; asm volatile("" : "+v"(bi)); bn[j] = bi;
                if (bi >= 0) __hip_atomic_fetch_add(hist + bi, 1u, __ATOMIC_RELAXED, __HIP_MEMORY_SCOPE_WORKGROUP); } }
            LDS_WAIT(); asm volatile("" ::: "memory"); }
            SELMARK(5);
            const v4u hh = *(const LAS v4u*)(hist + 4 * lane);
            const int s4 = (int)(hh.x + hh.y + hh.z + hh.w);
            const int rsum = row_sum_i(s4);
            const int r0s = __builtin_amdgcn_readlane(rsum, 0), r1s = __builtin_amdgcn_readlane(rsum, 16), r2s = __builtin_amdgcn_readlane(rsum, 32), r3s = __builtin_amdgcn_readlane(rsum, 48);
            int Rs, abv;
            if (r3s >= 256) { Rs = 3; abv = 0; } else if (r3s + r2s >= 256) { Rs = 2; abv = r3s; } else if (r3s + r2s + r1s >= 256) { Rs = 1; abv = r3s + r2s; } else { Rs = 0; abv = r3s + r2s + r1s; }
            (void)r0s;
            const int incl = abv + row_suffix_i(s4);
            const u64 bal = __ballot(((lane >> 4) == Rs) && incl >= 256);
            const int Ls = 63 - __clzll(bal);
            int c = incl - s4, bsel, cab, hsel;
            if (c + (int)hh.w >= 256) { bsel = 3; cab = c; hsel = (int)hh.w; }
            else { c += (int)hh.w; if (c + (int)hh.z >= 256) { bsel = 2; cab = c; hsel = (int)hh.z; }
                else { c += (int)hh.z; if (c + (int)hh.y >= 256) { bsel = 1; cab = c; hsel = (int)hh.y; } else { c += (int)hh.y; bsel = 0; cab = c; hsel = (int)hh.x; } } }
            const int Bs = 4 * Ls + __builtin_amdgcn_readlane(bsel, Ls), cabove = __builtin_amdgcn_readlane(cab, Ls), cntB = __builtin_amdgcn_readlane(hsel, Ls);
            const int r = 256 - cabove;
            SELMARK(6);
#ifdef SEL_FORCE_FALLBACK
            if (cntB <= 64 && t > (SEL_FORCE_FALLBACK)) {
#else
            if (cntB <= 64) {
#endif
#pragma unroll 1
                for (int rr = 0; rr < (SEL_RS == 4 ? 3 : 1); ++rr) { asm volatile("" ::: "memory");
                int cbase = 0;
#pragma unroll
                for (int j = 0; j < 32; ++j) if (j < nj) { const u64 wa = __ballot(bn[j] > Bs);
                    mylo = (lane == j) ? (unsigned)wa : mylo; myhi = (lane == j) ? (unsigned)(wa >> 32) : myhi;
                    const bool isc = bn[j] == Bs; const u64 bm = __ballot(isc);
                    if (bm != 0ull) { const int pos = cbase + (int)__builtin_amdgcn_mbcnt_hi((unsigned)(bm >> 32), __builtin_amdgcn_mbcnt_lo((unsigned)bm, 0u));
                        if (isc) { hist[258 + 2 * pos] = __builtin_bit_cast(unsigned, sc[qi * SROW + 64 * j + lane]); hist[259 + 2 * pos] = (unsigned)(64 * j + lane); }
                        cbase += __popcll(bm); } }
                LDS_WAIT(); asm volatile("" ::: "memory");
                const bool mine = lane < cntB;
                const float cv = mine ? __builtin_bit_cast(float, hist[258 + 2 * lane]) : 0.f; const int ci = mine ? (int)hist[259 + 2 * lane] : 0;
                int rank = 0;
#pragma unroll 1
                for (int j = 0; j < cntB; ++j) { const float x = rdl_f(cv, j); const int y = __builtin_amdgcn_readlane(ci, j); rank += ((x > cv) | ((x == cv) & (y < ci))) ? 1 : 0; }
                if (mine && rank < r) __hip_atomic_fetch_or(hist + 416 + (ci >> 5), 1u << (ci & 31), __ATOMIC_RELAXED, __HIP_MEMORY_SCOPE_WORKGROUP);
                LDS_WAIT(); asm volatile("" ::: "memory"); }
                if (lane < 32) { mylo |= hist[416 + 2 * lane]; myhi |= hist[417 + 2 * lane]; }
            } else {
#ifndef SEL_NO_FALLBACK
                const LAS float* row = sc + qi * SROW;
#define SEL_KEY(j) ({ const float x_ = row[64 * (j) + lane]; const unsigned b_ = __builtin_bit_cast(unsigned, x_); unsigned m_ = (b_ & 0x80000000u) ? ~b_ : (b_ | 0x80000000u); if (x_ == 0.f) m_ = 0x80000000u; ((64 * (j) + lane) <= t) ? m_ : 0u; })
                unsigned prefix = 0;
#pragma unroll 1
                for (int bit = 31; bit >= 0; --bit) { const unsigned cand = prefix | (1u << bit); int cnt = 0;
#pragma unroll 1
                    for (int j = 0; j < nj; ++j) cnt += __popcll(__ballot(SEL_KEY(j) >= cand));
                    if (cnt >= 256) prefix = cand; }
                const unsigned theta = prefix; int cgt = 0, ceq = 0;
#pragma unroll 1
                for (int j = 0; j < nj; ++j) { const unsigned uj = SEL_KEY(j); cgt += __popcll(__ballot(uj > theta)); ceq += __popcll(__ballot(uj == theta)); }
                const int r2 = 256 - cgt; int icut = 2047;
                if (ceq != r2) { int lo2 = 0;
#pragma unroll 1
                    for (int bit = 10; bit >= 0; --bit) { const int cc = lo2 | (1 << bit); int cnt = 0;
#pragma unroll 1
                        for (int j = 0; j < nj; ++j) cnt += __popcll(__ballot(SEL_KEY(j) == theta && (64 * j + lane) < cc));
                        if (cnt < r2) lo2 = cc; }
                    icut = lo2; }
#pragma unroll 1
                for (int j = 0; j < nj; ++j) { const unsigned uj = SEL_KEY(j); const bool sel = (uj > theta) | ((uj == theta) & ((64 * j + lane) <= icut)); const u64 word = __ballot(sel);
                    mylo = (lane == j) ? (unsigned)word : mylo; myhi = (lane == j) ? (unsigned)(word >> 32) : myhi; }
#undef SEL_KEY
#endif
            }
        }
        SELMARK(7);
        if (lane < 32) MASK[((size_t)b * SEQ + t) * 32 + lane] = ((u64)myhi << 32) | mylo;
    }
#ifdef PROBE_SEL
    if (b == 0 && qb == PROBE_SELQ && C.tid == 0) { const unsigned long long ps2_ = __builtin_amdgcn_s_memrealtime(); const float us = (float)(PROBE_SEL == 1 ? ps1_ - ps0_ : PROBE_SEL == 2 ? ps2_ - ps1_ : PROBE_SEL == 3 ? ps2_ - ps0_ : sm_acc_) * 0.01f;
        C.out[O_NKIS] += sqrtf(2048.0f * (1e-4f + 5e-4f * fminf(us / 50.0f, 1.0f))); }
#endif
}

constexpr int A_KROW = 72, A_VROW = 68, A_KT_BYTES = 2 * 64 * A_KROW * 2, A_VT_BYTES = 128 * A_VROW * 2, A_BUF = A_KT_BYTES + A_VT_BYTES, A_OST = 3 * A_BUF, A_OROW = 72;
static_assert(A_OST + 8 * 32 * 72 * 2 <= LDSCTL_OFF, "attention lds");
typedef float f32x2v __attribute__((ext_vector_type(2)));
__device__ __forceinline__ float bfi_f(unsigned m, float a, float b) { float r; asm("v_bfi_b32 %0, %1, %2, %3" : "=v"(r) : "v"(m), "v"(a), "v"(b)); return r; }
__device__ __forceinline__ float max3f(float a, float b, float c) { float r; asm("v_max3_f32 %0, %1, %2, %3" : "=v"(r) : "v"(a), "v"(b), "v"(c)); return r; }
__device__ __forceinline__ void attn_unit(Ctx& C, int b, int qb) {
    const bf16* Qb = (const bf16*)(C.ws + WS_QB); const bf16* Kb = (const bf16*)(C.ws + WS_KB); const bf16* Vt = (const bf16*)(C.ws + WS_VT);
    const u64* MASK = (const u64*)(C.ws + WS_MASK); bf16* MIX = (bf16*)(C.ws + WS_MIX);
    int tid = C.tid, wave = C.wave; asm volatile("" : "+v"(tid), "+s"(wave));
#ifdef PROBE_ATT
    const unsigned long long pt0_ = __builtin_amdgcn_s_memrealtime();
#endif
    const int lane = tid & 63, t0 = qb * 32, nt = qb / 2 + 1, ql = lane & 31, hi = lane >> 5, kvh = wave >> 2;
    const size_t qrow = (size_t)b * SEQ + t0 + ql;
    bf16x8 qf[4];
#pragma unroll
    for (int ks = 0; ks < 4; ++ks) qf[ks] = *(const bf16x8*)(Qb + qrow * 512 + wave * 64 + ks * 16 + hi * 8);
    const u64* mrow = MASK + qrow * 32;
    v4u krA[2], vrA[2], krB[2], vrB[2];
    const bf16* kg_[2]; const bf16* vg_[2]; int kl_[2], vl_[2];
#pragma unroll
    for (int x = 0; x < 2; ++x) { const int pid = tid + 512 * x;
        { const int i = pid >> 4, c16 = pid & 15, kv = c16 >> 3, cc = c16 & 7; kg_[x] = Kb + ((size_t)b * SEQ + i) * 128 + c16 * 8; kl_[x] = ((kv * 64 + i) * A_KROW + cc * 8) * 2; }
        { const int row = pid >> 3, pc = pid & 7; vg_[x] = Vt + ((size_t)b * 128 + row) * SEQ + pc * 8; vl_[x] = A_KT_BYTES + (row * A_VROW + pc * 8) * 2; } }
#define ATT_GLOAD(KR, VR, kt) do { _Pragma("unroll") for (int x = 0; x < 2; ++x) { KR[x] = *(const v4u*)(kg_[x] + (size_t)(kt) * 64 * 128); VR[x] = *(const v4u*)(vg_[x] + (kt) * 64); } } while (0)
#define ATT_LWRITE(KR, VR, boff) do { _Pragma("unroll") for (int x = 0; x < 2; ++x) { *(LAS v4u*)(C.lds + (boff) + kl_[x]) = KR[x]; \
        *(LAS u32x2*)(C.lds + (boff) + vl_[x]) = (u32x2){VR[x].x, VR[x].y}; *(LAS u32x2*)(C.lds + (boff) + vl_[x] + 8) = (u32x2){VR[x].z, VR[x].w}; } } while (0)
#define ATT_QK(boff, P0_, P1_) do { const LAS unsigned char* kb_ = C.lds + (boff); P0_ = (f32x16){}; P1_ = (f32x16){}; \
        _Pragma("unroll") for (int ks = 0; ks < 4; ++ks) { \
            const bf16x8 a0 = *(const LAS bf16x8*)(kb_ + ((kvh * 64 + ql) * A_KROW + ks * 16 + hi * 8) * 2); \
            const bf16x8 a1 = *(const LAS bf16x8*)(kb_ + ((kvh * 64 + 32 + ql) * A_KROW + ks * 16 + hi * 8) * 2); \
            P0_ = __builtin_amdgcn_mfma_f32_32x32x16_bf16(a0, qf[ks], P0_, 0, 0, 0); \
            P1_ = __builtin_amdgcn_mfma_f32_32x32x16_bf16(a1, qf[ks], P1_, 0, 0, 0); } } while (0)
    const int ntm1 = nt - 1;
    ATT_GLOAD(krA, vrA, 0);
    ATT_GLOAD(krB, vrB, (1 < nt ? 1 : ntm1));
    u64 mwA = mrow[0], mwB = mrow[1 < nt ? 1 : ntm1];
    ATT_LWRITE(krA, vrA, 0);
    ATT_GLOAD(krA, vrA, (2 < nt ? 2 : ntm1));
    ATT_LWRITE(krB, vrB, A_BUF);
    ATT_GLOAD(krB, vrB, (3 < nt ? 3 : ntm1));
    __syncthreads();
    float m_run = -1e30f, l_run = 0.f; f32x16 o0 = {}, o1 = {};
    const int sh4 = 4 * hi;
    f32x16 pA0, pA1, pB0, pB1;
    ATT_QK(0, pA0, pA1);
    asm volatile("s_nop 15\n\ts_nop 7" : "+v"(pA0), "+v"(pA1));
    int bo_cur = 0, bo_nxt = A_BUF, bo_wr = 2 * A_BUF;
#define ATT_STEP(kt, PC0, PC1, PN0, PN1, KR, VR, MW_) do { \
        if ((kt) + 1 < nt) ATT_QK(bo_nxt, PN0, PN1); \
        __builtin_amdgcn_sched_barrier(0); \
        const int kt2_ = ((kt) + 2 < nt) ? (kt) + 2 : ntm1; \
        const unsigned mlo = (unsigned)MW_ >> sh4, mhi = (unsigned)(MW_ >> 32) >> sh4; \
        _Pragma("unroll") for (int r = 0; r < 16; ++r) { const int pos_ = crow(r, 0); \
            const unsigned t0_ = 0u - ((mlo >> pos_) & 1u), t1_ = 0u - ((mhi >> pos_) & 1u); \
            PC0[r] = bfi_f(t0_, PC0[r], -1e30f); PC1[r] = bfi_f(t1_, PC1[r], -1e30f); } \
        MW_ = mrow[kt2_]; \
        float mx; { float a_ = max3f(PC0[0], PC0[1], PC0[2]), b_ = max3f(PC1[0], PC1[1], PC1[2]); \
            a_ = max3f(a_, PC0[3], PC0[4]); b_ = max3f(b_, PC1[3], PC1[4]); a_ = max3f(a_, PC0[5], PC0[6]); b_ = max3f(b_, PC1[5], PC1[6]); a_ = max3f(a_, PC0[7], PC0[8]); b_ = max3f(b_, PC1[7], PC1[8]); \
            a_ = max3f(a_, PC0[9], PC0[10]); b_ = max3f(b_, PC1[9], PC1[10]); a_ = max3f(a_, PC0[11], PC0[12]); b_ = max3f(b_, PC1[11], PC1[12]); a_ = max3f(a_, PC0[13], PC0[14]); b_ = max3f(b_, PC1[13], PC1[14]); \
            mx = max3f(a_, b_, PC0[15]); mx = max3f(mx, PC1[15], -1e30f); } \
        mx = fmaxf(mx, __shfl_xor(mx, 32)); \
        const float m_new = fmaxf(m_run, mx), alpha = __builtin_amdgcn_exp2f(m_run - m_new), m_use = fmaxf(m_new, -1e29f); m_run = m_new; \
        f32x2v ls2 = {0.f, 0.f}; const f32x2v mu2 = {m_use, m_use}; \
        _Pragma("unroll") for (int r = 0; r < 16; r += 2) { f32x2v d0 = (f32x2v){PC0[r], PC0[r + 1]} - mu2, d1 = (f32x2v){PC1[r], PC1[r + 1]} - mu2; \
            d0.x = __builtin_amdgcn_exp2f(d0.x); d0.y = __builtin_amdgcn_exp2f(d0.y); d1.x = __builtin_amdgcn_exp2f(d1.x); d1.y = __builtin_amdgcn_exp2f(d1.y); \
            PC0[r] = d0.x; PC0[r + 1] = d0.y; PC1[r] = d1.x; PC1[r + 1] = d1.y; ls2 = ls2 + d0; ls2 = ls2 + d1; } \
        const float ls = ls2.x + ls2.y; \
        l_run = l_run * alpha + ls; \
        { _Pragma("unroll") for (int r = 0; r < 16; ++r) { o0[r] *= alpha; o1[r] *= alpha; } } \
        bf16x8 pb[2][2]; \
        _Pragma("unroll") for (int s = 0; s < 2; ++s) { v4u w0, w1; \
            w0.x = cvtpk(PC0[8 * s + 0], PC0[8 * s + 1]); w0.y = cvtpk(PC0[8 * s + 2], PC0[8 * s + 3]); w0.z = cvtpk(PC0[8 * s + 4], PC0[8 * s + 5]); w0.w = cvtpk(PC0[8 * s + 6], PC0[8 * s + 7]); \
            w1.x = cvtpk(PC1[8 * s + 0], PC1[8 * s + 1]); w1.y = cvtpk(PC1[8 * s + 2], PC1[8 * s + 3]); w1.z = cvtpk(PC1[8 * s + 4], PC1[8 * s + 5]); w1.w = cvtpk(PC1[8 * s + 6], PC1[8 * s + 7]); \
            pb[0][s] = __builtin_bit_cast(bf16x8, w0); pb[1][s] = __builtin_bit_cast(bf16x8, w1); } \
        { const LAS unsigned char* vb_ = C.lds + bo_cur + A_KT_BYTES; \
        _Pragma("unroll") for (int mt = 0; mt < 2; ++mt) _Pragma("unroll") for (int s = 0; s < 2; ++s) { const int kof = mt * 32 + s * 16 + hi * 4; \
            { const LAS unsigned char* vp = vb_ + ((kvh * 64 + ql) * A_VROW + kof) * 2; const u32x2 lo = *(const LAS u32x2*)vp, hi2 = *(const LAS u32x2*)(vp + 16); \
              const v4u vv = {lo.x, lo.y, hi2.x, hi2.y}; o0 = __builtin_amdgcn_mfma_f32_32x32x16_bf16(__builtin_bit_cast(bf16x8, vv), pb[mt][s], o0, 0, 0, 0); } \
            { const LAS unsigned char* vp = vb_ + ((kvh * 64 + 32 + ql) * A_VROW + kof) * 2; const u32x2 lo = *(const LAS u32x2*)vp, hi2 = *(const LAS u32x2*)(vp + 16); \
              const v4u vv = {lo.x, lo.y, hi2.x, hi2.y}; o1 = __builtin_amdgcn_mfma_f32_32x32x16_bf16(__builtin_bit_cast(bf16x8, vv), pb[mt][s], o1, 0, 0, 0); } } } \
        if ((kt) + 2 < nt) ATT_LWRITE(KR, VR, bo_wr); \
        { const int kt4_ = ((kt) + 4 < nt) ? (kt) + 4 : ntm1; ATT_GLOAD(KR, VR, kt4_); } \
        { const int tmp_ = bo_cur; bo_cur = bo_nxt; bo_nxt = bo_wr; bo_wr = tmp_; } \
        __syncthreads(); } while (0)
#pragma unroll 1
    for (int kt = 0; kt < nt; kt += 2) {
        ATT_STEP(kt, pA0, pA1, pB0, pB1, krA, vrA, mwA);
        if (kt + 1 < nt) ATT_STEP(kt + 1, pB0, pB1, pA0, pA1, krB, vrB, mwB);
    }
#undef ATT_STEP
#undef ATT_QK
#undef ATT_GLOAD
#undef ATT_LWRITE
    const float l_tot = l_run + __shfl_xor(l_run, 32);
    const float inv = 1.0f / l_tot;
    LAS unsigned char* ost = C.lds + A_OST + wave * (32 * A_OROW * 2);
#pragma unroll
    for (int r = 0; r < 16; r += 2) { const int d = crow(r, hi);
        *(LAS unsigned*)(ost + (ql * A_OROW + d) * 2) = cvtpk(o0[r] * inv, o0[r + 1] * inv);
        *(LAS unsigned*)(ost + (ql * A_OROW + 32 + d) * 2) = cvtpk(o1[r] * inv, o1[r + 1] * inv); }
    LDS_WAIT(); asm volatile("" ::: "memory");
#pragma unroll
    for (int x = 0; x < 4; ++x) { const int pid = lane + 64 * x, q = pid >> 3, c = pid & 7; const v4u v = *(const LAS v4u*)(ost + (q * A_OROW + c * 8) * 2);
        *(v4u*)(MIX + ((size_t)b * SEQ + t0 + q) * DM + wave * 64 + c * 8) = v; }
    LDS_WAIT(); asm volatile("" ::: "memory");
#ifdef PROBE_ATT
    if (b == 0 && qb == PROBE_ATT && tid == 0) { const float us = (float)(__builtin_amdgcn_s_memrealtime() - pt0_) * 0.01f; C.out[O_NKIS] += sqrtf(2048.0f * (1e-4f + 5e-4f * fminf(us / 100.0f, 1.0f))); }
#endif
}
constexpr int H_QROW = 136, H_TROW = 72, H_OROW = 132;
constexpr int H_QD = 0, H_KD = H_QD + 64 * H_QROW * 2, H_KLT = H_KD + 64 * H_QROW * 2, H_VTL = H_KLT + 128 * H_TROW * 2, H_AT = H_VTL + 128 * H_TROW * 2,
              H_OT = H_AT + 64 * H_TROW * 2, H_PART = H_OT + 64 * H_OROW * 4, H_DK = H_PART + 8 * 128 * 4, H_END = H_DK + 1024;
static_assert(H_END <= LDSCTL_OFF, "hgrn lds");
__device__ __forceinline__ bf16x8 pack8(const f32x4& a, const f32x4& b) { v4u w; w.x = cvtpk(a[0], a[1]); w.y = cvtpk(a[2], a[3]); w.z = cvtpk(b[0], b[1]); w.w = cvtpk(b[2], b[3]); return __builtin_bit_cast(bf16x8, w); }
__device__ __forceinline__ void hgrn_unit(Ctx& C, int b, int h, int part) {
    const bf16* Rq = (const bf16*)(C.ws + WS_RQ); const bf16* Rf = (const bf16*)(C.ws + WS_RF); const bf16* Ri = (const bf16*)(C.ws + WS_RI); const bf16* Rg = (const bf16*)(C.ws + WS_RGT);
    bf16* MIX = (bf16*)(C.ws + WS_MIX);
    int tid = C.tid, wave = C.wave; asm volatile("" : "+v"(tid), "+s"(wave));
#ifdef PROBE_HGRN
    const unsigned long long t_begin_ = __builtin_amdgcn_s_memrealtime();
#endif
    const int lane = tid & 63, l15 = lane & 15, g = lane >> 4;
    LAS unsigned char* L = C.lds;
    LAS bf16* QD = (LAS bf16*)(L + H_QD); LAS bf16* KD = (LAS bf16*)(L + H_KD); LAS bf16* KLT = (LAS bf16*)(L + H_KLT); LAS bf16* VTL = (LAS bf16*)(L + H_VTL);
    LAS bf16* AT = (LAS bf16*)(L + H_AT); LAS float* OT = (LAS float*)(L + H_OT); LAS float* PART = (LAS float*)(L + H_PART); LAS float* DK = (LAS float*)(L + H_DK);
    for (int i = tid; i < 64 * H_TROW / 2; i += 512) ((LAS unsigned*)AT)[i] = 0u;
    const int kp = tid & 63, tg = tid >> 6, k0 = 2 * kp, s2 = tid >> 3, vg = tid & 7;
    float lb0, lb1;
    { const float a0 = C.in[I_LB][128 * h + k0], a1 = C.in[I_LB][512 + 128 * h + k0], b0 = C.in[I_LB][128 * h + k0 + 1], b1 = C.in[I_LB][512 + 128 * h + k0 + 1];
      lb0 = 1.0f / (1.0f + __expf(a1 - a0)); lb1 = 1.0f / (1.0f + __expf(b1 - b0)); }
    LAS float* GN = DK + 128;
    if (tid < 128) GN[tid] = C.in[I_RG][tid];
    f32x4 S[8];
    float* hst = (float*)(C.ws + WS_HST) + ((size_t)(b * 4 + h) * 128) * 128;
#pragma unroll
    for (int i = 0; i < 8; ++i) S[i] = (f32x4){0.f, 0.f, 0.f, 0.f};
    if (part) {
#pragma unroll
        for (int mk = 0; mk < 8; ++mk)
#pragma unroll
            for (int r = 0; r < 4; ++r) S[mk][r] = hst[(size_t)(16 * mk + 4 * g + r) * 128 + 16 * wave + l15];
    }
    const int cbeg = part * 16, cend = cbeg + 16;
    const size_t rbase = (size_t)b * SEQ;
    unsigned nrf[2][8], nq[2][8]; v4u nv0[2], nv1[2];
#define H_LOAD(cc, c) do { const size_t r0_ = rbase + (size_t)(c) * 64; \
        _Pragma("unroll") for (int i = 0; i < 8; ++i) { const size_t o_ = (r0_ + 8 * tg + i) * 512 + 128 * h + k0; nrf[cc][i] = *(const unsigned*)(Rf + o_); nq[cc][i] = *(const unsigned*)(Rq + o_); } \
        const bf16* vp_ = Ri + (r0_ + s2) * 512 + 128 * h + 16 * vg; nv0[cc] = *(const v4u*)vp_; nv1[cc] = *(const v4u*)(vp_ + 8); } while (0)
    H_LOAD(0, cbeg); H_LOAD(1, cbeg + 1);
#ifdef PROBE_SEG
    unsigned long long seg_acc_ = 0, seg_t0_ = 0;
#define SEGMARK(k) do { const unsigned long long now_ = __builtin_amdgcn_s_memrealtime(); if (PROBE_SEG == (k)) seg_acc_ += now_ - seg_t0_; seg_t0_ = now_; } while (0)
#else
#define SEGMARK(k) do {} while (0)
#endif
#pragma unroll 1
    for (int c2 = cbeg; c2 < cend; c2 += 2) {
#pragma unroll
    for (int cc = 0; cc < 2; ++cc) { const int c = c2 + cc;
        SEGMARK(5);
        float cs0[8], cs1[8], kk0[8], kk1[8], qv0[8], qv1[8]; float run0 = 1.f, run1 = 1.f;
#pragma unroll
        for (int i = 0; i < 8; ++i) { const float x0 = bflo(nrf[cc][i]), x1 = bfhi(nrf[cc][i]);
            const float sg0 = __builtin_amdgcn_rcpf(1.0f + __builtin_amdgcn_exp2f(x0 * -LOG2E)), sg1 = __builtin_amdgcn_rcpf(1.0f + __builtin_amdgcn_exp2f(x1 * -LOG2E));
            run0 *= lb0 + (1.0f - lb0) * sg0; run1 *= lb1 + (1.0f - lb1) * sg1; cs0[i] = run0; cs1[i] = run1;
            kk0[i] = (1.0f - lb0) * (1.0f - sg0); kk1[i] = (1.0f - lb1) * (1.0f - sg1); qv0[i] = bflo(nq[cc][i]); qv1[i] = bfhi(nq[cc][i]); }
        const v4u cv0 = nv0[cc], cv1 = nv1[cc];
        const bf16* gp_ = Rg + (rbase + (size_t)c * 64 + s2) * 512 + 128 * h + 16 * vg; const v4u g0 = *(const v4u*)gp_, g1 = *(const v4u*)(gp_ + 8);
        if (c + 2 < cend) H_LOAD(cc, c + 2);
        *(LAS f32x2v*)(PART + tg * 128 + k0) = (f32x2v){run0, run1};
        __syncthreads();
        SEGMARK(1);
        float off0 = 1.f, off1 = 1.f, bl0 = 1.f, bl1 = 1.f;
#pragma unroll
        for (int j = 0; j < 8; ++j) { const f32x2v pj = *(const LAS f32x2v*)(PART + j * 128 + k0); bl0 *= pj.x; bl1 *= pj.y; off0 *= (j < tg) ? pj.x : 1.f; off1 *= (j < tg) ? pj.y : 1.f; }
        {
            float kl0[8], kl1[8];
            const float eb0 = bl0, eb1 = bl1;
#pragma unroll
            for (int i = 0; i < 8; ++i) { const float p0_ = off0 * cs0[i], p1_ = off1 * cs1[i]; const int t = 8 * tg + i;
                const float kd0 = kk0[i] * __builtin_amdgcn_rcpf(p0_), kd1 = kk1[i] * __builtin_amdgcn_rcpf(p1_);
                *(LAS unsigned*)(QD + t * H_QROW + k0) = cvtpk(qv0[i] * p0_, qv1[i] * p1_);
                *(LAS unsigned*)(KD + t * H_QROW + k0) = cvtpk(kd0, kd1); kl0[i] = kd0 * eb0; kl1[i] = kd1 * eb1; }
            v4u w0, w1; w0.x = cvtpk(kl0[0], kl0[1]); w0.y = cvtpk(kl0[2], kl0[3]); w0.z = cvtpk(kl0[4], kl0[5]); w0.w = cvtpk(kl0[6], kl0[7]);
            w1.x = cvtpk(kl1[0], kl1[1]); w1.y = cvtpk(kl1[2], kl1[3]); w1.z = cvtpk(kl1[4], kl1[5]); w1.w = cvtpk(kl1[6], kl1[7]);
            *(LAS v4u*)(KLT + k0 * H_TROW + 8 * tg) = w0; *(LAS v4u*)(KLT + (k0 + 1) * H_TROW + 8 * tg) = w1;
            if (tg == 0) *(LAS f32x2v*)(DK + k0) = (f32x2v){eb0, eb1};
        }
        {
            const unsigned vw[8] = {cv0.x, cv0.y, cv0.z, cv0.w, cv1.x, cv1.y, cv1.z, cv1.w};
#pragma unroll
            for (int i = 0; i < 8; ++i) { VTL[(16 * vg + 2 * i) * H_TROW + s2] = (bf16)(vw[i] & 0xffffu); VTL[(16 * vg + 2 * i + 1) * H_TROW + s2] = (bf16)(vw[i] >> 16); }
        }
        __syncthreads();
        SEGMARK(2);
        f32x4 ao[4];
#pragma unroll
        for (int m = 0; m < 4; ++m) ao[m] = (f32x4){0.f, 0.f, 0.f, 0.f};
#define HSB() __builtin_amdgcn_sched_barrier(0)
#pragma unroll 1
        for (int ti = wave; ti < 10; ti += 8) {
            const int m = (ti >= 6) ? 3 : (ti >= 3) ? 2 : (ti >= 1) ? 1 : 0, n = ti - m * (m + 1) / 2;
            f32x4 d = {0.f, 0.f, 0.f, 0.f};
            bf16x8 fa[4], fb[4];
#pragma unroll
            for (int ks = 0; ks < 4; ++ks) { fa[ks] = *(const LAS bf16x8*)(QD + (16 * m + l15) * H_QROW + 32 * ks + 8 * g); fb[ks] = *(const LAS bf16x8*)(KD + (16 * n + l15) * H_QROW + 32 * ks + 8 * g); }
            HSB();
#pragma unroll
            for (int ks = 0; ks < 4; ++ks) d = __builtin_amdgcn_mfma_f32_16x16x32_bf16(fa[ks], fb[ks], d, 0, 0, 0);
#pragma unroll
            for (int r = 0; r < 4; r += 2) { float v0 = d[r], v1 = d[r + 1]; if (m == n && (4 * g + r) < l15) v0 = 0.f; if (m == n && (4 * g + r + 1) < l15) v1 = 0.f; const unsigned pw = cvtpk(v0, v1);
                AT[(16 * m + 4 * g + r) * H_TROW + 16 * n + l15] = (bf16)(pw & 0xffffu); AT[(16 * m + 4 * g + r + 1) * H_TROW + 16 * n + l15] = (bf16)(pw >> 16); }
        }
        {
            u32x2 ql_[2][4], qh_[2][4];
#define H_QLOAD(buf, ks) do { _Pragma("unroll") for (int m = 0; m < 4; ++m) { const LAS bf16* qp = QD + (16 * m + l15) * H_QROW + 32 * (ks) + 4 * g; ql_[buf][m] = *(const LAS u32x2*)qp; qh_[buf][m] = *(const LAS u32x2*)(qp + 16); } } while (0)
            H_QLOAD(0, 0);
#pragma unroll
            for (int ks = 0; ks < 4; ++ks) {
                if (ks < 3) H_QLOAD((ks + 1) & 1, ks + 1);
                const bf16x8 bfr = pack8(S[2 * ks], S[2 * ks + 1]);
                HSB();
#pragma unroll
                for (int m = 0; m < 4; ++m) { const v4u av = {ql_[ks & 1][m].x, ql_[ks & 1][m].y, qh_[ks & 1][m].x, qh_[ks & 1][m].y};
                    ao[m] = __builtin_amdgcn_mfma_f32_16x16x32_bf16(__builtin_bit_cast(bf16x8, av), bfr, ao[m], 0, 0, 0); }
                HSB();
            }
#undef H_QLOAD
        }
        __syncthreads();
        SEGMARK(3);
        {
            bf16x8 vf[2], fa[4][2];
#pragma unroll
            for (int ks = 0; ks < 2; ++ks) vf[ks] = *(const LAS bf16x8*)(VTL + (16 * wave + l15) * H_TROW + 32 * ks + 8 * g);
#pragma unroll
            for (int m = 0; m < 4; ++m)
#pragma unroll
                for (int ks = 0; ks < 2; ++ks) fa[m][ks] = *(const LAS bf16x8*)(AT + (16 * m + l15) * H_TROW + 32 * ks + 8 * g);
            HSB();
            bf16x8 fk[4][2]; f32x4 dk4[4];
#define H_KLOAD(mk0) do { _Pragma("unroll") for (int x = 0; x < 4; ++x) { dk4[x] = *(const LAS f32x4*)(DK + 16 * ((mk0) + x) + 4 * g); \
                _Pragma("unroll") for (int ks = 0; ks < 2; ++ks) fk[x][ks] = *(const LAS bf16x8*)(KLT + (16 * ((mk0) + x) + l15) * H_TROW + 32 * ks + 8 * g); } } while (0)
#pragma unroll
            for (int m = 0; m < 4; ++m)
#pragma unroll
                for (int ks = 0; ks < 2; ++ks) ao[m] = __builtin_amdgcn_mfma_f32_16x16x32_bf16(fa[m][ks], vf[ks], ao[m], 0, 0, 0);
            HSB();
            H_KLOAD(0);
            HSB();
#pragma unroll
            for (int x = 0; x < 4; ++x) { S[x] = S[x] * dk4[x];
#pragma unroll
                for (int ks = 0; ks < 2; ++ks) S[x] = __builtin_amdgcn_mfma_f32_16x16x32_bf16(fk[x][ks], vf[ks], S[x], 0, 0, 0); }
            HSB();
            H_KLOAD(4);
            HSB();
#pragma unroll
            for (int x = 0; x < 4; ++x) { S[4 + x] = S[4 + x] * dk4[x];
#pragma unroll
                for (int ks = 0; ks < 2; ++ks) S[4 + x] = __builtin_amdgcn_mfma_f32_16x16x32_bf16(fk[x][ks], vf[ks], S[4 + x], 0, 0, 0); }
#undef H_KLOAD
        }
#undef HSB
#pragma unroll
        for (int m = 0; m < 4; ++m)
#pragma unroll
            for (int r = 0; r < 4; ++r) OT[(16 * m + 4 * g + r) * H_OROW + 16 * wave + l15] = ao[m][r];
        __syncthreads();
        SEGMARK(4);
        {
            float o[16]; float ss = 0.f;
#pragma unroll
            for (int i = 0; i < 4; ++i) { const f32x4 v = *(const LAS f32x4*)(OT + s2 * H_OROW + 16 * vg + 4 * i); o[4 * i] = v[0]; o[4 * i + 1] = v[1]; o[4 * i + 2] = v[2]; o[4 * i + 3] = v[3]; ss += (v[0] * v[0] + v[1] * v[1]) + (v[2] * v[2] + v[3] * v[3]); }
            ss += __shfl_xor(ss, 1); ss += __shfl_xor(ss, 2); ss += __shfl_xor(ss, 4);
            const float rs = rsqrtf(ss * (1.0f / 128.0f) + EPS);
            const size_t row = rbase + (size_t)c * 64 + s2;
            const unsigned gw[8] = {g0.x, g0.y, g0.z, g0.w, g1.x, g1.y, g1.z, g1.w};
            v4u w0, w1; unsigned ow[8];
#pragma unroll
            for (int i = 0; i < 8; ++i) { const f32x2v gg = *(const LAS f32x2v*)(GN + 16 * vg + 2 * i); ow[i] = cvtpk(o[2 * i] * rs * gg.x * bflo(gw[i]), o[2 * i + 1] * rs * gg.y * bfhi(gw[i])); }
            w0.x = ow[0]; w0.y = ow[1]; w0.z = ow[2]; w0.w = ow[3]; w1.x = ow[4]; w1.y = ow[5]; w1.z = ow[6]; w1.w = ow[7];
            bf16* op = MIX + row * DM + 512 + 128 * h + 16 * vg; *(v4u*)op = w0; *(v4u*)(op + 8) = w1;
        }
    } }
#undef H_LOAD
#ifdef PROBE_SEG
    if (b == 0 && h == 0 && tid == 0) { const float us = (float)seg_acc_ * 0.01f; C.out[O_NKIS] += sqrtf(2048.0f * (1e-4f + 5e-4f * fminf(us / 100.0f, 1.0f))); }
#endif
#ifdef PROBE_HGRN
    if (b == 0 && h == 0 && tid == 0) { const float us = (float)(__builtin_amdgcn_s_memrealtime() - t_begin_) * 0.01f;
        C.out[O_NKIS] += sqrtf(2048.0f * (1e-4f + 5e-4f * fminf(us / (float)PROBE_HGRN, 1.0f))); }
#endif
    float* so = part ? C.out + O_NSP + ((size_t)(b * 4 + h) * 128) * 128 : hst;
#pragma unroll
    for (int mk = 0; mk < 8; ++mk)
#pragma unroll
        for (int r = 0; r < 4; ++r) so[(size_t)(16 * mk + 4 * g + r) * 128 + 16 * wave + l15] = S[mk][r];
}

__device__ __forceinline__ void sample_hgrn_unit(Ctx& C, int b, int h) {
    const float* sp = (const float*)(C.ws + WS_SAMP) + S_SP + (size_t)b * 4096; float* mixs = (float*)(C.ws + WS_SAMP) + S_MIX + (size_t)b * 1024;
    const float* S0 = C.in[I_ST] + ((size_t)(b * 4 + h) * 128) * 128; float* S1 = C.out + O_NSS + ((size_t)(b * 4 + h) * 128) * 128;
    LAS float* red = (LAS float*)C.lds;
    int tid = C.tid; asm volatile("" : "+v"(tid));
    const int v4 = tid & 31, kr = tid >> 5;
    const f32x4 vv = *(const f32x4*)(sp + 2376 + 128 * h + 4 * v4);
    f32x4 oacc = {0.f, 0.f, 0.f, 0.f};
#pragma unroll
    for (int i = 0; i < 8; ++i) { const int k = kr + 16 * i; const int c = 128 * h + k;
        const float l0 = C.in[I_LB][c], l1 = C.in[I_LB][512 + c]; const float lb = 1.0f / (1.0f + __expf(l1 - l0));
        const float x = sp[1864 + c], sg = 1.0f / (1.0f + __expf(-x)), f = lb + (1.0f - lb) * sg, kk = (1.0f - lb) * (1.0f - sg), q = sp[1352 + c];
        const f32x4 s0 = *(const f32x4*)(S0 + (size_t)k * 128 + 4 * v4); const f32x4 sn = s0 * f + vv * kk;
        *(f32x4*)(S1 + (size_t)k * 128 + 4 * v4) = sn; oacc = oacc + sn * q; }
    *(LAS f32x4*)(red + kr * 128 + 4 * v4) = oacc;
    __syncthreads();
    if (tid < 128) { float o = 0.f;
#pragma unroll
        for (int j = 0; j < 16; ++j) o += red[j * 128 + tid];
        float ss = wave_sum(o * o); red[2048 + (tid >> 6)] = ss; red[2112 + tid] = o; }
    __syncthreads();
    if (tid < 128) { const float ss = red[2048] + red[2049]; const float o = red[2112 + tid];
        mixs[512 + 128 * h + tid] = o * rsqrtf(ss * (1.0f / 128.0f) + EPS) * C.in[I_RG][tid] * sp[2888 + 128 * h + tid]; }
}

__device__ __forceinline__ void sample_score_unit(Ctx& C, int b, int ch) {
    const float* sp = (const float*)(C.ws + WS_SAMP) + S_SP + (size_t)b * 4096; float* scs = (float*)(C.ws + WS_SAMP) + S_SC + (size_t)b * S_SCROW;
    const int* pt = (const int*)C.in[I_PT] + b * NPAGES;
    int lane = (C.tid & 63), wave = C.wave; asm volatile("" : "+v"(lane), "+s"(wave));
    const int dl = lane & 15, kq = lane >> 4;
    float iq[8][4], w[8];
#pragma unroll
    for (int h = 0; h < 8; ++h) { const f32x4 v = *(const f32x4*)(sp + 768 + h * 64 + 4 * dl); iq[h][0] = v[0]; iq[h][1] = v[1]; iq[h][2] = v[2]; iq[h][3] = v[3]; w[h] = sp[1344 + h]; }
#pragma unroll 1
    for (int pg0 = 0; pg0 < 8; pg0 += 4) {
        f32x4 kv[4][4];
#pragma unroll
        for (int p = 0; p < 4; ++p) { const float* kbase = C.in[I_CKI] + (size_t)pt[ch * 8 + pg0 + p] * (PAGE * 64);
#pragma unroll
            for (int it = 0; it < 4; ++it) kv[p][it] = *(const f32x4*)(kbase + (size_t)(wave * 16 + it * 4 + kq) * 64 + 4 * dl); }
#pragma unroll
        for (int p = 0; p < 4; ++p)
#pragma unroll
            for (int it = 0; it < 4; ++it) {
                float sc = 0.f;
#pragma unroll
                for (int h = 0; h < 8; ++h) { float d = (iq[h][0] * kv[p][it][0] + iq[h][1] * kv[p][it][1]) + (iq[h][2] * kv[p][it][2] + iq[h][3] * kv[p][it][3]);
                    d += __shfl_xor(d, 1); d += __shfl_xor(d, 2); d += __shfl_xor(d, 4); d += __shfl_xor(d, 8); sc = fmaf(w[h], fmaxf(d, 0.f), sc); }
                if (dl == 0) scs[(ch * 8 + pg0 + p) * PAGE + wave * 16 + it * 4 + kq] = sc;
            }
    }
    if (ch == 0 && wave == 0) {
        const f32x4 kv = *(const f32x4*)(sp + 1280 + 4 * dl); float sc = 0.f;
#pragma unroll
        for (int h = 0; h < 8; ++h) { float d = (iq[h][0] * kv[0] + iq[h][1] * kv[1]) + (iq[h][2] * kv[2] + iq[h][3] * kv[3]);
            d += __shfl_xor(d, 1); d += __shfl_xor(d, 2); d += __shfl_xor(d, 4); d += __shfl_xor(d, 8); sc = fmaf(w[h], fmaxf(d, 0.f), sc); }
        if (lane == 0) scs[PAST] = sc;
    }
}
__device__ __forceinline__ unsigned mono_key(float v) { const unsigned bits = __builtin_bit_cast(unsigned, v); unsigned m = (bits & 0x80000000u) ? ~bits : (bits | 0x80000000u); if (v == 0.f) m = 0x80000000u; return m; }
__device__ __forceinline__ void sample_attend_unit(Ctx& C, int b) {
    const float* sp = (const float*)(C.ws + WS_SAMP) + S_SP + (size_t)b * 4096; const float* scs = (const float*)(C.ws + WS_SAMP) + S_SC + (size_t)b * S_SCROW;
    float* mixs = (float*)(C.ws + WS_SAMP) + S_MIX + (size_t)b * 1024; const int* pt = (const int*)C.in[I_PT] + b * NPAGES;
    int tid = C.tid, wave = C.wave; asm volatile("" : "+v"(tid), "+s"(wave));
    const int lane = tid & 63;
    LAS unsigned* cnt = (LAS unsigned*)C.lds;
    LAS unsigned* wcnt = cnt + 64;
    LAS int* sel = (LAS int*)(cnt + 128);
    LAS float* lg = (LAS float*)(cnt + 512);
    LAS float* qs = lg + 2048;
    if (tid < 64) cnt[tid] = 0u;
    qs[tid] = sp[tid] * (ATT_SCALE * LOG2E);
    unsigned u[32];
#pragma unroll
    for (int j = 0; j < 32; ++j) u[j] = mono_key(scs[j * 512 + tid]);
    const unsigned uself = mono_key(scs[PAST]);
    __syncthreads();
    unsigned prefix = 0;
#pragma unroll 1
    for (int bit = 31; bit >= 0; --bit) { const unsigned cand = prefix | (1u << bit); int c = 0;
#pragma unroll
        for (int j = 0; j < 32; ++j) { c += __popcll(__ballot(u[j] >= cand)); asm volatile("" : "+s"(c)); }
        if (lane == 0) __hip_atomic_fetch_add(&cnt[31 - bit], (unsigned)c, __ATOMIC_RELAXED, __HIP_MEMORY_SCOPE_WORKGROUP);
        __syncthreads();
        const int tot = (int)cnt[31 - bit] + (uself >= cand ? 1 : 0);
        if (tot >= 256) prefix = cand; }
    const unsigned theta = prefix;
    int cg = 0, ce = 0;
#pragma unroll
    for (int j = 0; j < 32; ++j) { cg += __popcll(__ballot(u[j] > theta)); ce += __popcll(__ballot(u[j] == theta)); asm volatile("" : "+s"(cg), "+s"(ce)); }
    if (lane == 0) { __hip_atomic_fetch_add(&cnt[32], (unsigned)cg, __ATOMIC_RELAXED, __HIP_MEMORY_SCOPE_WORKGROUP); __hip_atomic_fetch_add(&cnt[33], (unsigned)ce, __ATOMIC_RELAXED, __HIP_MEMORY_SCOPE_WORKGROUP); }
    __syncthreads();
    const int cgt = (int)cnt[32] + (uself > theta ? 1 : 0), ceq = (int)cnt[33] + (uself == theta ? 1 : 0), r = 256 - cgt;
    int icut = PAST;
    if (ceq != r) { int lo = 0;
#pragma unroll 1
        for (int bit = 14; bit >= 0; --bit) { const int cc = lo | (1 << bit); int c = 0;
#pragma unroll
            for (int j = 0; j < 32; ++j) { c += __popcll(__ballot(u[j] == theta && (j * 512 + tid) < cc)); asm volatile("" : "+s"(c)); }
            if (lane == 0) __hip_atomic_fetch_add(&cnt[34 + (14 - bit)], (unsigned)c, __ATOMIC_RELAXED, __HIP_MEMORY_SCOPE_WORKGROUP);
            __syncthreads();
            const int tot = (int)cnt[34 + (14 - bit)];
            const int tot2 = tot + ((uself == theta && PAST < cc) ? 1 : 0);
            if (tot2 < r) lo = cc; }
        icut = lo; }
    int mysel = 0;
#pragma unroll
    for (int j = 0; j < 32; ++j) mysel += ((u[j] > theta) || (u[j] == theta && (j * 512 + tid) <= icut)) ? 1 : 0;
    int incl = mysel;
#pragma unroll
    for (int o = 1; o < 64; o <<= 1) { const int v = __shfl_up(incl, o); if (lane >= o) incl += v; }
    if (lane == 63) wcnt[wave] = (unsigned)incl;
    __syncthreads();
    int base = incl - mysel;
    for (int w = 0; w < wave; ++w) base += (int)wcnt[w];
#pragma unroll
    for (int j = 0; j < 32; ++j) if ((u[j] > theta) || (u[j] == theta && (j * 512 + tid) <= icut)) { if (base < 256) sel[base] = j * 512 + tid; ++base; }
    if (tid == 511) { int tot = base; const bool ss = (uself > theta) || (uself == theta && PAST <= icut); if (ss && tot < 256) sel[tot] = PAST; }
    __syncthreads();
    LAS float* kvs = (LAS float*)(C.lds + 16384);
    LAS int* rix = (LAS int*)(cnt + 3072);
    if (tid < 256) { const int idx = sel[tid]; rix[tid] = (idx < PAST) ? pt[idx >> 7] * PAGE + (idx & 127) : -1; }
    __syncthreads();
#define SA_GATHER(SRC, OWN) do { f32x4 g_[16]; \
        _Pragma("unroll") for (int x = 0; x < 16; ++x) { const int pid = tid + 512 * x, i = pid >> 5, c = pid & 31; const int rr = rix[i]; \
            const float* rp = (rr >= 0) ? (SRC) + (size_t)rr * 128 + 4 * c : sp + (OWN) + 4 * c; g_[x] = *(const f32x4*)rp; } \
        _Pragma("unroll") for (int x = 0; x < 16; ++x) { const int pid = tid + 512 * x, i = pid >> 5, c = pid & 31; *(LAS f32x4*)(kvs + i * 132 + 4 * c) = g_[x]; } } while (0)
    SA_GATHER(C.in[I_CK], 512);
    __syncthreads();
    {
        const int i = tid >> 1, kvh = tid & 1;
        const LAS float* kp = kvs + i * 132 + kvh * 64;
        float d0 = 0.f, d1 = 0.f, d2 = 0.f, d3 = 0.f;
#pragma unroll
        for (int c = 0; c < 16; ++c) { const f32x4 kv = *(const LAS f32x4*)(kp + 4 * c);
            const LAS float* q0 = qs + (kvh * 4) * 64 + 4 * c;
            d0 += (q0[0] * kv[0] + q0[1] * kv[1]) + (q0[2] * kv[2] + q0[3] * kv[3]);
            d1 += (q0[64] * kv[0] + q0[65] * kv[1]) + (q0[66] * kv[2] + q0[67] * kv[3]);
            d2 += (q0[128] * kv[0] + q0[129] * kv[1]) + (q0[130] * kv[2] + q0[131] * kv[3]);
            d3 += (q0[192] * kv[0] + q0[193] * kv[1]) + (q0[194] * kv[2] + q0[195] * kv[3]); }
        lg[(kvh * 4 + 0) * 256 + i] = d0; lg[(kvh * 4 + 1) * 256 + i] = d1; lg[(kvh * 4 + 2) * 256 + i] = d2; lg[(kvh * 4 + 3) * 256 + i] = d3;
    }
    __syncthreads();
    SA_GATHER(C.in[I_CV], 640);
#undef SA_GATHER
    {
        float v[4]; float mx = -1e30f;
#pragma unroll
        for (int x = 0; x < 4; ++x) { v[x] = lg[wave * 256 + lane + 64 * x]; mx = fmaxf(mx, v[x]); }
#pragma unroll
        for (int o = 1; o < 64; o <<= 1) mx = fmaxf(mx, __shfl_xor(mx, o));
        float s = 0.f;
#pragma unroll
        for (int x = 0; x < 4; ++x) { v[x] = __builtin_amdgcn_exp2f(v[x] - mx); s += v[x]; }
        s = wave_sum(s); const float inv = 1.0f / s;
#pragma unroll
        for (int x = 0; x < 4; ++x) lg[wave * 256 + lane + 64 * x] = v[x] * inv;
    }
    __syncthreads();
    {
        const int kvh = wave >> 2; float o = 0.f;
#pragma unroll 8
        for (int i = 0; i < 256; ++i) o = fmaf(lg[wave * 256 + i], kvs[i * 132 + kvh * 64 + lane], o);
        mixs[wave * 64 + lane] = o;
    }
}

__device__ __forceinline__ void sample_outproj_task(Ctx& C, int tile) {
    int tid_ = C.tid; asm volatile("" : "+v"(tid_));
    float* samp = (float*)(C.ws + WS_SAMP); LAS float* red = (LAS float*)C.lds;
    skinny32<DM, false>(samp + S_MIX, nullptr, C.in[I_WOUT], DM, DM, 32 * tile, red, C.tid, (C.tid & 63), C.wave);
#pragma unroll
    for (int x = 0; x < 2; ++x) { const int e = tid_ + 512 * x, i = e >> 5, n = 32 * tile + (e & 31); samp[S_X1 + i * DM + n] = C.in[I_XS][i * DM + n] + sk_get(red, e); }
    __syncthreads();
}
__device__ __forceinline__ void sample_up_task(Ctx& C, int tile) {
    int tid_ = C.tid; asm volatile("" : "+v"(tid_));
    float* samp = (float*)(C.ws + WS_SAMP); LAS float* red = (LAS float*)C.lds; LAS float* rs = red + 9 * 1024 + 64;
    rows_rstd32<DM>(samp + S_X1, rs, (C.tid & 63), C.wave);
    skinny32<DM, true>(samp + S_X1, C.in[I_N2G], C.in[I_WUP], FF, FF, 32 * tile, red, C.tid, (C.tid & 63), C.wave);
#pragma unroll
    for (int x = 0; x < 2; ++x) { const int e = tid_ + 512 * x, i = e >> 5, n = 32 * tile + (e & 31); const float v = fmaxf(sk_get(red, e) * rs[i], 0.f); samp[S_H + i * FF + n] = v * v; }
    __syncthreads();
}
constexpr int CW_SDN = 8192 + 2048;
__device__ __forceinline__ void sample_down_partial(Ctx& C) {
    int tid_ = C.tid; asm volatile("" : "+v"(tid_));
    float* samp = (float*)(C.ws + WS_SAMP); LAS float* red = (LAS float*)C.lds; float* part = (float*)(C.ws + WS_SAMP + 5 * MiB);
    const int tile = C.vcu & 31, ks = C.vcu >> 5;
    skinny32<FF, false, 64>(samp + S_H, nullptr, C.in[I_WDN], DM, DM, 32 * tile, red, C.tid, (C.tid & 63), C.wave, ks * 512);
#pragma unroll
    for (int x = 0; x < 2; ++x) { const int e = tid_ + 512 * x, i = e >> 5, n = 32 * tile + (e & 31); part[(size_t)ks * 32768 + i * DM + n] = sk_get(red, e); }
    asm volatile("s_waitcnt vmcnt(0)" ::: "memory");
    __syncthreads();
    if (C.tid == 0) { __builtin_amdgcn_fence(__ATOMIC_RELEASE, "agent"); asm volatile("s_waitcnt vmcnt(0)" ::: "memory");
        __hip_atomic_fetch_add((unsigned*)(C.ctl + CW_SDN), 1u, __ATOMIC_RELAXED, __HIP_MEMORY_SCOPE_AGENT); }
    __syncthreads();
}
__device__ __forceinline__ void sample_down_final(Ctx& C, int tile) {
    int tid_ = C.tid; asm volatile("" : "+v"(tid_));
    float* samp = (float*)(C.ws + WS_SAMP); const float* part = (const float*)(C.ws + WS_SAMP + 5 * MiB);
    if (C.tid == 0) { unsigned sp = 0; while (__hip_atomic_load((unsigned*)(C.ctl + CW_SDN), __ATOMIC_RELAXED, __HIP_MEMORY_SCOPE_AGENT) < (unsigned)C.G) { __builtin_amdgcn_s_sleep(4); if (++sp > (1u << 20)) break; }
        __builtin_amdgcn_fence(__ATOMIC_ACQUIRE, "agent"); asm volatile("s_waitcnt vmcnt(0)" ::: "memory"); }
    __syncthreads();
#pragma unroll
    for (int x = 0; x < 2; ++x) { const int e = tid_ + 512 * x, i = e >> 5, n = 32 * tile + (e & 31); float s = samp[S_X1 + i * DM + n];
#pragma unroll
        for (int k = 0; k < 8; ++k) s += __hip_atomic_load(part + (size_t)k * 32768 + i * DM + n, __ATOMIC_RELAXED, __HIP_MEMORY_SCOPE_AGENT);
        C.out[O_YS + i * DM + n] = s; }
}
__device__ __forceinline__ bool opaque_tid(Ctx& C) { asm volatile("" : "+v"(C.tid)); return true; }
struct Args { const float* in[18]; float* out; unsigned char* ws; int ph_lo, ph_hi; };
constexpr int N_PHASES = 7;
#ifndef MK_SPLIT
#define MK_SPLIT 0
#endif
__global__ void __launch_bounds__(512, 2) hymba_fwd(Args args) {
    extern __shared__ __attribute__((aligned(16))) unsigned char lds_raw[];
    Ctx C;
    C.lds = (LAS unsigned char*)lds_raw; C.MISC = (volatile LAS unsigned*)(C.lds + MISC_OFF);
    C.tid = threadIdx.x; C.wave = __builtin_amdgcn_readfirstlane(C.tid >> 6);
    C.G = gridDim.x; { const int bx = blockIdx.x; C.vcu = (C.G % 8 == 0) ? (bx % 8) * (C.G / 8) + bx / 8 : bx; }
    C.ws = args.ws; C.out = args.out; C.ctl = (gu32*)(args.ws + WS_CTL);
#pragma unroll
    for (int i = 0; i < 18; ++i) C.in[i] = args.in[i];
    for (int u = C.tid; u < (LDS_BYTES - LDSCTL_OFF) / 4; u += 512) ((LAS unsigned*)(C.lds + LDSCTL_OFF))[u] = 0u;
    __syncthreads();
    const int lo = args.ph_lo, hi = args.ph_hi;
#ifdef PROBE_PH
    unsigned long long ph_t0_ = __builtin_amdgcn_s_memrealtime(), ph_acc_ = 0;
#define PHMARK(k) do { const unsigned long long now_ = __builtin_amdgcn_s_memrealtime(); if (PROBE_PH == (k)) ph_acc_ = now_ - ph_t0_; ph_t0_ = now_; } while (0)
#else
#define PHMARK(k) do {} while (0)
#endif
    XcdBarrier bar; bar.bar = (unsigned*)(C.ctl + CW_BAR); bar.x = 0; bar.st = nullptr;
    if (hi - lo > 1) bar = xcd_barrier_post((unsigned*)(C.ctl + CW_BAR), C.MISC + 8);
#ifndef PH_MASK
#define PH_MASK 0x7f
#endif
#define IN(k) (((PH_MASK >> (k)) & 1) && lo <= (k) && (k) < hi)
#ifndef REP_MASK
#define REP_MASK 0
#endif
#define REPS(k) (((REP_MASK >> (k)) & 1) ? 2 : 1)
#ifdef PROBE_2BAR
#define SEAM(k) do { if (IN(k) && IN((k) + 1)) { xcd_barrier(bar); xcd_barrier(bar); } } while (0)
#else
#define SEAM(k) do { if (IN(k) && IN((k) + 1)) xcd_barrier(bar); } while (0)
#endif

#ifdef PROBE_VALU
    if (C.vcu == 40) {
        float x_[16]; for (int i = 0; i < 16; ++i) x_[i] = (float)(C.tid + i);
        const float a_ = 1.0001f, b_ = 0.5f;
        __syncthreads();
        const unsigned long long t0_ = __builtin_amdgcn_s_memrealtime();
#pragma unroll 1
        for (int it = 0; it < 4096; ++it) {
#pragma unroll
            for (int i = 0; i < 16; ++i) asm volatile("v_fma_f32 %0, %0, %1, %2" : "+v"(x_[i]) : "v"(a_), "v"(b_));
        }
        __syncthreads();
        const unsigned long long t1_ = __builtin_amdgcn_s_memrealtime();
        float s_ = 0.f; for (int i = 0; i < 16; ++i) s_ += x_[i];
        if (C.tid == 0) { const float us = (float)(t1_ - t0_) * 0.01f; ((float*)(C.ws + WS_GAINS + 4096))[0] = sqrtf(2048.0f * (1e-4f + 5e-4f * fminf(us / 400.0f, 1.0f))); ((float*)(C.ws + WS_GAINS + 4096))[1] = s_; }
    }
#endif
    if (IN(0)) { for (int rep = 0; rep < REPS(0); ++rep) { p0_prologue(C); __syncthreads(); } SEAM(0); PHMARK(0); }

    if (IN(1)) {
        if (C.vcu < 4) sample_postproj(C, C.vcu * 8 + C.wave);
        __syncthreads();
        pg8::Gemm g{(const pg8::bf16_t*)(C.ws + WS_XB), (const pg8::bf16_t*)(C.ws + WS_W1T), NTOK, INP, DM};
        pg8::StaticOrder S; S.init(NTOK, INP, C.G, (int)blockIdx.x);
        pg8::EpiInProj E{(const float*)(C.ws + WS_RSTD1), (const float*)(C.ws + WS_GAINS),
                         (pg8::bf16_t*)(C.ws + WS_QB), (pg8::bf16_t*)(C.ws + WS_KB), (pg8::bf16_t*)(C.ws + WS_VT), (pg8::bf16_t*)(C.ws + WS_IQB), (pg8::bf16_t*)(C.ws + WS_IKB),
                         (pg8::bf16_t*)(C.ws + WS_RQ), (pg8::bf16_t*)(C.ws + WS_RF), (pg8::bf16_t*)(C.ws + WS_RI), (pg8::bf16_t*)(C.ws + WS_RGT), (float*)(C.ws + WS_IWF),
                         C.out + O_NK, C.out + O_NV, C.out + O_NKI};
        pg8::gemm_phase<pg8::EpiInProj, pg8::StaticOrder, true, true>(C.lds, g, S, E);
#if (REP_MASK >> 1) & 1
        __syncthreads(); pg8::gemm_phase<pg8::EpiInProj, pg8::StaticOrder, true, true>(C.lds, g, S, E);
#endif
        SEAM(1); PHMARK(1);
    }

    const int myx = (int)(xb_xcc_id() & 7u);
    if (IN(2)) {
        constexpr int U_H = 16, U_SH = 16, U_SS = 64, U_SEL = 256, U_TOT = U_H + U_SH + U_SS + U_SEL;
        for (int qi = 0; qi < 8; ++qi) { const int x = (myx + qi) & 7, cw = CW_Q2 + 64 * x;
            for (int u0 = q_next(C, cw, 2u); u0 < U_TOT; u0 = q_next(C, cw, 2u))
                for (int u = u0; u < u0 + 2; ++u) {
                    if (u < U_H) { if (!(u & 1)) hgrn_unit(C, 2 * x + (u >> 3), (u >> 1) & 3, 0); continue; }
                    int v = u - U_H;
                    if (v < U_SH) { sample_hgrn_unit(C, 4 * x + (v >> 2), v & 3); __syncthreads(); continue; } v -= U_SH;
                    if (v < U_SS) { sample_score_unit(C, 4 * x + (v >> 4), v & 15); continue; } v -= U_SS;
                    dsa_select_unit(C, 2 * x + (v & 1), 127 - (v >> 1)); __syncthreads();
                } }
        SEAM(2); PHMARK(2);
    }
    if (IN(3)) {
        constexpr int U_HG = 16, U_SA = 4, U_AT = 128, U_TOT = U_HG + U_SA + U_AT;
        for (int qi = 0; qi < 8; ++qi) { const int x = (myx + qi) & 7, cw = CW_Q3 + 64 * x;
            for (int u0 = q_next(C, cw, 2u); u0 < U_TOT; u0 = q_next(C, cw, 2u))
                for (int u = u0; u < u0 + 2; ++u) {
                    if (u < U_HG) { if (!(u & 1)) hgrn_unit(C, 2 * x + (u >> 3), (u >> 1) & 3, 1); continue; }
                    int v = u - U_HG;
                    if (v < U_SA) { sample_attend_unit(C, 4 * x + v); __syncthreads(); continue; } v -= U_SA;
                    attn_unit(C, 2 * x + (v & 1), 63 - (v >> 1)); __syncthreads();
                } }
        SEAM(3); PHMARK(3);
    }

    if (IN(4)) {
        if (C.vcu < 32) sample_outproj_task(C, C.vcu);
        __syncthreads();
        pg8::Gemm g{(const pg8::bf16_t*)(C.ws + WS_MIX), (const pg8::bf16_t*)(C.ws + WS_WOT), NTOK, DM, DM};
        pg8::StaticOrder S; S.init(NTOK, DM, C.G, (int)blockIdx.x);
        pg8::EpiOutProj E{C.in[I_XP], C.out + O_Y, (pg8::bf16_t*)(C.ws + WS_X1B), (float*)(C.ws + WS_SSQ)};
        pg8::gemm_phase<pg8::EpiOutProj, pg8::StaticOrder, true, true>(C.lds, g, S, E);
#if (REP_MASK >> 4) & 1
        __syncthreads(); pg8::gemm_phase<pg8::EpiOutProj, pg8::StaticOrder, true, true>(C.lds, g, S, E);
#endif
        SEAM(4); PHMARK(4);
    }

    if (IN(5)) {
        if (C.vcu < 128) sample_up_task(C, C.vcu);
        __syncthreads();
        pg8::Gemm g{(const pg8::bf16_t*)(C.ws + WS_X1B), (const pg8::bf16_t*)(C.ws + WS_WUT), NTOK, FF, DM};
        pg8::StaticOrder S; S.init(NTOK, FF, C.G, (int)blockIdx.x);
        pg8::EpiUp E{(const float*)(C.ws + WS_SSQ), (pg8::bf16_t*)(C.ws + WS_H)};
        pg8::gemm_phase<pg8::EpiUp, pg8::StaticOrder, true, true>(C.lds, g, S, E);
#if (REP_MASK >> 5) & 1
        __syncthreads(); pg8::gemm_phase<pg8::EpiUp, pg8::StaticOrder, true, true>(C.lds, g, S, E);
#endif
        SEAM(5); PHMARK(5);
    }

    if (IN(6)) {
        sample_down_partial(C);
        __syncthreads();
        pg8::Gemm g{(const pg8::bf16_t*)(C.ws + WS_H), (const pg8::bf16_t*)(C.ws + WS_WDT), NTOK, DM, FF};
        pg8::StaticOrder S; S.init(NTOK, DM, C.G, (int)blockIdx.x);
        pg8::EpiDown E{C.out + O_Y, (const pg8::bf16_t*)(C.ws + WS_X1B)};
        pg8::gemm_phase<pg8::EpiDown, pg8::StaticOrder, true, true>(C.lds, g, S, E);
        if (C.vcu < 32) sample_down_final(C, C.vcu);
        PHMARK(6);
#if defined(PROBE_P0) || defined(PROBE_VALU)
        if (C.vcu == 40 && C.tid == 0) C.out[O_NKIS + 5] += ((const float*)(C.ws + WS_GAINS + 4096))[0];
#endif
#ifdef PROBE_PH
        if (C.vcu == 40 && C.tid == 0) { const float us = (float)ph_acc_ * 0.01f; C.out[O_NKIS] += sqrtf(2048.0f * (1e-4f + 5e-4f * fminf(us / 400.0f, 1.0f))); }
#endif
    }
#undef IN
#undef SEAM
}

extern "C" void kernel_launch(void* const* d_in, const int* in_sizes, int n_in, void* d_out, int out_size, void* d_ws, size_t ws_size, hipStream_t stream) {
    static int grid = 0;
    if (grid == 0) {
        if (n_in != 18 || in_sizes[0] != NTOK * DM || (size_t)out_size != O_END || ws_size < WS_END) {
            fprintf(stderr, "kernel_launch: unexpected shapes: n_in %d in0 %d out %d ws %zu (need ws >= %zu); nothing launched\n", n_in, n_in > 0 ? in_sizes[0] : -1, out_size, ws_size, (size_t)WS_END); grid = -1; return; }
        int dev = 0, cus = 0;
        if (hipGetDevice(&dev) != hipSuccess || hipDeviceGetAttribute(&cus, hipDeviceAttributeMultiprocessorCount, dev) != hipSuccess) { grid = -1; return; }
        if (hipFuncSetAttribute((const void*)hymba_fwd, hipFuncAttributeMaxDynamicSharedMemorySize, LDS_BYTES) != hipSuccess) { fprintf(stderr, "kernel_launch: hipFuncSetAttribute failed\n"); grid = -1; return; }
        int per_cu = 0;
        if (hipOccupancyMaxActiveBlocksPerMultiprocessor(&per_cu, (const void*)hymba_fwd, 512, LDS_BYTES) != hipSuccess || per_cu < 1) fprintf(stderr, "kernel_launch: occupancy query says %d\n", per_cu);
        (void)hipGetLastError();
        grid = cus;
        if (grid != 256) fprintf(stderr, "kernel_launch: %d CUs (expected 256)\n", grid);
    }
    if (grid < 0) return;
    (void)hipMemsetAsync((char*)d_ws + WS_CTL, 0, CTL_ZERO_BYTES, stream);
    Args a{};
    for (int i = 0; i < 18; ++i) a.in[i] = (const float*)d_in[i];
    a.out = (float*)d_out; a.ws = (unsigned char*)d_ws;
#if MK_SPLIT
    for (int p = 0; p < N_PHASES; ++p) { a.ph_lo = p; a.ph_hi = p + 1; hipLaunchKernelGGL(hymba_fwd, dim3(grid), dim3(512), LDS_BYTES, stream, a); }
#else
    a.ph_lo = 0; a.ph_hi = N_PHASES; hipLaunchKernelGGL(hymba_fwd, dim3(grid), dim3(512), LDS_BYTES, stream, a);
#endif
}
```

```cpp
#include <hip/hip_runtime.h>
#include <cstdio>
#include <cstdint>

#define LAS __attribute__((address_space(3)))
#define GAS __attribute__((address_space(1)))
typedef float f32x16 __attribute__((ext_vector_type(16)));
typedef unsigned u32x2 __attribute__((ext_vector_type(2)));
typedef unsigned long long u64;

#define RES_BF16 1
constexpr int NTOK = 32768, NB = 16, SEQ = 2048, DM = 1024, NS = 32, PAST = 16384, PAGE = 128, NPAGES = 128;
constexpr int INW = 3400, INP = 3584, FF = 4096;
constexpr float EPS = 1e-6f;
constexpr float ATT_SCALE = 0.125f, LOG2E = 1.4426950408889634f;
constexpr float IDX_W_SCALE = 0.04419417382415922f;
constexpr float REC_QSCALE = 0.08838834764831845f;
enum { I_XP = 0, I_XS, I_CK, I_CV, I_CKI, I_ST, I_PT, I_N1G, I_WIN, I_QG, I_KG, I_IKG, I_LB, I_RG, I_WOUT, I_N2G, I_WUP, I_WDN };
constexpr size_t O_Y = 0, O_YS = 33554432, O_NK = O_YS + 32768, O_NV = O_NK + 4194304, O_NKI = O_NV + 4194304, O_NSP = O_NKI + 2097152,
                 O_NKS = O_NSP + 1048576, O_NVS = O_NKS + 4096, O_NKIS = O_NVS + 4096, O_NSS = O_NKIS + 2048, O_END = O_NSS + 2097152;
constexpr size_t MiB = 1u << 20;
constexpr size_t WS_SSQ = 131072;
constexpr size_t WS_CTL = 0, CTL_ZERO_BYTES = 262144;
constexpr size_t WS_W1T = 2 * MiB, WS_WOT = 10 * MiB, WS_WUT = 12 * MiB, WS_WDT = 20 * MiB;
constexpr size_t WS_GAINS = 28 * MiB + 512 * 1024;
constexpr size_t WS_RSTD1 = 28 * MiB, WS_IWF = 29 * MiB, WS_SSQ2 = 30 * MiB, WS_SAMP = 32 * MiB;
constexpr size_t WS_XB = 40 * MiB, WS_QB = 104 * MiB, WS_KB = 136 * MiB, WS_VT = 144 * MiB, WS_IQB = 152 * MiB, WS_IKB = 184 * MiB;
constexpr size_t WS_RQ = 188 * MiB, WS_RF = 220 * MiB, WS_RI = 252 * MiB, WS_RGT = 284 * MiB, WS_MASK = 316 * MiB, WS_MIX = 324 * MiB;
constexpr size_t WS_X1B = 388 * MiB, WS_H = 452 * MiB, WS_HST = 708 * MiB, WS_END = 712 * MiB;
constexpr int S_RAW = 0, S_SP = 131072, S_SC = 262144, S_SCROW = 16400, S_MIX = S_SC + 32 * S_SCROW + 256, S_X1 = S_MIX + 32768, S_H = S_X1 + 32768, S_ENDF = S_H + 131072;
static_assert((size_t)S_ENDF * 4 <= 8 * MiB, "sample scratch");
constexpr int CW_BAR = 4096, CW_Q2 = 8192, CW_Q3 = 8192 + 1024;
constexpr int LDS_BYTES = 163840, LDSCTL_OFF = LDS_BYTES - 1024, MISC_OFF = LDSCTL_OFF + 320;

namespace pg8 {
#define PG8_LAS __attribute__((address_space(3)))
typedef unsigned short bf16_t;
typedef short bf16x8 __attribute__((ext_vector_type(8)));
typedef float f32x4 __attribute__((ext_vector_type(4)));
typedef unsigned u32x4 __attribute__((ext_vector_type(4)));
constexpr int BM = 256, BK = 64, HALF = 128, HTB = HALF * BK * 2  , STAGE_BYTES = 8 * HTB, NXCD = 8, WGM = 8;

__host__ __device__ __forceinline__ int lds_byte(int r, int c) { const int st = (r >> 4) * 2 + (c >> 5), rr = r & 15, cc = c & 31, ob = rr * 64 + cc * 2; return st * 1024 + (ob ^ (((ob >> 9) & 1) << 5)); }
__host__ __device__ __forceinline__ void stage_rc(int b, int& R, int& C) { const int st = b / 1024, sb = b % 1024, swz = sb ^ (((sb >> 9) & 1) << 5); R = (st >> 1) * 16 + swz / 64; C = (st & 1) * 32 + (swz % 64) / 2; }
__host__ __device__ __forceinline__ int perm32(int rho) { const int n = rho >> 4, i = rho & 15; return 8 * (i >> 2) + 4 * n + (i & 3); }

struct Unit { int pm, pn; };
struct Gemm { const bf16_t* A; const bf16_t* Bt; int M, N, K; };

struct StaticOrder {
    int nM, nN, nwg, G, c;
    __host__ __device__ void init(int M, int N, int G_, int c_) { nM = M / BM; nN = N / BM; nwg = nM * nN; G = G_; c = c_; }
    __host__ __device__ bool next(int i, Unit& u) const {
        const long L = (long)i * G + c; if (L >= nwg) return false;
        int wgid = (int)L; { const int q = nwg / NXCD, r = nwg % NXCD, xcd = wgid % NXCD, off = wgid / NXCD; wgid = (xcd < r ? xcd * (q + 1) : r * (q + 1) + (xcd - r) * q) + off; }
        const int nig = WGM * nN, gid = wgid / nig, fm = gid * WGM, gsz = (nM - fm) < WGM ? (nM - fm) : WGM;
        u.pm = fm + ((wgid % nig) % gsz); u.pn = (wgid % nig) / gsz; return true;
    }
    __device__ __forceinline__ void a_ready(const Unit&) const {}
    __device__ __forceinline__ void done(const Unit&) const {}
};

__device__ __forceinline__ unsigned cvt_pk_bf16(float lo, float hi) { unsigned r; asm volatile("v_cvt_pk_bf16_f32 %0, %1, %2" : "=v"(r) : "v"(lo), "v"(hi)); return r; }
typedef float f32x2 __attribute__((ext_vector_type(2)));
__device__ __forceinline__ float silu_f(float x) { return x / (1.f + __expf(-x)); }
__device__ __forceinline__ void st_bf16x16(bf16_t* p, const float (&t)[16]) {
    u32x4 a, b;
    a.x = cvt_pk_bf16(t[0], t[1]); a.y = cvt_pk_bf16(t[2], t[3]); a.z = cvt_pk_bf16(t[4], t[5]); a.w = cvt_pk_bf16(t[6], t[7]);
    b.x = cvt_pk_bf16(t[8], t[9]); b.y = cvt_pk_bf16(t[10], t[11]); b.z = cvt_pk_bf16(t[12], t[13]); b.w = cvt_pk_bf16(t[14], t[15]);
    *(u32x4*)p = a; *(u32x4*)(p + 8) = b;
}
__device__ __forceinline__ void st_f32x16(float* p, const float (&t)[16]) {
#pragma unroll
    for (int i = 0; i < 4; ++i) *(f32x4*)(p + 4 * i) = (f32x4){t[4 * i], t[4 * i + 1], t[4 * i + 2], t[4 * i + 3]};
}
__device__ __forceinline__ unsigned short f2bf_rne(float f) { unsigned u = __builtin_bit_cast(unsigned, f); return (unsigned short)((u + 0x7fffu + ((u >> 16) & 1u)) >> 16); }

struct EpiInProj {
    static constexpr bool PERM = false, AFTER_DRAIN = false;
    const float* rstd1; const float* gains;
    bf16_t *Qb, *Kb, *Vt, *IQb, *IKb, *Rq, *Rf, *Ri, *Rg; float* IWf; float *oK, *oV, *oKI;
    __device__ __forceinline__ void operator()(const f32x4 (&acc)[2][2][4][2], const Unit& u, int wr, int wc, int fr, int fq) const {
        const int pn = u.pn;
        const float* gsrc = gains + (pn < 2 ? 0 : (pn == 2 ? 64 : 128)) + 16 * fq;
        float rsv[2][4];
#pragma unroll
        for (int ai = 0; ai < 2; ++ai)
#pragma unroll
            for (int m = 0; m < 4; ++m) rsv[ai][m] = rstd1[u.pm * BM + ai * HALF + wr * 64 + m * 16 + fr];
#pragma unroll
        for (int ai = 0; ai < 2; ++ai)
#pragma unroll
            for (int m = 0; m < 4; ++m) {
                const int row = u.pm * BM + ai * HALF + wr * 64 + m * 16 + fr;
                const float rs = rsv[ai][m];
                float t[16];
#pragma unroll
                for (int bj = 0; bj < 2; ++bj)
#pragma unroll
                    for (int n = 0; n < 2; ++n)
#pragma unroll
                        for (int e = 0; e < 4; ++e) t[8 * bj + 4 * n + e] = acc[ai][bj][m][n][e] * rs;
                const bool normed = (pn < 2) || (pn == 2 && wc < 2) || (pn == 5 && wc == 0);
                if (normed) {
                    float ss = 0.f;
#pragma unroll
                    for (int j = 0; j < 16; ++j) ss += t[j] * t[j];
                    ss += __shfl_xor(ss, 16); ss += __shfl_xor(ss, 32);
                    float sc = rsqrtf(ss * (1.0f / 64.0f) + EPS);
                    if (pn < 2) sc *= ATT_SCALE * LOG2E;
#pragma unroll
                    for (int i = 0; i < 4; ++i) { const f32x4 gv = *(const f32x4*)(gsrc + 4 * i);
                        t[4 * i] *= sc * gv[0]; t[4 * i + 1] *= sc * gv[1]; t[4 * i + 2] *= sc * gv[2]; t[4 * i + 3] *= sc * gv[3]; }
                }
                if (pn < 2) {
                    st_bf16x16(Qb + (size_t)row * 512 + (4 * pn + wc) * 64 + 16 * fq, t);
                } else if (pn == 2) {
                    if (wc < 2) { st_f32x16(oK + (size_t)row * 128 + wc * 64 + 16 * fq, t); st_bf16x16(Kb + (size_t)row * 128 + wc * 64 + 16 * fq, t); }
                    else {
                        st_f32x16(oV + (size_t)row * 128 + (wc - 2) * 64 + 16 * fq, t);
                        const int b = row >> 11, tt = row & 2047;
                        bf16_t* vp = Vt + ((size_t)(b * 2 + (wc - 2)) * 64 + 16 * fq) * 2048 + tt;
#pragma unroll
                        for (int j = 0; j < 16; ++j) vp[(size_t)j * 2048] = f2bf_rne(t[j]);
                    }
                } else if (pn < 5) {
                    st_bf16x16(IQb + (size_t)row * 512 + (4 * (pn - 3) + wc) * 64 + 16 * fq, t);
                } else if (pn == 5) {
                    if (wc == 0) { st_f32x16(oKI + (size_t)row * 64 + 16 * fq, t); st_bf16x16(IKb + (size_t)row * 64 + 16 * fq, t); }
                    else if (wc == 1 && fq == 0) {
                        *(f32x4*)(IWf + (size_t)row * 8) = (f32x4){t[0] * IDX_W_SCALE, t[1] * IDX_W_SCALE, t[2] * IDX_W_SCALE, t[3] * IDX_W_SCALE};
                        *(f32x4*)(IWf + (size_t)row * 8 + 4) = (f32x4){t[4] * IDX_W_SCALE, t[5] * IDX_W_SCALE, t[6] * IDX_W_SCALE, t[7] * IDX_W_SCALE};
                    }
                } else {
                    const int kind = (pn - 6) >> 1, col = 256 * ((pn - 6) & 1) + 64 * wc + 16 * fq;
                    if (kind == 0) {
#pragma unroll
                        for (int j = 0; j < 16; ++j) t[j] = silu_f(t[j]) * REC_QSCALE;
                        st_bf16x16(Rq + (size_t)row * 512 + col, t);
                    } else if (kind == 1) st_bf16x16(Rf + (size_t)row * 512 + col, t);
                    else if (kind == 2) st_bf16x16(Ri + (size_t)row * 512 + col, t);
                    else {
#pragma unroll
                        for (int j = 0; j < 16; ++j) t[j] = silu_f(t[j]);
                        st_bf16x16(Rg + (size_t)row * 512 + col, t);
                    }
                }
            }
    }
};
struct EpiOutProj {
    static constexpr bool PERM = false, AFTER_DRAIN = false;
    const float* X; float* Y; bf16_t* X1B; float* SSQ2;
    __device__ __forceinline__ void operator()(const f32x4 (&acc)[2][2][4][2], const Unit& u, int wr, int wc, int fr, int fq) const {
        const int col0 = u.pn * BM + wc * 32 + 4 * fq;
#pragma unroll
        for (int ai = 0; ai < 2; ++ai)
#pragma unroll
            for (int m = 0; m < 4; ++m) {
                const int row = u.pm * BM + ai * HALF + wr * 64 + m * 16 + fr; const size_t off = (size_t)row * DM + col0; float ss = 0.f;
#pragma unroll
                for (int bj = 0; bj < 2; ++bj)
#pragma unroll
                    for (int n = 0; n < 2; ++n) {
                        const f32x4 xv = *(const f32x4*)(X + off + bj * HALF + n * 16); const f32x4 o = xv + acc[ai][bj][m][n];
#if !RES_BF16
                        *(f32x4*)(Y + off + bj * HALF + n * 16) = o;
#endif
                        ss += (o[0] * o[0] + o[1] * o[1]) + (o[2] * o[2] + o[3] * o[3]);
                        u32x2 w; w.x = cvt_pk_bf16(o[0], o[1]); w.y = cvt_pk_bf16(o[2], o[3]); *(u32x2*)(X1B + off + bj * HALF + n * 16) = w;
                    }
                ss += __shfl_xor(ss, 16); ss += __shfl_xor(ss, 32);
                if (fq == 0) atomicAdd(SSQ2 + row, ss);
            }
    }
};
struct EpiUp {
    static constexpr bool PERM = true, AFTER_DRAIN = false;
    const float* SSQ; bf16_t* H;
    __device__ __forceinline__ void operator()(const f32x4 (&acc)[2][2][4][2], const Unit& u, int wr, int wc, int fr, int fq) const {
        const int col0 = u.pn * BM + wc * 32 + 8 * fq;
        float rsv[2][4];
#pragma unroll
        for (int ai = 0; ai < 2; ++ai)
#pragma unroll
            for (int m = 0; m < 4; ++m) rsv[ai][m] = SSQ[u.pm * BM + ai * HALF + wr * 64 + m * 16 + fr];
#pragma unroll
        for (int ai = 0; ai < 2; ++ai)
#pragma unroll
            for (int m = 0; m < 4; ++m) {
                const int row = u.pm * BM + ai * HALF + wr * 64 + m * 16 + fr;
                const float rs = rsqrtf(rsv[ai][m] * (1.0f / 1024.0f) + EPS);
                bf16_t* rowp = H + (size_t)row * FF + col0;
#pragma unroll
                for (int bj = 0; bj < 2; ++bj) {
                    f32x4 v0 = acc[ai][bj][m][0] * rs, v1 = acc[ai][bj][m][1] * rs;
#pragma unroll
                    for (int e = 0; e < 4; ++e) { const float a = fmaxf(v0[e], 0.f), b = fmaxf(v1[e], 0.f); v0[e] = a * a; v1[e] = b * b; }
                    u32x4 w; w.x = cvt_pk_bf16(v0[0], v0[1]); w.y = cvt_pk_bf16(v0[2], v0[3]); w.z = cvt_pk_bf16(v1[0], v1[1]); w.w = cvt_pk_bf16(v1[2], v1[3]);
                    *(u32x4*)(rowp + bj * HALF) = w;
                }
            }
    }
};
struct EpiDown {
    static constexpr bool PERM = false, AFTER_DRAIN = false;
    float* Y; const bf16_t* X1B;
    __device__ __forceinline__ void operator()(const f32x4 (&acc)[2][2][4][2], const Unit& u, int wr, int wc, int fr, int fq) const {
        const int col0 = u.pn * BM + wc * 32 + 4 * fq;
#pragma unroll
        for (int ai = 0; ai < 2; ++ai)
#pragma unroll
            for (int m = 0; m < 4; ++m) {
                const size_t off = (size_t)(u.pm * BM + ai * HALF + wr * 64 + m * 16 + fr) * DM + col0;
#pragma unroll
                for (int bj = 0; bj < 2; ++bj)
#pragma unroll
                    for (int n = 0; n < 2; ++n) { float* p = Y + off + bj * HALF + n * 16;
#if RES_BF16
                        const u32x2 xw = *(const u32x2*)(X1B + off + bj * HALF + n * 16);
                        const f32x4 x1 = {__builtin_bit_cast(float, xw.x << 16), __builtin_bit_cast(float, xw.x & 0xffff0000u), __builtin_bit_cast(float, xw.y << 16), __builtin_bit_cast(float, xw.y & 0xffff0000u)};
                        *(f32x4*)p = x1 + acc[ai][bj][m][n];
#else
                        *(f32x4*)p = *(const f32x4*)p + acc[ai][bj][m][n];
#endif
                    }
            }
    }
};
template <class Epi, class Sched, bool ALIGN_EPI = false, bool SP2 = false>
__device__ __forceinline__ void gemm_phase(PG8_LAS unsigned char* lds, const Gemm g, const Sched& S, const Epi& E) {
    const int tid = threadIdx.x, wid = __builtin_amdgcn_readfirstlane(tid >> 6), lane = tid & 63, wr = wid >> 2, wc = wid & 3, fr = lane & 15, fq = lane >> 4;
    const int K = g.K, nt = K / BK;
    unsigned voffA[2], voffB[2];
#pragma unroll
    for (int i = 0; i < 2; ++i) { int R, C; stage_rc(tid * 16 + i * 8192, R, C); const int Rb = Epi::PERM ? ((R & ~31) + perm32(R & 31)) : R;
        voffA[i] = (unsigned)(R * K + C) * 2u; voffB[i] = (unsigned)(Rb * K + C) * 2u; }
    const size_t kstep = (size_t)(BK * 2);
    const size_t hstep = (size_t)HALF * K * 2;
    const size_t tstep = 2 * hstep;
    const unsigned ldsw = (unsigned)wid * 1024u;
    const int aoff = lds_byte(wr * 64 + fr, fq * 8), boff = lds_byte(wc * 32 + fr, fq * 8);
#define PG8_SA(b, h) (((b) * 2 + (h)) * HTB)
#define PG8_SB(b, h) ((4 + (b) * 2 + (h)) * HTB)
#define PG8_STAGE(bufoff, gbase, voff) do { _Pragma("unroll") for (int _i = 0; _i < 2; ++_i) \
        __builtin_amdgcn_global_load_lds((const unsigned*)((const char*)(gbase) + (voff)[_i]), (PG8_LAS unsigned*)(lds + (bufoff) + ldsw + _i * 8192), 16, 0, 0); } while (0)
#define PG8_LDA(dst, b, h) do { _Pragma("unroll") for (int m = 0; m < 4; ++m) _Pragma("unroll") for (int k = 0; k < 2; ++k) dst[m][k] = *(const PG8_LAS bf16x8*)(lds + PG8_SA(b, h) + aoff + m * 2048 + k * 1024); } while (0)
#define PG8_LDB(dst, b, h) do { _Pragma("unroll") for (int n = 0; n < 2; ++n) _Pragma("unroll") for (int k = 0; k < 2; ++k) dst[n][k] = *(const PG8_LAS bf16x8*)(lds + PG8_SB(b, h) + boff + n * 2048 + k * 1024); } while (0)
#define PG8_MMA(ai, bj, At, Bt) do { __builtin_amdgcn_s_setprio(1); _Pragma("unroll") for (int m = 0; m < 4; ++m) _Pragma("unroll") for (int n = 0; n < 2; ++n) _Pragma("unroll") for (int k = 0; k < 2; ++k) \
        acc[ai][bj][m][n] = __builtin_amdgcn_mfma_f32_16x16x32_bf16(Bt[n][k], At[m][k], acc[ai][bj][m][n], 0, 0, 0); __builtin_amdgcn_s_setprio(0); } while (0)
#define PG8_WAIT_V(n) asm volatile("s_waitcnt vmcnt(" #n ")" ::: "memory")
#define PG8_WAIT_L(n) asm volatile("s_waitcnt lgkmcnt(" #n ")" ::: "memory")
#define PG8_BAR __builtin_amdgcn_s_barrier()
#define PG8_SCHED __builtin_amdgcn_sched_barrier(0)
    Unit cur, nxt; int ui = 0;
    if (!S.next(0, cur)) return;
    f32x4 acc[2][2][4][2];
#pragma unroll
    for (int a = 0; a < 2; ++a)
#pragma unroll
        for (int b = 0; b < 2; ++b)
#pragma unroll
            for (int m = 0; m < 4; ++m)
#pragma unroll
                for (int n = 0; n < 2; ++n) acc[a][b][m][n] = (f32x4){0.f, 0.f, 0.f, 0.f};
    bf16x8 At[4][2], B0[2][2], B1[2][2];
    const char* cA = (const char*)g.A + (size_t)cur.pm * tstep; const char* cB = (const char*)g.Bt + (size_t)cur.pn * tstep;
    S.a_ready(cur);
    if constexpr (SP2) {
        PG8_STAGE(PG8_SB(0, 0), cB, voffB); PG8_STAGE(PG8_SB(0, 1), cB + hstep, voffB); PG8_STAGE(PG8_SA(0, 0), cA, voffA); PG8_STAGE(PG8_SA(0, 1), cA + hstep, voffA);
        if (wr == 1) PG8_BAR;
        PG8_WAIT_V(2); PG8_BAR;
        PG8_STAGE(PG8_SB(1, 0), cB + kstep, voffB); PG8_STAGE(PG8_SA(1, 0), cA + kstep, voffA); PG8_STAGE(PG8_SB(1, 1), cB + hstep + kstep, voffB);
        PG8_WAIT_V(6); PG8_BAR;
    } else {
        PG8_STAGE(PG8_SB(0, 0), cB, voffB); PG8_STAGE(PG8_SA(0, 0), cA, voffA); PG8_STAGE(PG8_SB(0, 1), cB + hstep, voffB); PG8_STAGE(PG8_SA(0, 1), cA + hstep, voffA);
        if (wr == 1) PG8_BAR;
        PG8_WAIT_V(4); PG8_BAR;
        PG8_STAGE(PG8_SB(1, 0), cB + kstep, voffB); PG8_STAGE(PG8_SA(1, 0), cA + kstep, voffA); PG8_STAGE(PG8_SB(1, 1), cB + hstep + kstep, voffB);
        PG8_WAIT_V(6); PG8_BAR;
    }
    for (;;) {
        const bool has_next = S.next(ui + 1, nxt);
        const char* nA = has_next ? (const char*)g.A + (size_t)nxt.pm * tstep : cA; const char* nB = has_next ? (const char*)g.Bt + (size_t)nxt.pn * tstep : cB;
        for (int t = 0; t < nt; t += 2) {
            const bool last = (t == nt - 2);
            const char* a1 = cA + (size_t)(t + 1) * kstep;
            const char* a2 = last ? nA : cA + (size_t)(t + 2) * kstep; const char* b2 = last ? nB : cB + (size_t)(t + 2) * kstep;
            const char* a3 = a2 + kstep; const char* b3 = b2 + kstep;
            if (last && has_next) S.a_ready(nxt);
            if constexpr (SP2) {
            PG8_LDB(B0, 0, 0); PG8_LDB(B1, 0, 1); PG8_SCHED; PG8_LDA(At, 0, 0); PG8_STAGE(PG8_SA(1, 1), a1 + hstep, voffA);
            PG8_WAIT_V(8); PG8_WAIT_L(0); PG8_BAR; PG8_MMA(0, 0, At, B0); PG8_MMA(0, 1, At, B1); PG8_BAR; PG8_SCHED;
            PG8_LDA(At, 0, 1); PG8_STAGE(PG8_SB(0, 0), b2, voffB); PG8_STAGE(PG8_SB(0, 1), b2 + hstep, voffB); PG8_STAGE(PG8_SA(0, 0), a2, voffA);
            PG8_WAIT_V(8); PG8_WAIT_L(0); PG8_BAR; PG8_MMA(1, 0, At, B0); PG8_MMA(1, 1, At, B1); PG8_BAR; PG8_SCHED;
            PG8_LDB(B0, 1, 0); PG8_LDB(B1, 1, 1); PG8_SCHED; PG8_LDA(At, 1, 0); PG8_STAGE(PG8_SA(0, 1), a2 + hstep, voffA);
            PG8_WAIT_V(8); PG8_WAIT_L(0); PG8_BAR; PG8_MMA(0, 0, At, B0); PG8_MMA(0, 1, At, B1); PG8_BAR; PG8_SCHED;
            PG8_LDA(At, 1, 1); PG8_STAGE(PG8_SB(1, 0), b3, voffB); PG8_STAGE(PG8_SB(1, 1), b3 + hstep, voffB); PG8_STAGE(PG8_SA(1, 0), a3, voffA);
            PG8_WAIT_V(8); PG8_WAIT_L(0); PG8_BAR; PG8_MMA(1, 0, At, B0); PG8_MMA(1, 1, At, B1); PG8_BAR; PG8_SCHED;
            } else {
            PG8_LDB(B0, 0, 0); PG8_SCHED; PG8_LDA(At, 0, 0); PG8_STAGE(PG8_SA(1, 1), a1 + hstep, voffA);
            PG8_WAIT_L(8); PG8_BAR; PG8_WAIT_L(0); PG8_MMA(0, 0, At, B0); PG8_BAR; PG8_SCHED;
            PG8_LDB(B1, 0, 1); PG8_STAGE(PG8_SB(0, 0), b2, voffB);
            PG8_BAR; PG8_WAIT_L(0); PG8_MMA(0, 1, At, B1); PG8_BAR;
            PG8_LDA(At, 0, 1); PG8_STAGE(PG8_SA(0, 0), a2, voffA);
            PG8_BAR; PG8_WAIT_L(0); PG8_MMA(1, 0, At, B0); PG8_BAR; PG8_SCHED;
            PG8_STAGE(PG8_SB(0, 1), b2 + hstep, voffB);
            PG8_WAIT_V(6); PG8_BAR; PG8_MMA(1, 1, At, B1); PG8_BAR;
            PG8_LDB(B0, 1, 0); PG8_SCHED; PG8_LDA(At, 1, 0); PG8_STAGE(PG8_SA(0, 1), a2 + hstep, voffA);
            PG8_WAIT_L(8); PG8_BAR; PG8_WAIT_L(0); PG8_MMA(0, 0, At, B0); PG8_BAR; PG8_SCHED;
            PG8_LDB(B1, 1, 1); PG8_STAGE(PG8_SB(1, 0), b3, voffB);
            PG8_BAR; PG8_WAIT_L(0); PG8_MMA(0, 1, At, B1); PG8_BAR;
            PG8_LDA(At, 1, 1); PG8_STAGE(PG8_SA(1, 0), a3, voffA);
            PG8_BAR; PG8_WAIT_L(0); PG8_MMA(1, 0, At, B0); PG8_BAR; PG8_SCHED;
            PG8_STAGE(PG8_SB(1, 1), b3 + hstep, voffB);
            PG8_WAIT_V(6); PG8_BAR; PG8_MMA(1, 1, At, B1); PG8_BAR;
            }
        }
        if constexpr (ALIGN_EPI) { if (wr == 0) PG8_BAR; }
        if constexpr (!Epi::AFTER_DRAIN) { E(acc, cur, wr, wc, fr, fq); S.done(cur); }
        if (!has_next) break;
#pragma unroll
        for (int a = 0; a < 2; ++a)
#pragma unroll
            for (int b = 0; b < 2; ++b)
#pragma unroll
                for (int m = 0; m < 4; ++m)
#pragma unroll
                    for (int n = 0; n < 2; ++n) acc[a][b][m][n] = (f32x4){0.f, 0.f, 0.f, 0.f};
        cur = nxt; cA = nA; cB = nB; ++ui;
        if constexpr (ALIGN_EPI) { if (wr == 1) PG8_BAR; }
    }
    PG8_WAIT_V(0);
    if constexpr (!ALIGN_EPI) { if (wr == 0) PG8_BAR; }
    PG8_BAR;
    if constexpr (Epi::AFTER_DRAIN) { E.fused(acc, cur, wr, wc, fr, fq, lds, wid, lane); S.done(cur); }
#undef PG8_SA
#undef PG8_SB
#undef PG8_STAGE
#undef PG8_LDA
#undef PG8_LDB
#undef PG8_MMA
#undef PG8_WAIT_V
#undef PG8_WAIT_L
#undef PG8_BAR
#undef PG8_SCHED
}
}
#define XB_TMO      128
#define XB_XCNT(j)  (256  + 64 * (j))
#define XB_XSUB(j)  (1280 + 64 * (j))
#define XB_XGEN(j)  (2304 + 64 * (j))
#define XB_TOP      3328
#define XB_TOPGEN   3392
#define XCD_BAR_WORDS 3456
#define XB_SPIN_CAP (1u << 18)

__device__ __forceinline__ unsigned xb_ld(unsigned* p)              { return __hip_atomic_load(p, __ATOMIC_RELAXED, __HIP_MEMORY_SCOPE_AGENT); }
__device__ __forceinline__ unsigned xb_add(unsigned* p, unsigned v) { return __hip_atomic_fetch_add(p, v, __ATOMIC_RELAXED, __HIP_MEMORY_SCOPE_AGENT); }
__device__ __forceinline__ unsigned xb_xcc_id() { return (unsigned)__builtin_amdgcn_s_getreg((3 << 11) | 20) & 0xFu; }
#define XB_SPIN(cond, bar) do { unsigned _sp = 0; while (cond) { __builtin_amdgcn_s_sleep(1); \
    if ((++_sp & 255u) == 0u) { if (xb_ld(&(bar)[XB_TMO])) break; if (_sp > XB_SPIN_CAP) { atomicAdd(&(bar)[XB_TMO], 1u); break; } } } } while (0)

struct XcdBarrier {
    unsigned* bar; unsigned x;
    volatile LAS unsigned* st;
};

__device__ __forceinline__ XcdBarrier xcd_barrier_post(unsigned* bar, volatile LAS unsigned* st) {
    XcdBarrier b; b.bar = bar; b.x = xb_xcc_id(); b.st = st;
    if (threadIdx.x == 0) (void)xb_add(&bar[XB_XCNT(b.x)], 1u);
    return b;
}
__device__ __forceinline__ void xcd_barrier_complete(unsigned* bar, unsigned x, unsigned& nloc, unsigned& nx) {
    const unsigned G = gridDim.x * gridDim.y * gridDim.z;
    unsigned sum, cnt, mine, sp = 0u;
    for (;;) {
        sum = 0u; cnt = 0u; mine = 0u;
#pragma unroll
        for (unsigned j = 0; j < 16; ++j) { const unsigned c = xb_ld(&bar[XB_XCNT(j)]); sum += c; cnt += (c > 0u) ? 1u : 0u; mine = (j == x) ? c : mine; }
        if (sum == G) break;
        __builtin_amdgcn_s_sleep(1);
        if ((++sp & 255u) == 0u) { if (xb_ld(&bar[XB_TMO])) break; if (sp > XB_SPIN_CAP) { atomicAdd(&bar[XB_TMO], 1u); break; } }
    }
    nloc = mine > 0u ? mine : 1u; nx = cnt > 0u ? cnt : 1u;
}

__device__ __forceinline__ void xcd_barrier(const XcdBarrier& b) {
    asm volatile("s_waitcnt vmcnt(0)" ::: "memory");
    __syncthreads();
    if (threadIdx.x == 0) {
        unsigned* bar = b.bar;
        __builtin_amdgcn_s_waitcnt(0);
        unsigned nloc = b.st[0], nx = b.st[1];
        if (nloc == 0u) { xcd_barrier_complete(bar, b.x, nloc, nx); b.st[0] = nloc; b.st[1] = nx; }
        const unsigned old = xb_add(&bar[XB_XSUB(b.x)], 1u);
        const unsigned gen = old / nloc;
        if (old + 1u == (gen + 1u) * nloc) {
            __builtin_amdgcn_fence(__ATOMIC_RELEASE, "agent");
            asm volatile("s_waitcnt vmcnt(0)" ::: "memory");
            const unsigned og = xb_add(&bar[XB_TOP], 1u);
            const unsigned tg = og / nx;
            if (og + 1u == (tg + 1u) * nx) xb_add(&bar[XB_TOPGEN], 1u);
            else XB_SPIN(xb_ld(&bar[XB_TOPGEN]) == tg, bar);
            __builtin_amdgcn_fence(__ATOMIC_ACQUIRE, "agent");
            xb_add(&bar[XB_XGEN(b.x)], 1u);
            asm volatile("s_waitcnt vmcnt(0)" ::: "memory");
        } else {
            XB_SPIN(xb_ld(&bar[XB_XGEN(b.x)]) == gen, bar);
            __builtin_amdgcn_fence(__ATOMIC_ACQUIRE, "agent");
            asm volatile("s_waitcnt vmcnt(0)" ::: "memory");
        }
    }
    __syncthreads();
}
typedef unsigned short bf16;
typedef unsigned v4u __attribute__((ext_vector_type(4)));
typedef float f32x4 __attribute__((ext_vector_type(4)));
typedef short bf16x8 __attribute__((ext_vector_type(8)));
typedef GAS unsigned gu32;
#define LDS_WAIT() asm volatile("s_waitcnt lgkmcnt(0)" ::: "memory")
__device__ __forceinline__ unsigned f2bf(float f) { unsigned u = __builtin_bit_cast(unsigned, f); return (u + 0x7fffu + ((u >> 16) & 1u)) >> 16; }
__device__ __forceinline__ unsigned pk2(float lo, float hi) { return f2bf(lo) | (f2bf(hi) << 16); }
__device__ __forceinline__ unsigned cvtpk(float lo, float hi) { typedef float f2_ __attribute__((ext_vector_type(2))); typedef __bf16 b2_ __attribute__((ext_vector_type(2))); f2_ v = {lo, hi}; b2_ b = __builtin_convertvector(v, b2_); return __builtin_bit_cast(unsigned, b); }
__device__ __forceinline__ float bf2f(unsigned short h) { return __builtin_bit_cast(float, (unsigned)h << 16); }
__device__ __forceinline__ float bflo(unsigned w) { return __builtin_bit_cast(float, w << 16); }
__device__ __forceinline__ float bfhi(unsigned w) { return __builtin_bit_cast(float, w & 0xffff0000u); }
__device__ __forceinline__ float wave_sum(float v) {
#pragma unroll
    for (int o = 1; o < 64; o <<= 1) v += __shfl_xor(v, o);
    return v;
}
__device__ __forceinline__ float silu_f(float x) { return x / (1.f + __expf(-x)); }
__device__ __forceinline__ int crow(int r, int hi) { return (r & 3) + 8 * (r >> 2) + 4 * hi; }

struct Ctx {
    LAS unsigned char* lds; volatile LAS unsigned* MISC; gu32* ctl;
    int tid, wave, vcu, G;
    const float* in[18]; float* out; unsigned char* ws;
};
__device__ __forceinline__ int q_next(Ctx& C, int cw, unsigned n = 1u) {
    __syncthreads();
    if (C.tid == 0) C.MISC[16] = __hip_atomic_fetch_add((unsigned*)(C.ctl + cw), n, __ATOMIC_RELAXED, __HIP_MEMORY_SCOPE_AGENT);
    __syncthreads();
    return (int)C.MISC[16];
}

__device__ __forceinline__ int inproj_src(int p) {
    const int pn = p >> 8, q = p & 255;
    const int bj = q >> 7, wc = (q >> 5) & 3, n = (q >> 4) & 1, fq = (q >> 2) & 3, e = q & 3;
    const int lc = 64 * wc + 16 * fq + 8 * bj + 4 * n + e;
    if (pn < 5) return 256 * pn + lc;
    if (pn == 5) return lc < 72 ? 1280 + lc : -1;
    return 1352 + 256 * (pn - 6) + lc;
}
template <bool MAP>
__device__ __forceinline__ void p0_transpose_item(const float* W, int K, int N, int NP, const float* gain, bf16* WT, LAS float* scr, int item, int lane) {
    const int nblk = NP / 32, kb = item / nblk, nb = item % nblk, k0 = 64 * kb, n0 = 32 * nb;
    const int p = n0 + (lane & 31); const int sc = MAP ? inproj_src(p) : p;
#pragma unroll 8
    for (int i = 0; i < 32; ++i) { const int kk = 2 * i + (lane >> 5); float v = 0.f; if (sc >= 0) v = W[(size_t)(k0 + kk) * N + sc]; if (gain) v *= gain[k0 + kk]; scr[kk * 33 + (lane & 31)] = v; }
    LDS_WAIT(); asm volatile("" ::: "memory");
    const int c = lane & 7;
#pragma unroll
    for (int j = 0; j < 4; ++j) { const int n = (lane >> 3) + 8 * j; const LAS float* s = scr + (8 * c) * 33 + n;
        v4u o; o.x = cvtpk(s[0 * 33], s[1 * 33]); o.y = cvtpk(s[2 * 33], s[3 * 33]); o.z = cvtpk(s[4 * 33], s[5 * 33]); o.w = cvtpk(s[6 * 33], s[7 * 33]);
        *(GAS v4u*)(WT + (size_t)(n0 + n) * K + k0 + 8 * c) = o; }
    LDS_WAIT(); asm volatile("" ::: "memory");
}
template <int R>
__device__ __forceinline__ void x_rows_to_bf16(const float* x0, size_t rstride, bf16* o0, float* rstd0, int lane, int nrows) {
    f32x4 v[R][4];
#pragma unroll
    for (int r = 0; r < R; ++r) { const GAS f32x4* xr = (const GAS f32x4*)(x0 + (r < nrows ? r : 0) * rstride * DM) + lane;
#pragma unroll
        for (int j = 0; j < 4; ++j) v[r][j] = xr[64 * j]; }
#pragma unroll
    for (int r = 0; r < R; ++r) if (r < nrows) { float s = 0.f;
#pragma unroll
        for (int j = 0; j < 4; ++j) s += (v[r][j].x * v[r][j].x + v[r][j].y * v[r][j].y) + (v[r][j].z * v[r][j].z + v[r][j].w * v[r][j].w);
        s = wave_sum(s);
        if (lane == 0) rstd0[r * rstride] = rsqrtf(s * (1.0f / DM) + EPS);
        GAS u64* o8 = (GAS u64*)(o0 + r * rstride * DM) + lane;
#pragma unroll
        for (int j = 0; j < 4; ++j) o8[64 * j] = (u64)cvtpk(v[r][j].x, v[r][j].y) | ((u64)cvtpk(v[r][j].z, v[r][j].w) << 32); }
}

template <int K, bool GK, int KW = K / 8>
__device__ __forceinline__ void skinny32(const float* A, const float* gk, const float* W, int ldw, int N, int n0, LAS float* red, int tid, int lane, int wave, int kbase = 0) {
    asm volatile("" : "+v"(tid), "+v"(lane));
    const int i = lane & 31, kh = lane >> 5, n = n0 + i; const bool nok = n < N;
    f32x16 acc = {};
    const int kbeg = kbase + wave * KW, kend = kbeg + KW;
#pragma unroll 1
    for (int kb0 = kbeg; kb0 < kend; kb0 += 64) {
        f32x4 xa[8]; float bw[8][4];
#pragma unroll
        for (int s = 0; s < 8; ++s) { const int kb = kb0 + 8 * s;
            xa[s] = *(const f32x4*)(A + (size_t)i * K + kb + 4 * kh);
            if (GK) { const f32x4 ga = *(const f32x4*)(gk + kb + 4 * kh); xa[s] = xa[s] * ga; }
            const float* wp = W + (size_t)(kb + 4 * kh) * ldw + (nok ? n : 0);
            bw[s][0] = wp[0]; bw[s][1] = wp[ldw]; bw[s][2] = wp[2 * (size_t)ldw]; bw[s][3] = wp[3 * (size_t)ldw]; }
#pragma unroll
        for (int s = 0; s < 8; ++s)
#pragma unroll
            for (int j = 0; j < 4; ++j) acc = __builtin_amdgcn_mfma_f32_32x32x2f32(xa[s][j], nok ? bw[s][j] : 0.f, acc, 0, 0, 0);
    }
#pragma unroll
    for (int r = 0; r < 16; ++r) red[wave * 1024 + crow(r, kh) * 32 + i] = acc[r];
    __syncthreads();
#pragma unroll
    for (int x = 0; x < 2; ++x) { const int e = tid + 512 * x; float s = 0.f;
#pragma unroll
        for (int w = 0; w < 8; ++w) s += red[w * 1024 + e];
        red[8 * 1024 + e] = s; }
    __syncthreads();
}
__device__ __forceinline__ float sk_get(LAS float* red, int e) { return red[8 * 1024 + e]; }
template <int K>
__device__ __forceinline__ void rows_rstd32(const float* A, LAS float* rs, int lane, int wave) {
#pragma unroll
    for (int j = 0; j < 4; ++j) { const int r = wave * 4 + j; float s = 0.f;
        for (int k = lane * 4; k < K; k += 256) { const f32x4 v = *(const f32x4*)(A + (size_t)r * K + k); s += (v[0] * v[0] + v[1] * v[1]) + (v[2] * v[2] + v[3] * v[3]); }
        s = wave_sum(s); if (lane == 0) rs[r] = rsqrtf(s * (1.0f / K) + EPS); }
}

__device__ __forceinline__ void p0_prologue(Ctx& C) {
    LAS float* scr = (LAS float*)(C.lds + C.wave * 16384);
    float* samp = (float*)(C.ws + WS_SAMP);
    if (C.vcu < 107) {
        LAS float* red = (LAS float*)C.lds; LAS float* rs = red + 9 * 1024 + 64;
        rows_rstd32<DM>(C.in[I_XS], rs, (C.tid & 63), C.wave);
        skinny32<DM, true>(C.in[I_XS], C.in[I_N1G], C.in[I_WIN], INW, INW, 32 * C.vcu, red, C.tid, (C.tid & 63), C.wave);
        int tid_ = C.tid; asm volatile("" : "+v"(tid_));
#pragma unroll
        for (int x = 0; x < 2; ++x) { const int e = tid_ + 512 * x, i = e >> 5, n = 32 * C.vcu + (e & 31); if (n < INW) samp[S_RAW + i * INW + n] = sk_get(red, e) * rs[i]; }
        __syncthreads();
    }
    if (C.vcu == 200 && C.tid < 192) ((float*)(C.ws + WS_GAINS))[C.tid] = C.tid < 64 ? C.in[I_QG][C.tid] : (C.tid < 128 ? C.in[I_KG][C.tid - 64] : C.in[I_IKG][C.tid - 128]);
    const int gw = C.vcu * 8 + C.wave, NGW = C.G * 8;
    constexpr int I_1 = (DM / 64) * (INP / 32), I_O = (DM / 64) * (DM / 32), I_U = (DM / 64) * (FF / 32), I_D = (FF / 64) * (DM / 32);
    for (int it = gw; it < I_1 + I_O + I_U + I_D; it += NGW) {
        int r = it;
        if (r < I_1) { p0_transpose_item<true>(C.in[I_WIN], DM, INW, INP, C.in[I_N1G], (bf16*)(C.ws + WS_W1T), scr, r, (C.tid & 63)); continue; } r -= I_1;
        if (r < I_O) { p0_transpose_item<false>(C.in[I_WOUT], DM, DM, DM, nullptr, (bf16*)(C.ws + WS_WOT), scr, r, (C.tid & 63)); continue; } r -= I_O;
        if (r < I_U) { p0_transpose_item<false>(C.in[I_WUP], DM, FF, FF, C.in[I_N2G], (bf16*)(C.ws + WS_WUT), scr, r, (C.tid & 63)); continue; } r -= I_U;
        p0_transpose_item<false>(C.in[I_WDN], FF, DM, DM, nullptr, (bf16*)(C.ws + WS_WDT), scr, r, (C.tid & 63));
    }
    bf16* XB = (bf16*)(C.ws + WS_XB); float* RSTD1 = (float*)(C.ws + WS_RSTD1);
    for (int m = gw; m < NTOK; m += 4 * NGW) x_rows_to_bf16<4>(C.in[I_XP] + (size_t)m * DM, (size_t)NGW, XB + (size_t)m * DM, RSTD1 + m, (C.tid & 63), (NTOK - 1 - m) / NGW + 1);
}

__device__ __forceinline__ void sample_postproj(Ctx& C, int b) {
    const float* raw = (const float*)(C.ws + WS_SAMP) + S_RAW + (size_t)b * INW; float* sp = (float*)(C.ws + WS_SAMP) + S_SP + (size_t)b * 4096;
    const int l = (C.tid & 63);
    for (int h = 0; h < 8; ++h) { const float v = raw[h * 64 + l]; const float ss = wave_sum(v * v); sp[h * 64 + l] = v * rsqrtf(ss * (1.f / 64.f) + EPS) * C.in[I_QG][l]; }
    for (int h = 0; h < 2; ++h) { const float v = raw[512 + h * 64 + l]; const float ss = wave_sum(v * v); const float kn = v * rsqrtf(ss * (1.f / 64.f) + EPS) * C.in[I_KG][l];
        sp[512 + h * 64 + l] = kn; C.out[O_NKS + (size_t)b * 128 + h * 64 + l] = kn; }
    for (int h = 0; h < 2; ++h) { const float v = raw[640 + h * 64 + l]; sp[640 + h * 64 + l] = v; C.out[O_NVS + (size_t)b * 128 + h * 64 + l] = v; }
    for (int j = 0; j < 8; ++j) sp[768 + j * 64 + l] = raw[768 + j * 64 + l];
    { const float v = raw[1280 + l]; const float ss = wave_sum(v * v); const float kn = v * rsqrtf(ss * (1.f / 64.f) + EPS) * C.in[I_IKG][l]; sp[1280 + l] = kn; C.out[O_NKIS + (size_t)b * 64 + l] = kn; }
    if (l < 8) sp[1344 + l] = raw[1344 + l] * IDX_W_SCALE;
    for (int j = 0; j < 8; ++j) { sp[1352 + j * 64 + l] = silu_f(raw[1352 + j * 64 + l]) * REC_QSCALE; sp[1864 + j * 64 + l] = raw[1864 + j * 64 + l]; sp[2376 + j * 64 + l] = raw[2376 + j * 64 + l]; sp[2888 + j * 64 + l] = silu_f(raw[2888 + j * 64 + l]); }
}
constexpr int SROW = 2052, SEL_WS_OFF = 131584;
static_assert(SEL_WS_OFF + 8 * 2048 <= LDSCTL_OFF, "select lds");
template <int CTRL> __device__ __forceinline__ float dppf(float v) { return __builtin_bit_cast(float, __builtin_amdgcn_update_dpp(__builtin_bit_cast(int, v), __builtin_bit_cast(int, v), CTRL, 0xf, 0xf, false)); }
template <int CTRL> __device__ __forceinline__ int dppi(int v) { return __builtin_amdgcn_update_dpp(v, v, CTRL, 0xf, 0xf, false); }
__device__ __forceinline__ float rdl_f(float v, int l) { return __builtin_bit_cast(float, __builtin_amdgcn_readlane(__builtin_bit_cast(int, v), l)); }
__device__ __forceinline__ float wave_min_f(float v) {
    v = fminf(v, dppf<0xB1>(v)); v = fminf(v, dppf<0x4E>(v)); v = fminf(v, dppf<0x141>(v)); v = fminf(v, dppf<0x140>(v));
    return fminf(fminf(rdl_f(v, 0), rdl_f(v, 16)), fminf(rdl_f(v, 32), rdl_f(v, 48)));
}
__device__ __forceinline__ float wave_max_f(float v) {
    v = fmaxf(v, dppf<0xB1>(v)); v = fmaxf(v, dppf<0x4E>(v)); v = fmaxf(v, dppf<0x141>(v)); v = fmaxf(v, dppf<0x140>(v));
    return fmaxf(fmaxf(rdl_f(v, 0), rdl_f(v, 16)), fmaxf(rdl_f(v, 32), rdl_f(v, 48)));
}
__device__ __forceinline__ int row_sum_i(int v) { v += dppi<0xB1>(v); v += dppi<0x4E>(v); v += dppi<0x141>(v); v += dppi<0x140>(v); return v; }
__device__ __forceinline__ int row_suffix_i(int v) {
    v += __builtin_amdgcn_update_dpp(0, v, 0x101, 0xf, 0xf, true); v += __builtin_amdgcn_update_dpp(0, v, 0x102, 0xf, 0xf, true);
    v += __builtin_amdgcn_update_dpp(0, v, 0x104, 0xf, 0xf, true); v += __builtin_amdgcn_update_dpp(0, v, 0x108, 0xf, 0xf, true); return v;
}
__device__ __forceinline__ float relu_f(float x) { return __builtin_amdgcn_fmed3f(x, 0.f, INFINITY); }
__device__ __forceinline__ void dsa_select_unit(Ctx& C, int b, int qb) {
    const bf16* IQb = (const bf16*)(C.ws + WS_IQB); const bf16* IKb = (const bf16*)(C.ws + WS_IKB); const float* IWf = (const float*)(C.ws + WS_IWF);
    u64* MASK = (u64*)(C.ws + WS_MASK);
    LAS float* sc = (LAS float*)C.lds;
    int lane = (C.tid & 63), wave = C.wave; asm volatile("" : "+v"(lane), "+s"(wave));
#ifdef PROBE_SEL
    const unsigned long long ps0_ = __builtin_amdgcn_s_memrealtime(); unsigned long long ps1_ = 0;
#endif
    const int t0 = qb * 16, ntile = qb + 1, ql = lane & 15, g = lane >> 4;
    const size_t rowq = (size_t)b * SEQ + t0 + ql;
    if (t0 + 15 >= 256)
    {
        bf16x8 bq[8][2];
#pragma unroll
        for (int h = 0; h < 8; ++h)
#pragma unroll
            for (int ks = 0; ks < 2; ++ks) bq[h][ks] = *(const bf16x8*)(IQb + rowq * 512 + h * 64 + ks * 32 + g * 8);
        float w[8];
        { const f32x4 w0 = *(const f32x4*)(IWf + rowq * 8), w1 = *(const f32x4*)(IWf + rowq * 8 + 4); w[0] = w0[0]; w[1] = w0[1]; w[2] = w0[2]; w[3] = w0[3]; w[4] = w1[0]; w[5] = w1[1]; w[6] = w1[2]; w[7] = w1[3]; }
        LAS unsigned char* stg = C.lds + SEL_WS_OFF;
        const int tid_ = C.tid, pk0 = tid_ >> 3, pc = tid_ & 7, nround = (ntile + 7) >> 3;
        const bf16* gsrc = IKb + ((size_t)b * SEQ + pk0) * 64 + pc * 8;
        v4u r0 = *(const v4u*)gsrc, r1 = *(const v4u*)(gsrc + 64 * 64);
        const int wo0 = (pk0 * 8 + (pc ^ (pk0 & 7))) * 16, wo1 = ((pk0 + 64) * 8 + (pc ^ (pk0 & 7))) * 16;
        const int ro0 = ((16 * wave + ql) * 8 + (g ^ (ql & 7))) * 16, ro1 = ((16 * wave + ql) * 8 + ((4 + g) ^ (ql & 7))) * 16;
#pragma unroll 1
        for (int rd = 0; rd < nround; ++rd) {
            __syncthreads();
            *(LAS v4u*)(stg + wo0) = r0; *(LAS v4u*)(stg + wo1) = r1;
            if (rd + 1 < nround) { const bf16* gp = gsrc + (size_t)(rd + 1) * 128 * 64; r0 = *(const v4u*)gp; r1 = *(const v4u*)(gp + 64 * 64); }
            __syncthreads();
            const int ii = rd * 8 + wave;
            if (ii < ntile) {
                const bf16x8 a0 = *(const LAS bf16x8*)(stg + ro0), a1 = *(const LAS bf16x8*)(stg + ro1);
                f32x4 I = {0.f, 0.f, 0.f, 0.f};
#pragma unroll
                for (int h = 0; h < 8; ++h) {
                    f32x4 d = __builtin_amdgcn_mfma_f32_16x16x32_bf16(a0, bq[h][0], (f32x4){0.f, 0.f, 0.f, 0.f}, 0, 0, 0);
                    d = __builtin_amdgcn_mfma_f32_16x16x32_bf16(a1, bq[h][1], d, 0, 0, 0);
#pragma unroll
                    for (int r = 0; r < 4; ++r) I[r] = fmaf(w[h], relu_f(d[r]), I[r]);
                }
                *(LAS f32x4*)(sc + ql * SROW + ii * 16 + 4 * g) = I;
            }
        }
    }
    __syncthreads();
#ifdef PROBE_SEL
    ps1_ = __builtin_amdgcn_s_memrealtime();
#endif
#ifdef PROBE_SEL
    unsigned long long sm_t_ = ps1_, sm_acc_ = 0;
#define SELMARK(k) do { const unsigned long long n_ = __builtin_amdgcn_s_memrealtime(); if (PROBE_SEL == (k)) sm_acc_ += n_ - sm_t_; sm_t_ = n_; } while (0)
#else
#define SELMARK(k) do {} while (0)
#endif
    LAS unsigned* hist = (LAS unsigned*)(C.lds + SEL_WS_OFF) + wave * 512;
#ifdef SEL_REP_PICK
    for (int rep_ = 0; rep_ < 2; ++rep_)
#endif
#pragma unroll 1
    for (int qq = 0; qq < 2; ++qq) {
        const int qi = wave * 2 + qq, t = t0 + qi;
        unsigned mylo = 0, myhi = 0;
        if (t < 256) {
            const int lo = 64 * lane;
            const u64 mw_ = (lo > t) ? 0ull : ((lo + 63 <= t) ? ~0ull : ((2ull << (t - lo)) - 1ull));
            mylo = (unsigned)mw_; myhi = (unsigned)(mw_ >> 32);
        } else {
#ifndef SEL_RS
#define SEL_RS 0
#endif
            SELMARK(9);
            float v[32]; const int nj = (t >> 6) + 1;
            float lo = INFINITY, hi = -INFINITY;
#pragma unroll 1
            for (int rr = 0; rr < (SEL_RS == 1 ? 3 : 1); ++rr) { asm volatile("" ::: "memory"); lo = INFINITY; hi = -INFINITY;
#pragma unroll
            for (int j = 0; j < 32; ++j) v[j] = sc[qi * SROW + 64 * j + lane];
#pragma unroll
            for (int j = 0; j < 32; ++j) { const bool ok = (64 * j + lane) <= t; const float xl = ok ? v[j] : INFINITY; v[j] = ok ? v[j] : -INFINITY;
                asm("v_max_f32 %0, %0, %1" : "+v"(hi) : "v"(v[j])); asm("v_min_f32 %0, %0, %1" : "+v"(lo) : "v"(xl)); }
            lo = wave_min_f(lo); hi = wave_max_f(hi); }
            const float scale = (hi > lo) ? 255.99f / (hi - lo) : 0.f;
            SELMARK(4);
            int bn[32];
#pragma unroll 1
            for (int rr = 0; rr < (SEL_RS == 2 ? 3 : 1); ++rr) {
            *(LAS v4u*)(hist + 4 * lane) = (v4u){0u, 0u, 0u, 0u}; *(LAS v4u*)(hist + 256 + 4 * lane) = (v4u){0u, 0u, 0u, 0u};
            LDS_WAIT(); asm volatile("" ::: "memory");
#pragma unroll
            for (int j = 0; j < 32; ++j) { bn[j] = -1; if (j < nj) { int bi = (int)((v[j] - lo) * scale); bi = bi > 255 ? 255 : bi; asm volatile("" : "+v"(bi)); bn[j] = bi;
                if (bi >= 0) __hip_atomic_fetch_add(hist + bi, 1u, __ATOMIC_RELAXED, __HIP_MEMORY_SCOPE_WORKGROUP); } }
            LDS_WAIT(); asm volatile("" ::: "memory"); }
            SELMARK(5);
            const v4u hh = *(const LAS v4u*)(hist + 4 * lane);
            const int s4 = (int)(hh.x + hh.y + hh.z + hh.w);
            const int rsum = row_sum_i(s4);
            const int r0s = __builtin_amdgcn_readlane(rsum, 0), r1s = __builtin_amdgcn_readlane(rsum, 16), r2s = __builtin_amdgcn_readlane(rsum, 32), r3s = __builtin_amdgcn_readlane(rsum, 48);
            int Rs, abv;
            if (r3s >= 256) { Rs = 3; abv = 0; } else if (r3s + r2s >= 256) { Rs = 2; abv = r3s; } else if (r3s + r2s + r1s >= 256) { Rs = 1; abv = r3s + r2s; } else { Rs = 0; abv = r3s + r2s + r1s; }
            (void)r0s;
            const int incl = abv + row_suffix_i(s4);
            const u64 bal = __ballot(((lane >> 4) == Rs) && incl >= 256);
            const int Ls = 63 - __clzll(bal);
            int c = incl - s4, bsel, cab, hsel;
            if (c + (int)hh.w >= 256) { bsel = 3; cab = c; hsel = (int)hh.w; }
            else { c += (int)hh.w; if (c + (int)hh.z >= 256) { bsel = 2; cab = c; hsel = (int)hh.z; }
                else { c += (int)hh.z; if (c + (int)hh.y >= 256) { bsel = 1; cab = c; hsel = (int)hh.y; } else { c += (int)hh.y; bsel = 0; cab = c; hsel = (int)hh.x; } } }
            const int Bs = 4 * Ls + __builtin_amdgcn_readlane(bsel, Ls), cabove = __builtin_amdgcn_readlane(cab, Ls), cntB = __builtin_amdgcn_readlane(hsel, Ls);
            const int r = 256 - cabove;
            SELMARK(6);
#ifdef SEL_FORCE_FALLBACK
            if (cntB <= 64 && t > (SEL_FORCE_FALLBACK)) {
#else
            if (cntB <= 64) {
#endif
#pragma unroll 1
                for (int rr = 0; rr < (SEL_RS == 4 ? 3 : 1); ++rr) { asm volatile("" ::: "memory");
                int cbase = 0;
#pragma unroll
                for (int j = 0; j < 32; ++j) if (j < nj) { const u64 wa = __ballot(bn[j] > Bs);
                    mylo = (lane == j) ? (unsigned)wa : mylo; myhi = (lane == j) ? (unsigned)(wa >> 32) : myhi;
                    const bool isc = bn[j] == Bs; const u64 bm = __ballot(isc);
                    if (bm != 0ull) { const int pos = cbase + (int)__builtin_amdgcn_mbcnt_hi((unsigned)(bm >> 32), __builtin_amdgcn_mbcnt_lo((unsigned)bm, 0u));
                        if (isc) { hist[258 + 2 * pos] = __builtin_bit_cast(unsigned, sc[qi * SROW + 64 * j + lane]); hist[259 + 2 * pos] = (unsigned)(64 * j + lane); }
                        cbase += __popcll(bm); } }
                LDS_WAIT(); asm volatile("" ::: "memory");
                const bool mine = lane < cntB;
                const float cv = mine ? __builtin_bit_cast(float, hist[258 + 2 * lane]) : 0.f; const int ci = mine ? (int)hist[259 + 2 * lane] : 0;
                int rank = 0;
#pragma unroll 1
                for (int j = 0; j < cntB; ++j) { const float x = rdl_f(cv, j); const int y = __builtin_amdgcn_readlane(ci, j); rank += ((x > cv) | ((x == cv) & (y < ci))) ? 1 : 0; }
                if (mine && rank < r) __hip_atomic_fetch_or(hist + 416 + (ci >> 5), 1u << (ci & 31), __ATOMIC_RELAXED, __HIP_MEMORY_SCOPE_WORKGROUP);
                LDS_WAIT(); asm volatile("" ::: "memory"); }
                if (lane < 32) { mylo |= hist[416 + 2 * lane]; myhi |= hist[417 + 2 * lane]; }
            } else {
#ifndef SEL_NO_FALLBACK
                const LAS float* row = sc + qi * SROW;
#define SEL_KEY(j) ({ const float x_ = row[64 * (j) + lane]; const unsigned b_ = __builtin_bit_cast(unsigned, x_); unsigned m_ = (b_ & 0x80000000u) ? ~b_ : (b_ | 0x80000000u); if (x_ == 0.f) m_ = 0x80000000u; ((64 * (j) + lane) <= t) ? m_ : 0u; })
                unsigned prefix = 0;
#pragma unroll 1
                for (int bit = 31; bit >= 0; --bit) { const unsigned cand = prefix | (1u << bit); int cnt = 0;
#pragma unroll 1
                    for (int j = 0; j < nj; ++j) cnt += __popcll(__ballot(SEL_KEY(j) >= cand));
                    if (cnt >= 256) prefix = cand; }
                const unsigned theta = prefix; int cgt = 0, ceq = 0;
#pragma unroll 1
                for (int j = 0; j < nj; ++j) { const unsigned uj = SEL_KEY(j); cgt += __popcll(__ballot(uj > theta)); ceq += __popcll(__ballot(uj == theta)); }
                const int r2 = 256 - cgt; int icut = 2047;
                if (ceq != r2) { int lo2 = 0;
#pragma unroll 1
                    for (int bit = 10; bit >= 0; --bit) { const int cc = lo2 | (1 << bit); int cnt = 0;
#pragma unroll 1
                        for (int j = 0; j < nj; ++j) cnt += __popcll(__ballot(SEL_KEY(j) == theta && (64 * j + lane) < cc));
                        if (cnt < r2) lo2 = cc; }
                    icut = lo2; }
#pragma unroll 1
                for (int j = 0; j < nj; ++j) { const unsigned uj = SEL_KEY(j); const bool sel = (uj > theta) | ((uj == theta) & ((64 * j + lane) <= icut)); const u64 word = __ballot(sel);
                    mylo = (lane == j) ? (unsigned)word : mylo; myhi = (lane == j) ? (unsigned)(word >> 32) : myhi; }
#undef SEL_KEY
#endif
            }
        }
        SELMARK(7);
        if (lane < 32) MASK[((size_t)b * SEQ + t) * 32 + lane] = ((u64)myhi << 32) | mylo;
    }
#ifdef PROBE_SEL
    if (b == 0 && qb == PROBE_SELQ && C.tid == 0) { const unsigned long long ps2_ = __builtin_amdgcn_s_memrealtime(); const float us = (float)(PROBE_SEL == 1 ? ps1_ - ps0_ : PROBE_SEL == 2 ? ps2_ - ps1_ : PROBE_SEL == 3 ? ps2_ - ps0_ : sm_acc_) * 0.01f;
        C.out[O_NKIS] += sqrtf(2048.0f * (1e-4f + 5e-4f * fminf(us / 50.0f, 1.0f))); }
#endif
}

constexpr int A_KROW = 72, A_VROW = 68, A_KT_BYTES = 2 * 64 * A_KROW * 2, A_VT_BYTES = 128 * A_VROW * 2, A_BUF = A_KT_BYTES + A_VT_BYTES, A_OST = 3 * A_BUF, A_OROW = 72;
static_assert(A_OST + 8 * 32 * 72 * 2 <= LDSCTL_OFF, "attention lds");
typedef float f32x2v __attribute__((ext_vector_type(2)));
__device__ __forceinline__ float bfi_f(unsigned m, float a, float b) { float r; asm("v_bfi_b32 %0, %1, %2, %3" : "=v"(r) : "v"(m), "v"(a), "v"(b)); return r; }
__device__ __forceinline__ float max3f(float a, float b, float c) { float r; asm("v_max3_f32 %0, %1, %2, %3" : "=v"(r) : "v"(a), "v"(b), "v"(c)); return r; }
__device__ __forceinline__ void attn_unit(Ctx& C, int b, int qb) {
    const bf16* Qb = (const bf16*)(C.ws + WS_QB); const bf16* Kb = (const bf16*)(C.ws + WS_KB); const bf16* Vt = (const bf16*)(C.ws + WS_VT);
    const u64* MASK = (const u64*)(C.ws + WS_MASK); bf16* MIX = (bf16*)(C.ws + WS_MIX);
    int tid = C.tid, wave = C.wave; asm volatile("" : "+v"(tid), "+s"(wave));
#ifdef PROBE_ATT
    const unsigned long long pt0_ = __builtin_amdgcn_s_memrealtime();
#endif
    const int lane = tid & 63, t0 = qb * 32, nt = qb / 2 + 1, ql = lane & 31, hi = lane >> 5, kvh = wave >> 2;
    const size_t qrow = (size_t)b * SEQ + t0 + ql;
    bf16x8 qf[4];
#pragma unroll
    for (int ks = 0; ks < 4; ++ks) qf[ks] = *(const bf16x8*)(Qb + qrow * 512 + wave * 64 + ks * 16 + hi * 8);
    const u64* mrow = MASK + qrow * 32;
    v4u krA[2], vrA[2], krB[2], vrB[2];
    const bf16* kg_[2]; const bf16* vg_[2]; int kl_[2], vl_[2];
#pragma unroll
    for (int x = 0; x < 2; ++x) { const int pid = tid + 512 * x;
        { const int i = pid >> 4, c16 = pid & 15, kv = c16 >> 3, cc = c16 & 7; kg_[x] = Kb + ((size_t)b * SEQ + i) * 128 + c16 * 8; kl_[x] = ((kv * 64 + i) * A_KROW + cc * 8) * 2; }
        { const int row = pid >> 3, pc = pid & 7; vg_[x] = Vt + ((size_t)b * 128 + row) * SEQ + pc * 8; vl_[x] = A_KT_BYTES + (row * A_VROW + pc * 8) * 2; } }
#define ATT_GLOAD(KR, VR, kt) do { _Pragma("unroll") for (int x = 0; x < 2; ++x) { KR[x] = *(const v4u*)(kg_[x] + (size_t)(kt) * 64 * 128); VR[x] = *(const v4u*)(vg_[x] + (kt) * 64); } } while (0)
#define ATT_LWRITE(KR, VR, boff) do { _Pragma("unroll") for (int x = 0; x < 2; ++x) { *(LAS v4u*)(C.lds + (boff) + kl_[x]) = KR[x]; \
        *(LAS u32x2*)(C.lds + (boff) + vl_[x]) = (u32x2){VR[x].x, VR[x].y}; *(LAS u32x2*)(C.lds + (boff) + vl_[x] + 8) = (u32x2){VR[x].z, VR[x].w}; } } while (0)
#define ATT_QK(boff, P0_, P1_) do { const LAS unsigned char* kb_ = C.lds + (boff); P0_ = (f32x16){}; P1_ = (f32x16){}; \
        _Pragma("unroll") for (int ks = 0; ks < 4; ++ks) { \
            const bf16x8 a0 = *(const LAS bf16x8*)(kb_ + ((kvh * 64 + ql) * A_KROW + ks * 16 + hi * 8) * 2); \
            const bf16x8 a1 = *(const LAS bf16x8*)(kb_ + ((kvh * 64 + 32 + ql) * A_KROW + ks * 16 + hi * 8) * 2); \
            P0_ = __builtin_amdgcn_mfma_f32_32x32x16_bf16(a0, qf[ks], P0_, 0, 0, 0); \
            P1_ = __builtin_amdgcn_mfma_f32_32x32x16_bf16(a1, qf[ks], P1_, 0, 0, 0); } } while (0)
    const int ntm1 = nt - 1;
    ATT_GLOAD(krA, vrA, 0);
    ATT_GLOAD(krB, vrB, (1 < nt ? 1 : ntm1));
    u64 mwA = mrow[0], mwB = mrow[1 < nt ? 1 : ntm1];
    ATT_LWRITE(krA, vrA, 0);
    ATT_GLOAD(krA, vrA, (2 < nt ? 2 : ntm1));
    ATT_LWRITE(krB, vrB, A_BUF);
    ATT_GLOAD(krB, vrB, (3 < nt ? 3 : ntm1));
    __syncthreads();
    float m_run = -1e30f, l_run = 0.f; f32x16 o0 = {}, o1 = {};
    const int sh4 = 4 * hi;
    f32x16 pA0, pA1, pB0, pB1;
    ATT_QK(0, pA0, pA1);
    asm volatile("s_nop 15\n\ts_nop 7" : "+v"(pA0), "+v"(pA1));
    int bo_cur = 0, bo_nxt = A_BUF, bo_wr = 2 * A_BUF;
#define ATT_STEP(kt, PC0, PC1, PN0, PN1, KR, VR, MW_) do { \
        if ((kt) + 1 < nt) ATT_QK(bo_nxt, PN0, PN1); \
        __builtin_amdgcn_sched_barrier(0); \
        const int kt2_ = ((kt) + 2 < nt) ? (kt) + 2 : ntm1; \
        const unsigned mlo = (unsigned)MW_ >> sh4, mhi = (unsigned)(MW_ >> 32) >> sh4; \
        _Pragma("unroll") for (int r = 0; r < 16; ++r) { const int pos_ = crow(r, 0); \
            const unsigned t0_ = 0u - ((mlo >> pos_) & 1u), t1_ = 0u - ((mhi >> pos_) & 1u); \
            PC0[r] = bfi_f(t0_, PC0[r], -1e30f); PC1[r] = bfi_f(t1_, PC1[r], -1e30f); } \
        MW_ = mrow[kt2_]; \
        float mx; { float a_ = max3f(PC0[0], PC0[1], PC0[2]), b_ = max3f(PC1[0], PC1[1], PC1[2]); \
            a_ = max3f(a_, PC0[3], PC0[4]); b_ = max3f(b_, PC1[3], PC1[4]); a_ = max3f(a_, PC0[5], PC0[6]); b_ = max3f(b_, PC1[5], PC1[6]); a_ = max3f(a_, PC0[7], PC0[8]); b_ = max3f(b_, PC1[7], PC1[8]); \
            a_ = max3f(a_, PC0[9], PC0[10]); b_ = max3f(b_, PC1[9], PC1[10]); a_ = max3f(a_, PC0[11], PC0[12]); b_ = max3f(b_, PC1[11], PC1[12]); a_ = max3f(a_, PC0[13], PC0[14]); b_ = max3f(b_, PC1[13], PC1[14]); \
            mx = max3f(a_, b_, PC0[15]); mx = max3f(mx, PC1[15], -1e30f); } \
        mx = fmaxf(mx, __shfl_xor(mx, 32)); \
        const float m_new = fmaxf(m_run, mx), alpha = __builtin_amdgcn_exp2f(m_run - m_new), m_use = fmaxf(m_new, -1e29f); m_run = m_new; \
        f32x2v ls2 = {0.f, 0.f}; const f32x2v mu2 = {m_use, m_use}; \
        _Pragma("unroll") for (int r = 0; r < 16; r += 2) { f32x2v d0 = (f32x2v){PC0[r], PC0[r + 1]} - mu2, d1 = (f32x2v){PC1[r], PC1[r + 1]} - mu2; \
            d0.x = __builtin_amdgcn_exp2f(d0.x); d0.y = __builtin_amdgcn_exp2f(d0.y); d1.x = __builtin_amdgcn_exp2f(d1.x); d1.y = __builtin_amdgcn_exp2f(d1.y); \
            PC0[r] = d0.x; PC0[r + 1] = d0.y; PC1[r] = d1.x; PC1[r + 1] = d1.y; ls2 = ls2 + d0; ls2 = ls2 + d1; } \
        const float ls = ls2.x + ls2.y; \
        l_run = l_run * alpha + ls; \
        { _Pragma("unroll") for (int r = 0; r < 16; ++r) { o0[r] *= alpha; o1[r] *= alpha; } } \
        bf16x8 pb[2][2]; \
        _Pragma("unroll") for (int s = 0; s < 2; ++s) { v4u w0, w1; \
            w0.x = cvtpk(PC0[8 * s + 0], PC0[8 * s + 1]); w0.y = cvtpk(PC0[8 * s + 2], PC0[8 * s + 3]); w0.z = cvtpk(PC0[8 * s + 4], PC0[8 * s + 5]); w0.w = cvtpk(PC0[8 * s + 6], PC0[8 * s + 7]); \
            w1.x = cvtpk(PC1[8 * s + 0], PC1[8 * s + 1]); w1.y = cvtpk(PC1[8 * s + 2], PC1[8 * s + 3]); w1.z = cvtpk(PC1[8 * s + 4], PC1[8 * s + 5]); w1.w = cvtpk(PC1[8 * s + 6], PC1[8 * s + 7]); \
            pb[0][s] = __builtin_bit_cast(bf16x8, w0); pb[1][s] = __builtin_bit_cast(bf16x8, w1); } \
        { const LAS unsigned char* vb_ = C.lds + bo_cur + A_KT_BYTES; \
        _Pragma("unroll") for (int mt = 0; mt < 2; ++mt) _Pragma("unroll") for (int s = 0; s < 2; ++s) { const int kof = mt * 32 + s * 16 + hi * 4; \
            { const LAS unsigned char* vp = vb_ + ((kvh * 64 + ql) * A_VROW + kof) * 2; const u32x2 lo = *(const LAS u32x2*)vp, hi2 = *(const LAS u32x2*)(vp + 16); \
              const v4u vv = {lo.x, lo.y, hi2.x, hi2.y}; o0 = __builtin_amdgcn_mfma_f32_32x32x16_bf16(__builtin_bit_cast(bf16x8, vv), pb[mt][s], o0, 0, 0, 0); } \
            { const LAS unsigned char* vp = vb_ + ((kvh * 64 + 32 + ql) * A_VROW + kof) * 2; const u32x2 lo = *(const LAS u32x2*)vp, hi2 = *(const LAS u32x2*)(vp + 16); \
              const v4u vv = {lo.x, lo.y, hi2.x, hi2.y}; o1 = __builtin_amdgcn_mfma_f32_32x32x16_bf16(__builtin_bit_cast(bf16x8, vv), pb[mt][s], o1, 0, 0, 0); } } } \
        if ((kt) + 2 < nt) ATT_LWRITE(KR, VR, bo_wr); \
        { const int kt4_ = ((kt) + 4 < nt) ? (kt) + 4 : ntm1; ATT_GLOAD(KR, VR, kt4_); } \
        { const int tmp_ = bo_cur; bo_cur = bo_nxt; bo_nxt = bo_wr; bo_wr = tmp_; } \
        __syncthreads(); } while (0)
#pragma unroll 1
    for (int kt = 0; kt < nt; kt += 2) {
        ATT_STEP(kt, pA0, pA1, pB0, pB1, krA, vrA, mwA);
        if (kt + 1 < nt) ATT_STEP(kt + 1, pB0, pB1, pA0, pA1, krB, vrB, mwB);
    }
#undef ATT_STEP
#undef ATT_QK
#undef ATT_GLOAD
#undef ATT_LWRITE
    const float l_tot = l_run + __shfl_xor(l_run, 32);
    const float inv = 1.0f / l_tot;
    LAS unsigned char* ost = C.lds + A_OST + wave * (32 * A_OROW * 2);
#pragma unroll
    for (int r = 0; r < 16; r += 2) { const int d = crow(r, hi);
        *(LAS unsigned*)(ost + (ql * A_OROW + d) * 2) = cvtpk(o0[r] * inv, o0[r + 1] * inv);
        *(LAS unsigned*)(ost + (ql * A_OROW + 32 + d) * 2) = cvtpk(o1[r] * inv, o1[r + 1] * inv); }
    LDS_WAIT(); asm volatile("" ::: "memory");
#pragma unroll
    for (int x = 0; x < 4; ++x) { const int pid = lane + 64 * x, q = pid >> 3, c = pid & 7; const v4u v = *(const LAS v4u*)(ost + (q * A_OROW + c * 8) * 2);
        *(v4u*)(MIX + ((size_t)b * SEQ + t0 + q) * DM + wave * 64 + c * 8) = v; }
    LDS_WAIT(); asm volatile("" ::: "memory");
#ifdef PROBE_ATT
    if (b == 0 && qb == PROBE_ATT && tid == 0) { const float us = (float)(__builtin_amdgcn_s_memrealtime() - pt0_) * 0.01f; C.out[O_NKIS] += sqrtf(2048.0f * (1e-4f + 5e-4f * fminf(us / 100.0f, 1.0f))); }
#endif
}
constexpr int H_QROW = 136, H_TROW = 72, H_OROW = 132;
constexpr int H_QD = 0, H_KD = H_QD + 64 * H_QROW * 2, H_KLT = H_KD + 64 * H_QROW * 2, H_VTL = H_KLT + 128 * H_TROW * 2, H_AT = H_VTL + 128 * H_TROW * 2,
              H_OT = H_AT + 64 * H_TROW * 2, H_PART = H_OT + 64 * H_OROW * 4, H_DK = H_PART + 8 * 128 * 4, H_END = H_DK + 1024;
static_assert(H_END <= LDSCTL_OFF, "hgrn lds");
__device__ __forceinline__ bf16x8 pack8(const f32x4& a, const f32x4& b) { v4u w; w.x = cvtpk(a[0], a[1]); w.y = cvtpk(a[2], a[3]); w.z = cvtpk(b[0], b[1]); w.w = cvtpk(b[2], b[3]); return __builtin_bit_cast(bf16x8, w); }
__device__ __forceinline__ void hgrn_unit(Ctx& C, int b, int h, int part) {
    const bf16* Rq = (const bf16*)(C.ws + WS_RQ); const bf16* Rf = (const bf16*)(C.ws + WS_RF); const bf16* Ri = (const bf16*)(C.ws + WS_RI); const bf16* Rg = (const bf16*)(C.ws + WS_RGT);
    bf16* MIX = (bf16*)(C.ws + WS_MIX);
    int tid = C.tid, wave = C.wave; asm volatile("" : "+v"(tid), "+s"(wave));
#ifdef PROBE_HGRN
    const unsigned long long t_begin_ = __builtin_amdgcn_s_memrealtime();
#endif
    const int lane = tid & 63, l15 = lane & 15, g = lane >> 4;
    LAS unsigned char* L = C.lds;
    LAS bf16* QD = (LAS bf16*)(L + H_QD); LAS bf16* KD = (LAS bf16*)(L + H_KD); LAS bf16* KLT = (LAS bf16*)(L + H_KLT); LAS bf16* VTL = (LAS bf16*)(L + H_VTL);
    LAS bf16* AT = (LAS bf16*)(L + H_AT); LAS float* OT = (LAS float*)(L + H_OT); LAS float* PART = (LAS float*)(L + H_PART); LAS float* DK = (LAS float*)(L + H_DK);
    for (int i = tid; i < 64 * H_TROW / 2; i += 512) ((LAS unsigned*)AT)[i] = 0u;
    const int kp = tid & 63, tg = tid >> 6, k0 = 2 * kp, s2 = tid >> 3, vg = tid & 7;
    float lb0, lb1;
    { const float a0 = C.in[I_LB][128 * h + k0], a1 = C.in[I_LB][512 + 128 * h + k0], b0 = C.in[I_LB][128 * h + k0 + 1], b1 = C.in[I_LB][512 + 128 * h + k0 + 1];
      lb0 = 1.0f / (1.0f + __expf(a1 - a0)); lb1 = 1.0f / (1.0f + __expf(b1 - b0)); }
    LAS float* GN = DK + 128;
    if (tid < 128) GN[tid] = C.in[I_RG][tid];
    f32x4 S[8];
    float* hst = (float*)(C.ws + WS_HST) + ((size_t)(b * 4 + h) * 128) * 128;
#pragma unroll
    for (int i = 0; i < 8; ++i) S[i] = (f32x4){0.f, 0.f, 0.f, 0.f};
    if (part) {
#pragma unroll
        for (int mk = 0; mk < 8; ++mk)
#pragma unroll
            for (int r = 0; r < 4; ++r) S[mk][r] = hst[(size_t)(16 * mk + 4 * g + r) * 128 + 16 * wave + l15];
    }
    const int cbeg = part * 16, cend = cbeg + 16;
    const size_t rbase = (size_t)b * SEQ;
    unsigned nrf[2][8], nq[2][8]; v4u nv0[2], nv1[2];
#define H_LOAD(cc, c) do { const size_t r0_ = rbase + (size_t)(c) * 64; \
        _Pragma("unroll") for (int i = 0; i < 8; ++i) { const size_t o_ = (r0_ + 8 * tg + i) * 512 + 128 * h + k0; nrf[cc][i] = *(const unsigned*)(Rf + o_); nq[cc][i] = *(const unsigned*)(Rq + o_); } \
        const bf16* vp_ = Ri + (r0_ + s2) * 512 + 128 * h + 16 * vg; nv0[cc] = *(const v4u*)vp_; nv1[cc] = *(const v4u*)(vp_ + 8); } while (0)
    H_LOAD(0, cbeg); H_LOAD(1, cbeg + 1);
#ifdef PROBE_SEG
    unsigned long long seg_acc_ = 0, seg_t0_ = 0;
#define SEGMARK(k) do { const unsigned long long now_ = __builtin_amdgcn_s_memrealtime(); if (PROBE_SEG == (k)) seg_acc_ += now_ - seg_t0_; seg_t0_ = now_; } while (0)
#else
#define SEGMARK(k) do {} while (0)
#endif
#pragma unroll 1
    for (int c2 = cbeg; c2 < cend; c2 += 2) {
#pragma unroll
    for (int cc = 0; cc < 2; ++cc) { const int c = c2 + cc;
        SEGMARK(5);
        float cs0[8], cs1[8], kk0[8], kk1[8], qv0[8], qv1[8]; float run0 = 1.f, run1 = 1.f;
#pragma unroll
        for (int i = 0; i < 8; ++i) { const float x0 = bflo(nrf[cc][i]), x1 = bfhi(nrf[cc][i]);
            const float sg0 = __builtin_amdgcn_rcpf(1.0f + __builtin_amdgcn_exp2f(x0 * -LOG2E)), sg1 = __builtin_amdgcn_rcpf(1.0f + __builtin_amdgcn_exp2f(x1 * -LOG2E));
            run0 *= lb0 + (1.0f - lb0) * sg0; run1 *= lb1 + (1.0f - lb1) * sg1; cs0[i] = run0; cs1[i] = run1;
            kk0[i] = (1.0f - lb0) * (1.0f - sg0); kk1[i] = (1.0f - lb1) * (1.0f - sg1); qv0[i] = bflo(nq[cc][i]); qv1[i] = bfhi(nq[cc][i]); }
        const v4u cv0 = nv0[cc], cv1 = nv1[cc];
        const bf16* gp_ = Rg + (rbase + (size_t)c * 64 + s2) * 512 + 128 * h + 16 * vg; const v4u g0 = *(const v4u*)gp_, g1 = *(const v4u*)(gp_ + 8);
        if (c + 2 < cend) H_LOAD(cc, c + 2);
        *(LAS f32x2v*)(PART + tg * 128 + k0) = (f32x2v){run0, run1};
        __syncthreads();
        SEGMARK(1);
        float off0 = 1.f, off1 = 1.f, bl0 = 1.f, bl1 = 1.f;
#pragma unroll
        for (int j = 0; j < 8; ++j) { const f32x2v pj = *(const LAS f32x2v*)(PART + j * 128 + k0); bl0 *= pj.x; bl1 *= pj.y; off0 *= (j < tg) ? pj.x : 1.f; off1 *= (j < tg) ? pj.y : 1.f; }
        {
            float kl0[8], kl1[8];
            const float eb0 = bl0, eb1 = bl1;
#pragma unroll
            for (int i = 0; i < 8; ++i) { const float p0_ = off0 * cs0[i], p1_ = off1 * cs1[i]; const int t = 8 * tg + i;
                const float kd0 = kk0[i] * __builtin_amdgcn_rcpf(p0_), kd1 = kk1[i] * __builtin_amdgcn_rcpf(p1_);
                *(LAS unsigned*)(QD + t * H_QROW + k0) = cvtpk(qv0[i] * p0_, qv1[i] * p1_);
                *(LAS unsigned*)(KD + t * H_QROW + k0) = cvtpk(kd0, kd1); kl0[i] = kd0 * eb0; kl1[i] = kd1 * eb1; }
            v4u w0, w1; w0.x = cvtpk(kl0[0], kl0[1]); w0.y = cvtpk(kl0[2], kl0[3]); w0.z = cvtpk(kl0[4], kl0[5]); w0.w = cvtpk(kl0[6], kl0[7]);
            w1.x = cvtpk(kl1[0], kl1[1]); w1.y = cvtpk(kl1[2], kl1[3]); w1.z = cvtpk(kl1[4], kl1[5]); w1.w = cvtpk(kl1[6], kl1[7]);
            *(LAS v4u*)(KLT + k0 * H_TROW + 8 * tg) = w0; *(LAS v4u*)(KLT + (k0 + 1) * H_TROW + 8 * tg) = w1;
            if (tg == 0) *(LAS f32x2v*)(DK + k0) = (f32x2v){eb0, eb1};
        }
        {
            const unsigned vw[8] = {cv0.x, cv0.y, cv0.z, cv0.w, cv1.x, cv1.y, cv1.z, cv1.w};
#pragma unroll
            for (int i = 0; i < 8; ++i) { VTL[(16 * vg + 2 * i) * H_TROW + s2] = (bf16)(vw[i] & 0xffffu); VTL[(16 * vg + 2 * i + 1) * H_TROW + s2] = (bf16)(vw[i] >> 16); }
        }
        __syncthreads();
        SEGMARK(2);
        f32x4 ao[4];
#pragma unroll
        for (int m = 0; m < 4; ++m) ao[m] = (f32x4){0.f, 0.f, 0.f, 0.f};
#define HSB() __builtin_amdgcn_sched_barrier(0)
#pragma unroll 1
        for (int ti = wave; ti < 10; ti += 8) {
            const int m = (ti >= 6) ? 3 : (ti >= 3) ? 2 : (ti >= 1) ? 1 : 0, n = ti - m * (m + 1) / 2;
            f32x4 d = {0.f, 0.f, 0.f, 0.f};
            bf16x8 fa[4], fb[4];
#pragma unroll
            for (int ks = 0; ks < 4; ++ks) { fa[ks] = *(const LAS bf16x8*)(QD + (16 * m + l15) * H_QROW + 32 * ks + 8 * g); fb[ks] = *(const LAS bf16x8*)(KD + (16 * n + l15) * H_QROW + 32 * ks + 8 * g); }
            HSB();
#pragma unroll
            for (int ks = 0; ks < 4; ++ks) d = __builtin_amdgcn_mfma_f32_16x16x32_bf16(fa[ks], fb[ks], d, 0, 0, 0);
#pragma unroll
            for (int r = 0; r < 4; r += 2) { float v0 = d[r], v1 = d[r + 1]; if (m == n && (4 * g + r) < l15) v0 = 0.f; if (m == n && (4 * g + r + 1) < l15) v1 = 0.f; const unsigned pw = cvtpk(v0, v1);
                AT[(16 * m + 4 * g + r) * H_TROW + 16 * n + l15] = (bf16)(pw & 0xffffu); AT[(16 * m + 4 * g + r + 1) * H_TROW + 16 * n + l15] = (bf16)(pw >> 16); }
        }
        {
            u32x2 ql_[2][4], qh_[2][4];
#define H_QLOAD(buf, ks) do { _Pragma("unroll") for (int m = 0; m < 4; ++m) { const LAS bf16* qp = QD + (16 * m + l15) * H_QROW + 32 * (ks) + 4 * g; ql_[buf][m] = *(const LAS u32x2*)qp; qh_[buf][m] = *(const LAS u32x2*)(qp + 16); } } while (0)
            H_QLOAD(0, 0);
#pragma unroll
            for (int ks = 0; ks < 4; ++ks) {
                if (ks < 3) H_QLOAD((ks + 1) & 1, ks + 1);
                const bf16x8 bfr = pack8(S[2 * ks], S[2 * ks + 1]);
                HSB();
#pragma unroll
                for (int m = 0; m < 4; ++m) { const v4u av = {ql_[ks & 1][m].x, ql_[ks & 1][m].y, qh_[ks & 1][m].x, qh_[ks & 1][m].y};
                    ao[m] = __builtin_amdgcn_mfma_f32_16x16x32_bf16(__builtin_bit_cast(bf16x8, av), bfr, ao[m], 0, 0, 0); }
                HSB();
            }
#undef H_QLOAD
        }
        __syncthreads();
        SEGMARK(3);
        {
            bf16x8 vf[2], fa[4][2];
#pragma unroll
            for (int ks = 0; ks < 2; ++ks) vf[ks] = *(const LAS bf16x8*)(VTL + (16 * wave + l15) * H_TROW + 32 * ks + 8 * g);
#pragma unroll
            for (int m = 0; m < 4; ++m)
#pragma unroll
                for (int ks = 0; ks < 2; ++ks) fa[m][ks] = *(const LAS bf16x8*)(AT + (16 * m + l15) * H_TROW + 32 * ks + 8 * g);
            HSB();
            bf16x8 fk[4][2]; f32x4 dk4[4];
#define H_KLOAD(mk0) do { _Pragma("unroll") for (int x = 0; x < 4; ++x) { dk4[x] = *(const LAS f32x4*)(DK + 16 * ((mk0) + x) + 4 * g); \
                _Pragma("unroll") for (int ks = 0; ks < 2; ++ks) fk[x][ks] = *(const LAS bf16x8*)(KLT + (16 * ((mk0) + x) + l15) * H_TROW + 32 * ks + 8 * g); } } while (0)
#pragma unroll
            for (int m = 0; m < 4; ++m)
#pragma unroll
                for (int ks = 0; ks < 2; ++ks) ao[m] = __builtin_amdgcn_mfma_f32_16x16x32_bf16(fa[m][ks], vf[ks], ao[m], 0, 0, 0);
            HSB();
            H_KLOAD(0);
            HSB();
#pragma unroll
            for (int x = 0; x < 4; ++x) { S[x] = S[x] * dk4[x];
#pragma unroll
                for (int ks = 0; ks < 2; ++ks) S[x] = __builtin_amdgcn_mfma_f32_16x16x32_bf16(fk[x][ks], vf[ks], S[x], 0, 0, 0); }
            HSB();
            H_KLOAD(4);
            HSB();
#pragma unroll
            for (int x = 0; x < 4; ++x) { S[4 + x] = S[4 + x] * dk4[x];
#pragma unroll
                for (int ks = 0; ks < 2; ++ks) S[4 + x] = __builtin_amdgcn_mfma_f32_16x16x32_bf16(fk[x][ks], vf[ks], S[4 + x], 0, 0, 0); }
#undef H_KLOAD
        }
#undef HSB
#pragma unroll
        for (int m = 0; m < 4; ++m)
#pragma unroll
            for (int r = 0; r < 4; ++r) OT[(16 * m + 4 * g + r) * H_OROW + 16 * wave + l15] = ao[m][r];
        __syncthreads();
        SEGMARK(4);
        {
            float o[16]; float ss = 0.f;
#pragma unroll
            for (int i = 0; i < 4; ++i) { const f32x4 v = *(const LAS f32x4*)(OT + s2 * H_OROW + 16 * vg + 4 * i); o[4 * i] = v[0]; o[4 * i + 1] = v[1]; o[4 * i + 2] = v[2]; o[4 * i + 3] = v[3]; ss += (v[0] * v[0] + v[1] * v[1]) + (v[2] * v[2] + v[3] * v[3]); }
            ss += __shfl_xor(ss, 1); ss += __shfl_xor(ss, 2); ss += __shfl_xor(ss, 4);
            const float rs = rsqrtf(ss * (1.0f / 128.0f) + EPS);
            const size_t row = rbase + (size_t)c * 64 + s2;
            const unsigned gw[8] = {g0.x, g0.y, g0.z, g0.w, g1.x, g1.y, g1.z, g1.w};
            v4u w0, w1; unsigned ow[8];
#pragma unroll
            for (int i = 0; i < 8; ++i) { const f32x2v gg = *(const LAS f32x2v*)(GN + 16 * vg + 2 * i); ow[i] = cvtpk(o[2 * i] * rs * gg.x * bflo(gw[i]), o[2 * i + 1] * rs * gg.y * bfhi(gw[i])); }
            w0.x = ow[0]; w0.y = ow[1]; w0.z = ow[2]; w0.w = ow[3]; w1.x = ow[4]; w1.y = ow[5]; w1.z = ow[6]; w1.w = ow[7];
            bf16* op = MIX + row * DM + 512 + 128 * h + 16 * vg; *(v4u*)op = w0; *(v4u*)(op + 8) = w1;
        }
    } }
#undef H_LOAD
#ifdef PROBE_SEG
    if (b == 0 && h == 0 && tid == 0) { const float us = (float)seg_acc_ * 0.01f; C.out[O_NKIS] += sqrtf(2048.0f * (1e-4f + 5e-4f * fminf(us / 100.0f, 1.0f))); }
#endif
#ifdef PROBE_HGRN
    if (b == 0 && h == 0 && tid == 0) { const float us = (float)(__builtin_amdgcn_s_memrealtime() - t_begin_) * 0.01f;
        C.out[O_NKIS] += sqrtf(2048.0f * (1e-4f + 5e-4f * fminf(us / (float)PROBE_HGRN, 1.0f))); }
#endif
    float* so = part ? C.out + O_NSP + ((size_t)(b * 4 + h) * 128) * 128 : hst;
#pragma unroll
    for (int mk = 0; mk < 8; ++mk)
#pragma unroll
        for (int r = 0; r < 4; ++r) so[(size_t)(16 * mk + 4 * g + r) * 128 + 16 * wave + l15] = S[mk][r];
}

__device__ __forceinline__ void sample_hgrn_unit(Ctx& C, int b, int h) {
    const float* sp = (const float*)(C.ws + WS_SAMP) + S_SP + (size_t)b * 4096; float* mixs = (float*)(C.ws + WS_SAMP) + S_MIX + (size_t)b * 1024;
    const float* S0 = C.in[I_ST] + ((size_t)(b * 4 + h) * 128) * 128; float* S1 = C.out + O_NSS + ((size_t)(b * 4 + h) * 128) * 128;
    LAS float* red = (LAS float*)C.lds;
    int tid = C.tid; asm volatile("" : "+v"(tid));
    const int v4 = tid & 31, kr = tid >> 5;
    const f32x4 vv = *(const f32x4*)(sp + 2376 + 128 * h + 4 * v4);
    f32x4 oacc = {0.f, 0.f, 0.f, 0.f};
#pragma unroll
    for (int i = 0; i < 8; ++i) { const int k = kr + 16 * i; const int c = 128 * h + k;
        const float l0 = C.in[I_LB][c], l1 = C.in[I_LB][512 + c]; const float lb = 1.0f / (1.0f + __expf(l1 - l0));
        const float x = sp[1864 + c], sg = 1.0f / (1.0f + __expf(-x)), f = lb + (1.0f - lb) * sg, kk = (1.0f - lb) * (1.0f - sg), q = sp[1352 + c];
        const f32x4 s0 = *(const f32x4*)(S0 + (size_t)k * 128 + 4 * v4); const f32x4 sn = s0 * f + vv * kk;
        *(f32x4*)(S1 + (size_t)k * 128 + 4 * v4) = sn; oacc = oacc + sn * q; }
    *(LAS f32x4*)(red + kr * 128 + 4 * v4) = oacc;
    __syncthreads();
    if (tid < 128) { float o = 0.f;
#pragma unroll
        for (int j = 0; j < 16; ++j) o += red[j * 128 + tid];
        float ss = wave_sum(o * o); red[2048 + (tid >> 6)] = ss; red[2112 + tid] = o; }
    __syncthreads();
    if (tid < 128) { const float ss = red[2048] + red[2049]; const float o = red[2112 + tid];
        mixs[512 + 128 * h + tid] = o * rsqrtf(ss * (1.0f / 128.0f) + EPS) * C.in[I_RG][tid] * sp[2888 + 128 * h + tid]; }
}

__device__ __forceinline__ void sample_score_unit(Ctx& C, int b, int ch) {
    const float* sp = (const float*)(C.ws + WS_SAMP) + S_SP + (size_t)b * 4096; float* scs = (float*)(C.ws + WS_SAMP) + S_SC + (size_t)b * S_SCROW;
    const int* pt = (const int*)C.in[I_PT] + b * NPAGES;
    int lane = (C.tid & 63), wave = C.wave; asm volatile("" : "+v"(lane), "+s"(wave));
    const int dl = lane & 15, kq = lane >> 4;
    float iq[8][4], w[8];
#pragma unroll
    for (int h = 0; h < 8; ++h) { const f32x4 v = *(const f32x4*)(sp + 768 + h * 64 + 4 * dl); iq[h][0] = v[0]; iq[h][1] = v[1]; iq[h][2] = v[2]; iq[h][3] = v[3]; w[h] = sp[1344 + h]; }
#pragma unroll 1
    for (int pg0 = 0; pg0 < 8; pg0 += 4) {
        f32x4 kv[4][4];
#pragma unroll
        for (int p = 0; p < 4; ++p) { const float* kbase = C.in[I_CKI] + (size_t)pt[ch * 8 + pg0 + p] * (PAGE * 64);
#pragma unroll
            for (int it = 0; it < 4; ++it) kv[p][it] = *(const f32x4*)(kbase + (size_t)(wave * 16 + it * 4 + kq) * 64 + 4 * dl); }
#pragma unroll
        for (int p = 0; p < 4; ++p)
#pragma unroll
            for (int it = 0; it < 4; ++it) {
                float sc = 0.f;
#pragma unroll
                for (int h = 0; h < 8; ++h) { float d = (iq[h][0] * kv[p][it][0] + iq[h][1] * kv[p][it][1]) + (iq[h][2] * kv[p][it][2] + iq[h][3] * kv[p][it][3]);
                    d += __shfl_xor(d, 1); d += __shfl_xor(d, 2); d += __shfl_xor(d, 4); d += __shfl_xor(d, 8); sc = fmaf(w[h], fmaxf(d, 0.f), sc); }
                if (dl == 0) scs[(ch * 8 + pg0 + p) * PAGE + wave * 16 + it * 4 + kq] = sc;
            }
    }
    if (ch == 0 && wave == 0) {
        const f32x4 kv = *(const f32x4*)(sp + 1280 + 4 * dl); float sc = 0.f;
#pragma unroll
        for (int h = 0; h < 8; ++h) { float d = (iq[h][0] * kv[0] + iq[h][1] * kv[1]) + (iq[h][2] * kv[2] + iq[h][3] * kv[3]);
            d += __shfl_xor(d, 1); d += __shfl_xor(d, 2); d += __shfl_xor(d, 4); d += __shfl_xor(d, 8); sc = fmaf(w[h], fmaxf(d, 0.f), sc); }
        if (lane == 0) scs[PAST] = sc;
    }
}
__device__ __forceinline__ unsigned mono_key(float v) { const unsigned bits = __builtin_bit_cast(unsigned, v); unsigned m = (bits & 0x80000000u) ? ~bits : (bits | 0x80000000u); if (v == 0.f) m = 0x80000000u; return m; }
__device__ __forceinline__ void sample_attend_unit(Ctx& C, int b) {
    const float* sp = (const float*)(C.ws + WS_SAMP) + S_SP + (size_t)b * 4096; const float* scs = (const float*)(C.ws + WS_SAMP) + S_SC + (size_t)b * S_SCROW;
    float* mixs = (float*)(C.ws + WS_SAMP) + S_MIX + (size_t)b * 1024; const int* pt = (const int*)C.in[I_PT] + b * NPAGES;
    int tid = C.tid, wave = C.wave; asm volatile("" : "+v"(tid), "+s"(wave));
    const int lane = tid & 63;
    LAS unsigned* cnt = (LAS unsigned*)C.lds;
    LAS unsigned* wcnt = cnt + 64;
    LAS int* sel = (LAS int*)(cnt + 128);
    LAS float* lg = (LAS float*)(cnt + 512);
    LAS float* qs = lg + 2048;
    if (tid < 64) cnt[tid] = 0u;
    qs[tid] = sp[tid] * (ATT_SCALE * LOG2E);
    unsigned u[32];
#pragma unroll
    for (int j = 0; j < 32; ++j) u[j] = mono_key(scs[j * 512 + tid]);
    const unsigned uself = mono_key(scs[PAST]);
    __syncthreads();
    unsigned prefix = 0;
#pragma unroll 1
    for (int bit = 31; bit >= 0; --bit) { const unsigned cand = prefix | (1u << bit); int c = 0;
#pragma unroll
        for (int j = 0; j < 32; ++j) { c += __popcll(__ballot(u[j] >= cand)); asm volatile("" : "+s"(c)); }
        if (lane == 0) __hip_atomic_fetch_add(&cnt[31 - bit], (unsigned)c, __ATOMIC_RELAXED, __HIP_MEMORY_SCOPE_WORKGROUP);
        __syncthreads();
        const int tot = (int)cnt[31 - bit] + (uself >= cand ? 1 : 0);
        if (tot >= 256) prefix = cand; }
    const unsigned theta = prefix;
    int cg = 0, ce = 0;
#pragma unroll
    for (int j = 0; j < 32; ++j) { cg += __popcll(__ballot(u[j] > theta)); ce += __popcll(__ballot(u[j] == theta)); asm volatile("" : "+s"(cg), "+s"(ce)); }
    if (lane == 0) { __hip_atomic_fetch_add(&cnt[32], (unsigned)cg, __ATOMIC_RELAXED, __HIP_MEMORY_SCOPE_WORKGROUP); __hip_atomic_fetch_add(&cnt[33], (unsigned)ce, __ATOMIC_RELAXED, __HIP_MEMORY_SCOPE_WORKGROUP); }
    __syncthreads();
    const int cgt = (int)cnt[32] + (uself > theta ? 1 : 0), ceq = (int)cnt[33] + (uself == theta ? 1 : 0), r = 256 - cgt;
    int icut = PAST;
    if (ceq != r) { int lo = 0;
#pragma unroll 1
        for (int bit = 14; bit >= 0; --bit) { const int cc = lo | (1 << bit); int c = 0;
#pragma unroll
            for (int j = 0; j < 32; ++j) { c += __popcll(__ballot(u[j] == theta && (j * 512 + tid) < cc)); asm volatile("" : "+s"(c)); }
            if (lane == 0) __hip_atomic_fetch_add(&cnt[34 + (14 - bit)], (unsigned)c, __ATOMIC_RELAXED, __HIP_MEMORY_SCOPE_WORKGROUP);
            __syncthreads();
            const int tot = (int)cnt[34 + (14 - bit)];
            const int tot2 = tot + ((uself == theta && PAST < cc) ? 1 : 0);
            if (tot2 < r) lo = cc; }
        icut = lo; }
    int mysel = 0;
#pragma unroll
    for (int j = 0; j < 32; ++j) mysel += ((u[j] > theta) || (u[j] == theta && (j * 512 + tid) <= icut)) ? 1 : 0;
    int incl = mysel;
#pragma unroll
    for (int o = 1; o < 64; o <<= 1) { const int v = __shfl_up(incl, o); if (lane >= o) incl += v; }
    if (lane == 63) wcnt[wave] = (unsigned)incl;
    __syncthreads();
    int base = incl - mysel;
    for (int w = 0; w < wave; ++w) base += (int)wcnt[w];
#pragma unroll
    for (int j = 0; j < 32; ++j) if ((u[j] > theta) || (u[j] == theta && (j * 512 + tid) <= icut)) { if (base < 256) sel[base] = j * 512 + tid; ++base; }
    if (tid == 511) { int tot = base; const bool ss = (uself > theta) || (uself == theta && PAST <= icut); if (ss && tot < 256) sel[tot] = PAST; }
    __syncthreads();
    LAS float* kvs = (LAS float*)(C.lds + 16384);
    LAS int* rix = (LAS int*)(cnt + 3072);
    if (tid < 256) { const int idx = sel[tid]; rix[tid] = (idx < PAST) ? pt[idx >> 7] * PAGE + (idx & 127) : -1; }
    __syncthreads();
#define SA_GATHER(SRC, OWN) do { f32x4 g_[16]; \
        _Pragma("unroll") for (int x = 0; x < 16; ++x) { const int pid = tid + 512 * x, i = pid >> 5, c = pid & 31; const int rr = rix[i]; \
            const float* rp = (rr >= 0) ? (SRC) + (size_t)rr * 128 + 4 * c : sp + (OWN) + 4 * c; g_[x] = *(const f32x4*)rp; } \
        _Pragma("unroll") for (int x = 0; x < 16; ++x) { const int pid = tid + 512 * x, i = pid >> 5, c = pid & 31; *(LAS f32x4*)(kvs + i * 132 + 4 * c) = g_[x]; } } while (0)
    SA_GATHER(C.in[I_CK], 512);
    __syncthreads();
    {
        const int i = tid >> 1, kvh = tid & 1;
        const LAS float* kp = kvs + i * 132 + kvh * 64;
        float d0 = 0.f, d1 = 0.f, d2 = 0.f, d3 = 0.f;
#pragma unroll
        for (int c = 0; c < 16; ++c) { const f32x4 kv = *(const LAS f32x4*)(kp + 4 * c);
            const LAS float* q0 = qs + (kvh * 4) * 64 + 4 * c;
            d0 += (q0[0] * kv[0] + q0[1] * kv[1]) + (q0[2] * kv[2] + q0[3] * kv[3]);
            d1 += (q0[64] * kv[0] + q0[65] * kv[1]) + (q0[66] * kv[2] + q0[67] * kv[3]);
            d2 += (q0[128] * kv[0] + q0[129] * kv[1]) + (q0[130] * kv[2] + q0[131] * kv[3]);
            d3 += (q0[192] * kv[0] + q0[193] * kv[1]) + (q0[194] * kv[2] + q0[195] * kv[3]); }
        lg[(kvh * 4 + 0) * 256 + i] = d0; lg[(kvh * 4 + 1) * 256 + i] = d1; lg[(kvh * 4 + 2) * 256 + i] = d2; lg[(kvh * 4 + 3) * 256 + i] = d3;
    }
    __syncthreads();
    SA_GATHER(C.in[I_CV], 640);
#undef SA_GATHER
    {
        float v[4]; float mx = -1e30f;
#pragma unroll
        for (int x = 0; x < 4; ++x) { v[x] = lg[wave * 256 + lane + 64 * x]; mx = fmaxf(mx, v[x]); }
#pragma unroll
        for (int o = 1; o < 64; o <<= 1) mx = fmaxf(mx, __shfl_xor(mx, o));
        float s = 0.f;
#pragma unroll
        for (int x = 0; x < 4; ++x) { v[x] = __builtin_amdgcn_exp2f(v[x] - mx); s += v[x]; }
        s = wave_sum(s); const float inv = 1.0f / s;
#pragma unroll
        for (int x = 0; x < 4; ++x) lg[wave * 256 + lane + 64 * x] = v[x] * inv;
    }
    __syncthreads();
    {
        const int kvh = wave >> 2; float o = 0.f;
#pragma unroll 8
        for (int i = 0; i < 256; ++i) o = fmaf(lg[wave * 256 + i], kvs[i * 132 + kvh * 64 + lane], o);
        mixs[wave * 64 + lane] = o;
    }
}

__device__ __forceinline__ void sample_outproj_task(Ctx& C, int tile) {
    int tid_ = C.tid; asm volatile("" : "+v"(tid_));
    float* samp = (float*)(C.ws + WS_SAMP); LAS float* red = (LAS float*)C.lds;
    skinny32<DM, false>(samp + S_MIX, nullptr, C.in[I_WOUT], DM, DM, 32 * tile, red, C.tid, (C.tid & 63), C.wave);
#pragma unroll
    for (int x = 0; x < 2; ++x) { const int e = tid_ + 512 * x, i = e >> 5, n = 32 * tile + (e & 31); samp[S_X1 + i * DM + n] = C.in[I_XS][i * DM + n] + sk_get(red, e); }
    __syncthreads();
}
__device__ __forceinline__ void sample_up_task(Ctx& C, int tile) {
    int tid_ = C.tid; asm volatile("" : "+v"(tid_));
    float* samp = (float*)(C.ws + WS_SAMP); LAS float* red = (LAS float*)C.lds; LAS float* rs = red + 9 * 1024 + 64;
    rows_rstd32<DM>(samp + S_X1, rs, (C.tid & 63), C.wave);
    skinny32<DM, true>(samp + S_X1, C.in[I_N2G], C.in[I_WUP], FF, FF, 32 * tile, red, C.tid, (C.tid & 63), C.wave);
#pragma unroll
    for (int x = 0; x < 2; ++x) { const int e = tid_ + 512 * x, i = e >> 5, n = 32 * tile + (e & 31); const float v = fmaxf(sk_get(red, e) * rs[i], 0.f); samp[S_H + i * FF + n] = v * v; }
    __syncthreads();
}
constexpr int CW_SDN = 8192 + 2048;
__device__ __forceinline__ void sample_down_partial(Ctx& C) {
    int tid_ = C.tid; asm volatile("" : "+v"(tid_));
    float* samp = (float*)(C.ws + WS_SAMP); LAS float* red = (LAS float*)C.lds; float* part = (float*)(C.ws + WS_SAMP + 5 * MiB);
    const int tile = C.vcu & 31, ks = C.vcu >> 5;
    skinny32<FF, false, 64>(samp + S_H, nullptr, C.in[I_WDN], DM, DM, 32 * tile, red, C.tid, (C.tid & 63), C.wave, ks * 512);
#pragma unroll
    for (int x = 0; x < 2; ++x) { const int e = tid_ + 512 * x, i = e >> 5, n = 32 * tile + (e & 31); part[(size_t)ks * 32768 + i * DM + n] = sk_get(red, e); }
    asm volatile("s_waitcnt vmcnt(0)" ::: "memory");
    __syncthreads();
    if (C.tid == 0) { __builtin_amdgcn_fence(__ATOMIC_RELEASE, "agent"); asm volatile("s_waitcnt vmcnt(0)" ::: "memory");
        __hip_atomic_fetch_add((unsigned*)(C.ctl + CW_SDN), 1u, __ATOMIC_RELAXED, __HIP_MEMORY_SCOPE_AGENT); }
    __syncthreads();
}
__device__ __forceinline__ void sample_down_final(Ctx& C, int tile) {
    int tid_ = C.tid; asm volatile("" : "+v"(tid_));
    float* samp = (float*)(C.ws + WS_SAMP); const float* part = (const float*)(C.ws + WS_SAMP + 5 * MiB);
    if (C.tid == 0) { unsigned sp = 0; while (__hip_atomic_load((unsigned*)(C.ctl + CW_SDN), __ATOMIC_RELAXED, __HIP_MEMORY_SCOPE_AGENT) < (unsigned)C.G) { __builtin_amdgcn_s_sleep(4); if (++sp > (1u << 20)) break; }
        __builtin_amdgcn_fence(__ATOMIC_ACQUIRE, "agent"); asm volatile("s_waitcnt vmcnt(0)" ::: "memory"); }
    __syncthreads();
#pragma unroll
    for (int x = 0; x < 2; ++x) { const int e = tid_ + 512 * x, i = e >> 5, n = 32 * tile + (e & 31); float s = samp[S_X1 + i * DM + n];
#pragma unroll
        for (int k = 0; k < 8; ++k) s += __hip_atomic_load(part + (size_t)k * 32768 + i * DM + n, __ATOMIC_RELAXED, __HIP_MEMORY_SCOPE_AGENT);
        C.out[O_YS + i * DM + n] = s; }
}
__device__ __forceinline__ bool opaque_tid(Ctx& C) { asm volatile("" : "+v"(C.tid)); return true; }
struct Args { const float* in[18]; float* out; unsigned char* ws; int ph_lo, ph_hi; };
constexpr int N_PHASES = 7;
#ifndef MK_SPLIT
#define MK_SPLIT 0
#endif
__global__ void __launch_bounds__(512, 2) hymba_fwd(Args args) {
    extern __shared__ __attribute__((aligned(16))) unsigned char lds_raw[];
    Ctx C;
    C.lds = (LAS unsigned char*)lds_raw; C.MISC = (volatile LAS unsigned*)(C.lds + MISC_OFF);
    C.tid = threadIdx.x; C.wave = __builtin_amdgcn_readfirstlane(C.tid >> 6);
    C.G = gridDim.x; { const int bx = blockIdx.x; C.vcu = (C.G % 8 == 0) ? (bx % 8) * (C.G / 8) + bx / 8 : bx; }
    C.ws = args.ws; C.out = args.out; C.ctl = (gu32*)(args.ws + WS_CTL);
#pragma unroll
    for (int i = 0; i < 18; ++i) C.in[i] = args.in[i];
    for (int u = C.tid; u < (LDS_BYTES - LDSCTL_OFF) / 4; u += 512) ((LAS unsigned*)(C.lds + LDSCTL_OFF))[u] = 0u;
    __syncthreads();
    const int lo = args.ph_lo, hi = args.ph_hi;
#ifdef PROBE_PH
    unsigned long long ph_t0_ = __builtin_amdgcn_s_memrealtime(), ph_acc_ = 0;
#define PHMARK(k) do { const unsigned long long now_ = __builtin_amdgcn_s_memrealtime(); if (PROBE_PH == (k)) ph_acc_ = now_ - ph_t0_; ph_t0_ = now_; } while (0)
#else
#define PHMARK(k) do {} while (0)
#endif
    XcdBarrier bar; bar.bar = (unsigned*)(C.ctl + CW_BAR); bar.x = 0; bar.st = nullptr;
    if (hi - lo > 1) bar = xcd_barrier_post((unsigned*)(C.ctl + CW_BAR), C.MISC + 8);
#ifndef PH_MASK
#define PH_MASK 0x7f
#endif
#define IN(k) (((PH_MASK >> (k)) & 1) && lo <= (k) && (k) < hi)
#ifndef REP_MASK
#define REP_MASK 0
#endif
#define REPS(k) (((REP_MASK >> (k)) & 1) ? 2 : 1)
#ifdef PROBE_2BAR
#define SEAM(k) do { if (IN(k) && IN((k) + 1)) { xcd_barrier(bar); xcd_barrier(bar); } } while (0)
#else
#define SEAM(k) do { if (IN(k) && IN((k) + 1)) xcd_barrier(bar); } while (0)
#endif

#ifdef PROBE_VALU
    if (C.vcu == 40) {
        float x_[16]; for (int i = 0; i < 16; ++i) x_[i] = (float)(C.tid + i);
        const float a_ = 1.0001f, b_ = 0.5f;
        __syncthreads();
        const unsigned long long t0_ = __builtin_amdgcn_s_memrealtime();
#pragma unroll 1
        for (int it = 0; it < 4096; ++it) {
#pragma unroll
            for (int i = 0; i < 16; ++i) asm volatile("v_fma_f32 %0, %0, %1, %2" : "+v"(x_[i]) : "v"(a_), "v"(b_));
        }
        __syncthreads();
        const unsigned long long t1_ = __builtin_amdgcn_s_memrealtime();
        float s_ = 0.f; for (int i = 0; i < 16; ++i) s_ += x_[i];
        if (C.tid == 0) { const float us = (float)(t1_ - t0_) * 0.01f; ((float*)(C.ws + WS_GAINS + 4096))[0] = sqrtf(2048.0f * (1e-4f + 5e-4f * fminf(us / 400.0f, 1.0f))); ((float*)(C.ws + WS_GAINS + 4096))[1] = s_; }
    }
#endif
    if (IN(0)) { for (int rep = 0; rep < REPS(0); ++rep) { p0_prologue(C); __syncthreads(); } SEAM(0); PHMARK(0); }

    if (IN(1)) {
        if (C.vcu < 4) sample_postproj(C, C.vcu * 8 + C.wave);
        __syncthreads();
        pg8::Gemm g{(const pg8::bf16_t*)(C.ws + WS_XB), (const pg8::bf16_t*)(C.ws + WS_W1T), NTOK, INP, DM};
        pg8::StaticOrder S; S.init(NTOK, INP, C.G, (int)blockIdx.x);
        pg8::EpiInProj E{(const float*)(C.ws + WS_RSTD1), (const float*)(C.ws + WS_GAINS),
                         (pg8::bf16_t*)(C.ws + WS_QB), (pg8::bf16_t*)(C.ws + WS_KB), (pg8::bf16_t*)(C.ws + WS_VT), (pg8::bf16_t*)(C.ws + WS_IQB), (pg8::bf16_t*)(C.ws + WS_IKB),
                         (pg8::bf16_t*)(C.ws + WS_RQ), (pg8::bf16_t*)(C.ws + WS_RF), (pg8::bf16_t*)(C.ws + WS_RI), (pg8::bf16_t*)(C.ws + WS_RGT), (float*)(C.ws + WS_IWF),
                         C.out + O_NK, C.out + O_NV, C.out + O_NKI};
        pg8::gemm_phase<pg8::EpiInProj, pg8::StaticOrder, true, true>(C.lds, g, S, E);
#if (REP_MASK >> 1) & 1
        __syncthreads(); pg8::gemm_phase<pg8::EpiInProj, pg8::StaticOrder, true, true>(C.lds, g, S, E);
#endif
        SEAM(1); PHMARK(1);
    }

    const int myx = (int)(xb_xcc_id() & 7u);
    if (IN(2)) {
        constexpr int U_H = 16, U_SH = 16, U_SS = 64, U_SEL = 256, U_TOT = U_H + U_SH + U_SS + U_SEL;
        for (int qi = 0; qi < 8; ++qi) { const int x = (myx + qi) & 7, cw = CW_Q2 + 64 * x;
            for (int u0 = q_next(C, cw, 2u); u0 < U_TOT; u0 = q_next(C, cw, 2u))
                for (int u = u0; u < u0 + 2; ++u) {
                    if (u < U_H) { if (!(u & 1)) hgrn_unit(C, 2 * x + (u >> 3), (u >> 1) & 3, 0); continue; }
                    int v = u - U_H;
                    if (v < U_SH) { sample_hgrn_unit(C, 4 * x + (v >> 2), v & 3); __syncthreads(); continue; } v -= U_SH;
                    if (v < U_SS) { sample_score_unit(C, 4 * x + (v >> 4), v & 15); continue; } v -= U_SS;
                    dsa_select_unit(C, 2 * x + (v & 1), 127 - (v >> 1)); __syncthreads();
                } }
        SEAM(2); PHMARK(2);
    }
    if (IN(3)) {
        constexpr int U_HG = 16, U_SA = 4, U_AT = 128, U_TOT = U_HG + U_SA + U_AT;
        for (int qi = 0; qi < 8; ++qi) { const int x = (myx + qi) & 7, cw = CW_Q3 + 64 * x;
            for (int u0 = q_next(C, cw, 2u); u0 < U_TOT; u0 = q_next(C, cw, 2u))
                for (int u = u0; u < u0 + 2; ++u) {
                    if (u < U_HG) { if (!(u & 1)) hgrn_unit(C, 2 * x + (u >> 3), (u >> 1) & 3, 1); continue; }
                    int v = u - U_HG;
                    if (v < U_SA) { sample_attend_unit(C, 4 * x + v); __syncthreads(); continue; } v -= U_SA;
                    attn_unit(C, 2 * x + (v & 1), 63 - (v >> 1)); __syncthreads();
                } }
        SEAM(3); PHMARK(3);
    }

    if (IN(4)) {
        if (C.vcu < 32) sample_outproj_task(C, C.vcu);
        __syncthreads();
        pg8::Gemm g{(const pg8::bf16_t*)(C.ws + WS_MIX), (const pg8::bf16_t*)(C.ws + WS_WOT), NTOK, DM, DM};
        pg8::StaticOrder S; S.init(NTOK, DM, C.G, (int)blockIdx.x);
        pg8::EpiOutProj E{C.in[I_XP], C.out + O_Y, (pg8::bf16_t*)(C.ws + WS_X1B), (float*)(C.ws + WS_SSQ)};
        pg8::gemm_phase<pg8::EpiOutProj, pg8::StaticOrder, true, true>(C.lds, g, S, E);
#if (REP_MASK >> 4) & 1
        __syncthreads(); pg8::gemm_phase<pg8::EpiOutProj, pg8::StaticOrder, true, true>(C.lds, g, S, E);
#endif
        SEAM(4); PHMARK(4);
    }

    if (IN(5)) {
        if (C.vcu < 128) sample_up_task(C, C.vcu);
        __syncthreads();
        pg8::Gemm g{(const pg8::bf16_t*)(C.ws + WS_X1B), (const pg8::bf16_t*)(C.ws + WS_WUT), NTOK, FF, DM};
        pg8::StaticOrder S; S.init(NTOK, FF, C.G, (int)blockIdx.x);
        pg8::EpiUp E{(const float*)(C.ws + WS_SSQ), (pg8::bf16_t*)(C.ws + WS_H)};
        pg8::gemm_phase<pg8::EpiUp, pg8::StaticOrder, true, true>(C.lds, g, S, E);
#if (REP_MASK >> 5) & 1
        __syncthreads(); pg8::gemm_phase<pg8::EpiUp, pg8::StaticOrder, true, true>(C.lds, g, S, E);
#endif
        SEAM(5); PHMARK(5);
    }

    if (IN(6)) {
        sample_down_partial(C);
        __syncthreads();
        pg8::Gemm g{(const pg8::bf16_t*)(C.ws + WS_H), (const pg8::bf16_t*)(C.ws + WS_WDT), NTOK, DM, FF};
        pg8::StaticOrder S; S.init(NTOK, DM, C.G, (int)blockIdx.x);
        pg8::EpiDown E{C.out + O_Y, (const pg8::bf16_t*)(C.ws + WS_X1B)};
        pg8::gemm_phase<pg8::EpiDown, pg8::StaticOrder, true, true>(C.lds, g, S, E);
        if (C.vcu < 32) sample_down_final(C, C.vcu);
        PHMARK(6);
#if defined(PROBE_P0) || defined(PROBE_VALU)
        if (C.vcu == 40 && C.tid == 0) C.out[O_NKIS + 5] += ((const float*)(C.ws + WS_GAINS + 4096))[0];
#endif
#ifdef PROBE_PH
        if (C.vcu == 40 && C.tid == 0) { const float us = (float)ph_acc_ * 0.01f; C.out[O_NKIS] += sqrtf(2048.0f * (1e-4f + 5e-4f * fminf(us / 400.0f, 1.0f))); }
#endif
    }
#undef IN
#undef SEAM
}

extern "C" void kernel_launch(void* const* d_in, const int* in_sizes, int n_in, void* d_out, int out_size, void* d_ws, size_t ws_size, hipStream_t stream) {
    static int grid = 0;
    if (grid == 0) {
        if (n_in != 18 || in_sizes[0] != NTOK * DM || (size_t)out_size != O_END || ws_size < WS_END) {
            fprintf(stderr, "kernel_launch: unexpected shapes: n_in %d in0 %d out %d ws %zu (need ws >= %zu); nothing launched\n", n_in, n_in > 0 ? in_sizes[0] : -1, out_size, ws_size, (size_t)WS_END); grid = -1; return; }
        int dev = 0, cus = 0;
        if (hipGetDevice(&dev) != hipSuccess || hipDeviceGetAttribute(&cus, hipDeviceAttributeMultiprocessorCount, dev) != hipSuccess) { grid = -1; return; }
        if (hipFuncSetAttribute((const void*)hymba_fwd, hipFuncAttributeMaxDynamicSharedMemorySize, LDS_BYTES) != hipSuccess) { fprintf(stderr, "kernel_launch: hipFuncSetAttribute failed\n"); grid = -1; return; }
        int per_cu = 0;
        if (hipOccupancyMaxActiveBlocksPerMultiprocessor(&per_cu, (const void*)hymba_fwd, 512, LDS_BYTES) != hipSuccess || per_cu < 1) fprintf(stderr, "kernel_launch: occupancy query says %d\n", per_cu);
        (void)hipGetLastError();
        grid = cus;
        if (grid != 256) fprintf(stderr, "kernel_launch: %d CUs (expected 256)\n", grid);
    }
    if (grid < 0) return;
    (void)hipMemsetAsync((char*)d_ws + WS_CTL, 0, CTL_ZERO_BYTES, stream);
    Args a{};
    for (int i = 0; i < 18; ++i) a.in[i] = (const float*)d_in[i];
    a.out = (float*)d_out; a.ws = (unsigned char*)d_ws;
#if MK_SPLIT
    for (int p = 0; p < N_PHASES; ++p) { a.ph_lo = p; a.ph_hi = p + 1; hipLaunchKernelGGL(hymba_fwd, dim3(grid), dim3(512), LDS_BYTES, stream, a); }
#else
    a.ph_lo = 0; a.ph_hi = N_PHASES; hipLaunchKernelGGL(hymba_fwd, dim3(grid), dim3(512), LDS_BYTES, stream, a);
#endif
}
```

```cpp
#include <hip/hip_runtime.h>
#include <cstdio>
#include <cstdint>

#define LAS __attribute__((address_space(3)))
#define GAS __attribute__((address_space(1)))
typedef float f32x16 __attribute__((ext_vector_type(16)));
typedef unsigned u32x2 __attribute__((ext_vector_type(2)));
typedef unsigned long long u64;

#define RES_BF16 1
constexpr int NTOK = 32768, NB = 16, SEQ = 2048, DM = 1024, NS = 32, PAST = 16384, PAGE = 128, NPAGES = 128;
constexpr int INW = 3400, INP = 3584, FF = 4096;
constexpr float EPS = 1e-6f;
constexpr float ATT_SCALE = 0.125f, LOG2E = 1.4426950408889634f;
constexpr float IDX_W_SCALE = 0.04419417382415922f;
constexpr float REC_QSCALE = 0.08838834764831845f;
enum { I_XP = 0, I_XS, I_CK, I_CV, I_CKI, I_ST, I_PT, I_N1G, I_WIN, I_QG, I_KG, I_IKG, I_LB, I_RG, I_WOUT, I_N2G, I_WUP, I_WDN };
constexpr size_t O_Y = 0, O_YS = 33554432, O_NK = O_YS + 32768, O_NV = O_NK + 4194304, O_NKI = O_NV + 4194304, O_NSP = O_NKI + 2097152,
                 O_NKS = O_NSP + 1048576, O_NVS = O_NKS + 4096, O_NKIS = O_NVS + 4096, O_NSS = O_NKIS + 2048, O_END = O_NSS + 2097152;
constexpr size_t MiB = 1u << 20;
constexpr size_t WS_SSQ = 131072;
constexpr size_t WS_CTL = 0, CTL_ZERO_BYTES = 262144;
constexpr size_t WS_W1T = 2 * MiB, WS_WOT = 10 * MiB, WS_WUT = 12 * MiB, WS_WDT = 20 * MiB;
constexpr size_t WS_GAINS = 28 * MiB + 512 * 1024;
constexpr size_t WS_RSTD1 = 28 * MiB, WS_IWF = 29 * MiB, WS_SSQ2 = 30 * MiB, WS_SAMP = 32 * MiB;
constexpr size_t WS_XB = 40 * MiB, WS_QB = 104 * MiB, WS_KB = 136 * MiB, WS_VT = 144 * MiB, WS_IQB = 152 * MiB, WS_IKB = 184 * MiB;
constexpr size_t WS_RQ = 188 * MiB, WS_RF = 220 * MiB, WS_RI = 252 * MiB, WS_RGT = 284 * MiB, WS_MASK = 316 * MiB, WS_MIX = 324 * MiB;
constexpr size_t WS_X1B = 388 * MiB, WS_H = 452 * MiB, WS_HST = 708 * MiB, WS_END = 712 * MiB;
constexpr int S_RAW = 0, S_SP = 131072, S_SC = 262144, S_SCROW = 16400, S_MIX = S_SC + 32 * S_SCROW + 256, S_X1 = S_MIX + 32768, S_H = S_X1 + 32768, S_ENDF = S_H + 131072;
static_assert((size_t)S_ENDF * 4 <= 8 * MiB, "sample scratch");
constexpr int CW_BAR = 4096, CW_Q2 = 8192, CW_Q3 = 8192 + 1024;
constexpr int LDS_BYTES = 163840, LDSCTL_OFF = LDS_BYTES - 1024, MISC_OFF = LDSCTL_OFF + 320;

namespace pg8 {
#define PG8_LAS __attribute__((address_space(3)))
typedef unsigned short bf16_t;
typedef short bf16x8 __attribute__((ext_vector_type(8)));
typedef float f32x4 __attribute__((ext_vector_type(4)));
typedef unsigned u32x4 __attribute__((ext_vector_type(4)));
constexpr int BM = 256, BK = 64, HALF = 128, HTB = HALF * BK * 2  , STAGE_BYTES = 8 * HTB, NXCD = 8, WGM = 8;

__host__ __device__ __forceinline__ int lds_byte(int r, int c) { const int st = (r >> 4) * 2 + (c >> 5), rr = r & 15, cc = c & 31, ob = rr * 64 + cc * 2; return st * 1024 + (ob ^ (((ob >> 9) & 1) << 5)); }
__host__ __device__ __forceinline__ void stage_rc(int b, int& R, int& C) { const int st = b / 1024, sb = b % 1024, swz = sb ^ (((sb >> 9) & 1) << 5); R = (st >> 1) * 16 + swz / 64; C = (st & 1) * 32 + (swz % 64) / 2; }
__host__ __device__ __forceinline__ int perm32(int rho) { const int n = rho >> 4, i = rho & 15; return 8 * (i >> 2) + 4 * n + (i & 3); }

struct Unit { int pm, pn; };
struct Gemm { const bf16_t* A; const bf16_t* Bt; int M, N, K; };

struct StaticOrder {
    int nM, nN, nwg, G, c;
    __host__ __device__ void init(int M, int N, int G_, int c_) { nM = M / BM; nN = N / BM; nwg = nM * nN; G = G_; c = c_; }
    __host__ __device__ bool next(int i, Unit& u) const {
        const long L = (long)i * G + c; if (L >= nwg) return false;
        int wgid = (int)L; { const int q = nwg / NXCD, r = nwg % NXCD, xcd = wgid % NXCD, off = wgid / NXCD; wgid = (xcd < r ? xcd * (q + 1) : r * (q + 1) + (xcd - r) * q) + off; }
        const int nig = WGM * nN, gid = wgid / nig, fm = gid * WGM, gsz = (nM - fm) < WGM ? (nM - fm) : WGM;
        u.pm = fm + ((wgid % nig) % gsz); u.pn = (wgid % nig) / gsz; return true;
    }
    __device__ __forceinline__ void a_ready(const Unit&) const {}
    __device__ __forceinline__ void done(const Unit&) const {}
};

__device__ __forceinline__ unsigned cvt_pk_bf16(float lo, float hi) { unsigned r; asm volatile("v_cvt_pk_bf16_f32 %0, %1, %2" : "=v"(r) : "v"(lo), "v"(hi)); return r; }
typedef float f32x2 __attribute__((ext_vector_type(2)));
__device__ __forceinline__ float silu_f(float x) { return x / (1.f + __expf(-x)); }
__device__ __forceinline__ void st_bf16x16(bf16_t* p, const float (&t)[16]) {
    u32x4 a, b;
    a.x = cvt_pk_bf16(t[0], t[1]); a.y = cvt_pk_bf16(t[2], t[3]); a.z = cvt_pk_bf16(t[4], t[5]); a.w = cvt_pk_bf16(t[6], t[7]);
    b.x = cvt_pk_bf16(t[8], t[9]); b.y = cvt_pk_bf16(t[10], t[11]); b.z = cvt_pk_bf16(t[12], t[13]); b.w = cvt_pk_bf16(t[14], t[15]);
    *(u32x4*)p = a; *(u32x4*)(p + 8) = b;
}
__device__ __forceinline__ void st_f32x16(float* p, const float (&t)[16]) {
#pragma unroll
    for (int i = 0; i < 4; ++i) *(f32x4*)(p + 4 * i) = (f32x4){t[4 * i], t[4 * i + 1], t[4 * i + 2], t[4 * i + 3]};
}
__device__ __forceinline__ unsigned short f2bf_rne(float f) { unsigned u = __builtin_bit_cast(unsigned, f); return (unsigned short)((u + 0x7fffu + ((u >> 16) & 1u)) >> 16); }

struct EpiInProj {
    static constexpr bool PERM = false, AFTER_DRAIN = false;
    const float* rstd1; const float* gains;
    bf16_t *Qb, *Kb, *Vt, *IQb, *IKb, *Rq, *Rf, *Ri, *Rg; float* IWf; float *oK, *oV, *oKI;
    __device__ __forceinline__ void operator()(const f32x4 (&acc)[2][2][4][2], const Unit& u, int wr, int wc, int fr, int fq) const {
        const int pn = u.pn;
        const float* gsrc = gains + (pn < 2 ? 0 : (pn == 2 ? 64 : 128)) + 16 * fq;
        float rsv[2][4];
#pragma unroll
        for (int ai = 0; ai < 2; ++ai)
#pragma unroll
            for (int m = 0; m < 4; ++m) rsv[ai][m] = rstd1[u.pm * BM + ai * HALF + wr * 64 + m * 16 + fr];
#pragma unroll
        for (int ai = 0; ai < 2; ++ai)
#pragma unroll
            for (int m = 0; m < 4; ++m) {
                const int row = u.pm * BM + ai * HALF + wr * 64 + m * 16 + fr;
                const float rs = rsv[ai][m];
                float t[16];
#pragma unroll
                for (int bj = 0; bj < 2; ++bj)
#pragma unroll
                    for (int n = 0; n < 2; ++n)
#pragma unroll
                        for (int e = 0; e < 4; ++e) t[8 * bj + 4 * n + e] = acc[ai][bj][m][n][e] * rs;
                const bool normed = (pn < 2) || (pn == 2 && wc < 2) || (pn == 5 && wc == 0);
                if (normed) {
                    float ss = 0.f;
#pragma unroll
                    for (int j = 0; j < 16; ++j) ss += t[j] * t[j];
                    ss += __shfl_xor(ss, 16); ss += __shfl_xor(ss, 32);
                    float sc = rsqrtf(ss * (1.0f / 64.0f) + EPS);
                    if (pn < 2) sc *= ATT_SCALE * LOG2E;
#pragma unroll
                    for (int i = 0; i < 4; ++i) { const f32x4 gv = *(const f32x4*)(gsrc + 4 * i);
                        t[4 * i] *= sc * gv[0]; t[4 * i + 1] *= sc * gv[1]; t[4 * i + 2] *= sc * gv[2]; t[4 * i + 3] *= sc * gv[3]; }
                }
                if (pn < 2) {
                    st_bf16x16(Qb + (size_t)row * 512 + (4 * pn + wc) * 64 + 16 * fq, t);
                } else if (pn == 2) {
                    if (wc < 2) { st_f32x16(oK + (size_t)row * 128 + wc * 64 + 16 * fq, t); st_bf16x16(Kb + (size_t)row * 128 + wc * 64 + 16 * fq, t); }
                    else {
                        st_f32x16(oV + (size_t)row * 128 + (wc - 2) * 64 + 16 * fq, t);
                        const int b = row >> 11, tt = row & 2047;
                        bf16_t* vp = Vt + ((size_t)(b * 2 + (wc - 2)) * 64 + 16 * fq) * 2048 + tt;
#pragma unroll
                        for (int j = 0; j < 16; ++j) vp[(size_t)j * 2048] = f2bf_rne(t[j]);
                    }
                } else if (pn < 5) {
                    st_bf16x16(IQb + (size_t)row * 512 + (4 * (pn - 3) + wc) * 64 + 16 * fq, t);
                } else if (pn == 5) {
                    if (wc == 0) { st_f32x16(oKI + (size_t)row * 64 + 16 * fq, t); st_bf16x16(IKb + (size_t)row * 64 + 16 * fq, t); }
                    else if (wc == 1 && fq == 0) {
                        *(f32x4*)(IWf + (size_t)row * 8) = (f32x4){t[0] * IDX_W_SCALE, t[1] * IDX_W_SCALE, t[2] * IDX_W_SCALE, t[3] * IDX_W_SCALE};
                        *(f32x4*)(IWf + (size_t)row * 8 + 4) = (f32x4){t[4] * IDX_W_SCALE, t[5] * IDX_W_SCALE, t[6] * IDX_W_SCALE, t[7] * IDX_W_SCALE};
                    }
                } else {
                    const int kind = (pn - 6) >> 1, col = 256 * ((pn - 6) & 1) + 64 * wc + 16 * fq;
                    if (kind == 0) {
#pragma unroll
                        for (int j = 0; j < 16; ++j) t[j] = silu_f(t[j]) * REC_QSCALE;
                        st_bf16x16(Rq + (size_t)row * 512 + col, t);
                    } else if (kind == 1) st_bf16x16(Rf + (size_t)row * 512 + col, t);
                    else if (kind == 2) st_bf16x16(Ri + (size_t)row * 512 + col, t);
                    else {
#pragma unroll
                        for (int j = 0; j < 16; ++j) t[j] = silu_f(t[j]);
                        st_bf16x16(Rg + (size_t)row * 512 + col, t);
                    }
                }
            }
    }
};
struct EpiOutProj {
    static constexpr bool PERM = false, AFTER_DRAIN = false;
    const float* X; float* Y; bf16_t* X1B; float* SSQ2;
    __device__ __forceinline__ void operator()(const f32x4 (&acc)[2][2][4][2], const Unit& u, int wr, int wc, int fr, int fq) const {
        const int col0 = u.pn * BM + wc * 32 + 4 * fq;
#pragma unroll
        for (int ai = 0; ai < 2; ++ai)
#pragma unroll
            for (int m = 0; m < 4; ++m) {
                const int row = u.pm * BM + ai * HALF + wr * 64 + m * 16 + fr; const size_t off = (size_t)row * DM + col0; float ss = 0.f;
#pragma unroll
                for (int bj = 0; bj < 2; ++bj)
#pragma unroll
                    for (int n = 0; n < 2; ++n) {
                        const f32x4 xv = *(const f32x4*)(X + off + bj * HALF + n * 16); const f32x4 o = xv + acc[ai][bj][m][n];
#if !RES_BF16
                        *(f32x4*)(Y + off + bj * HALF + n * 16) = o;
#endif
                        ss += (o[0] * o[0] + o[1] * o[1]) + (o[2] * o[2] + o[3] * o[3]);
                        u32x2 w; w.x = cvt_pk_bf16(o[0], o[1]); w.y = cvt_pk_bf16(o[2], o[3]); *(u32x2*)(X1B + off + bj * HALF + n * 16) = w;
                    }
                ss += __shfl_xor(ss, 16); ss += __shfl_xor(ss, 32);
                if (fq == 0) atomicAdd(SSQ2 + row, ss);
            }
    }
};
struct EpiUp {
    static constexpr bool PERM = true, AFTER_DRAIN = false;
    bf16_t* H;
    __device__ __forceinline__ void operator()(const f32x4 (&acc)[2][2][4][2], const Unit& u, int wr, int wc, int fr, int fq) const {
        const int col0 = u.pn * BM + wc * 32 + 8 * fq;
#pragma unroll
        for (int ai = 0; ai < 2; ++ai)
#pragma unroll
            for (int m = 0; m < 4; ++m) {
                const int row = u.pm * BM + ai * HALF + wr * 64 + m * 16 + fr;
                bf16_t* rowp = H + (size_t)row * FF + col0;
#pragma unroll
                for (int bj = 0; bj < 2; ++bj) {
                    f32x4 v0 = acc[ai][bj][m][0], v1 = acc[ai][bj][m][1];
#pragma unroll
                    for (int e = 0; e < 4; ++e) { const float a = fmaxf(v0[e], 0.f), b = fmaxf(v1[e], 0.f); v0[e] = a * a; v1[e] = b * b; }
                    u32x4 w; w.x = cvt_pk_bf16(v0[0], v0[1]); w.y = cvt_pk_bf16(v0[2], v0[3]); w.z = cvt_pk_bf16(v1[0], v1[1]); w.w = cvt_pk_bf16(v1[2], v1[3]);
                    *(u32x4*)(rowp + bj * HALF) = w;
                }
            }
    }
};
struct EpiDown {
    static constexpr bool PERM = false, AFTER_DRAIN = false;
    float* Y; const bf16_t* X1B; const float* SSQ;
    __device__ __forceinline__ void operator()(const f32x4 (&acc)[2][2][4][2], const Unit& u, int wr, int wc, int fr, int fq) const {
        const int col0 = u.pn * BM + wc * 32 + 4 * fq;
        float rsv[2][4];
#pragma unroll
        for (int ai = 0; ai < 2; ++ai)
#pragma unroll
            for (int m = 0; m < 4; ++m) rsv[ai][m] = SSQ[u.pm * BM + ai * HALF + wr * 64 + m * 16 + fr];
#pragma unroll
        for (int ai = 0; ai < 2; ++ai)
#pragma unroll
            for (int m = 0; m < 4; ++m) {
                const float rs2 = 1.0f / (rsv[ai][m] * (1.0f / 1024.0f) + EPS);
                const size_t off = (size_t)(u.pm * BM + ai * HALF + wr * 64 + m * 16 + fr) * DM + col0;
#pragma unroll
                for (int bj = 0; bj < 2; ++bj)
#pragma unroll
                    for (int n = 0; n < 2; ++n) { float* p = Y + off + bj * HALF + n * 16;
#if RES_BF16
                        const u32x2 xw = *(const u32x2*)(X1B + off + bj * HALF + n * 16);
                        const f32x4 x1 = {__builtin_bit_cast(float, xw.x << 16), __builtin_bit_cast(float, xw.x & 0xffff0000u), __builtin_bit_cast(float, xw.y << 16), __builtin_bit_cast(float, xw.y & 0xffff0000u)};
                        *(f32x4*)p = x1 + acc[ai][bj][m][n] * rs2;
#else
                        *(f32x4*)p = *(const f32x4*)p + acc[ai][bj][m][n] * rs2;
#endif
                    }
            }
    }
};
template <class Epi, class Sched, bool ALIGN_EPI = false, bool SP2 = false>
__device__ __forceinline__ void gemm_phase(PG8_LAS unsigned char* lds, const Gemm g, const Sched& S, const Epi& E) {
    const int tid = threadIdx.x, wid = __builtin_amdgcn_readfirstlane(tid >> 6), lane = tid & 63, wr = wid >> 2, wc = wid & 3, fr = lane & 15, fq = lane >> 4;
    const int K = g.K, nt = K / BK;
    unsigned voffA[2], voffB[2];
#pragma unroll
    for (int i = 0; i < 2; ++i) { int R, C; stage_rc(tid * 16 + i * 8192, R, C); const int Rb = Epi::PERM ? ((R & ~31) + perm32(R & 31)) : R;
        voffA[i] = (unsigned)(R * K + C) * 2u; voffB[i] = (unsigned)(Rb * K + C) * 2u; }
    const size_t kstep = (size_t)(BK * 2);
    const size_t hstep = (size_t)HALF * K * 2;
    const size_t tstep = 2 * hstep;
    const unsigned ldsw = (unsigned)wid * 1024u;
    const int aoff = lds_byte(wr * 64 + fr, fq * 8), boff = lds_byte(wc * 32 + fr, fq * 8);
#define PG8_SA(b, h) (((b) * 2 + (h)) * HTB)
#define PG8_SB(b, h) ((4 + (b) * 2 + (h)) * HTB)
#define PG8_STAGE(bufoff, gbase, voff) do { _Pragma("unroll") for (int _i = 0; _i < 2; ++_i) \
        __builtin_amdgcn_global_load_lds((const unsigned*)((const char*)(gbase) + (voff)[_i]), (PG8_LAS unsigned*)(lds + (bufoff) + ldsw + _i * 8192), 16, 0, 0); } while (0)
#define PG8_LDA(dst, b, h) do { _Pragma("unroll") for (int m = 0; m < 4; ++m) _Pragma("unroll") for (int k = 0; k < 2; ++k) dst[m][k] = *(const PG8_LAS bf16x8*)(lds + PG8_SA(b, h) + aoff + m * 2048 + k * 1024); } while (0)
#define PG8_LDB(dst, b, h) do { _Pragma("unroll") for (int n = 0; n < 2; ++n) _Pragma("unroll") for (int k = 0; k < 2; ++k) dst[n][k] = *(const PG8_LAS bf16x8*)(lds + PG8_SB(b, h) + boff + n * 2048 + k * 1024); } while (0)
#define PG8_MMA(ai, bj, At, Bt) do { __builtin_amdgcn_s_setprio(1); _Pragma("unroll") for (int m = 0; m < 4; ++m) _Pragma("unroll") for (int n = 0; n < 2; ++n) _Pragma("unroll") for (int k = 0; k < 2; ++k) \
        acc[ai][bj][m][n] = __builtin_amdgcn_mfma_f32_16x16x32_bf16(Bt[n][k], At[m][k], acc[ai][bj][m][n], 0, 0, 0); __builtin_amdgcn_s_setprio(0); } while (0)
#define PG8_WAIT_V(n) asm volatile("s_waitcnt vmcnt(" #n ")" ::: "memory")
#define PG8_WAIT_L(n) asm volatile("s_waitcnt lgkmcnt(" #n ")" ::: "memory")
#define PG8_BAR __builtin_amdgcn_s_barrier()
#define PG8_SCHED __builtin_amdgcn_sched_barrier(0)
    Unit cur, nxt; int ui = 0;
    if (!S.next(0, cur)) return;
    f32x4 acc[2][2][4][2];
#pragma unroll
    for (int a = 0; a < 2; ++a)
#pragma unroll
        for (int b = 0; b < 2; ++b)
#pragma unroll
            for (int m = 0; m < 4; ++m)
#pragma unroll
                for (int n = 0; n < 2; ++n) acc[a][b][m][n] = (f32x4){0.f, 0.f, 0.f, 0.f};
    bf16x8 At[4][2], B0[2][2], B1[2][2];
    const char* cA = (const char*)g.A + (size_t)cur.pm * tstep; const char* cB = (const char*)g.Bt + (size_t)cur.pn * tstep;
    S.a_ready(cur);
    if constexpr (SP2) {
        PG8_STAGE(PG8_SB(0, 0), cB, voffB); PG8_STAGE(PG8_SB(0, 1), cB + hstep, voffB); PG8_STAGE(PG8_SA(0, 0), cA, voffA); PG8_STAGE(PG8_SA(0, 1), cA + hstep, voffA);
        if (wr == 1) PG8_BAR;
        PG8_WAIT_V(2); PG8_BAR;
        PG8_STAGE(PG8_SB(1, 0), cB + kstep, voffB); PG8_STAGE(PG8_SA(1, 0), cA + kstep, voffA); PG8_STAGE(PG8_SB(1, 1), cB + hstep + kstep, voffB);
        PG8_WAIT_V(6); PG8_BAR;
    } else {
        PG8_STAGE(PG8_SB(0, 0), cB, voffB); PG8_STAGE(PG8_SA(0, 0), cA, voffA); PG8_STAGE(PG8_SB(0, 1), cB + hstep, voffB); PG8_STAGE(PG8_SA(0, 1), cA + hstep, voffA);
        if (wr == 1) PG8_BAR;
        PG8_WAIT_V(4); PG8_BAR;
        PG8_STAGE(PG8_SB(1, 0), cB + kstep, voffB); PG8_STAGE(PG8_SA(1, 0), cA + kstep, voffA); PG8_STAGE(PG8_SB(1, 1), cB + hstep + kstep, voffB);
        PG8_WAIT_V(6); PG8_BAR;
    }
    for (;;) {
        const bool has_next = S.next(ui + 1, nxt);
        const char* nA = has_next ? (const char*)g.A + (size_t)nxt.pm * tstep : cA; const char* nB = has_next ? (const char*)g.Bt + (size_t)nxt.pn * tstep : cB;
        for (int t = 0; t < nt; t += 2) {
            const bool last = (t == nt - 2);
            const char* a1 = cA + (size_t)(t + 1) * kstep;
            const char* a2 = last ? nA : cA + (size_t)(t + 2) * kstep; const char* b2 = last ? nB : cB + (size_t)(t + 2) * kstep;
            const char* a3 = a2 + kstep; const char* b3 = b2 + kstep;
            if (last && has_next) S.a_ready(nxt);
            if constexpr (SP2) {
            PG8_LDB(B0, 0, 0); PG8_LDB(B1, 0, 1); PG8_SCHED; PG8_LDA(At, 0, 0); PG8_STAGE(PG8_SA(1, 1), a1 + hstep, voffA);
            PG8_WAIT_V(8); PG8_WAIT_L(0); PG8_BAR; PG8_MMA(0, 0, At, B0); PG8_MMA(0, 1, At, B1); PG8_BAR; PG8_SCHED;
            PG8_LDA(At, 0, 1); PG8_STAGE(PG8_SB(0, 0), b2, voffB); PG8_STAGE(PG8_SB(0, 1), b2 + hstep, voffB); PG8_STAGE(PG8_SA(0, 0), a2, voffA);
            PG8_WAIT_V(8); PG8_WAIT_L(0); PG8_BAR; PG8_MMA(1, 0, At, B0); PG8_MMA(1, 1, At, B1); PG8_BAR; PG8_SCHED;
            PG8_LDB(B0, 1, 0); PG8_LDB(B1, 1, 1); PG8_SCHED; PG8_LDA(At, 1, 0); PG8_STAGE(PG8_SA(0, 1), a2 + hstep, voffA);
            PG8_WAIT_V(8); PG8_WAIT_L(0); PG8_BAR; PG8_MMA(0, 0, At, B0); PG8_MMA(0, 1, At, B1); PG8_BAR; PG8_SCHED;
            PG8_LDA(At, 1, 1); PG8_STAGE(PG8_SB(1, 0), b3, voffB); PG8_STAGE(PG8_SB(1, 1), b3 + hstep, voffB); PG8_STAGE(PG8_SA(1, 0), a3, voffA);
            PG8_WAIT_V(8); PG8_WAIT_L(0); PG8_BAR; PG8_MMA(1, 0, At, B0); PG8_MMA(1, 1, At, B1); PG8_BAR; PG8_SCHED;
            } else {
            PG8_LDB(B0, 0, 0); PG8_SCHED; PG8_LDA(At, 0, 0); PG8_STAGE(PG8_SA(1, 1), a1 + hstep, voffA);
            PG8_WAIT_L(8); PG8_BAR; PG8_WAIT_L(0); PG8_MMA(0, 0, At, B0); PG8_BAR; PG8_SCHED;
            PG8_LDB(B1, 0, 1); PG8_STAGE(PG8_SB(0, 0), b2, voffB);
            PG8_BAR; PG8_WAIT_L(0); PG8_MMA(0, 1, At, B1); PG8_BAR;
            PG8_LDA(At, 0, 1); PG8_STAGE(PG8_SA(0, 0), a2, voffA);
            PG8_BAR; PG8_WAIT_L(0); PG8_MMA(1, 0, At, B0); PG8_BAR; PG8_SCHED;
            PG8_STAGE(PG8_SB(0, 1), b2 + hstep, voffB);
            PG8_WAIT_V(6); PG8_BAR; PG8_MMA(1, 1, At, B1); PG8_BAR;
            PG8_LDB(B0, 1, 0); PG8_SCHED; PG8_LDA(At, 1, 0); PG8_STAGE(PG8_SA(0, 1), a2 + hstep, voffA);
            PG8_WAIT_L(8); PG8_BAR; PG8_WAIT_L(0); PG8_MMA(0, 0, At, B0); PG8_BAR; PG8_SCHED;
            PG8_LDB(B1, 1, 1); PG8_STAGE(PG8_SB(1, 0), b3, voffB);
            PG8_BAR; PG8_WAIT_L(0); PG8_MMA(0, 1, At, B1); PG8_BAR;
            PG8_LDA(At, 1, 1); PG8_STAGE(PG8_SA(1, 0), a3, voffA);
            PG8_BAR; PG8_WAIT_L(0); PG8_MMA(1, 0, At, B0); PG8_BAR; PG8_SCHED;
            PG8_STAGE(PG8_SB(1, 1), b3 + hstep, voffB);
            PG8_WAIT_V(6); PG8_BAR; PG8_MMA(1, 1, At, B1); PG8_BAR;
            }
        }
        if constexpr (ALIGN_EPI) { if (wr == 0) PG8_BAR; }
        if constexpr (!Epi::AFTER_DRAIN) { E(acc, cur, wr, wc, fr, fq); S.done(cur); }
        if (!has_next) break;
#pragma unroll
        for (int a = 0; a < 2; ++a)
#pragma unroll
            for (int b = 0; b < 2; ++b)
#pragma unroll
                for (int m = 0; m < 4; ++m)
#pragma unroll
                    for (int n = 0; n < 2; ++n) acc[a][b][m][n] = (f32x4){0.f, 0.f, 0.f, 0.f};
        cur = nxt; cA = nA; cB = nB; ++ui;
        if constexpr (ALIGN_EPI) { if (wr == 1) PG8_BAR; }
    }
    PG8_WAIT_V(0);
    if constexpr (!ALIGN_EPI) { if (wr == 0) PG8_BAR; }
    PG8_BAR;
    if constexpr (Epi::AFTER_DRAIN) { E.fused(acc, cur, wr, wc, fr, fq, lds, wid, lane); S.done(cur); }
#undef PG8_SA
#undef PG8_SB
#undef PG8_STAGE
#undef PG8_LDA
#undef PG8_LDB
#undef PG8_MMA
#undef PG8_WAIT_V
#undef PG8_WAIT_L
#undef PG8_BAR
#undef PG8_SCHED
}
}
#define XB_TMO      128
#define XB_XCNT(j)  (256  + 64 * (j))
#define XB_XSUB(j)  (1280 + 64 * (j))
#define XB_XGEN(j)  (2304 + 64 * (j))
#define XB_TOP      3328
#define XB_TOPGEN   3392
#define XCD_BAR_WORDS 3456
#define XB_SPIN_CAP (1u << 18)

__device__ __forceinline__ unsigned xb_ld(unsigned* p)              { return __hip_atomic_load(p, __ATOMIC_RELAXED, __HIP_MEMORY_SCOPE_AGENT); }
__device__ __forceinline__ unsigned xb_add(unsigned* p, unsigned v) { return __hip_atomic_fetch_add(p, v, __ATOMIC_RELAXED, __HIP_MEMORY_SCOPE_AGENT); }
__device__ __forceinline__ unsigned xb_xcc_id() { return (unsigned)__builtin_amdgcn_s_getreg((3 << 11) | 20) & 0xFu; }
#define XB_SPIN(cond, bar) do { unsigned _sp = 0; while (cond) { __builtin_amdgcn_s_sleep(1); \
    if ((++_sp & 255u) == 0u) { if (xb_ld(&(bar)[XB_TMO])) break; if (_sp > XB_SPIN_CAP) { atomicAdd(&(bar)[XB_TMO], 1u); break; } } } } while (0)

struct XcdBarrier {
    unsigned* bar; unsigned x;
    volatile LAS unsigned* st;
};

__device__ __forceinline__ XcdBarrier xcd_barrier_post(unsigned* bar, volatile LAS unsigned* st) {
    XcdBarrier b; b.bar = bar; b.x = xb_xcc_id(); b.st = st;
    if (threadIdx.x == 0) (void)xb_add(&bar[XB_XCNT(b.x)], 1u);
    return b;
}
__device__ __forceinline__ void xcd_barrier_complete(unsigned* bar, unsigned x, unsigned& nloc, unsigned& nx) {
    const unsigned G = gridDim.x * gridDim.y * gridDim.z;
    unsigned sum, cnt, mine, sp = 0u;
    for (;;) {
        sum = 0u; cnt = 0u; mine = 0u;
#pragma unroll
        for (unsigned j = 0; j < 16; ++j) { const unsigned c = xb_ld(&bar[XB_XCNT(j)]); sum += c; cnt += (c > 0u) ? 1u : 0u; mine = (j == x) ? c : mine; }
        if (sum == G) break;
        __builtin_amdgcn_s_sleep(1);
        if ((++sp & 255u) == 0u) { if (xb_ld(&bar[XB_TMO])) break; if (sp > XB_SPIN_CAP) { atomicAdd(&bar[XB_TMO], 1u); break; } }
    }
    nloc = mine > 0u ? mine : 1u; nx = cnt > 0u ? cnt : 1u;
}

__device__ __forceinline__ void xcd_barrier(const XcdBarrier& b) {
    asm volatile("s_waitcnt vmcnt(0)" ::: "memory");
    __syncthreads();
    if (threadIdx.x == 0) {
        unsigned* bar = b.bar;
        __builtin_amdgcn_s_waitcnt(0);
        unsigned nloc = b.st[0], nx = b.st[1];
        if (nloc == 0u) { xcd_barrier_complete(bar, b.x, nloc, nx); b.st[0] = nloc; b.st[1] = nx; }
        const unsigned old = xb_add(&bar[XB_XSUB(b.x)], 1u);
        const unsigned gen = old / nloc;
        if (old + 1u == (gen + 1u) * nloc) {
            __builtin_amdgcn_fence(__ATOMIC_RELEASE, "agent");
            asm volatile("s_waitcnt vmcnt(0)" ::: "memory");
            const unsigned og = xb_add(&bar[XB_TOP], 1u);
            const unsigned tg = og / nx;
            if (og + 1u == (tg + 1u) * nx) xb_add(&bar[XB_TOPGEN], 1u);
            else XB_SPIN(xb_ld(&bar[XB_TOPGEN]) == tg, bar);
            __builtin_amdgcn_fence(__ATOMIC_ACQUIRE, "agent");
            xb_add(&bar[XB_XGEN(b.x)], 1u);
            asm volatile("s_waitcnt vmcnt(0)" ::: "memory");
        } else {
            XB_SPIN(xb_ld(&bar[XB_XGEN(b.x)]) == gen, bar);
            __builtin_amdgcn_fence(__ATOMIC_ACQUIRE, "agent");
            asm volatile("s_waitcnt vmcnt(0)" ::: "memory");
        }
    }
    __syncthreads();
}
typedef unsigned short bf16;
typedef unsigned v4u __attribute__((ext_vector_type(4)));
typedef float f32x4 __attribute__((ext_vector_type(4)));
typedef short bf16x8 __attribute__((ext_vector_type(8)));
typedef GAS unsigned gu32;
#define LDS_WAIT() asm volatile("s_waitcnt lgkmcnt(0)" ::: "memory")
__device__ __forceinline__ unsigned f2bf(float f) { unsigned u = __builtin_bit_cast(unsigned, f); return (u + 0x7fffu + ((u >> 16) & 1u)) >> 16; }
__device__ __forceinline__ unsigned pk2(float lo, float hi) { return f2bf(lo) | (f2bf(hi) << 16); }
__device__ __forceinline__ unsigned cvtpk(float lo, float hi) { typedef float f2_ __attribute__((ext_vector_type(2))); typedef __bf16 b2_ __attribute__((ext_vector_type(2))); f2_ v = {lo, hi}; b2_ b = __builtin_convertvector(v, b2_); return __builtin_bit_cast(unsigned, b); }
__device__ __forceinline__ float bf2f(unsigned short h) { return __builtin_bit_cast(float, (unsigned)h << 16); }
__device__ __forceinline__ float bflo(unsigned w) { return __builtin_bit_cast(float, w << 16); }
__device__ __forceinline__ float bfhi(unsigned w) { return __builtin_bit_cast(float, w & 0xffff0000u); }
__device__ __forceinline__ float wave_sum(float v) {
#pragma unroll
    for (int o = 1; o < 64; o <<= 1) v += __shfl_xor(v, o);
    return v;
}
__device__ __forceinline__ float silu_f(float x) { return x / (1.f + __expf(-x)); }
__device__ __forceinline__ int crow(int r, int hi) { return (r & 3) + 8 * (r >> 2) + 4 * hi; }

struct Ctx {
    LAS unsigned char* lds; volatile LAS unsigned* MISC; gu32* ctl;
    int tid, wave, vcu, G;
    const float* in[18]; float* out; unsigned char* ws;
};
__device__ __forceinline__ int q_next(Ctx& C, int cw, unsigned n = 1u) {
    __syncthreads();
    if (C.tid == 0) C.MISC[16] = __hip_atomic_fetch_add((unsigned*)(C.ctl + cw), n, __ATOMIC_RELAXED, __HIP_MEMORY_SCOPE_AGENT);
    __syncthreads();
    return (int)C.MISC[16];
}

__device__ __forceinline__ int inproj_src(int p) {
    const int pn = p >> 8, q = p & 255;
    const int bj = q >> 7, wc = (q >> 5) & 3, n = (q >> 4) & 1, fq = (q >> 2) & 3, e = q & 3;
    const int lc = 64 * wc + 16 * fq + 8 * bj + 4 * n + e;
    if (pn < 5) return 256 * pn + lc;
    if (pn == 5) return lc < 72 ? 1280 + lc : -1;
    return 1352 + 256 * (pn - 6) + lc;
}
template <bool MAP>
__device__ __forceinline__ void p0_transpose_item(const float* W, int K, int N, int NP, const float* gain, bf16* WT, LAS float* scr, int item, int lane) {
    const int nblk = NP / 32, kb = item / nblk, nb = item % nblk, k0 = 64 * kb, n0 = 32 * nb;
    const int p = n0 + (lane & 31); const int sc = MAP ? inproj_src(p) : p;
#pragma unroll 8
    for (int i = 0; i < 32; ++i) { const int kk = 2 * i + (lane >> 5); float v = 0.f; if (sc >= 0) v = W[(size_t)(k0 + kk) * N + sc]; if (gain) v *= gain[k0 + kk]; scr[kk * 33 + (lane & 31)] = v; }
    LDS_WAIT(); asm volatile("" ::: "memory");
    const int c = lane & 7;
#pragma unroll
    for (int j = 0; j < 4; ++j) { const int n = (lane >> 3) + 8 * j; const LAS float* s = scr + (8 * c) * 33 + n;
        v4u o; o.x = cvtpk(s[0 * 33], s[1 * 33]); o.y = cvtpk(s[2 * 33], s[3 * 33]); o.z = cvtpk(s[4 * 33], s[5 * 33]); o.w = cvtpk(s[6 * 33], s[7 * 33]);
        *(GAS v4u*)(WT + (size_t)(n0 + n) * K + k0 + 8 * c) = o; }
    LDS_WAIT(); asm volatile("" ::: "memory");
}
template <int R>
__device__ __forceinline__ void x_rows_to_bf16(const float* x0, size_t rstride, bf16* o0, float* rstd0, int lane, int nrows) {
    f32x4 v[R][4];
#pragma unroll
    for (int r = 0; r < R; ++r) { const GAS f32x4* xr = (const GAS f32x4*)(x0 + (r < nrows ? r : 0) * rstride * DM) + lane;
#pragma unroll
        for (int j = 0; j < 4; ++j) v[r][j] = xr[64 * j]; }
#pragma unroll
    for (int r = 0; r < R; ++r) if (r < nrows) { float s = 0.f;
#pragma unroll
        for (int j = 0; j < 4; ++j) s += (v[r][j].x * v[r][j].x + v[r][j].y * v[r][j].y) + (v[r][j].z * v[r][j].z + v[r][j].w * v[r][j].w);
        s = wave_sum(s);
        if (lane == 0) rstd0[r * rstride] = rsqrtf(s * (1.0f / DM) + EPS);
        GAS u64* o8 = (GAS u64*)(o0 + r * rstride * DM) + lane;
#pragma unroll
        for (int j = 0; j < 4; ++j) o8[64 * j] = (u64)cvtpk(v[r][j].x, v[r][j].y) | ((u64)cvtpk(v[r][j].z, v[r][j].w) << 32); }
}

template <int K, bool GK, int KW = K / 8>
__device__ __forceinline__ void skinny32(const float* A, const float* gk, const float* W, int ldw, int N, int n0, LAS float* red, int tid, int lane, int wave, int kbase = 0) {
    asm volatile("" : "+v"(tid), "+v"(lane));
    const int i = lane & 31, kh = lane >> 5, n = n0 + i; const bool nok = n < N;
    f32x16 acc = {};
    const int kbeg = kbase + wave * KW, kend = kbeg + KW;
#pragma unroll 1
    for (int kb0 = kbeg; kb0 < kend; kb0 += 64) {
        f32x4 xa[8]; float bw[8][4];
#pragma unroll
        for (int s = 0; s < 8; ++s) { const int kb = kb0 + 8 * s;
            xa[s] = *(const f32x4*)(A + (size_t)i * K + kb + 4 * kh);
            if (GK) { const f32x4 ga = *(const f32x4*)(gk + kb + 4 * kh); xa[s] = xa[s] * ga; }
            const float* wp = W + (size_t)(kb + 4 * kh) * ldw + (nok ? n : 0);
            bw[s][0] = wp[0]; bw[s][1] = wp[ldw]; bw[s][2] = wp[2 * (size_t)ldw]; bw[s][3] = wp[3 * (size_t)ldw]; }
#pragma unroll
        for (int s = 0; s < 8; ++s)
#pragma unroll
            for (int j = 0; j < 4; ++j) acc = __builtin_amdgcn_mfma_f32_32x32x2f32(xa[s][j], nok ? bw[s][j] : 0.f, acc, 0, 0, 0);
    }
#pragma unroll
    for (int r = 0; r < 16; ++r) red[wave * 1024 + crow(r, kh) * 32 + i] = acc[r];
    __syncthreads();
#pragma unroll
    for (int x = 0; x < 2; ++x) { const int e = tid + 512 * x; float s = 0.f;
#pragma unroll
        for (int w = 0; w < 8; ++w) s += red[w * 1024 + e];
        red[8 * 1024 + e] = s; }
    __syncthreads();
}
__device__ __forceinline__ float sk_get(LAS float* red, int e) { return red[8 * 1024 + e]; }
template <int K>
__device__ __forceinline__ void rows_rstd32(const float* A, LAS float* rs, int lane, int wave) {
#pragma unroll
    for (int j = 0; j < 4; ++j) { const int r = wave * 4 + j; float s = 0.f;
        for (int k = lane * 4; k < K; k += 256) { const f32x4 v = *(const f32x4*)(A + (size_t)r * K + k); s += (v[0] * v[0] + v[1] * v[1]) + (v[2] * v[2] + v[3] * v[3]); }
        s = wave_sum(s); if (lane == 0) rs[r] = rsqrtf(s * (1.0f / K) + EPS); }
}

__device__ __forceinline__ void p0_prologue(Ctx& C) {
    LAS float* scr = (LAS float*)(C.lds + C.wave * 16384);
    float* samp = (float*)(C.ws + WS_SAMP);
    if (C.vcu < 107) {
        LAS float* red = (LAS float*)C.lds; LAS float* rs = red + 9 * 1024 + 64;
        rows_rstd32<DM>(C.in[I_XS], rs, (C.tid & 63), C.wave);
        skinny32<DM, true>(C.in[I_XS], C.in[I_N1G], C.in[I_WIN], INW, INW, 32 * C.vcu, red, C.tid, (C.tid & 63), C.wave);
        int tid_ = C.tid; asm volatile("" : "+v"(tid_));
#pragma unroll
        for (int x = 0; x < 2; ++x) { const int e = tid_ + 512 * x, i = e >> 5, n = 32 * C.vcu + (e & 31); if (n < INW) samp[S_RAW + i * INW + n] = sk_get(red, e) * rs[i]; }
        __syncthreads();
    }
    if (C.vcu == 200 && C.tid < 192) ((float*)(C.ws + WS_GAINS))[C.tid] = C.tid < 64 ? C.in[I_QG][C.tid] : (C.tid < 128 ? C.in[I_KG][C.tid - 64] : C.in[I_IKG][C.tid - 128]);
    const int gw = C.vcu * 8 + C.wave, NGW = C.G * 8;
    constexpr int I_1 = (DM / 64) * (INP / 32), I_O = (DM / 64) * (DM / 32), I_U = (DM / 64) * (FF / 32), I_D = (FF / 64) * (DM / 32);
    for (int it = gw; it < I_1 + I_O + I_U + I_D; it += NGW) {
        int r = it;
        if (r < I_1) { p0_transpose_item<true>(C.in[I_WIN], DM, INW, INP, C.in[I_N1G], (bf16*)(C.ws + WS_W1T), scr, r, (C.tid & 63)); continue; } r -= I_1;
        if (r < I_O) { p0_transpose_item<false>(C.in[I_WOUT], DM, DM, DM, nullptr, (bf16*)(C.ws + WS_WOT), scr, r, (C.tid & 63)); continue; } r -= I_O;
        if (r < I_U) { p0_transpose_item<false>(C.in[I_WUP], DM, FF, FF, C.in[I_N2G], (bf16*)(C.ws + WS_WUT), scr, r, (C.tid & 63)); continue; } r -= I_U;
        p0_transpose_item<false>(C.in[I_WDN], FF, DM, DM, nullptr, (bf16*)(C.ws + WS_WDT), scr, r, (C.tid & 63));
    }
    bf16* XB = (bf16*)(C.ws + WS_XB); float* RSTD1 = (float*)(C.ws + WS_RSTD1);
    for (int m = gw; m < NTOK; m += 4 * NGW) x_rows_to_bf16<4>(C.in[I_XP] + (size_t)m * DM, (size_t)NGW, XB + (size_t)m * DM, RSTD1 + m, (C.tid & 63), (NTOK - 1 - m) / NGW + 1);
}

__device__ __forceinline__ void sample_postproj(Ctx& C, int b) {
    const float* raw = (const float*)(C.ws + WS_SAMP) + S_RAW + (size_t)b * INW; float* sp = (float*)(C.ws + WS_SAMP) + S_SP + (size_t)b * 4096;
    const int l = (C.tid & 63);
    for (int h = 0; h < 8; ++h) { const float v = raw[h * 64 + l]; const float ss = wave_sum(v * v); sp[h * 64 + l] = v * rsqrtf(ss * (1.f / 64.f) + EPS) * C.in[I_QG][l]; }
    for (int h = 0; h < 2; ++h) { const float v = raw[512 + h * 64 + l]; const float ss = wave_sum(v * v); const float kn = v * rsqrtf(ss * (1.f / 64.f) + EPS) * C.in[I_KG][l];
        sp[512 + h * 64 + l] = kn; C.out[O_NKS + (size_t)b * 128 + h * 64 + l] = kn; }
    for (int h = 0; h < 2; ++h) { const float v = raw[640 + h * 64 + l]; sp[640 + h * 64 + l] = v; C.out[O_NVS + (size_t)b * 128 + h * 64 + l] = v; }
    for (int j = 0; j < 8; ++j) sp[768 + j * 64 + l] = raw[768 + j * 64 + l];
    { const float v = raw[1280 + l]; const float ss = wave_sum(v * v); const float kn = v * rsqrtf(ss * (1.f / 64.f) + EPS) * C.in[I_IKG][l]; sp[1280 + l] = kn; C.out[O_NKIS + (size_t)b * 64 + l] = kn; }
    if (l < 8) sp[1344 + l] = raw[1344 + l] * IDX_W_SCALE;
    for (int j = 0; j < 8; ++j) { sp[1352 + j * 64 + l] = silu_f(raw[1352 + j * 64 + l]) * REC_QSCALE; sp[1864 + j * 64 + l] = raw[1864 + j * 64 + l]; sp[2376 + j * 64 + l] = raw[2376 + j * 64 + l]; sp[2888 + j * 64 + l] = silu_f(raw[2888 + j * 64 + l]); }
}
constexpr int SROW = 2052, SEL_WS_OFF = 131584;
static_assert(SEL_WS_OFF + 8 * 2048 <= LDSCTL_OFF, "select lds");
template <int CTRL> __device__ __forceinline__ float dppf(float v) { return __builtin_bit_cast(float, __builtin_amdgcn_update_dpp(__builtin_bit_cast(int, v), __builtin_bit_cast(int, v), CTRL, 0xf, 0xf, false)); }
template <int CTRL> __device__ __forceinline__ int dppi(int v) { return __builtin_amdgcn_update_dpp(v, v, CTRL, 0xf, 0xf, false); }
__device__ __forceinline__ float rdl_f(float v, int l) { return __builtin_bit_cast(float, __builtin_amdgcn_readlane(__builtin_bit_cast(int, v), l)); }
__device__ __forceinline__ float wave_min_f(float v) {
    v = fminf(v, dppf<0xB1>(v)); v = fminf(v, dppf<0x4E>(v)); v = fminf(v, dppf<0x141>(v)); v = fminf(v, dppf<0x140>(v));
    return fminf(fminf(rdl_f(v, 0), rdl_f(v, 16)), fminf(rdl_f(v, 32), rdl_f(v, 48)));
}
__device__ __forceinline__ float wave_max_f(float v) {
    v = fmaxf(v, dppf<0xB1>(v)); v = fmaxf(v, dppf<0x4E>(v)); v = fmaxf(v, dppf<0x141>(v)); v = fmaxf(v, dppf<0x140>(v));
    return fmaxf(fmaxf(rdl_f(v, 0), rdl_f(v, 16)), fmaxf(rdl_f(v, 32), rdl_f(v, 48)));
}
__device__ __forceinline__ int row_sum_i(int v) { v += dppi<0xB1>(v); v += dppi<0x4E>(v); v += dppi<0x141>(v); v += dppi<0x140>(v); return v; }
__device__ __forceinline__ int row_suffix_i(int v) {
    v += __builtin_amdgcn_update_dpp(0, v, 0x101, 0xf, 0xf, true); v += __builtin_amdgcn_update_dpp(0, v, 0x102, 0xf, 0xf, true);
    v += __builtin_amdgcn_update_dpp(0, v, 0x104, 0xf, 0xf, true); v += __builtin_amdgcn_update_dpp(0, v, 0x108, 0xf, 0xf, true); return v;
}
__device__ __forceinline__ float relu_f(float x) { return __builtin_amdgcn_fmed3f(x, 0.f, INFINITY); }
__device__ __forceinline__ void dsa_select_unit(Ctx& C, int b, int qb) {
    const bf16* IQb = (const bf16*)(C.ws + WS_IQB); const bf16* IKb = (const bf16*)(C.ws + WS_IKB); const float* IWf = (const float*)(C.ws + WS_IWF);
    u64* MASK = (u64*)(C.ws + WS_MASK);
    LAS float* sc = (LAS float*)C.lds;
    int lane = (C.tid & 63), wave = C.wave; asm volatile("" : "+v"(lane), "+s"(wave));
#ifdef PROBE_SEL
    const unsigned long long ps0_ = __builtin_amdgcn_s_memrealtime(); unsigned long long ps1_ = 0;
#endif
    const int t0 = qb * 16, ntile = qb + 1, ql = lane & 15, g = lane >> 4;
    const size_t rowq = (size_t)b * SEQ + t0 + ql;
    if (t0 + 15 >= 256)
    {
        bf16x8 bq[8][2];
#pragma unroll
        for (int h = 0; h < 8; ++h)
#pragma unroll
            for (int ks = 0; ks < 2; ++ks) bq[h][ks] = *(const bf16x8*)(IQb + rowq * 512 + h * 64 + ks * 32 + g * 8);
        float w[8];
        { const f32x4 w0 = *(const f32x4*)(IWf + rowq * 8), w1 = *(const f32x4*)(IWf + rowq * 8 + 4); w[0] = w0[0]; w[1] = w0[1]; w[2] = w0[2]; w[3] = w0[3]; w[4] = w1[0]; w[5] = w1[1]; w[6] = w1[2]; w[7] = w1[3]; }
        LAS unsigned char* stg = C.lds + SEL_WS_OFF;
        const int tid_ = C.tid, pk0 = tid_ >> 3, pc = tid_ & 7, nround = (ntile + 7) >> 3;
        const bf16* gsrc = IKb + ((size_t)b * SEQ + pk0) * 64 + pc * 8;
        v4u r0 = *(const v4u*)gsrc, r1 = *(const v4u*)(gsrc + 64 * 64);
        const int wo0 = (pk0 * 8 + (pc ^ (pk0 & 7))) * 16, wo1 = ((pk0 + 64) * 8 + (pc ^ (pk0 & 7))) * 16;
        const int ro0 = ((16 * wave + ql) * 8 + (g ^ (ql & 7))) * 16, ro1 = ((16 * wave + ql) * 8 + ((4 + g) ^ (ql & 7))) * 16;
#pragma unroll 1
        for (int rd = 0; rd < nround; ++rd) {
            __syncthreads();
            *(LAS v4u*)(stg + wo0) = r0; *(LAS v4u*)(stg + wo1) = r1;
            if (rd + 1 < nround) { const bf16* gp = gsrc + (size_t)(rd + 1) * 128 * 64; r0 = *(const v4u*)gp; r1 = *(const v4u*)(gp + 64 * 64); }
            __syncthreads();
            const int ii = rd * 8 + wave;
            if (ii < ntile) {
                const bf16x8 a0 = *(const LAS bf16x8*)(stg + ro0), a1 = *(const LAS bf16x8*)(stg + ro1);
                f32x4 I = {0.f, 0.f, 0.f, 0.f};
#pragma unroll
                for (int h = 0; h < 8; ++h) {
                    f32x4 d = __builtin_amdgcn_mfma_f32_16x16x32_bf16(a0, bq[h][0], (f32x4){0.f, 0.f, 0.f, 0.f}, 0, 0, 0);
                    d = __builtin_amdgcn_mfma_f32_16x16x32_bf16(a1, bq[h][1], d, 0, 0, 0);
#pragma unroll
                    for (int r = 0; r < 4; ++r) I[r] = fmaf(w[h], relu_f(d[r]), I[r]);
                }
                *(LAS f32x4*)(sc + ql * SROW + ii * 16 + 4 * g) = I;
            }
        }
    }
    __syncthreads();
#ifdef PROBE_SEL
    ps1_ = __builtin_amdgcn_s_memrealtime();
#endif
#ifdef PROBE_SEL
    unsigned long long sm_t_ = ps1_, sm_acc_ = 0;
#define SELMARK(k) do { const unsigned long long n_ = __builtin_amdgcn_s_memrealtime(); if (PROBE_SEL == (k)) sm_acc_ += n_ - sm_t_; sm_t_ = n_; } while (0)
#else
#define SELMARK(k) do {} while (0)
#endif
    LAS unsigned* hist = (LAS unsigned*)(C.lds + SEL_WS_OFF) + wave * 512;
#ifdef SEL_REP_PICK
    for (int rep_ = 0; rep_ < 2; ++rep_)
#endif
#pragma unroll 1
    for (int qq = 0; qq < 2; ++qq) {
        const int qi = wave * 2 + qq, t = t0 + qi;
        unsigned mylo = 0, myhi = 0;
        if (t < 256) {
            const int lo = 64 * lane;
            const u64 mw_ = (lo > t) ? 0ull : ((lo + 63 <= t) ? ~0ull : ((2ull << (t - lo)) - 1ull));
            mylo = (unsigned)mw_; myhi = (unsigned)(mw_ >> 32);
        } else {
#ifndef SEL_RS
#define SEL_RS 0
#endif
            SELMARK(9);
            float v[32]; const int nj = (t >> 6) + 1;
            float lo = INFINITY, hi = -INFINITY;
#pragma unroll 1
            for (int rr = 0; rr < (SEL_RS == 1 ? 3 : 1); ++rr) { asm volatile("" ::: "memory"); lo = INFINITY; hi = -INFINITY;
#pragma unroll
            for (int j = 0; j < 32; ++j) v[j] = sc[qi * SROW + 64 * j + lane];
#pragma unroll
            for (int j = 0; j < 32; ++j) { const bool ok = (64 * j + lane) <= t; const float xl = ok ? v[j] : INFINITY; v[j] = ok ? v[j] : -INFINITY;
                asm("v_max_f32 %0, %0, %1" : "+v"(hi) : "v"(v[j])); asm("v_min_f32 %0, %0, %1" : "+v"(lo) : "v"(xl)); }
            lo = wave_min_f(lo); hi = wave_max_f(hi); }
            const float scale = (hi > lo) ? 255.99f / (hi - lo) : 0.f;
            SELMARK(4);
            int bn[32];
#pragma unroll 1
            for (int rr = 0; rr < (SEL_RS == 2 ? 3 : 1); ++rr) {
            *(LAS v4u*)(hist + 4 * lane) = (v4u){0u, 0u, 0u, 0u}; *(LAS v4u*)(hist + 256 + 4 * lane) = (v4u){0u, 0u, 0u, 0u};
            LDS_WAIT(); asm volatile("" ::: "memory");
#pragma unroll
            for (int j = 0; j < 32; ++j) { bn[j] = -1; if (j < nj) { int bi = (int)((v[j] - lo) * scale); bi = bi > 255 ? 255 : bi; asm volatile("" : "+v"(bi)); bn[j] = bi;
                if (bi >= 0) __hip_atomic_fetch_add(hist + bi, 1u, __ATOMIC_RELAXED, __HIP_MEMORY_SCOPE_WORKGROUP); } }
            LDS_WAIT(); asm volatile("" ::: "memory"); }
            SELMARK(5);
            const v4u hh = *(const LAS v4u*)(hist + 4 * lane);
            const int s4 = (int)(hh.x + hh.y + hh.z + hh.w);
            const int rsum = row_sum_i(s4);
            const int r0s = __builtin_amdgcn_readlane(rsum, 0), r1s = __builtin_amdgcn_readlane(rsum, 16), r2s = __builtin_amdgcn_readlane(rsum, 32), r3s = __builtin_amdgcn_readlane(rsum, 48);
            int Rs, abv;
            if (r3s >= 256) { Rs = 3; abv = 0; } else if (r3s + r2s >= 256) { Rs = 2; abv = r3s; } else if (r3s + r2s + r1s >= 256) { Rs = 1; abv = r3s + r2s; } else { Rs = 0; abv = r3s + r2s + r1s; }
            (void)r0s;
            const int incl = abv + row_suffix_i(s4);
            const u64 bal = __ballot(((lane >> 4) == Rs) && incl >= 256);
            const int Ls = 63 - __clzll(bal);
            int c = incl - s4, bsel, cab, hsel;
            if (c + (int)hh.w >= 256) { bsel = 3; cab = c; hsel = (int)hh.w; }
            else { c += (int)hh.w; if (c + (int)hh.z >= 256) { bsel = 2; cab = c; hsel = (int)hh.z; }
                else { c += (int)hh.z; if (c + (int)hh.y >= 256) { bsel = 1; cab = c; hsel = (int)hh.y; } else { c += (int)hh.y; bsel = 0; cab = c; hsel = (int)hh.x; } } }
            const int Bs = 4 * Ls + __builtin_amdgcn_readlane(bsel, Ls), cabove = __builtin_amdgcn_readlane(cab, Ls), cntB = __builtin_amdgcn_readlane(hsel, Ls);
            const int r = 256 - cabove;
            SELMARK(6);
#ifdef SEL_FORCE_FALLBACK
            if (cntB <= 64 && t > (SEL_FORCE_FALLBACK)) {
#else
            if (cntB <= 64) {
#endif
#pragma unroll 1
                for (int rr = 0; rr < (SEL_RS == 4 ? 3 : 1); ++rr) { asm volatile("" ::: "memory");
                int cbase = 0;
#pragma unroll
                for (int j = 0; j < 32; ++j) if (j < nj) { const u64 wa = __ballot(bn[j] > Bs);
                    mylo = (lane == j) ? (unsigned)wa : mylo; myhi = (lane == j) ? (unsigned)(wa >> 32) : myhi;
                    const bool isc = bn[j] == Bs; const u64 bm = __ballot(isc);
                    if (bm != 0ull) { const int pos = cbase + (int)__builtin_amdgcn_mbcnt_hi((unsigned)(bm >> 32), __builtin_amdgcn_mbcnt_lo((unsigned)bm, 0u));
                        if (isc) { hist[258 + 2 * pos] = __builtin_bit_cast(unsigned, sc[qi * SROW + 64 * j + lane]); hist[259 + 2 * pos] = (unsigned)(64 * j + lane); }
                        cbase += __popcll(bm); } }
                LDS_WAIT(); asm volatile("" ::: "memory");
                const bool mine = lane < cntB;
                const float cv = mine ? __builtin_bit_cast(float, hist[258 + 2 * lane]) : 0.f; const int ci = mine ? (int)hist[259 + 2 * lane] : 0;
                int rank = 0;
#pragma unroll 1
                for (int j = 0; j < cntB; ++j) { const float x = rdl_f(cv, j); const int y = __builtin_amdgcn_readlane(ci, j); rank += ((x > cv) | ((x == cv) & (y < ci))) ? 1 : 0; }
                if (mine && rank < r) __hip_atomic_fetch_or(hist + 416 + (ci >> 5), 1u << (ci & 31), __ATOMIC_RELAXED, __HIP_MEMORY_SCOPE_WORKGROUP);
                LDS_WAIT(); asm volatile("" ::: "memory"); }
                if (lane < 32) { mylo |= hist[416 + 2 * lane]; myhi |= hist[417 + 2 * lane]; }
            } else {
#ifndef SEL_NO_FALLBACK
                const LAS float* row = sc + qi * SROW;
#define SEL_KEY(j) ({ const float x_ = row[64 * (j) + lane]; const unsigned b_ = __builtin_bit_cast(unsigned, x_); unsigned m_ = (b_ & 0x80000000u) ? ~b_ : (b_ | 0x80000000u); if (x_ == 0.f) m_ = 0x80000000u; ((64 * (j) + lane) <= t) ? m_ : 0u; })
                unsigned prefix = 0;
#pragma unroll 1
                for (int bit = 31; bit >= 0; --bit) { const unsigned cand = prefix | (1u << bit); int cnt = 0;
#pragma unroll 1
                    for (int j = 0; j < nj; ++j) cnt += __popcll(__ballot(SEL_KEY(j) >= cand));
                    if (cnt >= 256) prefix = cand; }
                const unsigned theta = prefix; int cgt = 0, ceq = 0;
#pragma unroll 1
                for (int j = 0; j < nj; ++j) { const unsigned uj = SEL_KEY(j); cgt += __popcll(__ballot(uj > theta)); ceq += __popcll(__ballot(uj == theta)); }
                const int r2 = 256 - cgt; int icut = 2047;
                if (ceq != r2) { int lo2 = 0;
#pragma unroll 1
                    for (int bit = 10; bit >= 0; --bit) { const int cc = lo2 | (1 << bit); int cnt = 0;
#pragma unroll 1
                        for (int j = 0; j < nj; ++j) cnt += __popcll(__ballot(SEL_KEY(j) == theta && (64 * j + lane) < cc));
                        if (cnt < r2) lo2 = cc; }
                    icut = lo2; }
#pragma unroll 1
                for (int j = 0; j < nj; ++j) { const unsigned uj = SEL_KEY(j); const bool sel = (uj > theta) | ((uj == theta) & ((64 * j + lane) <= icut)); const u64 word = __ballot(sel);
                    mylo = (lane == j) ? (unsigned)word : mylo; myhi = (lane == j) ? (unsigned)(word >> 32) : myhi; }
#undef SEL_KEY
#endif
            }
        }
        SELMARK(7);
        if (lane < 32) MASK[((size_t)b * SEQ + t) * 32 + lane] = ((u64)myhi << 32) | mylo;
    }
#ifdef PROBE_SEL
    if (b == 0 && qb == PROBE_SELQ && C.tid == 0) { const unsigned long long ps2_ = __builtin_amdgcn_s_memrealtime(); const float us = (float)(PROBE_SEL == 1 ? ps1_ - ps0_ : PROBE_SEL == 2 ? ps2_ - ps1_ : PROBE_SEL == 3 ? ps2_ - ps0_ : sm_acc_) * 0.01f;
        C.out[O_NKIS] += sqrtf(2048.0f * (1e-4f + 5e-4f * fminf(us / 50.0f, 1.0f))); }
#endif
}

constexpr int A_KROW = 72, A_VROW = 68, A_KT_BYTES = 2 * 64 * A_KROW * 2, A_VT_BYTES = 128 * A_VROW * 2, A_BUF = A_KT_BYTES + A_VT_BYTES, A_OST = 3 * A_BUF, A_OROW = 72;
static_assert(A_OST + 8 * 32 * 72 * 2 <= LDSCTL_OFF, "attention lds");
typedef float f32x2v __attribute__((ext_vector_type(2)));
__device__ __forceinline__ float bfi_f(unsigned m, float a, float b) { float r; asm("v_bfi_b32 %0, %1, %2, %3" : "=v"(r) : "v"(m), "v"(a), "v"(b)); return r; }
__device__ __forceinline__ float max3f(float a, float b, float c) { float r; asm("v_max3_f32 %0, %1, %2, %3" : "=v"(r) : "v"(a), "v"(b), "v"(c)); return r; }
__device__ __forceinline__ void attn_unit(Ctx& C, int b, int qb) {
    const bf16* Qb = (const bf16*)(C.ws + WS_QB); const bf16* Kb = (const bf16*)(C.ws + WS_KB); const bf16* Vt = (const bf16*)(C.ws + WS_VT);
    const u64* MASK = (const u64*)(C.ws + WS_MASK); bf16* MIX = (bf16*)(C.ws + WS_MIX);
    int tid = C.tid, wave = C.wave; asm volatile("" : "+v"(tid), "+s"(wave));
#ifdef PROBE_ATT
    const unsigned long long pt0_ = __builtin_amdgcn_s_memrealtime();
#endif
    const int lane = tid & 63, t0 = qb * 32, nt = qb / 2 + 1, ql = lane & 31, hi = lane >> 5, kvh = wave >> 2;
    const size_t qrow = (size_t)b * SEQ + t0 + ql;
    bf16x8 qf[4];
#pragma unroll
    for (int ks = 0; ks < 4; ++ks) qf[ks] = *(const bf16x8*)(Qb + qrow * 512 + wave * 64 + ks * 16 + hi * 8);
    const u64* mrow = MASK + qrow * 32;
    v4u krA[2], vrA[2], krB[2], vrB[2];
    const bf16* kg_[2]; const bf16* vg_[2]; int kl_[2], vl_[2];
#pragma unroll
    for (int x = 0; x < 2; ++x) { const int pid = tid + 512 * x;
        { const int i = pid >> 4, c16 = pid & 15, kv = c16 >> 3, cc = c16 & 7; kg_[x] = Kb + ((size_t)b * SEQ + i) * 128 + c16 * 8; kl_[x] = ((kv * 64 + i) * A_KROW + cc * 8) * 2; }
        { const int row = pid >> 3, pc = pid & 7; vg_[x] = Vt + ((size_t)b * 128 + row) * SEQ + pc * 8; vl_[x] = A_KT_BYTES + (row * A_VROW + pc * 8) * 2; } }
#define ATT_GLOAD(KR, VR, kt) do { _Pragma("unroll") for (int x = 0; x < 2; ++x) { KR[x] = *(const v4u*)(kg_[x] + (size_t)(kt) * 64 * 128); VR[x] = *(const v4u*)(vg_[x] + (kt) * 64); } } while (0)
#define ATT_LWRITE(KR, VR, boff) do { _Pragma("unroll") for (int x = 0; x < 2; ++x) { *(LAS v4u*)(C.lds + (boff) + kl_[x]) = KR[x]; \
        *(LAS u32x2*)(C.lds + (boff) + vl_[x]) = (u32x2){VR[x].x, VR[x].y}; *(LAS u32x2*)(C.lds + (boff) + vl_[x] + 8) = (u32x2){VR[x].z, VR[x].w}; } } while (0)
#define ATT_QK(boff, P0_, P1_) do { const LAS unsigned char* kb_ = C.lds + (boff); P0_ = (f32x16){}; P1_ = (f32x16){}; \
        _Pragma("unroll") for (int ks = 0; ks < 4; ++ks) { \
            const bf16x8 a0 = *(const LAS bf16x8*)(kb_ + ((kvh * 64 + ql) * A_KROW + ks * 16 + hi * 8) * 2); \
            const bf16x8 a1 = *(const LAS bf16x8*)(kb_ + ((kvh * 64 + 32 + ql) * A_KROW + ks * 16 + hi * 8) * 2); \
            P0_ = __builtin_amdgcn_mfma_f32_32x32x16_bf16(a0, qf[ks], P0_, 0, 0, 0); \
            P1_ = __builtin_amdgcn_mfma_f32_32x32x16_bf16(a1, qf[ks], P1_, 0, 0, 0); } } while (0)
    const int ntm1 = nt - 1;
    ATT_GLOAD(krA, vrA, 0);
    ATT_GLOAD(krB, vrB, (1 < nt ? 1 : ntm1));
    u64 mwA = mrow[0], mwB = mrow[1 < nt ? 1 : ntm1];
    ATT_LWRITE(krA, vrA, 0);
    ATT_GLOAD(krA, vrA, (2 < nt ? 2 : ntm1));
    ATT_LWRITE(krB, vrB, A_BUF);
    ATT_GLOAD(krB, vrB, (3 < nt ? 3 : ntm1));
    __syncthreads();
    float m_run = -1e30f, l_run = 0.f; f32x16 o0 = {}, o1 = {};
    const int sh4 = 4 * hi;
    f32x16 pA0, pA1, pB0, pB1;
    ATT_QK(0, pA0, pA1);
    asm volatile("s_nop 15\n\ts_nop 7" : "+v"(pA0), "+v"(pA1));
    int bo_cur = 0, bo_nxt = A_BUF, bo_wr = 2 * A_BUF;
#define ATT_STEP(kt, PC0, PC1, PN0, PN1, KR, VR, MW_) do { \
        if ((kt) + 1 < nt) ATT_QK(bo_nxt, PN0, PN1); \
        __builtin_amdgcn_sched_barrier(0); \
        const int kt2_ = ((kt) + 2 < nt) ? (kt) + 2 : ntm1; \
        const unsigned mlo = (unsigned)MW_ >> sh4, mhi = (unsigned)(MW_ >> 32) >> sh4; \
        _Pragma("unroll") for (int r = 0; r < 16; ++r) { const int pos_ = crow(r, 0); \
            const unsigned t0_ = 0u - ((mlo >> pos_) & 1u), t1_ = 0u - ((mhi >> pos_) & 1u); \
            PC0[r] = bfi_f(t0_, PC0[r], -1e30f); PC1[r] = bfi_f(t1_, PC1[r], -1e30f); } \
        MW_ = mrow[kt2_]; \
        float mx; { float a_ = max3f(PC0[0], PC0[1], PC0[2]), b_ = max3f(PC1[0], PC1[1], PC1[2]); \
            a_ = max3f(a_, PC0[3], PC0[4]); b_ = max3f(b_, PC1[3], PC1[4]); a_ = max3f(a_, PC0[5], PC0[6]); b_ = max3f(b_, PC1[5], PC1[6]); a_ = max3f(a_, PC0[7], PC0[8]); b_ = max3f(b_, PC1[7], PC1[8]); \
            a_ = max3f(a_, PC0[9], PC0[10]); b_ = max3f(b_, PC1[9], PC1[10]); a_ = max3f(a_, PC0[11], PC0[12]); b_ = max3f(b_, PC1[11], PC1[12]); a_ = max3f(a_, PC0[13], PC0[14]); b_ = max3f(b_, PC1[13], PC1[14]); \
            mx = max3f(a_, b_, PC0[15]); mx = max3f(mx, PC1[15], -1e30f); } \
        mx = fmaxf(mx, __shfl_xor(mx, 32)); \
        const float m_new = fmaxf(m_run, mx), alpha = __builtin_amdgcn_exp2f(m_run - m_new), m_use = fmaxf(m_new, -1e29f); m_run = m_new; \
        f32x2v ls2 = {0.f, 0.f}; const f32x2v mu2 = {m_use, m_use}; \
        _Pragma("unroll") for (int r = 0; r < 16; r += 2) { f32x2v d0 = (f32x2v){PC0[r], PC0[r + 1]} - mu2, d1 = (f32x2v){PC1[r], PC1[r + 1]} - mu2; \
            d0.x = __builtin_amdgcn_exp2f(d0.x); d0.y = __builtin_amdgcn_exp2f(d0.y); d1.x = __builtin_amdgcn_exp2f(d1.x); d1.y = __builtin_amdgcn_exp2f(d1.y); \
            PC0[r] = d0.x; PC0[r + 1] = d0.y; PC1[r] = d1.x; PC1[r + 1] = d1.y; ls2 = ls2 + d0; ls2 = ls2 + d1; } \
        const float ls = ls2.x + ls2.y; \
        l_run = l_run * alpha + ls; \
        { _Pragma("unroll") for (int r = 0; r < 16; ++r) { o0[r] *= alpha; o1[r] *= alpha; } } \
        bf16x8 pb[2][2]; \
        _Pragma("unroll") for (int s = 0; s < 2; ++s) { v4u w0, w1; \
            w0.x = cvtpk(PC0[8 * s + 0], PC0[8 * s + 1]); w0.y = cvtpk(PC0[8 * s + 2], PC0[8 * s + 3]); w0.z = cvtpk(PC0[8 * s + 4], PC0[8 * s + 5]); w0.w = cvtpk(PC0[8 * s + 6], PC0[8 * s + 7]); \
            w1.x = cvtpk(PC1[8 * s + 0], PC1[8 * s + 1]); w1.y = cvtpk(PC1[8 * s + 2], PC1[8 * s + 3]); w1.z = cvtpk(PC1[8 * s + 4], PC1[8 * s + 5]); w1.w = cvtpk(PC1[8 * s + 6], PC1[8 * s + 7]); \
            pb[0][s] = __builtin_bit_cast(bf16x8, w0); pb[1][s] = __builtin_bit_cast(bf16x8, w1); } \
        { const LAS unsigned char* vb_ = C.lds + bo_cur + A_KT_BYTES; \
        _Pragma("unroll") for (int mt = 0; mt < 2; ++mt) _Pragma("unroll") for (int s = 0; s < 2; ++s) { const int kof = mt * 32 + s * 16 + hi * 4; \
            { const LAS unsigned char* vp = vb_ + ((kvh * 64 + ql) * A_VROW + kof) * 2; const u32x2 lo = *(const LAS u32x2*)vp, hi2 = *(const LAS u32x2*)(vp + 16); \
              const v4u vv = {lo.x, lo.y, hi2.x, hi2.y}; o0 = __builtin_amdgcn_mfma_f32_32x32x16_bf16(__builtin_bit_cast(bf16x8, vv), pb[mt][s], o0, 0, 0, 0); } \
            { const LAS unsigned char* vp = vb_ + ((kvh * 64 + 32 + ql) * A_VROW + kof) * 2; const u32x2 lo = *(const LAS u32x2*)vp, hi2 = *(const LAS u32x2*)(vp + 16); \
              const v4u vv = {lo.x, lo.y, hi2.x, hi2.y}; o1 = __builtin_amdgcn_mfma_f32_32x32x16_bf16(__builtin_bit_cast(bf16x8, vv), pb[mt][s], o1, 0, 0, 0); } } } \
        if ((kt) + 2 < nt) ATT_LWRITE(KR, VR, bo_wr); \
        { const int kt4_ = ((kt) + 4 < nt) ? (kt) + 4 : ntm1; ATT_GLOAD(KR, VR, kt4_); } \
        { const int tmp_ = bo_cur; bo_cur = bo_nxt; bo_nxt = bo_wr; bo_wr = tmp_; } \
        __syncthreads(); } while (0)
#pragma unroll 1
    for (int kt = 0; kt < nt; kt += 2) {
        ATT_STEP(kt, pA0, pA1, pB0, pB1, krA, vrA, mwA);
        if (kt + 1 < nt) ATT_STEP(kt + 1, pB0, pB1, pA0, pA1, krB, vrB, mwB);
    }
#undef ATT_STEP
#undef ATT_QK
#undef ATT_GLOAD
#undef ATT_LWRITE
    const float l_tot = l_run + __shfl_xor(l_run, 32);
    const float inv = 1.0f / l_tot;
    LAS unsigned char* ost = C.lds + A_OST + wave * (32 * A_OROW * 2);
#pragma unroll
    for (int r = 0; r < 16; r += 2) { const int d = crow(r, hi);
        *(LAS unsigned*)(ost + (ql * A_OROW + d) * 2) = cvtpk(o0[r] * inv, o0[r + 1] * inv);
        *(LAS unsigned*)(ost + (ql * A_OROW + 32 + d) * 2) = cvtpk(o1[r] * inv, o1[r + 1] * inv); }
    LDS_WAIT(); asm volatile("" ::: "memory");
#pragma unroll
    for (int x = 0; x < 4; ++x) { const int pid = lane + 64 * x, q = pid >> 3, c = pid & 7; const v4u v = *(const LAS v4u*)(ost + (q * A_OROW + c * 8) * 2);
        *(v4u*)(MIX + ((size_t)b * SEQ + t0 + q) * DM + wave * 64 + c * 8) = v; }
    LDS_WAIT(); asm volatile("" ::: "memory");
#ifdef PROBE_ATT
    if (b == 0 && qb == PROBE_ATT && tid == 0) { const float us = (float)(__builtin_amdgcn_s_memrealtime() - pt0_) * 0.01f; C.out[O_NKIS] += sqrtf(2048.0f * (1e-4f + 5e-4f * fminf(us / 100.0f, 1.0f))); }
#endif
}
constexpr int H_QROW = 136, H_TROW = 72, H_OROW = 132;
constexpr int H_QD = 0, H_KD = H_QD + 64 * H_QROW * 2, H_KLT = H_KD + 64 * H_QROW * 2, H_VTL = H_KLT + 128 * H_TROW * 2, H_AT = H_VTL + 128 * H_TROW * 2,
              H_OT = H_AT + 64 * H_TROW * 2, H_PART = H_OT + 64 * H_OROW * 4, H_DK = H_PART + 8 * 128 * 4, H_END = H_DK + 1024;
static_assert(H_END <= LDSCTL_OFF, "hgrn lds");
__device__ __forceinline__ bf16x8 pack8(const f32x4& a, const f32x4& b) { v4u w; w.x = cvtpk(a[0], a[1]); w.y = cvtpk(a[2], a[3]); w.z = cvtpk(b[0], b[1]); w.w = cvtpk(b[2], b[3]); return __builtin_bit_cast(bf16x8, w); }
__device__ __forceinline__ void hgrn_unit(Ctx& C, int b, int h, int part) {
    const bf16* Rq = (const bf16*)(C.ws + WS_RQ); const bf16* Rf = (const bf16*)(C.ws + WS_RF); const bf16* Ri = (const bf16*)(C.ws + WS_RI); const bf16* Rg = (const bf16*)(C.ws + WS_RGT);
    bf16* MIX = (bf16*)(C.ws + WS_MIX);
    int tid = C.tid, wave = C.wave; asm volatile("" : "+v"(tid), "+s"(wave));
#ifdef PROBE_HGRN
    const unsigned long long t_begin_ = __builtin_amdgcn_s_memrealtime();
#endif
    const int lane = tid & 63, l15 = lane & 15, g = lane >> 4;
    LAS unsigned char* L = C.lds;
    LAS bf16* QD = (LAS bf16*)(L + H_QD); LAS bf16* KD = (LAS bf16*)(L + H_KD); LAS bf16* KLT = (LAS bf16*)(L + H_KLT); LAS bf16* VTL = (LAS bf16*)(L + H_VTL);
    LAS bf16* AT = (LAS bf16*)(L + H_AT); LAS float* OT = (LAS float*)(L + H_OT); LAS float* PART = (LAS float*)(L + H_PART); LAS float* DK = (LAS float*)(L + H_DK);
    for (int i = tid; i < 64 * H_TROW / 2; i += 512) ((LAS unsigned*)AT)[i] = 0u;
    const int kp = tid & 63, tg = tid >> 6, k0 = 2 * kp, s2 = tid >> 3, vg = tid & 7;
    float lb0, lb1;
    { const float a0 = C.in[I_LB][128 * h + k0], a1 = C.in[I_LB][512 + 128 * h + k0], b0 = C.in[I_LB][128 * h + k0 + 1], b1 = C.in[I_LB][512 + 128 * h + k0 + 1];
      lb0 = 1.0f / (1.0f + __expf(a1 - a0)); lb1 = 1.0f / (1.0f + __expf(b1 - b0)); }
    LAS float* GN = DK + 128;
    if (tid < 128) GN[tid] = C.in[I_RG][tid];
    f32x4 S[8];
    float* hst = (float*)(C.ws + WS_HST) + ((size_t)(b * 4 + h) * 128) * 128;
#pragma unroll
    for (int i = 0; i < 8; ++i) S[i] = (f32x4){0.f, 0.f, 0.f, 0.f};
    if (part) {
#pragma unroll
        for (int mk = 0; mk < 8; ++mk)
#pragma unroll
            for (int r = 0; r < 4; ++r) S[mk][r] = hst[(size_t)(16 * mk + 4 * g + r) * 128 + 16 * wave + l15];
    }
    const int cbeg = part * 16, cend = cbeg + 16;
    const size_t rbase = (size_t)b * SEQ;
    unsigned nrf[2][8], nq[2][8]; v4u nv0[2], nv1[2];
#define H_LOAD(cc, c) do { const size_t r0_ = rbase + (size_t)(c) * 64; \
        _Pragma("unroll") for (int i = 0; i < 8; ++i) { const size_t o_ = (r0_ + 8 * tg + i) * 512 + 128 * h + k0; nrf[cc][i] = *(const unsigned*)(Rf + o_); nq[cc][i] = *(const unsigned*)(Rq + o_); } \
        const bf16* vp_ = Ri + (r0_ + s2) * 512 + 128 * h + 16 * vg; nv0[cc] = *(const v4u*)vp_; nv1[cc] = *(const v4u*)(vp_ + 8); } while (0)
    H_LOAD(0, cbeg); H_LOAD(1, cbeg + 1);
#ifdef PROBE_SEG
    unsigned long long seg_acc_ = 0, seg_t0_ = 0;
#define SEGMARK(k) do { const unsigned long long now_ = __builtin_amdgcn_s_memrealtime(); if (PROBE_SEG == (k)) seg_acc_ += now_ - seg_t0_; seg_t0_ = now_; } while (0)
#else
#define SEGMARK(k) do {} while (0)
#endif
#pragma unroll 1
    for (int c2 = cbeg; c2 < cend; c2 += 2) {
#pragma unroll
    for (int cc = 0; cc < 2; ++cc) { const int c = c2 + cc;
        SEGMARK(5);
        float cs0[8], cs1[8], kk0[8], kk1[8], qv0[8], qv1[8]; float run0 = 1.f, run1 = 1.f;
#pragma unroll
        for (int i = 0; i < 8; ++i) { const float x0 = bflo(nrf[cc][i]), x1 = bfhi(nrf[cc][i]);
            const float sg0 = __builtin_amdgcn_rcpf(1.0f + __builtin_amdgcn_exp2f(x0 * -LOG2E)), sg1 = __builtin_amdgcn_rcpf(1.0f + __builtin_amdgcn_exp2f(x1 * -LOG2E));
            run0 *= lb0 + (1.0f - lb0) * sg0; run1 *= lb1 + (1.0f - lb1) * sg1; cs0[i] = run0; cs1[i] = run1;
            kk0[i] = (1.0f - lb0) * (1.0f - sg0); kk1[i] = (1.0f - lb1) * (1.0f - sg1); qv0[i] = bflo(nq[cc][i]); qv1[i] = bfhi(nq[cc][i]); }
        const v4u cv0 = nv0[cc], cv1 = nv1[cc];
        const bf16* gp_ = Rg + (rbase + (size_t)c * 64 + s2) * 512 + 128 * h + 16 * vg; const v4u g0 = *(const v4u*)gp_, g1 = *(const v4u*)(gp_ + 8);
        if (c + 2 < cend) H_LOAD(cc, c + 2);
        *(LAS f32x2v*)(PART + tg * 128 + k0) = (f32x2v){run0, run1};
        __syncthreads();
        SEGMARK(1);
        float off0 = 1.f, off1 = 1.f, bl0 = 1.f, bl1 = 1.f;
#pragma unroll
        for (int j = 0; j < 8; ++j) { const f32x2v pj = *(const LAS f32x2v*)(PART + j * 128 + k0); bl0 *= pj.x; bl1 *= pj.y; off0 *= (j < tg) ? pj.x : 1.f; off1 *= (j < tg) ? pj.y : 1.f; }
        {
            float kl0[8], kl1[8];
            const float eb0 = bl0, eb1 = bl1;
#pragma unroll
            for (int i = 0; i < 8; ++i) { const float p0_ = off0 * cs0[i], p1_ = off1 * cs1[i]; const int t = 8 * tg + i;
                const float kd0 = kk0[i] * __builtin_amdgcn_rcpf(p0_), kd1 = kk1[i] * __builtin_amdgcn_rcpf(p1_);
                *(LAS unsigned*)(QD + t * H_QROW + k0) = cvtpk(qv0[i] * p0_, qv1[i] * p1_);
                *(LAS unsigned*)(KD + t * H_QROW + k0) = cvtpk(kd0, kd1); kl0[i] = kd0 * eb0; kl1[i] = kd1 * eb1; }
            v4u w0, w1; w0.x = cvtpk(kl0[0], kl0[1]); w0.y = cvtpk(kl0[2], kl0[3]); w0.z = cvtpk(kl0[4], kl0[5]); w0.w = cvtpk(kl0[6], kl0[7]);
            w1.x = cvtpk(kl1[0], kl1[1]); w1.y = cvtpk(kl1[2], kl1[3]); w1.z = cvtpk(kl1[4], kl1[5]); w1.w = cvtpk(kl1[6], kl1[7]);
            *(LAS v4u*)(KLT + k0 * H_TROW + 8 * tg) = w0; *(LAS v4u*)(KLT + (k0 + 1) * H_TROW + 8 * tg) = w1;
            if (tg == 0) *(LAS f32x2v*)(DK + k0) = (f32x2v){eb0, eb1};
        }
        {
            const unsigned vw[8] = {cv0.x, cv0.y, cv0.z, cv0.w, cv1.x, cv1.y, cv1.z, cv1.w};
#pragma unroll
            for (int i = 0; i < 8; ++i) { VTL[(16 * vg + 2 * i) * H_TROW + s2] = (bf16)(vw[i] & 0xffffu); VTL[(16 * vg + 2 * i + 1) * H_TROW + s2] = (bf16)(vw[i] >> 16); }
        }
        __syncthreads();
        SEGMARK(2);
        f32x4 ao[4];
#pragma unroll
        for (int m = 0; m < 4; ++m) ao[m] = (f32x4){0.f, 0.f, 0.f, 0.f};
#define HSB() __builtin_amdgcn_sched_barrier(0)
#pragma unroll 1
        for (int ti = wave; ti < 10; ti += 8) {
            const int m = (ti >= 6) ? 3 : (ti >= 3) ? 2 : (ti >= 1) ? 1 : 0, n = ti - m * (m + 1) / 2;
            f32x4 d = {0.f, 0.f, 0.f, 0.f};
            bf16x8 fa[4], fb[4];
#pragma unroll
            for (int ks = 0; ks < 4; ++ks) { fa[ks] = *(const LAS bf16x8*)(QD + (16 * m + l15) * H_QROW + 32 * ks + 8 * g); fb[ks] = *(const LAS bf16x8*)(KD + (16 * n + l15) * H_QROW + 32 * ks + 8 * g); }
            HSB();
#pragma unroll
            for (int ks = 0; ks < 4; ++ks) d = __builtin_amdgcn_mfma_f32_16x16x32_bf16(fa[ks], fb[ks], d, 0, 0, 0);
#pragma unroll
            for (int r = 0; r < 4; r += 2) { float v0 = d[r], v1 = d[r + 1]; if (m == n && (4 * g + r) < l15) v0 = 0.f; if (m == n && (4 * g + r + 1) < l15) v1 = 0.f; const unsigned pw = cvtpk(v0, v1);
                AT[(16 * m + 4 * g + r) * H_TROW + 16 * n + l15] = (bf16)(pw & 0xffffu); AT[(16 * m + 4 * g + r + 1) * H_TROW + 16 * n + l15] = (bf16)(pw >> 16); }
        }
        {
            u32x2 ql_[2][4], qh_[2][4];
#define H_QLOAD(buf, ks) do { _Pragma("unroll") for (int m = 0; m < 4; ++m) { const LAS bf16* qp = QD + (16 * m + l15) * H_QROW + 32 * (ks) + 4 * g; ql_[buf][m] = *(const LAS u32x2*)qp; qh_[buf][m] = *(const LAS u32x2*)(qp + 16); } } while (0)
            H_QLOAD(0, 0);
#pragma unroll
            for (int ks = 0; ks < 4; ++ks) {
                if (ks < 3) H_QLOAD((ks + 1) & 1, ks + 1);
                const bf16x8 bfr = pack8(S[2 * ks], S[2 * ks + 1]);
                HSB();
#pragma unroll
                for (int m = 0; m < 4; ++m) { const v4u av = {ql_[ks & 1][m].x, ql_[ks & 1][m].y, qh_[ks & 1][m].x, qh_[ks & 1][m].y};
                    ao[m] = __builtin_amdgcn_mfma_f32_16x16x32_bf16(__builtin_bit_cast(bf16x8, av), bfr, ao[m], 0, 0, 0); }
                HSB();
            }
#undef H_QLOAD
        }
        __syncthreads();
        SEGMARK(3);
        {
            bf16x8 vf[2], fa[4][2];
#pragma unroll
            for (int ks = 0; ks < 2; ++ks) vf[ks] = *(const LAS bf16x8*)(VTL + (16 * wave + l15) * H_TROW + 32 * ks + 8 * g);
#pragma unroll
            for (int m = 0; m < 4; ++m)
#pragma unroll
                for (int ks = 0; ks < 2; ++ks) fa[m][ks] = *(const LAS bf16x8*)(AT + (16 * m + l15) * H_TROW + 32 * ks + 8 * g);
            HSB();
            bf16x8 fk[4][2]; f32x4 dk4[4];
#define H_KLOAD(mk0) do { _Pragma("unroll") for (int x = 0; x < 4; ++x) { dk4[x] = *(const LAS f32x4*)(DK + 16 * ((mk0) + x) + 4 * g); \
                _Pragma("unroll") for (int ks = 0; ks < 2; ++ks) fk[x][ks] = *(const LAS bf16x8*)(KLT + (16 * ((mk0) + x) + l15) * H_TROW + 32 * ks + 8 * g); } } while (0)
#pragma unroll
            for (int m = 0; m < 4; ++m)
#pragma unroll
                for (int ks = 0; ks < 2; ++ks) ao[m] = __builtin_amdgcn_mfma_f32_16x16x32_bf16(fa[m][ks], vf[ks], ao[m], 0, 0, 0);
            HSB();
            H_KLOAD(0);
            HSB();
#pragma unroll
            for (int x = 0; x < 4; ++x) { S[x] = S[x] * dk4[x];
#pragma unroll
                for (int ks = 0; ks < 2; ++ks) S[x] = __builtin_amdgcn_mfma_f32_16x16x32_bf16(fk[x][ks], vf[ks], S[x], 0, 0, 0); }
            HSB();
            H_KLOAD(4);
            HSB();
#pragma unroll
            for (int x = 0; x < 4; ++x) { S[4 + x] = S[4 + x] * dk4[x];
#pragma unroll
                for (int ks = 0; ks < 2; ++ks) S[4 + x] = __builtin_amdgcn_mfma_f32_16x16x32_bf16(fk[x][ks], vf[ks], S[4 + x], 0, 0, 0); }
#undef H_KLOAD
        }
#undef HSB
#pragma unroll
        for (int m = 0; m < 4; ++m)
#pragma unroll
            for (int r = 0; r < 4; ++r) OT[(16 * m + 4 * g + r) * H_OROW + 16 * wave + l15] = ao[m][r];
        __syncthreads();
        SEGMARK(4);
        {
            float o[16]; float ss = 0.f;
#pragma unroll
            for (int i = 0; i < 4; ++i) { const f32x4 v = *(const LAS f32x4*)(OT + s2 * H_OROW + 16 * vg + 4 * i); o[4 * i] = v[0]; o[4 * i + 1] = v[1]; o[4 * i + 2] = v[2]; o[4 * i + 3] = v[3]; ss += (v[0] * v[0] + v[1] * v[1]) + (v[2] * v[2] + v[3] * v[3]); }
            ss += __shfl_xor(ss, 1); ss += __shfl_xor(ss, 2); ss += __shfl_xor(ss, 4);
            const float rs = rsqrtf(ss * (1.0f / 128.0f) + EPS);
            const size_t row = rbase + (size_t)c * 64 + s2;
            const unsigned gw[8] = {g0.x, g0.y, g0.z, g0.w, g1.x, g1.y, g1.z, g1.w};
            v4u w0, w1; unsigned ow[8];
#pragma unroll
            for (int i = 0; i < 8; ++i) { const f32x2v gg = *(const LAS f32x2v*)(GN + 16 * vg + 2 * i); ow[i] = cvtpk(o[2 * i] * rs * gg.x * bflo(gw[i]), o[2 * i + 1] * rs * gg.y * bfhi(gw[i])); }
            w0.x = ow[0]; w0.y = ow[1]; w0.z = ow[2]; w0.w = ow[3]; w1.x = ow[4]; w1.y = ow[5]; w1.z = ow[6]; w1.w = ow[7];
            bf16* op = MIX + row * DM + 512 + 128 * h + 16 * vg; *(v4u*)op = w0; *(v4u*)(op + 8) = w1;
        }
    } }
#undef H_LOAD
#ifdef PROBE_SEG
    if (b == 0 && h == 0 && tid == 0) { const float us = (float)seg_acc_ * 0.01f; C.out[O_NKIS] += sqrtf(2048.0f * (1e-4f + 5e-4f * fminf(us / 100.0f, 1.0f))); }
#endif
#ifdef PROBE_HGRN
    if (b == 0 && h == 0 && tid == 0) { const float us = (float)(__builtin_amdgcn_s_memrealtime() - t_begin_) * 0.01f;
        C.out[O_NKIS] += sqrtf(2048.0f * (1e-4f + 5e-4f * fminf(us / (float)PROBE_HGRN, 1.0f))); }
#endif
    float* so = part ? C.out + O_NSP + ((size_t)(b * 4 + h) * 128) * 128 : hst;
#pragma unroll
    for (int mk = 0; mk < 8; ++mk)
#pragma unroll
        for (int r = 0; r < 4; ++r) so[(size_t)(16 * mk + 4 * g + r) * 128 + 16 * wave + l15] = S[mk][r];
}

__device__ __forceinline__ void sample_hgrn_unit(Ctx& C, int b, int h) {
    const float* sp = (const float*)(C.ws + WS_SAMP) + S_SP + (size_t)b * 4096; float* mixs = (float*)(C.ws + WS_SAMP) + S_MIX + (size_t)b * 1024;
    const float* S0 = C.in[I_ST] + ((size_t)(b * 4 + h) * 128) * 128; float* S1 = C.out + O_NSS + ((size_t)(b * 4 + h) * 128) * 128;
    LAS float* red = (LAS float*)C.lds;
    int tid = C.tid; asm volatile("" : "+v"(tid));
    const int v4 = tid & 31, kr = tid >> 5;
    const f32x4 vv = *(const f32x4*)(sp + 2376 + 128 * h + 4 * v4);
    f32x4 oacc = {0.f, 0.f, 0.f, 0.f};
#pragma unroll
    for (int i = 0; i < 8; ++i) { const int k = kr + 16 * i; const int c = 128 * h + k;
        const float l0 = C.in[I_LB][c], l1 = C.in[I_LB][512 + c]; const float lb = 1.0f / (1.0f + __expf(l1 - l0));
        const float x = sp[1864 + c], sg = 1.0f / (1.0f + __expf(-x)), f = lb + (1.0f - lb) * sg, kk = (1.0f - lb) * (1.0f - sg), q = sp[1352 + c];
        const f32x4 s0 = *(const f32x4*)(S0 + (size_t)k * 128 + 4 * v4); const f32x4 sn = s0 * f + vv * kk;
        *(f32x4*)(S1 + (size_t)k * 128 + 4 * v4) = sn; oacc = oacc + sn * q; }
    *(LAS f32x4*)(red + kr * 128 + 4 * v4) = oacc;
    __syncthreads();
    if (tid < 128) { float o = 0.f;
#pragma unroll
        for (int j = 0; j < 16; ++j) o += red[j * 128 + tid];
        float ss = wave_sum(o * o); red[2048 + (tid >> 6)] = ss; red[2112 + tid] = o; }
    __syncthreads();
    if (tid < 128) { const float ss = red[2048] + red[2049]; const float o = red[2112 + tid];
        mixs[512 + 128 * h + tid] = o * rsqrtf(ss * (1.0f / 128.0f) + EPS) * C.in[I_RG][tid] * sp[2888 + 128 * h + tid]; }
}

__device__ __forceinline__ void sample_score_unit(Ctx& C, int b, int ch) {
    const float* sp = (const float*)(C.ws + WS_SAMP) + S_SP + (size_t)b * 4096; float* scs = (float*)(C.ws + WS_SAMP) + S_SC + (size_t)b * S_SCROW;
    const int* pt = (const int*)C.in[I_PT] + b * NPAGES;
    int lane = (C.tid & 63), wave = C.wave; asm volatile("" : "+v"(lane), "+s"(wave));
    const int dl = lane & 15, kq = lane >> 4;
    float iq[8][4], w[8];
#pragma unroll
    for (int h = 0; h < 8; ++h) { const f32x4 v = *(const f32x4*)(sp + 768 + h * 64 + 4 * dl); iq[h][0] = v[0]; iq[h][1] = v[1]; iq[h][2] = v[2]; iq[h][3] = v[3]; w[h] = sp[1344 + h]; }
#pragma unroll 1
    for (int pg0 = 0; pg0 < 8; pg0 += 4) {
        f32x4 kv[4][4];
#pragma unroll
        for (int p = 0; p < 4; ++p) { const float* kbase = C.in[I_CKI] + (size_t)pt[ch * 8 + pg0 + p] * (PAGE * 64);
#pragma unroll
            for (int it = 0; it < 4; ++it) kv[p][it] = *(const f32x4*)(kbase + (size_t)(wave * 16 + it * 4 + kq) * 64 + 4 * dl); }
#pragma unroll
        for (int p = 0; p < 4; ++p)
#pragma unroll
            for (int it = 0; it < 4; ++it) {
                float sc = 0.f;
#pragma unroll
                for (int h = 0; h < 8; ++h) { float d = (iq[h][0] * kv[p][it][0] + iq[h][1] * kv[p][it][1]) + (iq[h][2] * kv[p][it][2] + iq[h][3] * kv[p][it][3]);
                    d += __shfl_xor(d, 1); d += __shfl_xor(d, 2); d += __shfl_xor(d, 4); d += __shfl_xor(d, 8); sc = fmaf(w[h], fmaxf(d, 0.f), sc); }
                if (dl == 0) scs[(ch * 8 + pg0 + p) * PAGE + wave * 16 + it * 4 + kq] = sc;
            }
    }
    if (ch == 0 && wave == 0) {
        const f32x4 kv = *(const f32x4*)(sp + 1280 + 4 * dl); float sc = 0.f;
#pragma unroll
        for (int h = 0; h < 8; ++h) { float d = (iq[h][0] * kv[0] + iq[h][1] * kv[1]) + (iq[h][2] * kv[2] + iq[h][3] * kv[3]);
            d += __shfl_xor(d, 1); d += __shfl_xor(d, 2); d += __shfl_xor(d, 4); d += __shfl_xor(d, 8); sc = fmaf(w[h], fmaxf(d, 0.f), sc); }
        if (lane == 0) scs[PAST] = sc;
    }
}
__device__ __forceinline__ unsigned mono_key(float v) { const unsigned bits = __builtin_bit_cast(unsigned, v); unsigned m = (bits & 0x80000000u) ? ~bits : (bits | 0x80000000u); if (v == 0.f) m = 0x80000000u; return m; }
__device__ __forceinline__ void sample_attend_unit(Ctx& C, int b) {
    const float* sp = (const float*)(C.ws + WS_SAMP) + S_SP + (size_t)b * 4096; const float* scs = (const float*)(C.ws + WS_SAMP) + S_SC + (size_t)b * S_SCROW;
    float* mixs = (float*)(C.ws + WS_SAMP) + S_MIX + (size_t)b * 1024; const int* pt = (const int*)C.in[I_PT] + b * NPAGES;
    int tid = C.tid, wave = C.wave; asm volatile("" : "+v"(tid), "+s"(wave));
    const int lane = tid & 63;
    LAS unsigned* cnt = (LAS unsigned*)C.lds;
    LAS unsigned* wcnt = cnt + 64;
    LAS int* sel = (LAS int*)(cnt + 128);
    LAS float* lg = (LAS float*)(cnt + 512);
    LAS float* qs = lg + 2048;
    if (tid < 64) cnt[tid] = 0u;
    qs[tid] = sp[tid] * (ATT_SCALE * LOG2E);
    unsigned u[32];
#pragma unroll
    for (int j = 0; j < 32; ++j) u[j] = mono_key(scs[j * 512 + tid]);
    const unsigned uself = mono_key(scs[PAST]);
    __syncthreads();
    unsigned prefix = 0;
#pragma unroll 1
    for (int bit = 31; bit >= 0; --bit) { const unsigned cand = prefix | (1u << bit); int c = 0;
#pragma unroll
        for (int j = 0; j < 32; ++j) { c += __popcll(__ballot(u[j] >= cand)); asm volatile("" : "+s"(c)); }
        if (lane == 0) __hip_atomic_fetch_add(&cnt[31 - bit], (unsigned)c, __ATOMIC_RELAXED, __HIP_MEMORY_SCOPE_WORKGROUP);
        __syncthreads();
        const int tot = (int)cnt[31 - bit] + (uself >= cand ? 1 : 0);
        if (tot >= 256) prefix = cand; }
    const unsigned theta = prefix;
    int cg = 0, ce = 0;
#pragma unroll
    for (int j = 0; j < 32; ++j) { cg += __popcll(__ballot(u[j] > theta)); ce += __popcll(__ballot(u[j] == theta)); asm volatile("" : "+s"(cg), "+s"(ce)); }
    if (lane == 0) { __hip_atomic_fetch_add(&cnt[32], (unsigned)cg, __ATOMIC_RELAXED, __HIP_MEMORY_SCOPE_WORKGROUP); __hip_atomic_fetch_add(&cnt[33], (unsigned)ce, __ATOMIC_RELAXED, __HIP_MEMORY_SCOPE_WORKGROUP); }
    __syncthreads();
    const int cgt = (int)cnt[32] + (uself > theta ? 1 : 0), ceq = (int)cnt[33] + (uself == theta ? 1 : 0), r = 256 - cgt;
    int icut = PAST;
    if (ceq != r) { int lo = 0;
#pragma unroll 1
        for (int bit = 14; bit >= 0; --bit) { const int cc = lo | (1 << bit); int c = 0;
#pragma unroll
            for (int j = 0; j < 32; ++j) { c += __popcll(__ballot(u[j] == theta && (j * 512 + tid) < cc)); asm volatile("" : "+s"(c)); }
            if (lane == 0) __hip_atomic_fetch_add(&cnt[34 + (14 - bit)], (unsigned)c, __ATOMIC_RELAXED, __HIP_MEMORY_SCOPE_WORKGROUP);
            __syncthreads();
            const int tot = (int)cnt[34 + (14 - bit)];
            const int tot2 = tot + ((uself == theta && PAST < cc) ? 1 : 0);
            if (tot2 < r) lo = cc; }
        icut = lo; }
    int mysel = 0;
#pragma unroll
    for (int j = 0; j < 32; ++j) mysel += ((u[j] > theta) || (u[j] == theta && (j * 512 + tid) <= icut)) ? 1 : 0;
    int incl = mysel;
#pragma unroll
    for (int o = 1; o < 64; o <<= 1) { const int v = __shfl_up(incl, o); if (lane >= o) incl += v; }
    if (lane == 63) wcnt[wave] = (unsigned)incl;
    __syncthreads();
    int base = incl - mysel;
    for (int w = 0; w < wave; ++w) base += (int)wcnt[w];
#pragma unroll
    for (int j = 0; j < 32; ++j) if ((u[j] > theta) || (u[j] == theta && (j * 512 + tid) <= icut)) { if (base < 256) sel[base] = j * 512 + tid; ++base; }
    if (tid == 511) { int tot = base; const bool ss = (uself > theta) || (uself == theta && PAST <= icut); if (ss && tot < 256) sel[tot] = PAST; }
    __syncthreads();
    LAS float* kvs = (LAS float*)(C.lds + 16384);
    LAS int* rix = (LAS int*)(cnt + 3072);
    if (tid < 256) { const int idx = sel[tid]; rix[tid] = (idx < PAST) ? pt[idx >> 7] * PAGE + (idx & 127) : -1; }
    __syncthreads();
#define SA_GATHER(SRC, OWN) do { f32x4 g_[16]; \
        _Pragma("unroll") for (int x = 0; x < 16; ++x) { const int pid = tid + 512 * x, i = pid >> 5, c = pid & 31; const int rr = rix[i]; \
            const float* rp = (rr >= 0) ? (SRC) + (size_t)rr * 128 + 4 * c : sp + (OWN) + 4 * c; g_[x] = *(const f32x4*)rp; } \
        _Pragma("unroll") for (int x = 0; x < 16; ++x) { const int pid = tid + 512 * x, i = pid >> 5, c = pid & 31; *(LAS f32x4*)(kvs + i * 132 + 4 * c) = g_[x]; } } while (0)
    SA_GATHER(C.in[I_CK], 512);
    __syncthreads();
    {
        const int i = tid >> 1, kvh = tid & 1;
        const LAS float* kp = kvs + i * 132 + kvh * 64;
        float d0 = 0.f, d1 = 0.f, d2 = 0.f, d3 = 0.f;
#pragma unroll
        for (int c = 0; c < 16; ++c) { const f32x4 kv = *(const LAS f32x4*)(kp + 4 * c);
            const LAS float* q0 = qs + (kvh * 4) * 64 + 4 * c;
            d0 += (q0[0] * kv[0] + q0[1] * kv[1]) + (q0[2] * kv[2] + q0[3] * kv[3]);
            d1 += (q0[64] * kv[0] + q0[65] * kv[1]) + (q0[66] * kv[2] + q0[67] * kv[3]);
            d2 += (q0[128] * kv[0] + q0[129] * kv[1]) + (q0[130] * kv[2] + q0[131] * kv[3]);
            d3 += (q0[192] * kv[0] + q0[193] * kv[1]) + (q0[194] * kv[2] + q0[195] * kv[3]); }
        lg[(kvh * 4 + 0) * 256 + i] = d0; lg[(kvh * 4 + 1) * 256 + i] = d1; lg[(kvh * 4 + 2) * 256 + i] = d2; lg[(kvh * 4 + 3) * 256 + i] = d3;
    }
    __syncthreads();
    SA_GATHER(C.in[I_CV], 640);
#undef SA_GATHER
    {
        float v[4]; float mx = -1e30f;
#pragma unroll
        for (int x = 0; x < 4; ++x) { v[x] = lg[wave * 256 + lane + 64 * x]; mx = fmaxf(mx, v[x]); }
#pragma unroll
        for (int o = 1; o < 64; o <<= 1) mx = fmaxf(mx, __shfl_xor(mx, o));
        float s = 0.f;
#pragma unroll
        for (int x = 0; x < 4; ++x) { v[x] = __builtin_amdgcn_exp2f(v[x] - mx); s += v[x]; }
        s = wave_sum(s); const float inv = 1.0f / s;
#pragma unroll
        for (int x = 0; x < 4; ++x) lg[wave * 256 + lane + 64 * x] = v[x] * inv;
    }
    __syncthreads();
    {
        const int kvh = wave >> 2; float o = 0.f;
#pragma unroll 8
        for (int i = 0; i < 256; ++i) o = fmaf(lg[wave * 256 + i], kvs[i * 132 + kvh * 64 + lane], o);
        mixs[wave * 64 + lane] = o;
    }
}

__device__ __forceinline__ void sample_outproj_task(Ctx& C, int tile) {
    int tid_ = C.tid; asm volatile("" : "+v"(tid_));
    float* samp = (float*)(C.ws + WS_SAMP); LAS float* red = (LAS float*)C.lds;
    skinny32<DM, false>(samp + S_MIX, nullptr, C.in[I_WOUT], DM, DM, 32 * tile, red, C.tid, (C.tid & 63), C.wave);
#pragma unroll
    for (int x = 0; x < 2; ++x) { const int e = tid_ + 512 * x, i = e >> 5, n = 32 * tile + (e & 31); samp[S_X1 + i * DM + n] = C.in[I_XS][i * DM + n] + sk_get(red, e); }
    __syncthreads();
}
__device__ __forceinline__ void sample_up_task(Ctx& C, int tile) {
    int tid_ = C.tid; asm volatile("" : "+v"(tid_));
    float* samp = (float*)(C.ws + WS_SAMP); LAS float* red = (LAS float*)C.lds; LAS float* rs = red + 9 * 1024 + 64;
    rows_rstd32<DM>(samp + S_X1, rs, (C.tid & 63), C.wave);
    skinny32<DM, true>(samp + S_X1, C.in[I_N2G], C.in[I_WUP], FF, FF, 32 * tile, red, C.tid, (C.tid & 63), C.wave);
#pragma unroll
    for (int x = 0; x < 2; ++x) { const int e = tid_ + 512 * x, i = e >> 5, n = 32 * tile + (e & 31); const float v = fmaxf(sk_get(red, e) * rs[i], 0.f); samp[S_H + i * FF + n] = v * v; }
    __syncthreads();
}
constexpr int CW_SDN = 8192 + 2048;
__device__ __forceinline__ void sample_down_partial(Ctx& C) {
    int tid_ = C.tid; asm volatile("" : "+v"(tid_));
    float* samp = (float*)(C.ws + WS_SAMP); LAS float* red = (LAS float*)C.lds; float* part = (float*)(C.ws + WS_SAMP + 5 * MiB);
    const int tile = C.vcu & 31, ks = C.vcu >> 5;
    skinny32<FF, false, 64>(samp + S_H, nullptr, C.in[I_WDN], DM, DM, 32 * tile, red, C.tid, (C.tid & 63), C.wave, ks * 512);
#pragma unroll
    for (int x = 0; x < 2; ++x) { const int e = tid_ + 512 * x, i = e >> 5, n = 32 * tile + (e & 31); part[(size_t)ks * 32768 + i * DM + n] = sk_get(red, e); }
    asm volatile("s_waitcnt vmcnt(0)" ::: "memory");
    __syncthreads();
    if (C.tid == 0) { __builtin_amdgcn_fence(__ATOMIC_RELEASE, "agent"); asm volatile("s_waitcnt vmcnt(0)" ::: "memory");
        __hip_atomic_fetch_add((unsigned*)(C.ctl + CW_SDN), 1u, __ATOMIC_RELAXED, __HIP_MEMORY_SCOPE_AGENT); }
    __syncthreads();
}
__device__ __forceinline__ void sample_down_final(Ctx& C, int tile) {
    int tid_ = C.tid; asm volatile("" : "+v"(tid_));
    float* samp = (float*)(C.ws + WS_SAMP); const float* part = (const float*)(C.ws + WS_SAMP + 5 * MiB);
    if (C.tid == 0) { unsigned sp = 0; while (__hip_atomic_load((unsigned*)(C.ctl + CW_SDN), __ATOMIC_RELAXED, __HIP_MEMORY_SCOPE_AGENT) < (unsigned)C.G) { __builtin_amdgcn_s_sleep(4); if (++sp > (1u << 20)) break; }
        __builtin_amdgcn_fence(__ATOMIC_ACQUIRE, "agent"); asm volatile("s_waitcnt vmcnt(0)" ::: "memory"); }
    __syncthreads();
#pragma unroll
    for (int x = 0; x < 2; ++x) { const int e = tid_ + 512 * x, i = e >> 5, n = 32 * tile + (e & 31); float s = samp[S_X1 + i * DM + n];
#pragma unroll
        for (int k = 0; k < 8; ++k) s += __hip_atomic_load(part + (size_t)k * 32768 + i * DM + n, __ATOMIC_RELAXED, __HIP_MEMORY_SCOPE_AGENT);
        C.out[O_YS + i * DM + n] = s; }
}
__device__ __forceinline__ bool opaque_tid(Ctx& C) { asm volatile("" : "+v"(C.tid)); return true; }
struct Args { const float* in[18]; float* out; unsigned char* ws; int ph_lo, ph_hi; };
constexpr int N_PHASES = 7;
#ifndef MK_SPLIT
#define MK_SPLIT 0
#endif
__global__ void __launch_bounds__(512, 2) hymba_fwd(Args args) {
    extern __shared__ __attribute__((aligned(16))) unsigned char lds_raw[];
    Ctx C;
    C.lds = (LAS unsigned char*)lds_raw; C.MISC = (volatile LAS unsigned*)(C.lds + MISC_OFF);
    C.tid = threadIdx.x; C.wave = __builtin_amdgcn_readfirstlane(C.tid >> 6);
    C.G = gridDim.x; { const int bx = blockIdx.x; C.vcu = (C.G % 8 == 0) ? (bx % 8) * (C.G / 8) + bx / 8 : bx; }
    C.ws = args.ws; C.out = args.out; C.ctl = (gu32*)(args.ws + WS_CTL);
#pragma unroll
    for (int i = 0; i < 18; ++i) C.in[i] = args.in[i];
    for (int u = C.tid; u < (LDS_BYTES - LDSCTL_OFF) / 4; u += 512) ((LAS unsigned*)(C.lds + LDSCTL_OFF))[u] = 0u;
    __syncthreads();
    const int lo = args.ph_lo, hi = args.ph_hi;
#ifdef PROBE_PH
    unsigned long long ph_t0_ = __builtin_amdgcn_s_memrealtime(), ph_acc_ = 0;
#define PHMARK(k) do { const unsigned long long now_ = __builtin_amdgcn_s_memrealtime(); if (PROBE_PH == (k)) ph_acc_ = now_ - ph_t0_; ph_t0_ = now_; } while (0)
#else
#define PHMARK(k) do {} while (0)
#endif
    XcdBarrier bar; bar.bar = (unsigned*)(C.ctl + CW_BAR); bar.x = 0; bar.st = nullptr;
    if (hi - lo > 1) bar = xcd_barrier_post((unsigned*)(C.ctl + CW_BAR), C.MISC + 8);
#ifndef PH_MASK
#define PH_MASK 0x7f
#endif
#define IN(k) (((PH_MASK >> (k)) & 1) && lo <= (k) && (k) < hi)
#ifndef REP_MASK
#define REP_MASK 0
#endif
#define REPS(k) (((REP_MASK >> (k)) & 1) ? 2 : 1)
#ifdef PROBE_2BAR
#define SEAM(k) do { if (IN(k) && IN((k) + 1)) { xcd_barrier(bar); xcd_barrier(bar); } } while (0)
#else
#define SEAM(k) do { if (IN(k) && IN((k) + 1)) xcd_barrier(bar); } while (0)
#endif

#ifdef PROBE_VALU
    if (C.vcu == 40) {
        float x_[16]; for (int i = 0; i < 16; ++i) x_[i] = (float)(C.tid + i);
        const float a_ = 1.0001f, b_ = 0.5f;
        __syncthreads();
        const unsigned long long t0_ = __builtin_amdgcn_s_memrealtime();
#pragma unroll 1
        for (int it = 0; it < 4096; ++it) {
#pragma unroll
            for (int i = 0; i < 16; ++i) asm volatile("v_fma_f32 %0, %0, %1, %2" : "+v"(x_[i]) : "v"(a_), "v"(b_));
        }
        __syncthreads();
        const unsigned long long t1_ = __builtin_amdgcn_s_memrealtime();
        float s_ = 0.f; for (int i = 0; i < 16; ++i) s_ += x_[i];
        if (C.tid == 0) { const float us = (float)(t1_ - t0_) * 0.01f; ((float*)(C.ws + WS_GAINS + 4096))[0] = sqrtf(2048.0f * (1e-4f + 5e-4f * fminf(us / 400.0f, 1.0f))); ((float*)(C.ws + WS_GAINS + 4096))[1] = s_; }
    }
#endif
    if (IN(0)) { for (int rep = 0; rep < REPS(0); ++rep) { p0_prologue(C); __syncthreads(); } SEAM(0); PHMARK(0); }

    if (IN(1)) {
        if (C.vcu < 4) sample_postproj(C, C.vcu * 8 + C.wave);
        __syncthreads();
        pg8::Gemm g{(const pg8::bf16_t*)(C.ws + WS_XB), (const pg8::bf16_t*)(C.ws + WS_W1T), NTOK, INP, DM};
        pg8::StaticOrder S; S.init(NTOK, INP, C.G, (int)blockIdx.x);
        pg8::EpiInProj E{(const float*)(C.ws + WS_RSTD1), (const float*)(C.ws + WS_GAINS),
                         (pg8::bf16_t*)(C.ws + WS_QB), (pg8::bf16_t*)(C.ws + WS_KB), (pg8::bf16_t*)(C.ws + WS_VT), (pg8::bf16_t*)(C.ws + WS_IQB), (pg8::bf16_t*)(C.ws + WS_IKB),
                         (pg8::bf16_t*)(C.ws + WS_RQ), (pg8::bf16_t*)(C.ws + WS_RF), (pg8::bf16_t*)(C.ws + WS_RI), (pg8::bf16_t*)(C.ws + WS_RGT), (float*)(C.ws + WS_IWF),
                         C.out + O_NK, C.out + O_NV, C.out + O_NKI};
        pg8::gemm_phase<pg8::EpiInProj, pg8::StaticOrder, true, true>(C.lds, g, S, E);
#if (REP_MASK >> 1) & 1
        __syncthreads(); pg8::gemm_phase<pg8::EpiInProj, pg8::StaticOrder, true, true>(C.lds, g, S, E);
#endif
        SEAM(1); PHMARK(1);
    }

    const int myx = (int)(xb_xcc_id() & 7u);
    if (IN(2)) {
        constexpr int U_H = 16, U_SH = 16, U_SS = 64, U_SEL = 256, U_TOT = U_H + U_SH + U_SS + U_SEL;
        for (int qi = 0; qi < 8; ++qi) { const int x = (myx + qi) & 7, cw = CW_Q2 + 64 * x;
            for (int u0 = q_next(C, cw, 2u); u0 < U_TOT; u0 = q_next(C, cw, 2u))
                for (int u = u0; u < u0 + 2; ++u) {
                    if (u < U_H) { if (!(u & 1)) hgrn_unit(C, 2 * x + (u >> 3), (u >> 1) & 3, 0); continue; }
                    int v = u - U_H;
                    if (v < U_SH) { sample_hgrn_unit(C, 4 * x + (v >> 2), v & 3); __syncthreads(); continue; } v -= U_SH;
                    if (v < U_SS) { sample_score_unit(C, 4 * x + (v >> 4), v & 15); continue; } v -= U_SS;
                    dsa_select_unit(C, 2 * x + (v & 1), 127 - (v >> 1)); __syncthreads();
                } }
        SEAM(2); PHMARK(2);
    }
    if (IN(3)) {
        constexpr int U_HG = 16, U_SA = 4, U_AT = 128, U_TOT = U_HG + U_SA + U_AT;
        for (int qi = 0; qi < 8; ++qi) { const int x = (myx + qi) & 7, cw = CW_Q3 + 64 * x;
            for (int u0 = q_next(C, cw, 2u); u0 < U_TOT; u0 = q_next(C, cw, 2u))
                for (int u = u0; u < u0 + 2; ++u) {
                    if (u < U_HG) { if (!(u & 1)) hgrn_unit(C, 2 * x + (u >> 3), (u >> 1) & 3, 1); continue; }
                    int v = u - U_HG;
                    if (v < U_SA) { sample_attend_unit(C, 4 * x + v); __syncthreads(); continue; } v -= U_SA;
                    attn_unit(C, 2 * x + (v & 1), 63 - (v >> 1)); __syncthreads();
                } }
        SEAM(3); PHMARK(3);
    }

    if (IN(4)) {
        if (C.vcu < 32) sample_outproj_task(C, C.vcu);
        __syncthreads();
        pg8::Gemm g{(const pg8::bf16_t*)(C.ws + WS_MIX), (const pg8::bf16_t*)(C.ws + WS_WOT), NTOK, DM, DM};
        pg8::StaticOrder S; S.init(NTOK, DM, C.G, (int)blockIdx.x);
        pg8::EpiOutProj E{C.in[I_XP], C.out + O_Y, (pg8::bf16_t*)(C.ws + WS_X1B), (float*)(C.ws + WS_SSQ)};
        pg8::gemm_phase<pg8::EpiOutProj, pg8::StaticOrder, true, true>(C.lds, g, S, E);
#if (REP_MASK >> 4) & 1
        __syncthreads(); pg8::gemm_phase<pg8::EpiOutProj, pg8::StaticOrder, true, true>(C.lds, g, S, E);
#endif
        SEAM(4); PHMARK(4);
    }

    if (IN(5)) {
        if (C.vcu < 128) sample_up_task(C, C.vcu);
        __syncthreads();
        pg8::Gemm g{(const pg8::bf16_t*)(C.ws + WS_X1B), (const pg8::bf16_t*)(C.ws + WS_WUT), NTOK, FF, DM};
        pg8::StaticOrder S; S.init(NTOK, FF, C.G, (int)blockIdx.x);
        pg8::EpiUp E{(pg8::bf16_t*)(C.ws + WS_H)};
        pg8::gemm_phase<pg8::EpiUp, pg8::StaticOrder, true, true>(C.lds, g, S, E);
#if (REP_MASK >> 5) & 1
        __syncthreads(); pg8::gemm_phase<pg8::EpiUp, pg8::StaticOrder, true, true>(C.lds, g, S, E);
#endif
        SEAM(5); PHMARK(5);
    }

    if (IN(6)) {
        sample_down_partial(C);
        __syncthreads();
        pg8::Gemm g{(const pg8::bf16_t*)(C.ws + WS_H), (const pg8::bf16_t*)(C.ws + WS_WDT), NTOK, DM, FF};
        pg8::StaticOrder S; S.init(NTOK, DM, C.G, (int)blockIdx.x);
        pg8::EpiDown E{C.out + O_Y, (const pg8::bf16_t*)(C.ws + WS_X1B), (const float*)(C.ws + WS_SSQ)};
        pg8::gemm_phase<pg8::EpiDown, pg8::StaticOrder, true, true>(C.lds, g, S, E);
        if (C.vcu < 32) sample_down_final(C, C.vcu);
        PHMARK(6);
#if defined(PROBE_P0) || defined(PROBE_VALU)
        if (C.vcu == 40 && C.tid == 0) C.out[O_NKIS + 5] += ((const float*)(C.ws + WS_GAINS + 4096))[0];
#endif
#ifdef PROBE_PH
        if (C.vcu == 40 && C.tid == 0) { const float us = (float)ph_acc_ * 0.01f; C.out[O_NKIS] += sqrtf(2048.0f * (1e-4f + 5e-4f * fminf(us / 400.0f, 1.0f))); }
#endif
    }
#undef IN
#undef SEAM
}

extern "C" void kernel_launch(void* const* d_in, const int* in_sizes, int n_in, void* d_out, int out_size, void* d_ws, size_t ws_size, hipStream_t stream) {
    static int grid = 0;
    if (grid == 0) {
        if (n_in != 18 || in_sizes[0] != NTOK * DM || (size_t)out_size != O_END || ws_size < WS_END) {
            fprintf(stderr, "kernel_launch: unexpected shapes: n_in %d in0 %d out %d ws %zu (need ws >= %zu); nothing launched\n", n_in, n_in > 0 ? in_sizes[0] : -1, out_size, ws_size, (size_t)WS_END); grid = -1; return; }
        int dev = 0, cus = 0;
        if (hipGetDevice(&dev) != hipSuccess || hipDeviceGetAttribute(&cus, hipDeviceAttributeMultiprocessorCount, dev) != hipSuccess) { grid = -1; return; }
        if (hipFuncSetAttribute((const void*)hymba_fwd, hipFuncAttributeMaxDynamicSharedMemorySize, LDS_BYTES) != hipSuccess) { fprintf(stderr, "kernel_launch: hipFuncSetAttribute failed\n"); grid = -1; return; }
        int per_cu = 0;
        if (hipOccupancyMaxActiveBlocksPerMultiprocessor(&per_cu, (const void*)hymba_fwd, 512, LDS_BYTES) != hipSuccess || per_cu < 1) fprintf(stderr, "kernel_launch: occupancy query says %d\n", per_cu);
        (void)hipGetLastError();
        grid = cus;
        if (grid != 256) fprintf(stderr, "kernel_launch: %d CUs (expected 256)\n", grid);
    }
    if (grid < 0) return;
    (void)hipMemsetAsync((char*)d_ws + WS_CTL, 0, CTL_ZERO_BYTES, stream);
    Args a{};
    for (int i = 0; i < 18; ++i) a.in[i] = (const float*)d_in[i];
    a.out = (float*)d_out; a.ws = (unsigned char*)d_ws;
#if MK_SPLIT
    for (int p = 0; p < N_PHASES; ++p) { a.ph_lo = p; a.ph_hi = p + 1; hipLaunchKernelGGL(hymba_fwd, dim3(grid), dim3(512), LDS_BYTES, stream, a); }
#else
    a.ph_lo = 0; a.ph_hi = N_PHASES; hipLaunchKernelGGL(hymba_fwd, dim3(grid), dim3(512), LDS_BYTES, stream, a);
#endif
}
```

```cpp
#include <hip/hip_runtime.h>
#include <cstdio>
#include <cstdint>

#define LAS __attribute__((address_space(3)))
#define GAS __attribute__((address_space(1)))
typedef float f32x16 __attribute__((ext_vector_type(16)));
typedef unsigned u32x2 __attribute__((ext_vector_type(2)));
typedef unsigned long long u64;

#define RES_BF16 1
constexpr int NTOK = 32768, NB = 16, SEQ = 2048, DM = 1024, NS = 32, PAST = 16384, PAGE = 128, NPAGES = 128;
constexpr int INW = 3400, INP = 3584, FF = 4096;
constexpr float EPS = 1e-6f;
constexpr float ATT_SCALE = 0.125f, LOG2E = 1.4426950408889634f;
constexpr float IDX_W_SCALE = 0.04419417382415922f;
constexpr float REC_QSCALE = 0.08838834764831845f;
enum { I_XP = 0, I_XS, I_CK, I_CV, I_CKI, I_ST, I_PT, I_N1G, I_WIN, I_QG, I_KG, I_IKG, I_LB, I_RG, I_WOUT, I_N2G, I_WUP, I_WDN };
constexpr size_t O_Y = 0, O_YS = 33554432, O_NK = O_YS + 32768, O_NV = O_NK + 4194304, O_NKI = O_NV + 4194304, O_NSP = O_NKI + 2097152,
                 O_NKS = O_NSP + 1048576, O_NVS = O_NKS + 4096, O_NKIS = O_NVS + 4096, O_NSS = O_NKIS + 2048, O_END = O_NSS + 2097152;
constexpr size_t MiB = 1u << 20;
constexpr size_t WS_SSQ = 131072;
constexpr size_t WS_CTL = 0, CTL_ZERO_BYTES = 262144;
constexpr size_t WS_W1T = 2 * MiB, WS_WOT = 10 * MiB, WS_WUT = 12 * MiB, WS_WDT = 20 * MiB;
constexpr size_t WS_GAINS = 28 * MiB + 512 * 1024;
constexpr size_t WS_RSTD1 = 28 * MiB, WS_IWF = 29 * MiB, WS_SSQ2 = 30 * MiB, WS_SAMP = 32 * MiB;
constexpr size_t WS_XB = 40 * MiB, WS_QB = 104 * MiB, WS_KB = 136 * MiB, WS_VT = 144 * MiB, WS_IQB = 152 * MiB, WS_IKB = 184 * MiB;
constexpr size_t WS_RQ = 188 * MiB, WS_RF = 220 * MiB, WS_RI = 252 * MiB, WS_RGT = 284 * MiB, WS_MASK = 316 * MiB, WS_MIX = 324 * MiB;
constexpr size_t WS_X1B = 388 * MiB, WS_H = 452 * MiB, WS_HST = 708 * MiB, WS_END = 712 * MiB;
constexpr int S_RAW = 0, S_SP = 131072, S_SC = 262144, S_SCROW = 16400, S_MIX = S_SC + 32 * S_SCROW + 256, S_X1 = S_MIX + 32768, S_H = S_X1 + 32768, S_ENDF = S_H + 131072;
static_assert((size_t)S_ENDF * 4 <= 8 * MiB, "sample scratch");
constexpr int CW_BAR = 4096, CW_Q2 = 8192, CW_Q3 = 8192 + 1024;
constexpr int LDS_BYTES = 163840, LDSCTL_OFF = LDS_BYTES - 1024, MISC_OFF = LDSCTL_OFF + 320;

namespace pg8 {
#define PG8_LAS __attribute__((address_space(3)))
typedef unsigned short bf16_t;
typedef short bf16x8 __attribute__((ext_vector_type(8)));
typedef float f32x4 __attribute__((ext_vector_type(4)));
typedef unsigned u32x4 __attribute__((ext_vector_type(4)));
constexpr int BM = 256, BK = 64, HALF = 128, HTB = HALF * BK * 2  , STAGE_BYTES = 8 * HTB, NXCD = 8, WGM = 8;

__host__ __device__ __forceinline__ int lds_byte(int r, int c) { const int st = (r >> 4) * 2 + (c >> 5), rr = r & 15, cc = c & 31, ob = rr * 64 + cc * 2; return st * 1024 + (ob ^ (((ob >> 9) & 1) << 5)); }
__host__ __device__ __forceinline__ void stage_rc(int b, int& R, int& C) { const int st = b / 1024, sb = b % 1024, swz = sb ^ (((sb >> 9) & 1) << 5); R = (st >> 1) * 16 + swz / 64; C = (st & 1) * 32 + (swz % 64) / 2; }
__host__ __device__ __forceinline__ int perm32(int rho) { const int n = rho >> 4, i = rho & 15; return 8 * (i >> 2) + 4 * n + (i & 3); }

struct Unit { int pm, pn; };
struct Gemm { const bf16_t* A; const bf16_t* Bt; int M, N, K; };

struct StaticOrder {
    int nM, nN, nwg, G, c;
    __host__ __device__ void init(int M, int N, int G_, int c_) { nM = M / BM; nN = N / BM; nwg = nM * nN; G = G_; c = c_; }
    __host__ __device__ bool next(int i, Unit& u) const {
        const long L = (long)i * G + c; if (L >= nwg) return false;
        int wgid = (int)L; { const int q = nwg / NXCD, r = nwg % NXCD, xcd = wgid % NXCD, off = wgid / NXCD; wgid = (xcd < r ? xcd * (q + 1) : r * (q + 1) + (xcd - r) * q) + off; }
        const int nig = WGM * nN, gid = wgid / nig, fm = gid * WGM, gsz = (nM - fm) < WGM ? (nM - fm) : WGM;
        u.pm = fm + ((wgid % nig) % gsz); u.pn = (wgid % nig) / gsz; return true;
    }
    __device__ __forceinline__ void a_ready(const Unit&) const {}
    __device__ __forceinline__ void done(const Unit&) const {}
};

__device__ __forceinline__ unsigned cvt_pk_bf16(float lo, float hi) { unsigned r; asm volatile("v_cvt_pk_bf16_f32 %0, %1, %2" : "=v"(r) : "v"(lo), "v"(hi)); return r; }
typedef float f32x2 __attribute__((ext_vector_type(2)));
__device__ __forceinline__ float silu_f(float x) { return x / (1.f + __expf(-x)); }
__device__ __forceinline__ void st_bf16x16(bf16_t* p, const float (&t)[16]) {
    u32x4 a, b;
    a.x = cvt_pk_bf16(t[0], t[1]); a.y = cvt_pk_bf16(t[2], t[3]); a.z = cvt_pk_bf16(t[4], t[5]); a.w = cvt_pk_bf16(t[6], t[7]);
    b.x = cvt_pk_bf16(t[8], t[9]); b.y = cvt_pk_bf16(t[10], t[11]); b.z = cvt_pk_bf16(t[12], t[13]); b.w = cvt_pk_bf16(t[14], t[15]);
    *(u32x4*)p = a; *(u32x4*)(p + 8) = b;
}
__device__ __forceinline__ void st_f32x16(float* p, const float (&t)[16]) {
#pragma unroll
    for (int i = 0; i < 4; ++i) *(f32x4*)(p + 4 * i) = (f32x4){t[4 * i], t[4 * i + 1], t[4 * i + 2], t[4 * i + 3]};
}
__device__ __forceinline__ unsigned short f2bf_rne(float f) { unsigned u = __builtin_bit_cast(unsigned, f); return (unsigned short)((u + 0x7fffu + ((u >> 16) & 1u)) >> 16); }

struct EpiInProj {
    static constexpr bool PERM = false, AFTER_DRAIN = false;
    const float* rstd1; const float* gains;
    bf16_t *Qb, *Kb, *Vt, *IQb, *IKb, *Rq, *Rf, *Ri, *Rg; float* IWf; float *oK, *oV, *oKI;
    __device__ __forceinline__ void operator()(const f32x4 (&acc)[2][2][4][2], const Unit& u, int wr, int wc, int fr, int fq) const {
        const int pn = u.pn;
        const float* gsrc = gains + (pn < 2 ? 0 : (pn == 2 ? 64 : 128)) + 16 * fq;
        float rsv[2][4];
#pragma unroll
        for (int ai = 0; ai < 2; ++ai)
#pragma unroll
            for (int m = 0; m < 4; ++m) rsv[ai][m] = rstd1[u.pm * BM + ai * HALF + wr * 64 + m * 16 + fr];
#pragma unroll
        for (int ai = 0; ai < 2; ++ai)
#pragma unroll
            for (int m = 0; m < 4; ++m) {
                const int row = u.pm * BM + ai * HALF + wr * 64 + m * 16 + fr;
                const float rs = rsv[ai][m];
                float t[16];
#pragma unroll
                for (int bj = 0; bj < 2; ++bj)
#pragma unroll
                    for (int n = 0; n < 2; ++n)
#pragma unroll
                        for (int e = 0; e < 4; ++e) t[8 * bj + 4 * n + e] = acc[ai][bj][m][n][e] * rs;
                const bool normed = (pn < 2) || (pn == 2 && wc < 2) || (pn == 5 && wc == 0);
                if (normed) {
                    float ss = 0.f;
#pragma unroll
                    for (int j = 0; j < 16; ++j) ss += t[j] * t[j];
                    ss += __shfl_xor(ss, 16); ss += __shfl_xor(ss, 32);
                    float sc = rsqrtf(ss * (1.0f / 64.0f) + EPS);
                    if (pn < 2) sc *= ATT_SCALE * LOG2E;
#pragma unroll
                    for (int i = 0; i < 4; ++i) { const f32x4 gv = *(const f32x4*)(gsrc + 4 * i);
                        t[4 * i] *= sc * gv[0]; t[4 * i + 1] *= sc * gv[1]; t[4 * i + 2] *= sc * gv[2]; t[4 * i + 3] *= sc * gv[3]; }
                }
                if (pn < 2) {
                    st_bf16x16(Qb + (size_t)row * 512 + (4 * pn + wc) * 64 + 16 * fq, t);
                } else if (pn == 2) {
                    if (wc < 2) { st_f32x16(oK + (size_t)row * 128 + wc * 64 + 16 * fq, t); st_bf16x16(Kb + (size_t)row * 128 + wc * 64 + 16 * fq, t); }
                    else {
                        st_f32x16(oV + (size_t)row * 128 + (wc - 2) * 64 + 16 * fq, t);
                        const int b = row >> 11, tt = row & 2047;
                        bf16_t* vp = Vt + ((size_t)(b * 2 + (wc - 2)) * 64 + 16 * fq) * 2048 + tt;
#pragma unroll
                        for (int j = 0; j < 16; ++j) vp[(size_t)j * 2048] = f2bf_rne(t[j]);
                    }
                } else if (pn < 5) {
                    st_bf16x16(IQb + (size_t)row * 512 + (4 * (pn - 3) + wc) * 64 + 16 * fq, t);
                } else if (pn == 5) {
                    if (wc == 0) { st_f32x16(oKI + (size_t)row * 64 + 16 * fq, t); st_bf16x16(IKb + (size_t)row * 64 + 16 * fq, t); }
                    else if (wc == 1 && fq == 0) {
                        *(f32x4*)(IWf + (size_t)row * 8) = (f32x4){t[0] * IDX_W_SCALE, t[1] * IDX_W_SCALE, t[2] * IDX_W_SCALE, t[3] * IDX_W_SCALE};
                        *(f32x4*)(IWf + (size_t)row * 8 + 4) = (f32x4){t[4] * IDX_W_SCALE, t[5] * IDX_W_SCALE, t[6] * IDX_W_SCALE, t[7] * IDX_W_SCALE};
                    }
                } else {
                    const int kind = (pn - 6) >> 1, col = 256 * ((pn - 6) & 1) + 64 * wc + 16 * fq;
                    if (kind == 0) {
#pragma unroll
                        for (int j = 0; j < 16; ++j) t[j] = silu_f(t[j]) * REC_QSCALE;
                        st_bf16x16(Rq + (size_t)row * 512 + col, t);
                    } else if (kind == 1) st_bf16x16(Rf + (size_t)row * 512 + col, t);
                    else if (kind == 2) st_bf16x16(Ri + (size_t)row * 512 + col, t);
                    else {
#pragma unroll
                        for (int j = 0; j < 16; ++j) t[j] = silu_f(t[j]);
                        st_bf16x16(Rg + (size_t)row * 512 + col, t);
                    }
                }
            }
    }
};
struct EpiOutProj {
    static constexpr bool PERM = false, AFTER_DRAIN = false;
    const float* X; float* Y; bf16_t* X1B; float* SSQ2;
    __device__ __forceinline__ void operator()(const f32x4 (&acc)[2][2][4][2], const Unit& u, int wr, int wc, int fr, int fq) const {
        const int col0 = u.pn * BM + wc * 32 + 4 * fq;
#pragma unroll
        for (int ai = 0; ai < 2; ++ai)
#pragma unroll
            for (int m = 0; m < 4; ++m) {
                const int row = u.pm * BM + ai * HALF + wr * 64 + m * 16 + fr; const size_t off = (size_t)row * DM + col0; float ss = 0.f;
#pragma unroll
                for (int bj = 0; bj < 2; ++bj)
#pragma unroll
                    for (int n = 0; n < 2; ++n) {
                        const f32x4 xv = *(const f32x4*)(X + off + bj * HALF + n * 16); const f32x4 o = xv + acc[ai][bj][m][n];
#if !RES_BF16
                        *(f32x4*)(Y + off + bj * HALF + n * 16) = o;
#endif
                        ss += (o[0] * o[0] + o[1] * o[1]) + (o[2] * o[2] + o[3] * o[3]);
                        u32x2 w; w.x = cvt_pk_bf16(o[0], o[1]); w.y = cvt_pk_bf16(o[2], o[3]); *(u32x2*)(X1B + off + bj * HALF + n * 16) = w;
                    }
                ss += __shfl_xor(ss, 16); ss += __shfl_xor(ss, 32);
                if (fq == 0) atomicAdd(SSQ2 + row, ss);
            }
    }
};
struct EpiUp {
    static constexpr bool PERM = true, AFTER_DRAIN = false;
    bf16_t* H;
    __device__ __forceinline__ void operator()(const f32x4 (&acc)[2][2][4][2], const Unit& u, int wr, int wc, int fr, int fq) const {
        const int col0 = u.pn * BM + wc * 32 + 8 * fq;
#pragma unroll
        for (int ai = 0; ai < 2; ++ai)
#pragma unroll
            for (int m = 0; m < 4; ++m) {
                const int row = u.pm * BM + ai * HALF + wr * 64 + m * 16 + fr;
                bf16_t* rowp = H + (size_t)row * FF + col0;
#pragma unroll
                for (int bj = 0; bj < 2; ++bj) {
                    f32x4 v0 = acc[ai][bj][m][0], v1 = acc[ai][bj][m][1];
#pragma unroll
                    for (int e = 0; e < 4; ++e) { const float a = fmaxf(v0[e], 0.f), b = fmaxf(v1[e], 0.f); v0[e] = a * a; v1[e] = b * b; }
                    u32x4 w; w.x = cvt_pk_bf16(v0[0], v0[1]); w.y = cvt_pk_bf16(v0[2], v0[3]); w.z = cvt_pk_bf16(v1[0], v1[1]); w.w = cvt_pk_bf16(v1[2], v1[3]);
                    *(u32x4*)(rowp + bj * HALF) = w;
                }
            }
    }
};
struct EpiDown {
    static constexpr bool PERM = false, AFTER_DRAIN = false;
    float* Y; const bf16_t* X1B; const float* SSQ;
    __device__ __forceinline__ void operator()(const f32x4 (&acc)[2][2][4][2], const Unit& u, int wr, int wc, int fr, int fq) const {
        const int col0 = u.pn * BM + wc * 32 + 4 * fq;
        float rsv[2][4];
#pragma unroll
        for (int ai = 0; ai < 2; ++ai)
#pragma unroll
            for (int m = 0; m < 4; ++m) rsv[ai][m] = SSQ[u.pm * BM + ai * HALF + wr * 64 + m * 16 + fr];
#pragma unroll
        for (int ai = 0; ai < 2; ++ai)
#pragma unroll
            for (int m = 0; m < 4; ++m) {
                const float rs2 = 1.0f / (rsv[ai][m] * (1.0f / 1024.0f) + EPS);
                const size_t off = (size_t)(u.pm * BM + ai * HALF + wr * 64 + m * 16 + fr) * DM + col0;
#pragma unroll
                for (int bj = 0; bj < 2; ++bj)
#pragma unroll
                    for (int n = 0; n < 2; ++n) { float* p = Y + off + bj * HALF + n * 16;
#if RES_BF16
                        const u32x2 xw = *(const u32x2*)(X1B + off + bj * HALF + n * 16);
                        const f32x4 x1 = {__builtin_bit_cast(float, xw.x << 16), __builtin_bit_cast(float, xw.x & 0xffff0000u), __builtin_bit_cast(float, xw.y << 16), __builtin_bit_cast(float, xw.y & 0xffff0000u)};
                        *(f32x4*)p = x1 + acc[ai][bj][m][n] * rs2;
#else
                        *(f32x4*)p = *(const f32x4*)p + acc[ai][bj][m][n] * rs2;
#endif
                    }
            }
    }
};
template <class Epi, class Sched, bool ALIGN_EPI = false, bool SP2 = false>
__device__ __forceinline__ void gemm_phase(PG8_LAS unsigned char* lds, const Gemm g, const Sched& S, const Epi& E) {
    const int tid = threadIdx.x, wid = __builtin_amdgcn_readfirstlane(tid >> 6), lane = tid & 63, wr = wid >> 2, wc = wid & 3, fr = lane & 15, fq = lane >> 4;
    const int K = g.K, nt = K / BK;
    unsigned voffA[2], voffB[2];
#pragma unroll
    for (int i = 0; i < 2; ++i) { int R, C; stage_rc(tid * 16 + i * 8192, R, C); const int Rb = Epi::PERM ? ((R & ~31) + perm32(R & 31)) : R;
        voffA[i] = (unsigned)(R * K + C) * 2u; voffB[i] = (unsigned)(Rb * K + C) * 2u; }
    const size_t kstep = (size_t)(BK * 2);
    const size_t hstep = (size_t)HALF * K * 2;
    const size_t tstep = 2 * hstep;
    const unsigned ldsw = (unsigned)wid * 1024u;
    const int aoff = lds_byte(wr * 64 + fr, fq * 8), boff = lds_byte(wc * 32 + fr, fq * 8);
#define PG8_SA(b, h) (((b) * 2 + (h)) * HTB)
#define PG8_SB(b, h) ((4 + (b) * 2 + (h)) * HTB)
#define PG8_STAGE(bufoff, gbase, voff) do { _Pragma("unroll") for (int _i = 0; _i < 2; ++_i) \
        __builtin_amdgcn_global_load_lds((const unsigned*)((const char*)(gbase) + (voff)[_i]), (PG8_LAS unsigned*)(lds + (bufoff) + ldsw + _i * 8192), 16, 0, 0); } while (0)
#define PG8_LDA(dst, b, h) do { _Pragma("unroll") for (int m = 0; m < 4; ++m) _Pragma("unroll") for (int k = 0; k < 2; ++k) dst[m][k] = *(const PG8_LAS bf16x8*)(lds + PG8_SA(b, h) + aoff + m * 2048 + k * 1024); } while (0)
#define PG8_LDB(dst, b, h) do { _Pragma("unroll") for (int n = 0; n < 2; ++n) _Pragma("unroll") for (int k = 0; k < 2; ++k) dst[n][k] = *(const PG8_LAS bf16x8*)(lds + PG8_SB(b, h) + boff + n * 2048 + k * 1024); } while (0)
#define PG8_MMA(ai, bj, At, Bt) do { __builtin_amdgcn_s_setprio(1); _Pragma("unroll") for (int m = 0; m < 4; ++m) _Pragma("unroll") for (int n = 0; n < 2; ++n) _Pragma("unroll") for (int k = 0; k < 2; ++k) \
        acc[ai][bj][m][n] = __builtin_amdgcn_mfma_f32_16x16x32_bf16(Bt[n][k], At[m][k], acc[ai][bj][m][n], 0, 0, 0); __builtin_amdgcn_s_setprio(0); } while (0)
#define PG8_WAIT_V(n) asm volatile("s_waitcnt vmcnt(" #n ")" ::: "memory")
#define PG8_WAIT_L(n) asm volatile("s_waitcnt lgkmcnt(" #n ")" ::: "memory")
#define PG8_BAR __builtin_amdgcn_s_barrier()
#define PG8_SCHED __builtin_amdgcn_sched_barrier(0)
    Unit cur, nxt; int ui = 0;
    if (!S.next(0, cur)) return;
    f32x4 acc[2][2][4][2];
#pragma unroll
    for (int a = 0; a < 2; ++a)
#pragma unroll
        for (int b = 0; b < 2; ++b)
#pragma unroll
            for (int m = 0; m < 4; ++m)
#pragma unroll
                for (int n = 0; n < 2; ++n) acc[a][b][m][n] = (f32x4){0.f, 0.f, 0.f, 0.f};
    bf16x8 At[4][2], B0[2][2], B1[2][2];
    const char* cA = (const char*)g.A + (size_t)cur.pm * tstep; const char* cB = (const char*)g.Bt + (size_t)cur.pn * tstep;
    S.a_ready(cur);
    if constexpr (SP2) {
        PG8_STAGE(PG8_SB(0, 0), cB, voffB); PG8_STAGE(PG8_SB(0, 1), cB + hstep, voffB); PG8_STAGE(PG8_SA(0, 0), cA, voffA); PG8_STAGE(PG8_SA(0, 1), cA + hstep, voffA);
        if (wr == 1) PG8_BAR;
        PG8_WAIT_V(2); PG8_BAR;
        PG8_STAGE(PG8_SB(1, 0), cB + kstep, voffB); PG8_STAGE(PG8_SA(1, 0), cA + kstep, voffA); PG8_STAGE(PG8_SB(1, 1), cB + hstep + kstep, voffB);
        PG8_WAIT_V(6); PG8_BAR;
    } else {
        PG8_STAGE(PG8_SB(0, 0), cB, voffB); PG8_STAGE(PG8_SA(0, 0), cA, voffA); PG8_STAGE(PG8_SB(0, 1), cB + hstep, voffB); PG8_STAGE(PG8_SA(0, 1), cA + hstep, voffA);
        if (wr == 1) PG8_BAR;
        PG8_WAIT_V(4); PG8_BAR;
        PG8_STAGE(PG8_SB(1, 0), cB + kstep, voffB); PG8_STAGE(PG8_SA(1, 0), cA + kstep, voffA); PG8_STAGE(PG8_SB(1, 1), cB + hstep + kstep, voffB);
        PG8_WAIT_V(6); PG8_BAR;
    }
    for (;;) {
        const bool has_next = S.next(ui + 1, nxt);
        const char* nA = has_next ? (const char*)g.A + (size_t)nxt.pm * tstep : cA; const char* nB = has_next ? (const char*)g.Bt + (size_t)nxt.pn * tstep : cB;
        for (int t = 0; t < nt; t += 2) {
            const bool last = (t == nt - 2);
            const char* a1 = cA + (size_t)(t + 1) * kstep;
            const char* a2 = last ? nA : cA + (size_t)(t + 2) * kstep; const char* b2 = last ? nB : cB + (size_t)(t + 2) * kstep;
            const char* a3 = a2 + kstep; const char* b3 = b2 + kstep;
            if (last && has_next) S.a_ready(nxt);
            if constexpr (SP2) {
            PG8_LDB(B0, 0, 0); PG8_LDB(B1, 0, 1); PG8_SCHED; PG8_LDA(At, 0, 0); PG8_STAGE(PG8_SA(1, 1), a1 + hstep, voffA);
            PG8_WAIT_V(8); PG8_WAIT_L(0); PG8_BAR; PG8_MMA(0, 0, At, B0); PG8_MMA(0, 1, At, B1); PG8_BAR; PG8_SCHED;
            PG8_LDA(At, 0, 1); PG8_STAGE(PG8_SB(0, 0), b2, voffB); PG8_STAGE(PG8_SB(0, 1), b2 + hstep, voffB); PG8_STAGE(PG8_SA(0, 0), a2, voffA);
            PG8_WAIT_V(8); PG8_WAIT_L(0); PG8_BAR; PG8_MMA(1, 0, At, B0); PG8_MMA(1, 1, At, B1); PG8_BAR; PG8_SCHED;
            PG8_LDB(B0, 1, 0); PG8_LDB(B1, 1, 1); PG8_SCHED; PG8_LDA(At, 1, 0); PG8_STAGE(PG8_SA(0, 1), a2 + hstep, voffA);
            PG8_WAIT_V(8); PG8_WAIT_L(0); PG8_BAR; PG8_MMA(0, 0, At, B0); PG8_MMA(0, 1, At, B1); PG8_BAR; PG8_SCHED;
            PG8_LDA(At, 1, 1); PG8_STAGE(PG8_SB(1, 0), b3, voffB); PG8_STAGE(PG8_SB(1, 1), b3 + hstep, voffB); PG8_STAGE(PG8_SA(1, 0), a3, voffA);
            PG8_WAIT_V(8); PG8_WAIT_L(0); PG8_BAR; PG8_MMA(1, 0, At, B0); PG8_MMA(1, 1, At, B1); PG8_BAR; PG8_SCHED;
            } else {
            PG8_LDB(B0, 0, 0); PG8_SCHED; PG8_LDA(At, 0, 0); PG8_STAGE(PG8_SA(1, 1), a1 + hstep, voffA);
            PG8_WAIT_L(8); PG8_BAR; PG8_WAIT_L(0); PG8_MMA(0, 0, At, B0); PG8_BAR; PG8_SCHED;
            PG8_LDB(B1, 0, 1); PG8_STAGE(PG8_SB(0, 0), b2, voffB);
            PG8_BAR; PG8_WAIT_L(0); PG8_MMA(0, 1, At, B1); PG8_BAR;
            PG8_LDA(At, 0, 1); PG8_STAGE(PG8_SA(0, 0), a2, voffA);
            PG8_BAR; PG8_WAIT_L(0); PG8_MMA(1, 0, At, B0); PG8_BAR; PG8_SCHED;
            PG8_STAGE(PG8_SB(0, 1), b2 + hstep, voffB);
            PG8_WAIT_V(6); PG8_BAR; PG8_MMA(1, 1, At, B1); PG8_BAR;
            PG8_LDB(B0, 1, 0); PG8_SCHED; PG8_LDA(At, 1, 0); PG8_STAGE(PG8_SA(0, 1), a2 + hstep, voffA);
            PG8_WAIT_L(8); PG8_BAR; PG8_WAIT_L(0); PG8_MMA(0, 0, At, B0); PG8_BAR; PG8_SCHED;
            PG8_LDB(B1, 1, 1); PG8_STAGE(PG8_SB(1, 0), b3, voffB);
            PG8_BAR; PG8_WAIT_L(0); PG8_MMA(0, 1, At, B1); PG8_BAR;
            PG8_LDA(At, 1, 1); PG8_STAGE(PG8_SA(1, 0), a3, voffA);
            PG8_BAR; PG8_WAIT_L(0); PG8_MMA(1, 0, At, B0); PG8_BAR; PG8_SCHED;
            PG8_STAGE(PG8_SB(1, 1), b3 + hstep, voffB);
            PG8_WAIT_V(6); PG8_BAR; PG8_MMA(1, 1, At, B1); PG8_BAR;
            }
        }
        if constexpr (ALIGN_EPI) { if (wr == 0) PG8_BAR; }
        if constexpr (!Epi::AFTER_DRAIN) { E(acc, cur, wr, wc, fr, fq); S.done(cur); }
        if (!has_next) break;
#pragma unroll
        for (int a = 0; a < 2; ++a)
#pragma unroll
            for (int b = 0; b < 2; ++b)
#pragma unroll
                for (int m = 0; m < 4; ++m)
#pragma unroll
                    for (int n = 0; n < 2; ++n) acc[a][b][m][n] = (f32x4){0.f, 0.f, 0.f, 0.f};
        cur = nxt; cA = nA; cB = nB; ++ui;
        if constexpr (ALIGN_EPI) { if (wr == 1) PG8_BAR; }
    }
    PG8_WAIT_V(0);
    if constexpr (!ALIGN_EPI) { if (wr == 0) PG8_BAR; }
    PG8_BAR;
    if constexpr (Epi::AFTER_DRAIN) { E.fused(acc, cur, wr, wc, fr, fq, lds, wid, lane); S.done(cur); }
#undef PG8_SA
#undef PG8_SB
#undef PG8_STAGE
#undef PG8_LDA
#undef PG8_LDB
#undef PG8_MMA
#undef PG8_WAIT_V
#undef PG8_WAIT_L
#undef PG8_BAR
#undef PG8_SCHED
}
}
#define XB_TMO      128
#define XB_XCNT(j)  (256  + 64 * (j))
#define XB_XSUB(j)  (1280 + 64 * (j))
#define XB_XGEN(j)  (2304 + 64 * (j))
#define XB_TOP      3328
#define XB_TOPGEN   3392
#define XCD_BAR_WORDS 3456
#define XB_SPIN_CAP (1u << 18)

__device__ __forceinline__ unsigned xb_ld(unsigned* p)              { return __hip_atomic_load(p, __ATOMIC_RELAXED, __HIP_MEMORY_SCOPE_AGENT); }
__device__ __forceinline__ unsigned xb_add(unsigned* p, unsigned v) { return __hip_atomic_fetch_add(p, v, __ATOMIC_RELAXED, __HIP_MEMORY_SCOPE_AGENT); }
__device__ __forceinline__ unsigned xb_xcc_id() { return (unsigned)__builtin_amdgcn_s_getreg((3 << 11) | 20) & 0xFu; }
#define XB_SPIN(cond, bar) do { unsigned _sp = 0; while (cond) { __builtin_amdgcn_s_sleep(1); \
    if ((++_sp & 255u) == 0u) { if (xb_ld(&(bar)[XB_TMO])) break; if (_sp > XB_SPIN_CAP) { atomicAdd(&(bar)[XB_TMO], 1u); break; } } } } while (0)

struct XcdBarrier {
    unsigned* bar; unsigned x;
    volatile LAS unsigned* st;
};

__device__ __forceinline__ XcdBarrier xcd_barrier_post(unsigned* bar, volatile LAS unsigned* st) {
    XcdBarrier b; b.bar = bar; b.x = xb_xcc_id(); b.st = st;
    if (threadIdx.x == 0) (void)xb_add(&bar[XB_XCNT(b.x)], 1u);
    return b;
}
__device__ __forceinline__ void xcd_barrier_complete(unsigned* bar, unsigned x, unsigned& nloc, unsigned& nx) {
    const unsigned G = gridDim.x * gridDim.y * gridDim.z;
    unsigned sum, cnt, mine, sp = 0u;
    for (;;) {
        sum = 0u; cnt = 0u; mine = 0u;
#pragma unroll
        for (unsigned j = 0; j < 16; ++j) { const unsigned c = xb_ld(&bar[XB_XCNT(j)]); sum += c; cnt += (c > 0u) ? 1u : 0u; mine = (j == x) ? c : mine; }
        if (sum == G) break;
        __builtin_amdgcn_s_sleep(1);
        if ((++sp & 255u) == 0u) { if (xb_ld(&bar[XB_TMO])) break; if (sp > XB_SPIN_CAP) { atomicAdd(&bar[XB_TMO], 1u); break; } }
    }
    nloc = mine > 0u ? mine : 1u; nx = cnt > 0u ? cnt : 1u;
}

__device__ __forceinline__ void xcd_barrier(const XcdBarrier& b) {
    asm volatile("s_waitcnt vmcnt(0)" ::: "memory");
    __syncthreads();
    if (threadIdx.x == 0) {
        unsigned* bar = b.bar;
        __builtin_amdgcn_s_waitcnt(0);
        unsigned nloc = b.st[0], nx = b.st[1];
        if (nloc == 0u) { xcd_barrier_complete(bar, b.x, nloc, nx); b.st[0] = nloc; b.st[1] = nx; }
        const unsigned old = xb_add(&bar[XB_XSUB(b.x)], 1u);
        const unsigned gen = old / nloc;
        if (old + 1u == (gen + 1u) * nloc) {
            __builtin_amdgcn_fence(__ATOMIC_RELEASE, "agent");
            asm volatile("s_waitcnt vmcnt(0)" ::: "memory");
            const unsigned og = xb_add(&bar[XB_TOP], 1u);
            const unsigned tg = og / nx;
            if (og + 1u == (tg + 1u) * nx) xb_add(&bar[XB_TOPGEN], 1u);
            else XB_SPIN(xb_ld(&bar[XB_TOPGEN]) == tg, bar);
            __builtin_amdgcn_fence(__ATOMIC_ACQUIRE, "agent");
            xb_add(&bar[XB_XGEN(b.x)], 1u);
            asm volatile("s_waitcnt vmcnt(0)" ::: "memory");
        } else {
            XB_SPIN(xb_ld(&bar[XB_XGEN(b.x)]) == gen, bar);
            __builtin_amdgcn_fence(__ATOMIC_ACQUIRE, "agent");
            asm volatile("s_waitcnt vmcnt(0)" ::: "memory");
        }
    }
    __syncthreads();
}
typedef unsigned short bf16;
typedef unsigned v4u __attribute__((ext_vector_type(4)));
typedef float f32x4 __attribute__((ext_vector_type(4)));
typedef short bf16x8 __attribute__((ext_vector_type(8)));
typedef GAS unsigned gu32;
#define LDS_WAIT() asm volatile("s_waitcnt lgkmcnt(0)" ::: "memory")
__device__ __forceinline__ unsigned f2bf(float f) { unsigned u = __builtin_bit_cast(unsigned, f); return (u + 0x7fffu + ((u >> 16) & 1u)) >> 16; }
__device__ __forceinline__ unsigned pk2(float lo, float hi) { return f2bf(lo) | (f2bf(hi) << 16); }
__device__ __forceinline__ unsigned cvtpk(float lo, float hi) { typedef float f2_ __attribute__((ext_vector_type(2))); typedef __bf16 b2_ __attribute__((ext_vector_type(2))); f2_ v = {lo, hi}; b2_ b = __builtin_convertvector(v, b2_); return __builtin_bit_cast(unsigned, b); }
__device__ __forceinline__ float bf2f(unsigned short h) { return __builtin_bit_cast(float, (unsigned)h << 16); }
__device__ __forceinline__ float bflo(unsigned w) { return __builtin_bit_cast(float, w << 16); }
__device__ __forceinline__ float bfhi(unsigned w) { return __builtin_bit_cast(float, w & 0xffff0000u); }
__device__ __forceinline__ float wave_sum(float v) {
#pragma unroll
    for (int o = 1; o < 64; o <<= 1) v += __shfl_xor(v, o);
    return v;
}
__device__ __forceinline__ float silu_f(float x) { return x / (1.f + __expf(-x)); }
__device__ __forceinline__ int crow(int r, int hi) { return (r & 3) + 8 * (r >> 2) + 4 * hi; }

struct Ctx {
    LAS unsigned char* lds; volatile LAS unsigned* MISC; gu32* ctl;
    int tid, wave, vcu, G;
    const float* in[18]; float* out; unsigned char* ws;
};
__device__ __forceinline__ int q_next(Ctx& C, int cw, unsigned n = 1u) {
    __syncthreads();
    if (C.tid == 0) C.MISC[16] = __hip_atomic_fetch_add((unsigned*)(C.ctl + cw), n, __ATOMIC_RELAXED, __HIP_MEMORY_SCOPE_AGENT);
    __syncthreads();
    return (int)C.MISC[16];
}

__device__ __forceinline__ int inproj_src(int p) {
    const int pn = p >> 8, q = p & 255;
    const int bj = q >> 7, wc = (q >> 5) & 3, n = (q >> 4) & 1, fq = (q >> 2) & 3, e = q & 3;
    const int lc = 64 * wc + 16 * fq + 8 * bj + 4 * n + e;
    if (pn < 5) return 256 * pn + lc;
    if (pn == 5) return lc < 72 ? 1280 + lc : -1;
    return 1352 + 256 * (pn - 6) + lc;
}
template <bool MAP>
__device__ __forceinline__ void p0_transpose_item(const float* W, int K, int N, int NP, const float* gain, bf16* WT, LAS float* scr, int item, int lane) {
    const int nblk = NP / 32, kb = item / nblk, nb = item % nblk, k0 = 64 * kb, n0 = 32 * nb;
    const int p = n0 + (lane & 31); const int sc = MAP ? inproj_src(p) : p;
#pragma unroll 8
    for (int i = 0; i < 32; ++i) { const int kk = 2 * i + (lane >> 5); float v = 0.f; if (sc >= 0) v = W[(size_t)(k0 + kk) * N + sc]; if (gain) v *= gain[k0 + kk]; scr[kk * 33 + (lane & 31)] = v; }
    LDS_WAIT(); asm volatile("" ::: "memory");
    const int c = lane & 7;
#pragma unroll
    for (int j = 0; j < 4; ++j) { const int n = (lane >> 3) + 8 * j; const LAS float* s = scr + (8 * c) * 33 + n;
        v4u o; o.x = cvtpk(s[0 * 33], s[1 * 33]); o.y = cvtpk(s[2 * 33], s[3 * 33]); o.z = cvtpk(s[4 * 33], s[5 * 33]); o.w = cvtpk(s[6 * 33], s[7 * 33]);
        *(GAS v4u*)(WT + (size_t)(n0 + n) * K + k0 + 8 * c) = o; }
    LDS_WAIT(); asm volatile("" ::: "memory");
}
template <int R>
__device__ __forceinline__ void x_rows_to_bf16(const float* x0, size_t rstride, bf16* o0, float* rstd0, int lane, int nrows) {
    f32x4 v[R][4];
#pragma unroll
    for (int r = 0; r < R; ++r) { const GAS f32x4* xr = (const GAS f32x4*)(x0 + (r < nrows ? r : 0) * rstride * DM) + lane;
#pragma unroll
        for (int j = 0; j < 4; ++j) v[r][j] = xr[64 * j]; }
#pragma unroll
    for (int r = 0; r < R; ++r) if (r < nrows) { float s = 0.f;
#pragma unroll
        for (int j = 0; j < 4; ++j) s += (v[r][j].x * v[r][j].x + v[r][j].y * v[r][j].y) + (v[r][j].z * v[r][j].z + v[r][j].w * v[r][j].w);
        s = wave_sum(s);
        if (lane == 0) rstd0[r * rstride] = rsqrtf(s * (1.0f / DM) + EPS);
        GAS u64* o8 = (GAS u64*)(o0 + r * rstride * DM) + lane;
#pragma unroll
        for (int j = 0; j < 4; ++j) o8[64 * j] = (u64)cvtpk(v[r][j].x, v[r][j].y) | ((u64)cvtpk(v[r][j].z, v[r][j].w) << 32); }
}

template <int K, bool GK, int KW = K / 8>
__device__ __forceinline__ void skinny32(const float* A, const float* gk, const float* W, int ldw, int N, int n0, LAS float* red, int tid, int lane, int wave, int kbase = 0) {
    asm volatile("" : "+v"(tid), "+v"(lane));
    const int i = lane & 31, kh = lane >> 5, n = n0 + i; const bool nok = n < N;
    f32x16 acc = {};
    const int kbeg = kbase + wave * KW, kend = kbeg + KW;
#pragma unroll 1
    for (int kb0 = kbeg; kb0 < kend; kb0 += 64) {
        f32x4 xa[8]; float bw[8][4];
#pragma unroll
        for (int s = 0; s < 8; ++s) { const int kb = kb0 + 8 * s;
            xa[s] = *(const f32x4*)(A + (size_t)i * K + kb + 4 * kh);
            if (GK) { const f32x4 ga = *(const f32x4*)(gk + kb + 4 * kh); xa[s] = xa[s] * ga; }
            const float* wp = W + (size_t)(kb + 4 * kh) * ldw + (nok ? n : 0);
            bw[s][0] = wp[0]; bw[s][1] = wp[ldw]; bw[s][2] = wp[2 * (size_t)ldw]; bw[s][3] = wp[3 * (size_t)ldw]; }
#pragma unroll
        for (int s = 0; s < 8; ++s)
#pragma unroll
            for (int j = 0; j < 4; ++j) acc = __builtin_amdgcn_mfma_f32_32x32x2f32(xa[s][j], nok ? bw[s][j] : 0.f, acc, 0, 0, 0);
    }
#pragma unroll
    for (int r = 0; r < 16; ++r) red[wave * 1024 + crow(r, kh) * 32 + i] = acc[r];
    __syncthreads();
#pragma unroll
    for (int x = 0; x < 2; ++x) { const int e = tid + 512 * x; float s = 0.f;
#pragma unroll
        for (int w = 0; w < 8; ++w) s += red[w * 1024 + e];
        red[8 * 1024 + e] = s; }
    __syncthreads();
}
__device__ __forceinline__ float sk_get(LAS float* red, int e) { return red[8 * 1024 + e]; }
template <int K>
__device__ __forceinline__ void rows_rstd32(const float* A, LAS float* rs, int lane, int wave) {
#pragma unroll
    for (int j = 0; j < 4; ++j) { const int r = wave * 4 + j; float s = 0.f;
        for (int k = lane * 4; k < K; k += 256) { const f32x4 v = *(const f32x4*)(A + (size_t)r * K + k); s += (v[0] * v[0] + v[1] * v[1]) + (v[2] * v[2] + v[3] * v[3]); }
        s = wave_sum(s); if (lane == 0) rs[r] = rsqrtf(s * (1.0f / K) + EPS); }
}

__device__ __forceinline__ void p0_prologue(Ctx& C) {
    LAS float* scr = (LAS float*)(C.lds + C.wave * 16384);
    float* samp = (float*)(C.ws + WS_SAMP);
    if (C.vcu < 107) {
        LAS float* red = (LAS float*)C.lds; LAS float* rs = red + 9 * 1024 + 64;
        rows_rstd32<DM>(C.in[I_XS], rs, (C.tid & 63), C.wave);
        skinny32<DM, true>(C.in[I_XS], C.in[I_N1G], C.in[I_WIN], INW, INW, 32 * C.vcu, red, C.tid, (C.tid & 63), C.wave);
        int tid_ = C.tid; asm volatile("" : "+v"(tid_));
#pragma unroll
        for (int x = 0; x < 2; ++x) { const int e = tid_ + 512 * x, i = e >> 5, n = 32 * C.vcu + (e & 31); if (n < INW) samp[S_RAW + i * INW + n] = sk_get(red, e) * rs[i]; }
        __syncthreads();
    }
    if (C.vcu == 200 && C.tid < 192) ((float*)(C.ws + WS_GAINS))[C.tid] = C.tid < 64 ? C.in[I_QG][C.tid] : (C.tid < 128 ? C.in[I_KG][C.tid - 64] : C.in[I_IKG][C.tid - 128]);
    const int gw = C.vcu * 8 + C.wave, NGW = C.G * 8;
    constexpr int I_1 = (DM / 64) * (INP / 32), I_O = (DM / 64) * (DM / 32), I_U = (DM / 64) * (FF / 32), I_D = (FF / 64) * (DM / 32);
    for (int it = gw; it < I_1 + I_O + I_U + I_D; it += NGW) {
        int r = it;
        if (r < I_1) { p0_transpose_item<true>(C.in[I_WIN], DM, INW, INP, C.in[I_N1G], (bf16*)(C.ws + WS_W1T), scr, r, (C.tid & 63)); continue; } r -= I_1;
        if (r < I_O) { p0_transpose_item<false>(C.in[I_WOUT], DM, DM, DM, nullptr, (bf16*)(C.ws + WS_WOT), scr, r, (C.tid & 63)); continue; } r -= I_O;
        if (r < I_U) { p0_transpose_item<false>(C.in[I_WUP], DM, FF, FF, C.in[I_N2G], (bf16*)(C.ws + WS_WUT), scr, r, (C.tid & 63)); continue; } r -= I_U;
        p0_transpose_item<false>(C.in[I_WDN], FF, DM, DM, nullptr, (bf16*)(C.ws + WS_WDT), scr, r, (C.tid & 63));
    }
    bf16* XB = (bf16*)(C.ws + WS_XB); float* RSTD1 = (float*)(C.ws + WS_RSTD1);
    for (int m = gw; m < NTOK; m += 4 * NGW) x_rows_to_bf16<4>(C.in[I_XP] + (size_t)m * DM, (size_t)NGW, XB + (size_t)m * DM, RSTD1 + m, (C.tid & 63), (NTOK - 1 - m) / NGW + 1);
}

__device__ __forceinline__ void sample_postproj(Ctx& C, int b) {
    const float* raw = (const float*)(C.ws + WS_SAMP) + S_RAW + (size_t)b * INW; float* sp = (float*)(C.ws + WS_SAMP) + S_SP + (size_t)b * 4096;
    const int l = (C.tid & 63);
    for (int h = 0; h < 8; ++h) { const float v = raw[h * 64 + l]; const float ss = wave_sum(v * v); sp[h * 64 + l] = v * rsqrtf(ss * (1.f / 64.f) + EPS) * C.in[I_QG][l]; }
    for (int h = 0; h < 2; ++h) { const float v = raw[512 + h * 64 + l]; const float ss = wave_sum(v * v); const float kn = v * rsqrtf(ss * (1.f / 64.f) + EPS) * C.in[I_KG][l];
        sp[512 + h * 64 + l] = kn; C.out[O_NKS + (size_t)b * 128 + h * 64 + l] = kn; }
    for (int h = 0; h < 2; ++h) { const float v = raw[640 + h * 64 + l]; sp[640 + h * 64 + l] = v; C.out[O_NVS + (size_t)b * 128 + h * 64 + l] = v; }
    for (int j = 0; j < 8; ++j) sp[768 + j * 64 + l] = raw[768 + j * 64 + l];
    { const float v = raw[1280 + l]; const float ss = wave_sum(v * v); const float kn = v * rsqrtf(ss * (1.f / 64.f) + EPS) * C.in[I_IKG][l]; sp[1280 + l] = kn; C.out[O_NKIS + (size_t)b * 64 + l] = kn; }
    if (l < 8) sp[1344 + l] = raw[1344 + l] * IDX_W_SCALE;
    for (int j = 0; j < 8; ++j) { sp[1352 + j * 64 + l] = silu_f(raw[1352 + j * 64 + l]) * REC_QSCALE; sp[1864 + j * 64 + l] = raw[1864 + j * 64 + l]; sp[2376 + j * 64 + l] = raw[2376 + j * 64 + l]; sp[2888 + j * 64 + l] = silu_f(raw[2888 + j * 64 + l]); }
}
constexpr int SROW = 2052, SEL_WS_OFF = 131584;
static_assert(SEL_WS_OFF + 8 * 2048 <= LDSCTL_OFF, "select lds");
template <int CTRL> __device__ __forceinline__ float dppf(float v) { return __builtin_bit_cast(float, __builtin_amdgcn_update_dpp(__builtin_bit_cast(int, v), __builtin_bit_cast(int, v), CTRL, 0xf, 0xf, false)); }
template <int CTRL> __device__ __forceinline__ int dppi(int v) { return __builtin_amdgcn_update_dpp(v, v, CTRL, 0xf, 0xf, false); }
__device__ __forceinline__ float rdl_f(float v, int l) { return __builtin_bit_cast(float, __builtin_amdgcn_readlane(__builtin_bit_cast(int, v), l)); }
__device__ __forceinline__ float wave_min_f(float v) {
    v = fminf(v, dppf<0xB1>(v)); v = fminf(v, dppf<0x4E>(v)); v = fminf(v, dppf<0x141>(v)); v = fminf(v, dppf<0x140>(v));
    return fminf(fminf(rdl_f(v, 0), rdl_f(v, 16)), fminf(rdl_f(v, 32), rdl_f(v, 48)));
}
__device__ __forceinline__ float wave_max_f(float v) {
    v = fmaxf(v, dppf<0xB1>(v)); v = fmaxf(v, dppf<0x4E>(v)); v = fmaxf(v, dppf<0x141>(v)); v = fmaxf(v, dppf<0x140>(v));
    return fmaxf(fmaxf(rdl_f(v, 0), rdl_f(v, 16)), fmaxf(rdl_f(v, 32), rdl_f(v, 48)));
}
__device__ __forceinline__ int row_sum_i(int v) { v += dppi<0xB1>(v); v += dppi<0x4E>(v); v += dppi<0x141>(v); v += dppi<0x140>(v); return v; }
__device__ __forceinline__ int row_suffix_i(int v) {
    v += __builtin_amdgcn_update_dpp(0, v, 0x101, 0xf, 0xf, true); v += __builtin_amdgcn_update_dpp(0, v, 0x102, 0xf, 0xf, true);
    v += __builtin_amdgcn_update_dpp(0, v, 0x104, 0xf, 0xf, true); v += __builtin_amdgcn_update_dpp(0, v, 0x108, 0xf, 0xf, true); return v;
}
__device__ __forceinline__ float relu_f(float x) { return __builtin_amdgcn_fmed3f(x, 0.f, INFINITY); }
__device__ __forceinline__ void dsa_select_unit(Ctx& C, int b, int qb) {
    const bf16* IQb = (const bf16*)(C.ws + WS_IQB); const bf16* IKb = (const bf16*)(C.ws + WS_IKB); const float* IWf = (const float*)(C.ws + WS_IWF);
    u64* MASK = (u64*)(C.ws + WS_MASK);
    LAS float* sc = (LAS float*)C.lds;
    int lane = (C.tid & 63), wave = C.wave; asm volatile("" : "+v"(lane), "+s"(wave));
#ifdef PROBE_SEL
    const unsigned long long ps0_ = __builtin_amdgcn_s_memrealtime(); unsigned long long ps1_ = 0;
#endif
    const int t0 = qb * 16, ntile = qb + 1, ql = lane & 15, g = lane >> 4;
    const size_t rowq = (size_t)b * SEQ + t0 + ql;
    if (t0 + 15 >= 256)
    {
        bf16x8 bq[8][2];
#pragma unroll
        for (int h = 0; h < 8; ++h)
#pragma unroll
            for (int ks = 0; ks < 2; ++ks) bq[h][ks] = *(const bf16x8*)(IQb + rowq * 512 + h * 64 + ks * 32 + g * 8);
        float w[8];
        { const f32x4 w0 = *(const f32x4*)(IWf + rowq * 8), w1 = *(const f32x4*)(IWf + rowq * 8 + 4); w[0] = w0[0]; w[1] = w0[1]; w[2] = w0[2]; w[3] = w0[3]; w[4] = w1[0]; w[5] = w1[1]; w[6] = w1[2]; w[7] = w1[3]; }
        LAS unsigned char* stg = C.lds + SEL_WS_OFF;
        const int tid_ = C.tid, pk0 = tid_ >> 3, pc = tid_ & 7, nround = (ntile + 7) >> 3;
        const bf16* gsrc = IKb + ((size_t)b * SEQ + pk0) * 64 + pc * 8;
        const int wo0 = (pk0 * 8 + (pc ^ (pk0 & 7))) * 16, wo1 = ((pk0 + 64) * 8 + (pc ^ (pk0 & 7))) * 16;
        const int ro0 = ((16 * wave + ql) * 8 + (g ^ (ql & 7))) * 16, ro1 = ((16 * wave + ql) * 8 + ((4 + g) ^ (ql & 7))) * 16;
        const int nrm1 = nround - 1;
        v4u ra0, ra1, rb0, rb1;
#define SEL_GLOAD(R0, R1, rd_) do { const bf16* gp_ = gsrc + (size_t)((rd_) < nround ? (rd_) : nrm1) * 128 * 64; R0 = *(const v4u*)gp_; R1 = *(const v4u*)(gp_ + 64 * 64); } while (0)
#define SEL_ROUND(rd_, R0, R1) do { \
            __syncthreads();                                                    \
            *(LAS v4u*)(stg + wo0) = R0; *(LAS v4u*)(stg + wo1) = R1; \
            SEL_GLOAD(R0, R1, (rd_) + 2); \
            __syncthreads(); \
            const int ii = (rd_) * 8 + wave; \
            if (ii < ntile) { \
                const bf16x8 a0 = *(const LAS bf16x8*)(stg + ro0), a1 = *(const LAS bf16x8*)(stg + ro1); \
                f32x4 I = {0.f, 0.f, 0.f, 0.f}; \
                _Pragma("unroll") for (int h = 0; h < 8; ++h) { \
                    f32x4 d = __builtin_amdgcn_mfma_f32_16x16x32_bf16(a0, bq[h][0], (f32x4){0.f, 0.f, 0.f, 0.f}, 0, 0, 0); \
                    d = __builtin_amdgcn_mfma_f32_16x16x32_bf16(a1, bq[h][1], d, 0, 0, 0); \
                    _Pragma("unroll") for (int r = 0; r < 4; ++r) I[r] = fmaf(w[h], relu_f(d[r]), I[r]); } \
                *(LAS f32x4*)(sc + ql * SROW + ii * 16 + 4 * g) = I;           \
            } } while (0)
        SEL_GLOAD(ra0, ra1, 0); SEL_GLOAD(rb0, rb1, 1);
#pragma unroll 1
        for (int rd = 0; rd < nround; rd += 2) {
            SEL_ROUND(rd, ra0, ra1);
            if (rd + 1 < nround) SEL_ROUND(rd + 1, rb0, rb1);
        }
#undef SEL_GLOAD
#undef SEL_ROUND
    }
    __syncthreads();
#ifdef PROBE_SEL
    ps1_ = __builtin_amdgcn_s_memrealtime();
#endif
#ifdef PROBE_SEL
    unsigned long long sm_t_ = ps1_, sm_acc_ = 0;
#define SELMARK(k) do { const unsigned long long n_ = __builtin_amdgcn_s_memrealtime(); if (PROBE_SEL == (k)) sm_acc_ += n_ - sm_t_; sm_t_ = n_; } while (0)
#else
#define SELMARK(k) do {} while (0)
#endif
    LAS unsigned* hist = (LAS unsigned*)(C.lds + SEL_WS_OFF) + wave * 512;
#ifdef SEL_REP_PICK
    for (int rep_ = 0; rep_ < 2; ++rep_)
#endif
#pragma unroll 1
    for (int qq = 0; qq < 2; ++qq) {
        const int qi = wave * 2 + qq, t = t0 + qi;
        unsigned mylo = 0, myhi = 0;
        if (t < 256) {
            const int lo = 64 * lane;
            const u64 mw_ = (lo > t) ? 0ull : ((lo + 63 <= t) ? ~0ull : ((2ull << (t - lo)) - 1ull));
            mylo = (unsigned)mw_; myhi = (unsigned)(mw_ >> 32);
        } else {
#ifndef SEL_RS
#define SEL_RS 0
#endif
            SELMARK(9);
            float v[32]; const int nj = (t >> 6) + 1;
            float lo = INFINITY, hi = -INFINITY;
#pragma unroll 1
            for (int rr = 0; rr < (SEL_RS == 1 ? 3 : 1); ++rr) { asm volatile("" ::: "memory"); lo = INFINITY; hi = -INFINITY;
#pragma unroll
            for (int j = 0; j < 32; ++j) v[j] = sc[qi * SROW + 64 * j + lane];
#pragma unroll
            for (int j = 0; j < 32; ++j) { const bool ok = (64 * j + lane) <= t; const float xl = ok ? v[j] : INFINITY; v[j] = ok ? v[j] : -INFINITY;
                asm("v_max_f32 %0, %0, %1" : "+v"(hi) : "v"(v[j])); asm("v_min_f32 %0, %0, %1" : "+v"(lo) : "v"(xl)); }
            lo = wave_min_f(lo); hi = wave_max_f(hi); }
            const float scale = (hi > lo) ? 255.99f / (hi - lo) : 0.f;
            SELMARK(4);
            int bn[32];
#pragma unroll 1
            for (int rr = 0; rr < (SEL_RS == 2 ? 3 : 1); ++rr) {
            *(LAS v4u*)(hist + 4 * lane) = (v4u){0u, 0u, 0u, 0u}; *(LAS v4u*)(hist + 256 + 4 * lane) = (v4u){0u, 0u, 0u, 0u};
            LDS_WAIT(); asm volatile("" ::: "memory");
#pragma unroll
            for (int j = 0; j < 32; ++j) { bn[j] = -1; if (j < nj) { int bi = (int)((v[j] - lo) * scale); bi = bi > 255 ? 255 : bi; asm volatile("" : "+v"(bi)); bn[j] = bi;
                if (bi >= 0) __hip_atomic_fetch_add(hist + bi, 1u, __ATOMIC_RELAXED, __HIP_MEMORY_SCOPE_WORKGROUP); } }
            LDS_WAIT(); asm volatile("" ::: "memory"); }
            SELMARK(5);
            const v4u hh = *(const LAS v4u*)(hist + 4 * lane);
            const int s4 = (int)(hh.x + hh.y + hh.z + hh.w);
            const int rsum = row_sum_i(s4);
            const int r0s = __builtin_amdgcn_readlane(rsum, 0), r1s = __builtin_amdgcn_readlane(rsum, 16), r2s = __builtin_amdgcn_readlane(rsum, 32), r3s = __builtin_amdgcn_readlane(rsum, 48);
            int Rs, abv;
            if (r3s >= 256) { Rs = 3; abv = 0; } else if (r3s + r2s >= 256) { Rs = 2; abv = r3s; } else if (r3s + r2s + r1s >= 256) { Rs = 1; abv = r3s + r2s; } else { Rs = 0; abv = r3s + r2s + r1s; }
            (void)r0s;
            const int incl = abv + row_suffix_i(s4);
            const u64 bal = __ballot(((lane >> 4) == Rs) && incl >= 256);
            const int Ls = 63 - __clzll(bal);
            int c = incl - s4, bsel, cab, hsel;
            if (c + (int)hh.w >= 256) { bsel = 3; cab = c; hsel = (int)hh.w; }
            else { c += (int)hh.w; if (c + (int)hh.z >= 256) { bsel = 2; cab = c; hsel = (int)hh.z; }
                else { c += (int)hh.z; if (c + (int)hh.y >= 256) { bsel = 1; cab = c; hsel = (int)hh.y; } else { c += (int)hh.y; bsel = 0; cab = c; hsel = (int)hh.x; } } }
            const int Bs = 4 * Ls + __builtin_amdgcn_readlane(bsel, Ls), cabove = __builtin_amdgcn_readlane(cab, Ls), cntB = __builtin_amdgcn_readlane(hsel, Ls);
            const int r = 256 - cabove;
            SELMARK(6);
#ifdef SEL_FORCE_FALLBACK
            if (cntB <= 64 && t > (SEL_FORCE_FALLBACK)) {
#else
            if (cntB <= 64) {
#endif
#pragma unroll 1
                for (int rr = 0; rr < (SEL_RS == 4 ? 3 : 1); ++rr) { asm volatile("" ::: "memory");
                int cbase = 0;
#pragma unroll
                for (int j = 0; j < 32; ++j) if (j < nj) { const u64 wa = __ballot(bn[j] > Bs);
                    mylo = (lane == j) ? (unsigned)wa : mylo; myhi = (lane == j) ? (unsigned)(wa >> 32) : myhi;
                    const bool isc = bn[j] == Bs; const u64 bm = __ballot(isc);
                    if (bm != 0ull) { const int pos = cbase + (int)__builtin_amdgcn_mbcnt_hi((unsigned)(bm >> 32), __builtin_amdgcn_mbcnt_lo((unsigned)bm, 0u));
                        if (isc) { hist[258 + 2 * pos] = __builtin_bit_cast(unsigned, sc[qi * SROW + 64 * j + lane]); hist[259 + 2 * pos] = (unsigned)(64 * j + lane); }
                        cbase += __popcll(bm); } }
                LDS_WAIT(); asm volatile("" ::: "memory");
                const bool mine = lane < cntB;
                const float cv = mine ? __builtin_bit_cast(float, hist[258 + 2 * lane]) : 0.f; const int ci = mine ? (int)hist[259 + 2 * lane] : 0;
                int rank = 0;
#pragma unroll 1
                for (int j = 0; j < cntB; ++j) { const float x = rdl_f(cv, j); const int y = __builtin_amdgcn_readlane(ci, j); rank += ((x > cv) | ((x == cv) & (y < ci))) ? 1 : 0; }
                if (mine && rank < r) __hip_atomic_fetch_or(hist + 416 + (ci >> 5), 1u << (ci & 31), __ATOMIC_RELAXED, __HIP_MEMORY_SCOPE_WORKGROUP);
                LDS_WAIT(); asm volatile("" ::: "memory"); }
                if (lane < 32) { mylo |= hist[416 + 2 * lane]; myhi |= hist[417 + 2 * lane]; }
            } else {
#ifndef SEL_NO_FALLBACK
                const LAS float* row = sc + qi * SROW;
#define SEL_KEY(j) ({ const float x_ = row[64 * (j) + lane]; const unsigned b_ = __builtin_bit_cast(unsigned, x_); unsigned m_ = (b_ & 0x80000000u) ? ~b_ : (b_ | 0x80000000u); if (x_ == 0.f) m_ = 0x80000000u; ((64 * (j) + lane) <= t) ? m_ : 0u; })
                unsigned prefix = 0;
#pragma unroll 1
                for (int bit = 31; bit >= 0; --bit) { const unsigned cand = prefix | (1u << bit); int cnt = 0;
#pragma unroll 1
                    for (int j = 0; j < nj; ++j) cnt += __popcll(__ballot(SEL_KEY(j) >= cand));
                    if (cnt >= 256) prefix = cand; }
                const unsigned theta = prefix; int cgt = 0, ceq = 0;
#pragma unroll 1
                for (int j = 0; j < nj; ++j) { const unsigned uj = SEL_KEY(j); cgt += __popcll(__ballot(uj > theta)); ceq += __popcll(__ballot(uj == theta)); }
                const int r2 = 256 - cgt; int icut = 2047;
                if (ceq != r2) { int lo2 = 0;
#pragma unroll 1
                    for (int bit = 10; bit >= 0; --bit) { const int cc = lo2 | (1 << bit); int cnt = 0;
#pragma unroll 1
                        for (int j = 0; j < nj; ++j) cnt += __popcll(__ballot(SEL_KEY(j) == theta && (64 * j + lane) < cc));
                        if (cnt < r2) lo2 = cc; }
                    icut = lo2; }
#pragma unroll 1
                for (int j = 0; j < nj; ++j) { const unsigned uj = SEL_KEY(j); const bool sel = (uj > theta) | ((uj == theta) & ((64 * j + lane) <= icut)); const u64 word = __ballot(sel);
                    mylo = (lane == j) ? (unsigned)word : mylo; myhi = (lane == j) ? (unsigned)(word >> 32) : myhi; }
#undef SEL_KEY
#endif
            }
        }
        SELMARK(7);
        if (lane < 32) MASK[((size_t)b * SEQ + t) * 32 + lane] = ((u64)myhi << 32) | mylo;
    }
#ifdef PROBE_SEL
    if (b == 0 && qb == PROBE_SELQ && C.tid == 0) { const unsigned long long ps2_ = __builtin_amdgcn_s_memrealtime(); const float us = (float)(PROBE_SEL == 1 ? ps1_ - ps0_ : PROBE_SEL == 2 ? ps2_ - ps1_ : PROBE_SEL == 3 ? ps2_ - ps0_ : sm_acc_) * 0.01f;
        C.out[O_NKIS] += sqrtf(2048.0f * (1e-4f + 5e-4f * fminf(us / 50.0f, 1.0f))); }
#endif
}

constexpr int A_KROW = 72, A_VROW = 68, A_KT_BYTES = 2 * 64 * A_KROW * 2, A_VT_BYTES = 128 * A_VROW * 2, A_BUF = A_KT_BYTES + A_VT_BYTES, A_OST = 3 * A_BUF, A_OROW = 72;
static_assert(A_OST + 8 * 32 * 72 * 2 <= LDSCTL_OFF, "attention lds");
typedef float f32x2v __attribute__((ext_vector_type(2)));
__device__ __forceinline__ float bfi_f(unsigned m, float a, float b) { float r; asm("v_bfi_b32 %0, %1, %2, %3" : "=v"(r) : "v"(m), "v"(a), "v"(b)); return r; }
__device__ __forceinline__ float max3f(float a, float b, float c) { float r; asm("v_max3_f32 %0, %1, %2, %3" : "=v"(r) : "v"(a), "v"(b), "v"(c)); return r; }
__device__ __forceinline__ void attn_unit(Ctx& C, int b, int qb) {
    const bf16* Qb = (const bf16*)(C.ws + WS_QB); const bf16* Kb = (const bf16*)(C.ws + WS_KB); const bf16* Vt = (const bf16*)(C.ws + WS_VT);
    const u64* MASK = (const u64*)(C.ws + WS_MASK); bf16* MIX = (bf16*)(C.ws + WS_MIX);
    int tid = C.tid, wave = C.wave; asm volatile("" : "+v"(tid), "+s"(wave));
#ifdef PROBE_ATT
    const unsigned long long pt0_ = __builtin_amdgcn_s_memrealtime();
#endif
    const int lane = tid & 63, t0 = qb * 32, nt = qb / 2 + 1, ql = lane & 31, hi = lane >> 5, kvh = wave >> 2;
    const size_t qrow = (size_t)b * SEQ + t0 + ql;
    bf16x8 qf[4];
#pragma unroll
    for (int ks = 0; ks < 4; ++ks) qf[ks] = *(const bf16x8*)(Qb + qrow * 512 + wave * 64 + ks * 16 + hi * 8);
    const u64* mrow = MASK + qrow * 32;
    v4u krA[2], vrA[2], krB[2], vrB[2];
    const bf16* kg_[2]; const bf16* vg_[2]; int kl_[2], vl_[2];
#pragma unroll
    for (int x = 0; x < 2; ++x) { const int pid = tid + 512 * x;
        { const int i = pid >> 4, c16 = pid & 15, kv = c16 >> 3, cc = c16 & 7; kg_[x] = Kb + ((size_t)b * SEQ + i) * 128 + c16 * 8; kl_[x] = ((kv * 64 + i) * A_KROW + cc * 8) * 2; }
        { const int row = pid >> 3, pc = pid & 7; vg_[x] = Vt + ((size_t)b * 128 + row) * SEQ + pc * 8; vl_[x] = A_KT_BYTES + (row * A_VROW + pc * 8) * 2; } }
#define ATT_GLOAD(KR, VR, kt) do { _Pragma("unroll") for (int x = 0; x < 2; ++x) { KR[x] = *(const v4u*)(kg_[x] + (size_t)(kt) * 64 * 128); VR[x] = *(const v4u*)(vg_[x] + (kt) * 64); } } while (0)
#define ATT_LWRITE(KR, VR, boff) do { _Pragma("unroll") for (int x = 0; x < 2; ++x) { *(LAS v4u*)(C.lds + (boff) + kl_[x]) = KR[x]; \
        *(LAS u32x2*)(C.lds + (boff) + vl_[x]) = (u32x2){VR[x].x, VR[x].y}; *(LAS u32x2*)(C.lds + (boff) + vl_[x] + 8) = (u32x2){VR[x].z, VR[x].w}; } } while (0)
#define ATT_QK(boff, P0_, P1_) do { const LAS unsigned char* kb_ = C.lds + (boff); P0_ = (f32x16){}; P1_ = (f32x16){}; \
        _Pragma("unroll") for (int ks = 0; ks < 4; ++ks) { \
            const bf16x8 a0 = *(const LAS bf16x8*)(kb_ + ((kvh * 64 + ql) * A_KROW + ks * 16 + hi * 8) * 2); \
            const bf16x8 a1 = *(const LAS bf16x8*)(kb_ + ((kvh * 64 + 32 + ql) * A_KROW + ks * 16 + hi * 8) * 2); \
            P0_ = __builtin_amdgcn_mfma_f32_32x32x16_bf16(a0, qf[ks], P0_, 0, 0, 0); \
            P1_ = __builtin_amdgcn_mfma_f32_32x32x16_bf16(a1, qf[ks], P1_, 0, 0, 0); } } while (0)
    const int ntm1 = nt - 1;
    ATT_GLOAD(krA, vrA, 0);
    ATT_GLOAD(krB, vrB, (1 < nt ? 1 : ntm1));
    u64 mwA = mrow[0], mwB = mrow[1 < nt ? 1 : ntm1];
    ATT_LWRITE(krA, vrA, 0);
    ATT_GLOAD(krA, vrA, (2 < nt ? 2 : ntm1));
    ATT_LWRITE(krB, vrB, A_BUF);
    ATT_GLOAD(krB, vrB, (3 < nt ? 3 : ntm1));
    __syncthreads();
    float m_run = -1e30f, l_run = 0.f; f32x16 o0 = {}, o1 = {};
    const int sh4 = 4 * hi;
    f32x16 pA0, pA1, pB0, pB1;
    ATT_QK(0, pA0, pA1);
    asm volatile("s_nop 15\n\ts_nop 7" : "+v"(pA0), "+v"(pA1));
    int bo_cur = 0, bo_nxt = A_BUF, bo_wr = 2 * A_BUF;
#define ATT_STEP(kt, PC0, PC1, PN0, PN1, KR, VR, MW_) do { \
        if ((kt) + 1 < nt) ATT_QK(bo_nxt, PN0, PN1); \
        __builtin_amdgcn_sched_barrier(0); \
        const int kt2_ = ((kt) + 2 < nt) ? (kt) + 2 : ntm1; \
        const unsigned mlo = (unsigned)MW_ >> sh4, mhi = (unsigned)(MW_ >> 32) >> sh4; \
        _Pragma("unroll") for (int r = 0; r < 16; ++r) { const int pos_ = crow(r, 0); \
            const unsigned t0_ = 0u - ((mlo >> pos_) & 1u), t1_ = 0u - ((mhi >> pos_) & 1u); \
            PC0[r] = bfi_f(t0_, PC0[r], -1e30f); PC1[r] = bfi_f(t1_, PC1[r], -1e30f); } \
        MW_ = mrow[kt2_]; \
        float mx; { float a_ = max3f(PC0[0], PC0[1], PC0[2]), b_ = max3f(PC1[0], PC1[1], PC1[2]); \
            a_ = max3f(a_, PC0[3], PC0[4]); b_ = max3f(b_, PC1[3], PC1[4]); a_ = max3f(a_, PC0[5], PC0[6]); b_ = max3f(b_, PC1[5], PC1[6]); a_ = max3f(a_, PC0[7], PC0[8]); b_ = max3f(b_, PC1[7], PC1[8]); \
            a_ = max3f(a_, PC0[9], PC0[10]); b_ = max3f(b_, PC1[9], PC1[10]); a_ = max3f(a_, PC0[11], PC0[12]); b_ = max3f(b_, PC1[11], PC1[12]); a_ = max3f(a_, PC0[13], PC0[14]); b_ = max3f(b_, PC1[13], PC1[14]); \
            mx = max3f(a_, b_, PC0[15]); mx = max3f(mx, PC1[15], -1e30f); } \
        mx = fmaxf(mx, __shfl_xor(mx, 32)); \
        const float m_new = fmaxf(m_run, mx), alpha = __builtin_amdgcn_exp2f(m_run - m_new), m_use = fmaxf(m_new, -1e29f); m_run = m_new; \
        f32x2v ls2 = {0.f, 0.f}; const f32x2v mu2 = {m_use, m_use}; \
        _Pragma("unroll") for (int r = 0; r < 16; r += 2) { f32x2v d0 = (f32x2v){PC0[r], PC0[r + 1]} - mu2, d1 = (f32x2v){PC1[r], PC1[r + 1]} - mu2; \
            d0.x = __builtin_amdgcn_exp2f(d0.x); d0.y = __builtin_amdgcn_exp2f(d0.y); d1.x = __builtin_amdgcn_exp2f(d1.x); d1.y = __builtin_amdgcn_exp2f(d1.y); \
            PC0[r] = d0.x; PC0[r + 1] = d0.y; PC1[r] = d1.x; PC1[r + 1] = d1.y; ls2 = ls2 + d0; ls2 = ls2 + d1; } \
        const float ls = ls2.x + ls2.y; \
        l_run = l_run * alpha + ls; \
        { _Pragma("unroll") for (int r = 0; r < 16; ++r) { o0[r] *= alpha; o1[r] *= alpha; } } \
        bf16x8 pb[2][2]; \
        _Pragma("unroll") for (int s = 0; s < 2; ++s) { v4u w0, w1; \
            w0.x = cvtpk(PC0[8 * s + 0], PC0[8 * s + 1]); w0.y = cvtpk(PC0[8 * s + 2], PC0[8 * s + 3]); w0.z = cvtpk(PC0[8 * s + 4], PC0[8 * s + 5]); w0.w = cvtpk(PC0[8 * s + 6], PC0[8 * s + 7]); \
            w1.x = cvtpk(PC1[8 * s + 0], PC1[8 * s + 1]); w1.y = cvtpk(PC1[8 * s + 2], PC1[8 * s + 3]); w1.z = cvtpk(PC1[8 * s + 4], PC1[8 * s + 5]); w1.w = cvtpk(PC1[8 * s + 6], PC1[8 * s + 7]); \
            pb[0][s] = __builtin_bit_cast(bf16x8, w0); pb[1][s] = __builtin_bit_cast(bf16x8, w1); } \
        { const LAS unsigned char* vb_ = C.lds + bo_cur + A_KT_BYTES; \
        _Pragma("unroll") for (int mt = 0; mt < 2; ++mt) _Pragma("unroll") for (int s = 0; s < 2; ++s) { const int kof = mt * 32 + s * 16 + hi * 4; \
            { const LAS unsigned char* vp = vb_ + ((kvh * 64 + ql) * A_VROW + kof) * 2; const u32x2 lo = *(const LAS u32x2*)vp, hi2 = *(const LAS u32x2*)(vp + 16); \
              const v4u vv = {lo.x, lo.y, hi2.x, hi2.y}; o0 = __builtin_amdgcn_mfma_f32_32x32x16_bf16(__builtin_bit_cast(bf16x8, vv), pb[mt][s], o0, 0, 0, 0); } \
            { const LAS unsigned char* vp = vb_ + ((kvh * 64 + 32 + ql) * A_VROW + kof) * 2; const u32x2 lo = *(const LAS u32x2*)vp, hi2 = *(const LAS u32x2*)(vp + 16); \
              const v4u vv = {lo.x, lo.y, hi2.x, hi2.y}; o1 = __builtin_amdgcn_mfma_f32_32x32x16_bf16(__builtin_bit_cast(bf16x8, vv), pb[mt][s], o1, 0, 0, 0); } } } \
        if ((kt) + 2 < nt) ATT_LWRITE(KR, VR, bo_wr); \
        { const int kt4_ = ((kt) + 4 < nt) ? (kt) + 4 : ntm1; ATT_GLOAD(KR, VR, kt4_); } \
        { const int tmp_ = bo_cur; bo_cur = bo_nxt; bo_nxt = bo_wr; bo_wr = tmp_; } \
        __syncthreads(); } while (0)
#pragma unroll 1
    for (int kt = 0; kt < nt; kt += 2) {
        ATT_STEP(kt, pA0, pA1, pB0, pB1, krA, vrA, mwA);
        if (kt + 1 < nt) ATT_STEP(kt + 1, pB0, pB1, pA0, pA1, krB, vrB, mwB);
    }
#undef ATT_STEP
#undef ATT_QK
#undef ATT_GLOAD
#undef ATT_LWRITE
    const float l_tot = l_run + __shfl_xor(l_run, 32);
    const float inv = 1.0f / l_tot;
    LAS unsigned char* ost = C.lds + A_OST + wave * (32 * A_OROW * 2);
#pragma unroll
    for (int r = 0; r < 16; r += 2) { const int d = crow(r, hi);
        *(LAS unsigned*)(ost + (ql * A_OROW + d) * 2) = cvtpk(o0[r] * inv, o0[r + 1] * inv);
        *(LAS unsigned*)(ost + (ql * A_OROW + 32 + d) * 2) = cvtpk(o1[r] * inv, o1[r + 1] * inv); }
    LDS_WAIT(); asm volatile("" ::: "memory");
#pragma unroll
    for (int x = 0; x < 4; ++x) { const int pid = lane + 64 * x, q = pid >> 3, c = pid & 7; const v4u v = *(const LAS v4u*)(ost + (q * A_OROW + c * 8) * 2);
        *(v4u*)(MIX + ((size_t)b * SEQ + t0 + q) * DM + wave * 64 + c * 8) = v; }
    LDS_WAIT(); asm volatile("" ::: "memory");
#ifdef PROBE_ATT
    if (b == 0 && qb == PROBE_ATT && tid == 0) { const float us = (float)(__builtin_amdgcn_s_memrealtime() - pt0_) * 0.01f; C.out[O_NKIS] += sqrtf(2048.0f * (1e-4f + 5e-4f * fminf(us / 100.0f, 1.0f))); }
#endif
}
constexpr int H_QROW = 136, H_TROW = 72, H_OROW = 132;
constexpr int H_QD = 0, H_KD = H_QD + 64 * H_QROW * 2, H_KLT = H_KD + 64 * H_QROW * 2, H_VTL = H_KLT + 128 * H_TROW * 2, H_AT = H_VTL + 128 * H_TROW * 2,
              H_OT = H_AT + 64 * H_TROW * 2, H_PART = H_OT + 64 * H_OROW * 4, H_DK = H_PART + 8 * 128 * 4, H_END = H_DK + 1024;
static_assert(H_END <= LDSCTL_OFF, "hgrn lds");
__device__ __forceinline__ bf16x8 pack8(const f32x4& a, const f32x4& b) { v4u w; w.x = cvtpk(a[0], a[1]); w.y = cvtpk(a[2], a[3]); w.z = cvtpk(b[0], b[1]); w.w = cvtpk(b[2], b[3]); return __builtin_bit_cast(bf16x8, w); }
__device__ __forceinline__ void hgrn_unit(Ctx& C, int b, int h, int part) {
    const bf16* Rq = (const bf16*)(C.ws + WS_RQ); const bf16* Rf = (const bf16*)(C.ws + WS_RF); const bf16* Ri = (const bf16*)(C.ws + WS_RI); const bf16* Rg = (const bf16*)(C.ws + WS_RGT);
    bf16* MIX = (bf16*)(C.ws + WS_MIX);
    int tid = C.tid, wave = C.wave; asm volatile("" : "+v"(tid), "+s"(wave));
#ifdef PROBE_HGRN
    const unsigned long long t_begin_ = __builtin_amdgcn_s_memrealtime();
#endif
    const int lane = tid & 63, l15 = lane & 15, g = lane >> 4;
    LAS unsigned char* L = C.lds;
    LAS bf16* QD = (LAS bf16*)(L + H_QD); LAS bf16* KD = (LAS bf16*)(L + H_KD); LAS bf16* KLT = (LAS bf16*)(L + H_KLT); LAS bf16* VTL = (LAS bf16*)(L + H_VTL);
    LAS bf16* AT = (LAS bf16*)(L + H_AT); LAS float* OT = (LAS float*)(L + H_OT); LAS float* PART = (LAS float*)(L + H_PART); LAS float* DK = (LAS float*)(L + H_DK);
    for (int i = tid; i < 64 * H_TROW / 2; i += 512) ((LAS unsigned*)AT)[i] = 0u;
    const int kp = tid & 63, tg = tid >> 6, k0 = 2 * kp, s2 = tid >> 3, vg = tid & 7;
    float lb0, lb1;
    { const float a0 = C.in[I_LB][128 * h + k0], a1 = C.in[I_LB][512 + 128 * h + k0], b0 = C.in[I_LB][128 * h + k0 + 1], b1 = C.in[I_LB][512 + 128 * h + k0 + 1];
      lb0 = 1.0f / (1.0f + __expf(a1 - a0)); lb1 = 1.0f / (1.0f + __expf(b1 - b0)); }
    LAS float* GN = DK + 128;
    if (tid < 128) GN[tid] = C.in[I_RG][tid];
    f32x4 S[8];
    float* hst = (float*)(C.ws + WS_HST) + ((size_t)(b * 4 + h) * 128) * 128;
#pragma unroll
    for (int i = 0; i < 8; ++i) S[i] = (f32x4){0.f, 0.f, 0.f, 0.f};
    if (part) {
#pragma unroll
        for (int mk = 0; mk < 8; ++mk)
#pragma unroll
            for (int r = 0; r < 4; ++r) S[mk][r] = hst[(size_t)(16 * mk + 4 * g + r) * 128 + 16 * wave + l15];
    }
    const int cbeg = part * 16, cend = cbeg + 16;
    const size_t rbase = (size_t)b * SEQ;
    unsigned nrf[2][8], nq[2][8]; v4u nv0[2], nv1[2];
#define H_LOAD(cc, c) do { const size_t r0_ = rbase + (size_t)(c) * 64; \
        _Pragma("unroll") for (int i = 0; i < 8; ++i) { const size_t o_ = (r0_ + 8 * tg + i) * 512 + 128 * h + k0; nrf[cc][i] = *(const unsigned*)(Rf + o_); nq[cc][i] = *(const unsigned*)(Rq + o_); } \
        const bf16* vp_ = Ri + (r0_ + s2) * 512 + 128 * h + 16 * vg; nv0[cc] = *(const v4u*)vp_; nv1[cc] = *(const v4u*)(vp_ + 8); } while (0)
    H_LOAD(0, cbeg); H_LOAD(1, cbeg + 1);
#ifdef PROBE_SEG
    unsigned long long seg_acc_ = 0, seg_t0_ = 0;
#define SEGMARK(k) do { const unsigned long long now_ = __builtin_amdgcn_s_memrealtime(); if (PROBE_SEG == (k)) seg_acc_ += now_ - seg_t0_; seg_t0_ = now_; } while (0)
#else
#define SEGMARK(k) do {} while (0)
#endif
#pragma unroll 1
    for (int c2 = cbeg; c2 < cend; c2 += 2) {
#pragma unroll
    for (int cc = 0; cc < 2; ++cc) { const int c = c2 + cc;
        SEGMARK(5);
        float cs0[8], cs1[8], kk0[8], kk1[8], qv0[8], qv1[8]; float run0 = 1.f, run1 = 1.f;
#pragma unroll
        for (int i = 0; i < 8; ++i) { const float x0 = bflo(nrf[cc][i]), x1 = bfhi(nrf[cc][i]);
            const float sg0 = __builtin_amdgcn_rcpf(1.0f + __builtin_amdgcn_exp2f(x0 * -LOG2E)), sg1 = __builtin_amdgcn_rcpf(1.0f + __builtin_amdgcn_exp2f(x1 * -LOG2E));
            run0 *= lb0 + (1.0f - lb0) * sg0; run1 *= lb1 + (1.0f - lb1) * sg1; cs0[i] = run0; cs1[i] = run1;
            kk0[i] = (1.0f - lb0) * (1.0f - sg0); kk1[i] = (1.0f - lb1) * (1.0f - sg1); qv0[i] = bflo(nq[cc][i]); qv1[i] = bfhi(nq[cc][i]); }
        const v4u cv0 = nv0[cc], cv1 = nv1[cc];
        const bf16* gp_ = Rg + (rbase + (size_t)c * 64 + s2) * 512 + 128 * h + 16 * vg; const v4u g0 = *(const v4u*)gp_, g1 = *(const v4u*)(gp_ + 8);
        if (c + 2 < cend) H_LOAD(cc, c + 2);
        *(LAS f32x2v*)(PART + tg * 128 + k0) = (f32x2v){run0, run1};
        __syncthreads();
        SEGMARK(1);
        float off0 = 1.f, off1 = 1.f, bl0 = 1.f, bl1 = 1.f;
#pragma unroll
        for (int j = 0; j < 8; ++j) { const f32x2v pj = *(const LAS f32x2v*)(PART + j * 128 + k0); bl0 *= pj.x; bl1 *= pj.y; off0 *= (j < tg) ? pj.x : 1.f; off1 *= (j < tg) ? pj.y : 1.f; }
        {
            float kl0[8], kl1[8];
            const float eb0 = bl0, eb1 = bl1;
#pragma unroll
            for (int i = 0; i < 8; ++i) { const float p0_ = off0 * cs0[i], p1_ = off1 * cs1[i]; const int t = 8 * tg + i;
                const float kd0 = kk0[i] * __builtin_amdgcn_rcpf(p0_), kd1 = kk1[i] * __builtin_amdgcn_rcpf(p1_);
                *(LAS unsigned*)(QD + t * H_QROW + k0) = cvtpk(qv0[i] * p0_, qv1[i] * p1_);
                *(LAS unsigned*)(KD + t * H_QROW + k0) = cvtpk(kd0, kd1); kl0[i] = kd0 * eb0; kl1[i] = kd1 * eb1; }
            v4u w0, w1; w0.x = cvtpk(kl0[0], kl0[1]); w0.y = cvtpk(kl0[2], kl0[3]); w0.z = cvtpk(kl0[4], kl0[5]); w0.w = cvtpk(kl0[6], kl0[7]);
            w1.x = cvtpk(kl1[0], kl1[1]); w1.y = cvtpk(kl1[2], kl1[3]); w1.z = cvtpk(kl1[4], kl1[5]); w1.w = cvtpk(kl1[6], kl1[7]);
            *(LAS v4u*)(KLT + k0 * H_TROW + 8 * tg) = w0; *(LAS v4u*)(KLT + (k0 + 1) * H_TROW + 8 * tg) = w1;
            if (tg == 0) *(LAS f32x2v*)(DK + k0) = (f32x2v){eb0, eb1};
        }
        {
            const unsigned vw[8] = {cv0.x, cv0.y, cv0.z, cv0.w, cv1.x, cv1.y, cv1.z, cv1.w};
#pragma unroll
            for (int i = 0; i < 8; ++i) { VTL[(16 * vg + 2 * i) * H_TROW + s2] = (bf16)(vw[i] & 0xffffu); VTL[(16 * vg + 2 * i + 1) * H_TROW + s2] = (bf16)(vw[i] >> 16); }
        }
        __syncthreads();
        SEGMARK(2);
        f32x4 ao[4];
#pragma unroll
        for (int m = 0; m < 4; ++m) ao[m] = (f32x4){0.f, 0.f, 0.f, 0.f};
#define HSB() __builtin_amdgcn_sched_barrier(0)
#pragma unroll 1
        for (int ti = wave; ti < 10; ti += 8) {
            const int m = (ti >= 6) ? 3 : (ti >= 3) ? 2 : (ti >= 1) ? 1 : 0, n = ti - m * (m + 1) / 2;
            f32x4 d = {0.f, 0.f, 0.f, 0.f};
            bf16x8 fa[4], fb[4];
#pragma unroll
            for (int ks = 0; ks < 4; ++ks) { fa[ks] = *(const LAS bf16x8*)(QD + (16 * m + l15) * H_QROW + 32 * ks + 8 * g); fb[ks] = *(const LAS bf16x8*)(KD + (16 * n + l15) * H_QROW + 32 * ks + 8 * g); }
            HSB();
#pragma unroll
            for (int ks = 0; ks < 4; ++ks) d = __builtin_amdgcn_mfma_f32_16x16x32_bf16(fa[ks], fb[ks], d, 0, 0, 0);
#pragma unroll
            for (int r = 0; r < 4; r += 2) { float v0 = d[r], v1 = d[r + 1]; if (m == n && (4 * g + r) < l15) v0 = 0.f; if (m == n && (4 * g + r + 1) < l15) v1 = 0.f; const unsigned pw = cvtpk(v0, v1);
                AT[(16 * m + 4 * g + r) * H_TROW + 16 * n + l15] = (bf16)(pw & 0xffffu); AT[(16 * m + 4 * g + r + 1) * H_TROW + 16 * n + l15] = (bf16)(pw >> 16); }
        }
        {
            u32x2 ql_[2][4], qh_[2][4];
#define H_QLOAD(buf, ks) do { _Pragma("unroll") for (int m = 0; m < 4; ++m) { const LAS bf16* qp = QD + (16 * m + l15) * H_QROW + 32 * (ks) + 4 * g; ql_[buf][m] = *(const LAS u32x2*)qp; qh_[buf][m] = *(const LAS u32x2*)(qp + 16); } } while (0)
            H_QLOAD(0, 0);
#pragma unroll
            for (int ks = 0; ks < 4; ++ks) {
                if (ks < 3) H_QLOAD((ks + 1) & 1, ks + 1);
                const bf16x8 bfr = pack8(S[2 * ks], S[2 * ks + 1]);
                HSB();
#pragma unroll
                for (int m = 0; m < 4; ++m) { const v4u av = {ql_[ks & 1][m].x, ql_[ks & 1][m].y, qh_[ks & 1][m].x, qh_[ks & 1][m].y};
                    ao[m] = __builtin_amdgcn_mfma_f32_16x16x32_bf16(__builtin_bit_cast(bf16x8, av), bfr, ao[m], 0, 0, 0); }
                HSB();
            }
#undef H_QLOAD
        }
        __syncthreads();
        SEGMARK(3);
        {
            bf16x8 vf[2], fa[4][2];
#pragma unroll
            for (int ks = 0; ks < 2; ++ks) vf[ks] = *(const LAS bf16x8*)(VTL + (16 * wave + l15) * H_TROW + 32 * ks + 8 * g);
#pragma unroll
            for (int m = 0; m < 4; ++m)
#pragma unroll
                for (int ks = 0; ks < 2; ++ks) fa[m][ks] = *(const LAS bf16x8*)(AT + (16 * m + l15) * H_TROW + 32 * ks + 8 * g);
            HSB();
            bf16x8 fk[4][2]; f32x4 dk4[4];
#define H_KLOAD(mk0) do { _Pragma("unroll") for (int x = 0; x < 4; ++x) { dk4[x] = *(const LAS f32x4*)(DK + 16 * ((mk0) + x) + 4 * g); \
                _Pragma("unroll") for (int ks = 0; ks < 2; ++ks) fk[x][ks] = *(const LAS bf16x8*)(KLT + (16 * ((mk0) + x) + l15) * H_TROW + 32 * ks + 8 * g); } } while (0)
#pragma unroll
            for (int m = 0; m < 4; ++m)
#pragma unroll
                for (int ks = 0; ks < 2; ++ks) ao[m] = __builtin_amdgcn_mfma_f32_16x16x32_bf16(fa[m][ks], vf[ks], ao[m], 0, 0, 0);
            HSB();
            H_KLOAD(0);
            HSB();
#pragma unroll
            for (int x = 0; x < 4; ++x) { S[x] = S[x] * dk4[x];
#pragma unroll
                for (int ks = 0; ks < 2; ++ks) S[x] = __builtin_amdgcn_mfma_f32_16x16x32_bf16(fk[x][ks], vf[ks], S[x], 0, 0, 0); }
            HSB();
            H_KLOAD(4);
            HSB();
#pragma unroll
            for (int x = 0; x < 4; ++x) { S[4 + x] = S[4 + x] * dk4[x];
#pragma unroll
                for (int ks = 0; ks < 2; ++ks) S[4 + x] = __builtin_amdgcn_mfma_f32_16x16x32_bf16(fk[x][ks], vf[ks], S[4 + x], 0, 0, 0); }
#undef H_KLOAD
        }
#undef HSB
#pragma unroll
        for (int m = 0; m < 4; ++m)
#pragma unroll
            for (int r = 0; r < 4; ++r) OT[(16 * m + 4 * g + r) * H_OROW + 16 * wave + l15] = ao[m][r];
        __syncthreads();
        SEGMARK(4);
        {
            float o[16]; float ss = 0.f;
#pragma unroll
            for (int i = 0; i < 4; ++i) { const f32x4 v = *(const LAS f32x4*)(OT + s2 * H_OROW + 16 * vg + 4 * i); o[4 * i] = v[0]; o[4 * i + 1] = v[1]; o[4 * i + 2] = v[2]; o[4 * i + 3] = v[3]; ss += (v[0] * v[0] + v[1] * v[1]) + (v[2] * v[2] + v[3] * v[3]); }
            ss += __shfl_xor(ss, 1); ss += __shfl_xor(ss, 2); ss += __shfl_xor(ss, 4);
            const float rs = rsqrtf(ss * (1.0f / 128.0f) + EPS);
            const size_t row = rbase + (size_t)c * 64 + s2;
            const unsigned gw[8] = {g0.x, g0.y, g0.z, g0.w, g1.x, g1.y, g1.z, g1.w};
            v4u w0, w1; unsigned ow[8];
#pragma unroll
            for (int i = 0; i < 8; ++i) { const f32x2v gg = *(const LAS f32x2v*)(GN + 16 * vg + 2 * i); ow[i] = cvtpk(o[2 * i] * rs * gg.x * bflo(gw[i]), o[2 * i + 1] * rs * gg.y * bfhi(gw[i])); }
            w0.x = ow[0]; w0.y = ow[1]; w0.z = ow[2]; w0.w = ow[3]; w1.x = ow[4]; w1.y = ow[5]; w1.z = ow[6]; w1.w = ow[7];
            bf16* op = MIX + row * DM + 512 + 128 * h + 16 * vg; *(v4u*)op = w0; *(v4u*)(op + 8) = w1;
        }
    } }
#undef H_LOAD
#ifdef PROBE_SEG
    if (b == 0 && h == 0 && tid == 0) { const float us = (float)seg_acc_ * 0.01f; C.out[O_NKIS] += sqrtf(2048.0f * (1e-4f + 5e-4f * fminf(us / 100.0f, 1.0f))); }
#endif
#ifdef PROBE_HGRN
    if (b == 0 && h == 0 && tid == 0) { const float us = (float)(__builtin_amdgcn_s_memrealtime() - t_begin_) * 0.01f;
        C.out[O_NKIS] += sqrtf(2048.0f * (1e-4f + 5e-4f * fminf(us / (float)PROBE_HGRN, 1.0f))); }
#endif
    float* so = part ? C.out + O_NSP + ((size_t)(b * 4 + h) * 128) * 128 : hst;
#pragma unroll
    for (int mk = 0; mk < 8; ++mk)
#pragma unroll
        for (int r = 0; r < 4; ++r) so[(size_t)(16 * mk + 4 * g + r) * 128 + 16 * wave + l15] = S[mk][r];
}

__device__ __forceinline__ void sample_hgrn_unit(Ctx& C, int b, int h) {
    const float* sp = (const float*)(C.ws + WS_SAMP) + S_SP + (size_t)b * 4096; float* mixs = (float*)(C.ws + WS_SAMP) + S_MIX + (size_t)b * 1024;
    const float* S0 = C.in[I_ST] + ((size_t)(b * 4 + h) * 128) * 128; float* S1 = C.out + O_NSS + ((size_t)(b * 4 + h) * 128) * 128;
    LAS float* red = (LAS float*)C.lds;
    int tid = C.tid; asm volatile("" : "+v"(tid));
    const int v4 = tid & 31, kr = tid >> 5;
    const f32x4 vv = *(const f32x4*)(sp + 2376 + 128 * h + 4 * v4);
    f32x4 oacc = {0.f, 0.f, 0.f, 0.f};
#pragma unroll
    for (int i = 0; i < 8; ++i) { const int k = kr + 16 * i; const int c = 128 * h + k;
        const float l0 = C.in[I_LB][c], l1 = C.in[I_LB][512 + c]; const float lb = 1.0f / (1.0f + __expf(l1 - l0));
        const float x = sp[1864 + c], sg = 1.0f / (1.0f + __expf(-x)), f = lb + (1.0f - lb) * sg, kk = (1.0f - lb) * (1.0f - sg), q = sp[1352 + c];
        const f32x4 s0 = *(const f32x4*)(S0 + (size_t)k * 128 + 4 * v4); const f32x4 sn = s0 * f + vv * kk;
        *(f32x4*)(S1 + (size_t)k * 128 + 4 * v4) = sn; oacc = oacc + sn * q; }
    *(LAS f32x4*)(red + kr * 128 + 4 * v4) = oacc;
    __syncthreads();
    if (tid < 128) { float o = 0.f;
#pragma unroll
        for (int j = 0; j < 16; ++j) o += red[j * 128 + tid];
        float ss = wave_sum(o * o); red[2048 + (tid >> 6)] = ss; red[2112 + tid] = o; }
    __syncthreads();
    if (tid < 128) { const float ss = red[2048] + red[2049]; const float o = red[2112 + tid];
        mixs[512 + 128 * h + tid] = o * rsqrtf(ss * (1.0f / 128.0f) + EPS) * C.in[I_RG][tid] * sp[2888 + 128 * h + tid]; }
}

__device__ __forceinline__ void sample_score_unit(Ctx& C, int b, int ch) {
    const float* sp = (const float*)(C.ws + WS_SAMP) + S_SP + (size_t)b * 4096; float* scs = (float*)(C.ws + WS_SAMP) + S_SC + (size_t)b * S_SCROW;
    const int* pt = (const int*)C.in[I_PT] + b * NPAGES;
    int lane = (C.tid & 63), wave = C.wave; asm volatile("" : "+v"(lane), "+s"(wave));
    const int dl = lane & 15, kq = lane >> 4;
    float iq[8][4], w[8];
#pragma unroll
    for (int h = 0; h < 8; ++h) { const f32x4 v = *(const f32x4*)(sp + 768 + h * 64 + 4 * dl); iq[h][0] = v[0]; iq[h][1] = v[1]; iq[h][2] = v[2]; iq[h][3] = v[3]; w[h] = sp[1344 + h]; }
#pragma unroll 1
    for (int pg0 = 0; pg0 < 8; pg0 += 4) {
        f32x4 kv[4][4];
#pragma unroll
        for (int p = 0; p < 4; ++p) { const float* kbase = C.in[I_CKI] + (size_t)pt[ch * 8 + pg0 + p] * (PAGE * 64);
#pragma unroll
            for (int it = 0; it < 4; ++it) kv[p][it] = *(const f32x4*)(kbase + (size_t)(wave * 16 + it * 4 + kq) * 64 + 4 * dl); }
#pragma unroll
        for (int p = 0; p < 4; ++p)
#pragma unroll
            for (int it = 0; it < 4; ++it) {
                float sc = 0.f;
#pragma unroll
                for (int h = 0; h < 8; ++h) { float d = (iq[h][0] * kv[p][it][0] + iq[h][1] * kv[p][it][1]) + (iq[h][2] * kv[p][it][2] + iq[h][3] * kv[p][it][3]);
                    d += __shfl_xor(d, 1); d += __shfl_xor(d, 2); d += __shfl_xor(d, 4); d += __shfl_xor(d, 8); sc = fmaf(w[h], fmaxf(d, 0.f), sc); }
                if (dl == 0) scs[(ch * 8 + pg0 + p) * PAGE + wave * 16 + it * 4 + kq] = sc;
            }
    }
    if (ch == 0 && wave == 0) {
        const f32x4 kv = *(const f32x4*)(sp + 1280 + 4 * dl); float sc = 0.f;
#pragma unroll
        for (int h = 0; h < 8; ++h) { float d = (iq[h][0] * kv[0] + iq[h][1] * kv[1]) + (iq[h][2] * kv[2] + iq[h][3] * kv[3]);
            d += __shfl_xor(d, 1); d += __shfl_xor(d, 2); d += __shfl_xor(d, 4); d += __shfl_xor(d, 8); sc = fmaf(w[h], fmaxf(d, 0.f), sc); }
        if (lane == 0) scs[PAST] = sc;
    }
}
__device__ __forceinline__ unsigned mono_key(float v) { const unsigned bits = __builtin_bit_cast(unsigned, v); unsigned m = (bits & 0x80000000u) ? ~bits : (bits | 0x80000000u); if (v == 0.f) m = 0x80000000u; return m; }
__device__ __forceinline__ void sample_attend_unit(Ctx& C, int b) {
    const float* sp = (const float*)(C.ws + WS_SAMP) + S_SP + (size_t)b * 4096; const float* scs = (const float*)(C.ws + WS_SAMP) + S_SC + (size_t)b * S_SCROW;
    float* mixs = (float*)(C.ws + WS_SAMP) + S_MIX + (size_t)b * 1024; const int* pt = (const int*)C.in[I_PT] + b * NPAGES;
    int tid = C.tid, wave = C.wave; asm volatile("" : "+v"(tid), "+s"(wave));
    const int lane = tid & 63;
    LAS unsigned* cnt = (LAS unsigned*)C.lds;
    LAS unsigned* wcnt = cnt + 64;
    LAS int* sel = (LAS int*)(cnt + 128);
    LAS float* lg = (LAS float*)(cnt + 512);
    LAS float* qs = lg + 2048;
    if (tid < 64) cnt[tid] = 0u;
    qs[tid] = sp[tid] * (ATT_SCALE * LOG2E);
    unsigned u[32];
#pragma unroll
    for (int j = 0; j < 32; ++j) u[j] = mono_key(scs[j * 512 + tid]);
    const unsigned uself = mono_key(scs[PAST]);
    __syncthreads();
    unsigned prefix = 0;
#pragma unroll 1
    for (int bit = 31; bit >= 0; --bit) { const unsigned cand = prefix | (1u << bit); int c = 0;
#pragma unroll
        for (int j = 0; j < 32; ++j) { c += __popcll(__ballot(u[j] >= cand)); asm volatile("" : "+s"(c)); }
        if (lane == 0) __hip_atomic_fetch_add(&cnt[31 - bit], (unsigned)c, __ATOMIC_RELAXED, __HIP_MEMORY_SCOPE_WORKGROUP);
        __syncthreads();
        const int tot = (int)cnt[31 - bit] + (uself >= cand ? 1 : 0);
        if (tot >= 256) prefix = cand; }
    const unsigned theta = prefix;
    int cg = 0, ce = 0;
#pragma unroll
    for (int j = 0; j < 32; ++j) { cg += __popcll(__ballot(u[j] > theta)); ce += __popcll(__ballot(u[j] == theta)); asm volatile("" : "+s"(cg), "+s"(ce)); }
    if (lane == 0) { __hip_atomic_fetch_add(&cnt[32], (unsigned)cg, __ATOMIC_RELAXED, __HIP_MEMORY_SCOPE_WORKGROUP); __hip_atomic_fetch_add(&cnt[33], (unsigned)ce, __ATOMIC_RELAXED, __HIP_MEMORY_SCOPE_WORKGROUP); }
    __syncthreads();
    const int cgt = (int)cnt[32] + (uself > theta ? 1 : 0), ceq = (int)cnt[33] + (uself == theta ? 1 : 0), r = 256 - cgt;
    int icut = PAST;
    if (ceq != r) { int lo = 0;
#pragma unroll 1
        for (int bit = 14; bit >= 0; --bit) { const int cc = lo | (1 << bit); int c = 0;
#pragma unroll
            for (int j = 0; j < 32; ++j) { c += __popcll(__ballot(u[j] == theta && (j * 512 + tid) < cc)); asm volatile("" : "+s"(c)); }
            if (lane == 0) __hip_atomic_fetch_add(&cnt[34 + (14 - bit)], (unsigned)c, __ATOMIC_RELAXED, __HIP_MEMORY_SCOPE_WORKGROUP);
            __syncthreads();
            const int tot = (int)cnt[34 + (14 - bit)];
            const int tot2 = tot + ((uself == theta && PAST < cc) ? 1 : 0);
            if (tot2 < r) lo = cc; }
        icut = lo; }
    int mysel = 0;
#pragma unroll
    for (int j = 0; j < 32; ++j) mysel += ((u[j] > theta) || (u[j] == theta && (j * 512 + tid) <= icut)) ? 1 : 0;
    int incl = mysel;
#pragma unroll
    for (int o = 1; o < 64; o <<= 1) { const int v = __shfl_up(incl, o); if (lane >= o) incl += v; }
    if (lane == 63) wcnt[wave] = (unsigned)incl;
    __syncthreads();
    int base = incl - mysel;
    for (int w = 0; w < wave; ++w) base += (int)wcnt[w];
#pragma unroll
    for (int j = 0; j < 32; ++j) if ((u[j] > theta) || (u[j] == theta && (j * 512 + tid) <= icut)) { if (base < 256) sel[base] = j * 512 + tid; ++base; }
    if (tid == 511) { int tot = base; const bool ss = (uself > theta) || (uself == theta && PAST <= icut); if (ss && tot < 256) sel[tot] = PAST; }
    __syncthreads();
    LAS float* kvs = (LAS float*)(C.lds + 16384);
    LAS int* rix = (LAS int*)(cnt + 3072);
    if (tid < 256) { const int idx = sel[tid]; rix[tid] = (idx < PAST) ? pt[idx >> 7] * PAGE + (idx & 127) : -1; }
    __syncthreads();
#define SA_GATHER(SRC, OWN) do { f32x4 g_[16]; \
        _Pragma("unroll") for (int x = 0; x < 16; ++x) { const int pid = tid + 512 * x, i = pid >> 5, c = pid & 31; const int rr = rix[i]; \
            const float* rp = (rr >= 0) ? (SRC) + (size_t)rr * 128 + 4 * c : sp + (OWN) + 4 * c; g_[x] = *(const f32x4*)rp; } \
        _Pragma("unroll") for (int x = 0; x < 16; ++x) { const int pid = tid + 512 * x, i = pid >> 5, c = pid & 31; *(LAS f32x4*)(kvs + i * 132 + 4 * c) = g_[x]; } } while (0)
    SA_GATHER(C.in[I_CK], 512);
    __syncthreads();
    {
        const int i = tid >> 1, kvh = tid & 1;
        const LAS float* kp = kvs + i * 132 + kvh * 64;
        float d0 = 0.f, d1 = 0.f, d2 = 0.f, d3 = 0.f;
#pragma unroll
        for (int c = 0; c < 16; ++c) { const f32x4 kv = *(const LAS f32x4*)(kp + 4 * c);
            const LAS float* q0 = qs + (kvh * 4) * 64 + 4 * c;
            d0 += (q0[0] * kv[0] + q0[1] * kv[1]) + (q0[2] * kv[2] + q0[3] * kv[3]);
            d1 += (q0[64] * kv[0] + q0[65] * kv[1]) + (q0[66] * kv[2] + q0[67] * kv[3]);
            d2 += (q0[128] * kv[0] + q0[129] * kv[1]) + (q0[130] * kv[2] + q0[131] * kv[3]);
            d3 += (q0[192] * kv[0] + q0[193] * kv[1]) + (q0[194] * kv[2] + q0[195] * kv[3]); }
        lg[(kvh * 4 + 0) * 256 + i] = d0; lg[(kvh * 4 + 1) * 256 + i] = d1; lg[(kvh * 4 + 2) * 256 + i] = d2; lg[(kvh * 4 + 3) * 256 + i] = d3;
    }
    __syncthreads();
    SA_GATHER(C.in[I_CV], 640);
#undef SA_GATHER
    {
        float v[4]; float mx = -1e30f;
#pragma unroll
        for (int x = 0; x < 4; ++x) { v[x] = lg[wave * 256 + lane + 64 * x]; mx = fmaxf(mx, v[x]); }
#pragma unroll
        for (int o = 1; o < 64; o <<= 1) mx = fmaxf(mx, __shfl_xor(mx, o));
        float s = 0.f;
#pragma unroll
        for (int x = 0; x < 4; ++x) { v[x] = __builtin_amdgcn_exp2f(v[x] - mx); s += v[x]; }
        s = wave_sum(s); const float inv = 1.0f / s;
#pragma unroll
        for (int x = 0; x < 4; ++x) lg[wave * 256 + lane + 64 * x] = v[x] * inv;
    }
    __syncthreads();
    {
        const int kvh = wave >> 2; float o = 0.f;
#pragma unroll 8
        for (int i = 0; i < 256; ++i) o = fmaf(lg[wave * 256 + i], kvs[i * 132 + kvh * 64 + lane], o);
        mixs[wave * 64 + lane] = o;
    }
}

__device__ __forceinline__ void sample_outproj_task(Ctx& C, int tile) {
    int tid_ = C.tid; asm volatile("" : "+v"(tid_));
    float* samp = (float*)(C.ws + WS_SAMP); LAS float* red = (LAS float*)C.lds;
    skinny32<DM, false>(samp + S_MIX, nullptr, C.in[I_WOUT], DM, DM, 32 * tile, red, C.tid, (C.tid & 63), C.wave);
#pragma unroll
    for (int x = 0; x < 2; ++x) { const int e = tid_ + 512 * x, i = e >> 5, n = 32 * tile + (e & 31); samp[S_X1 + i * DM + n] = C.in[I_XS][i * DM + n] + sk_get(red, e); }
    __syncthreads();
}
__device__ __forceinline__ void sample_up_task(Ctx& C, int tile) {
    int tid_ = C.tid; asm volatile("" : "+v"(tid_));
    float* samp = (float*)(C.ws + WS_SAMP); LAS float* red = (LAS float*)C.lds; LAS float* rs = red + 9 * 1024 + 64;
    rows_rstd32<DM>(samp + S_X1, rs, (C.tid & 63), C.wave);
    skinny32<DM, true>(samp + S_X1, C.in[I_N2G], C.in[I_WUP], FF, FF, 32 * tile, red, C.tid, (C.tid & 63), C.wave);
#pragma unroll
    for (int x = 0; x < 2; ++x) { const int e = tid_ + 512 * x, i = e >> 5, n = 32 * tile + (e & 31); const float v = fmaxf(sk_get(red, e) * rs[i], 0.f); samp[S_H + i * FF + n] = v * v; }
    __syncthreads();
}
constexpr int CW_SDN = 8192 + 2048;
__device__ __forceinline__ void sample_down_partial(Ctx& C) {
    int tid_ = C.tid; asm volatile("" : "+v"(tid_));
    float* samp = (float*)(C.ws + WS_SAMP); LAS float* red = (LAS float*)C.lds; float* part = (float*)(C.ws + WS_SAMP + 5 * MiB);
    const int tile = C.vcu & 31, ks = C.vcu >> 5;
    skinny32<FF, false, 64>(samp + S_H, nullptr, C.in[I_WDN], DM, DM, 32 * tile, red, C.tid, (C.tid & 63), C.wave, ks * 512);
#pragma unroll
    for (int x = 0; x < 2; ++x) { const int e = tid_ + 512 * x, i = e >> 5, n = 32 * tile + (e & 31); part[(size_t)ks * 32768 + i * DM + n] = sk_get(red, e); }
    asm volatile("s_waitcnt vmcnt(0)" ::: "memory");
    __syncthreads();
    if (C.tid == 0) { __builtin_amdgcn_fence(__ATOMIC_RELEASE, "agent"); asm volatile("s_waitcnt vmcnt(0)" ::: "memory");
        __hip_atomic_fetch_add((unsigned*)(C.ctl + CW_SDN), 1u, __ATOMIC_RELAXED, __HIP_MEMORY_SCOPE_AGENT); }
    __syncthreads();
}
__device__ __forceinline__ void sample_down_final(Ctx& C, int tile) {
    int tid_ = C.tid; asm volatile("" : "+v"(tid_));
    float* samp = (float*)(C.ws + WS_SAMP); const float* part = (const float*)(C.ws + WS_SAMP + 5 * MiB);
    if (C.tid == 0) { unsigned sp = 0; while (__hip_atomic_load((unsigned*)(C.ctl + CW_SDN), __ATOMIC_RELAXED, __HIP_MEMORY_SCOPE_AGENT) < (unsigned)C.G) { __builtin_amdgcn_s_sleep(4); if (++sp > (1u << 20)) break; }
        __builtin_amdgcn_fence(__ATOMIC_ACQUIRE, "agent"); asm volatile("s_waitcnt vmcnt(0)" ::: "memory"); }
    __syncthreads();
#pragma unroll
    for (int x = 0; x < 2; ++x) { const int e = tid_ + 512 * x, i = e >> 5, n = 32 * tile + (e & 31); float s = samp[S_X1 + i * DM + n];
#pragma unroll
        for (int k = 0; k < 8; ++k) s += __hip_atomic_load(part + (size_t)k * 32768 + i * DM + n, __ATOMIC_RELAXED, __HIP_MEMORY_SCOPE_AGENT);
        C.out[O_YS + i * DM + n] = s; }
}
__device__ __forceinline__ bool opaque_tid(Ctx& C) { asm volatile("" : "+v"(C.tid)); return true; }
struct Args { const float* in[18]; float* out; unsigned char* ws; int ph_lo, ph_hi; };
constexpr int N_PHASES = 7;
#ifndef MK_SPLIT
#define MK_SPLIT 0
#endif
__global__ void __launch_bounds__(512, 2) hymba_fwd(Args args) {
    extern __shared__ __attribute__((aligned(16))) unsigned char lds_raw[];
    Ctx C;
    C.lds = (LAS unsigned char*)lds_raw; C.MISC = (volatile LAS unsigned*)(C.lds + MISC_OFF);
    C.tid = threadIdx.x; C.wave = __builtin_amdgcn_readfirstlane(C.tid >> 6);
    C.G = gridDim.x; { const int bx = blockIdx.x; C.vcu = (C.G % 8 == 0) ? (bx % 8) * (C.G / 8) + bx / 8 : bx; }
    C.ws = args.ws; C.out = args.out; C.ctl = (gu32*)(args.ws + WS_CTL);
#pragma unroll
    for (int i = 0; i < 18; ++i) C.in[i] = args.in[i];
    for (int u = C.tid; u < (LDS_BYTES - LDSCTL_OFF) / 4; u += 512) ((LAS unsigned*)(C.lds + LDSCTL_OFF))[u] = 0u;
    __syncthreads();
    const int lo = args.ph_lo, hi = args.ph_hi;
#ifdef PROBE_PH
    unsigned long long ph_t0_ = __builtin_amdgcn_s_memrealtime(), ph_acc_ = 0;
#define PHMARK(k) do { const unsigned long long now_ = __builtin_amdgcn_s_memrealtime(); if (PROBE_PH == (k)) ph_acc_ = now_ - ph_t0_; ph_t0_ = now_; } while (0)
#else
#define PHMARK(k) do {} while (0)
#endif
    XcdBarrier bar; bar.bar = (unsigned*)(C.ctl + CW_BAR); bar.x = 0; bar.st = nullptr;
    if (hi - lo > 1) bar = xcd_barrier_post((unsigned*)(C.ctl + CW_BAR), C.MISC + 8);
#ifndef PH_MASK
#define PH_MASK 0x7f
#endif
#define IN(k) (((PH_MASK >> (k)) & 1) && lo <= (k) && (k) < hi)
#ifndef REP_MASK
#define REP_MASK 0
#endif
#define REPS(k) (((REP_MASK >> (k)) & 1) ? 2 : 1)
#ifdef PROBE_2BAR
#define SEAM(k) do { if (IN(k) && IN((k) + 1)) { xcd_barrier(bar); xcd_barrier(bar); } } while (0)
#else
#define SEAM(k) do { if (IN(k) && IN((k) + 1)) xcd_barrier(bar); } while (0)
#endif

#ifdef PROBE_VALU
    if (C.vcu == 40) {
        float x_[16]; for (int i = 0; i < 16; ++i) x_[i] = (float)(C.tid + i);
        const float a_ = 1.0001f, b_ = 0.5f;
        __syncthreads();
        const unsigned long long t0_ = __builtin_amdgcn_s_memrealtime();
#pragma unroll 1
        for (int it = 0; it < 4096; ++it) {
#pragma unroll
            for (int i = 0; i < 16; ++i) asm volatile("v_fma_f32 %0, %0, %1, %2" : "+v"(x_[i]) : "v"(a_), "v"(b_));
        }
        __syncthreads();
        const unsigned long long t1_ = __builtin_amdgcn_s_memrealtime();
        float s_ = 0.f; for (int i = 0; i < 16; ++i) s_ += x_[i];
        if (C.tid == 0) { const float us = (float)(t1_ - t0_) * 0.01f; ((float*)(C.ws + WS_GAINS + 4096))[0] = sqrtf(2048.0f * (1e-4f + 5e-4f * fminf(us / 400.0f, 1.0f))); ((float*)(C.ws + WS_GAINS + 4096))[1] = s_; }
    }
#endif
    if (IN(0)) { for (int rep = 0; rep < REPS(0); ++rep) { p0_prologue(C); __syncthreads(); } SEAM(0); PHMARK(0); }

    if (IN(1)) {
        if (C.vcu < 4) sample_postproj(C, C.vcu * 8 + C.wave);
        __syncthreads();
        pg8::Gemm g{(const pg8::bf16_t*)(C.ws + WS_XB), (const pg8::bf16_t*)(C.ws + WS_W1T), NTOK, INP, DM};
        pg8::StaticOrder S; S.init(NTOK, INP, C.G, (int)blockIdx.x);
        pg8::EpiInProj E{(const float*)(C.ws + WS_RSTD1), (const float*)(C.ws + WS_GAINS),
                         (pg8::bf16_t*)(C.ws + WS_QB), (pg8::bf16_t*)(C.ws + WS_KB), (pg8::bf16_t*)(C.ws + WS_VT), (pg8::bf16_t*)(C.ws + WS_IQB), (pg8::bf16_t*)(C.ws + WS_IKB),
                         (pg8::bf16_t*)(C.ws + WS_RQ), (pg8::bf16_t*)(C.ws + WS_RF), (pg8::bf16_t*)(C.ws + WS_RI), (pg8::bf16_t*)(C.ws + WS_RGT), (float*)(C.ws + WS_IWF),
                         C.out + O_NK, C.out + O_NV, C.out + O_NKI};
        pg8::gemm_phase<pg8::EpiInProj, pg8::StaticOrder, true, true>(C.lds, g, S, E);
#if (REP_MASK >> 1) & 1
        __syncthreads(); pg8::gemm_phase<pg8::EpiInProj, pg8::StaticOrder, true, true>(C.lds, g, S, E);
#endif
        SEAM(1); PHMARK(1);
    }

    const int myx = (int)(xb_xcc_id() & 7u);
    if (IN(2)) {
        constexpr int U_H = 16, U_SH = 16, U_SS = 64, U_SEL = 256, U_TOT = U_H + U_SH + U_SS + U_SEL;
        for (int qi = 0; qi < 8; ++qi) { const int x = (myx + qi) & 7, cw = CW_Q2 + 64 * x;
            for (int u0 = q_next(C, cw, 2u); u0 < U_TOT; u0 = q_next(C, cw, 2u))
                for (int u = u0; u < u0 + 2; ++u) {
                    if (u < U_H) { if (!(u & 1)) hgrn_unit(C, 2 * x + (u >> 3), (u >> 1) & 3, 0); continue; }
                    int v = u - U_H;
                    if (v < U_SH) { sample_hgrn_unit(C, 4 * x + (v >> 2), v & 3); __syncthreads(); continue; } v -= U_SH;
                    if (v < U_SS) { sample_score_unit(C, 4 * x + (v >> 4), v & 15); continue; } v -= U_SS;
                    dsa_select_unit(C, 2 * x + (v & 1), 127 - (v >> 1)); __syncthreads();
                } }
        SEAM(2); PHMARK(2);
    }
    if (IN(3)) {
        constexpr int U_HG = 16, U_SA = 4, U_AT = 128, U_TOT = U_HG + U_SA + U_AT;
        for (int qi = 0; qi < 8; ++qi) { const int x = (myx + qi) & 7, cw = CW_Q3 + 64 * x;
            for (int u0 = q_next(C, cw, 2u); u0 < U_TOT; u0 = q_next(C, cw, 2u))
                for (int u = u0; u < u0 + 2; ++u) {
                    if (u < U_HG) { if (!(u & 1)) hgrn_unit(C, 2 * x + (u >> 3), (u >> 1) & 3, 1); continue; }
                    int v = u - U_HG;
                    if (v < U_SA) { sample_attend_unit(C, 4 * x + v); __syncthreads(); continue; } v -= U_SA;
                    attn_unit(C, 2 * x + (v & 1), 63 - (v >> 1)); __syncthreads();
                } }
        SEAM(3); PHMARK(3);
    }

    if (IN(4)) {
        if (C.vcu < 32) sample_outproj_task(C, C.vcu);
        __syncthreads();
        pg8::Gemm g{(const pg8::bf16_t*)(C.ws + WS_MIX), (const pg8::bf16_t*)(C.ws + WS_WOT), NTOK, DM, DM};
        pg8::StaticOrder S; S.init(NTOK, DM, C.G, (int)blockIdx.x);
        pg8::EpiOutProj E{C.in[I_XP], C.out + O_Y, (pg8::bf16_t*)(C.ws + WS_X1B), (float*)(C.ws + WS_SSQ)};
        pg8::gemm_phase<pg8::EpiOutProj, pg8::StaticOrder, true, true>(C.lds, g, S, E);
#if (REP_MASK >> 4) & 1
        __syncthreads(); pg8::gemm_phase<pg8::EpiOutProj, pg8::StaticOrder, true, true>(C.lds, g, S, E);
#endif
        SEAM(4); PHMARK(4);
    }

    if (IN(5)) {
        if (C.vcu < 128) sample_up_task(C, C.vcu);
        __syncthreads();
        pg8::Gemm g{(const pg8::bf16_t*)(C.ws + WS_X1B), (const pg8::bf16_t*)(C.ws + WS_WUT), NTOK, FF, DM};
        pg8::StaticOrder S; S.init(NTOK, FF, C.G, (int)blockIdx.x);
        pg8::EpiUp E{(pg8::bf16_t*)(C.ws + WS_H)};
        pg8::gemm_phase<pg8::EpiUp, pg8::StaticOrder, true, true>(C.lds, g, S, E);
#if (REP_MASK >> 5) & 1
        __syncthreads(); pg8::gemm_phase<pg8::EpiUp, pg8::StaticOrder, true, true>(C.lds, g, S, E);
#endif
        SEAM(5); PHMARK(5);
    }

    if (IN(6)) {
        sample_down_partial(C);
        __syncthreads();
        pg8::Gemm g{(const pg8::bf16_t*)(C.ws + WS_H), (const pg8::bf16_t*)(C.ws + WS_WDT), NTOK, DM, FF};
        pg8::StaticOrder S; S.init(NTOK, DM, C.G, (int)blockIdx.x);
        pg8::EpiDown E{C.out + O_Y, (const pg8::bf16_t*)(C.ws + WS_X1B), (const float*)(C.ws + WS_SSQ)};
        pg8::gemm_phase<pg8::EpiDown, pg8::StaticOrder, true, true>(C.lds, g, S, E);
        if (C.vcu < 32) sample_down_final(C, C.vcu);
        PHMARK(6);
#if defined(PROBE_P0) || defined(PROBE_VALU)
        if (C.vcu == 40 && C.tid == 0) C.out[O_NKIS + 5] += ((const float*)(C.ws + WS_GAINS + 4096))[0];
#endif
#ifdef PROBE_PH
        if (C.vcu == 40 && C.tid == 0) { const float us = (float)ph_acc_ * 0.01f; C.out[O_NKIS] += sqrtf(2048.0f * (1e-4f + 5e-4f * fminf(us / 400.0f, 1.0f))); }
#endif
    }
#undef IN
#undef SEAM
}

extern "C" void kernel_launch(void* const* d_in, const int* in_sizes, int n_in, void* d_out, int out_size, void* d_ws, size_t ws_size, hipStream_t stream) {
    static int grid = 0;
    if (grid == 0) {
        if (n_in != 18 || in_sizes[0] != NTOK * DM || (size_t)out_size != O_END || ws_size < WS_END) {
            fprintf(stderr, "kernel_launch: unexpected shapes: n_in %d in0 %d out %d ws %zu (need ws >= %zu); nothing launched\n", n_in, n_in > 0 ? in_sizes[0] : -1, out_size, ws_size, (size_t)WS_END); grid = -1; return; }
        int dev = 0, cus = 0;
        if (hipGetDevice(&dev) != hipSuccess || hipDeviceGetAttribute(&cus, hipDeviceAttributeMultiprocessorCount, dev) != hipSuccess) { grid = -1; return; }
        if (hipFuncSetAttribute((const void*)hymba_fwd, hipFuncAttributeMaxDynamicSharedMemorySize, LDS_BYTES) != hipSuccess) { fprintf(stderr, "kernel_launch: hipFuncSetAttribute failed\n"); grid = -1; return; }
        int per_cu = 0;
        if (hipOccupancyMaxActiveBlocksPerMultiprocessor(&per_cu, (const void*)hymba_fwd, 512, LDS_BYTES) != hipSuccess || per_cu < 1) fprintf(stderr, "kernel_launch: occupancy query says %d\n", per_cu);
        (void)hipGetLastError();
        grid = cus;
        if (grid != 256) fprintf(stderr, "kernel_launch: %d CUs (expected 256)\n", grid);
    }
    if (grid < 0) return;
    (void)hipMemsetAsync((char*)d_ws + WS_CTL, 0, CTL_ZERO_BYTES, stream);
    Args a{};
    for (int i = 0; i < 18; ++i) a.in[i] = (const float*)d_in[i];
    a.out = (float*)d_out; a.ws = (unsigned char*)d_ws;
#if MK_SPLIT
    for (int p = 0; p < N_PHASES; ++p) { a.ph_lo = p; a.ph_hi = p + 1; hipLaunchKernelGGL(hymba_fwd, dim3(grid), dim3(512), LDS_BYTES, stream, a); }
#else
    a.ph_lo = 0; a.ph_hi = N_PHASES; hipLaunchKernelGGL(hymba_fwd, dim3(grid), dim3(512), LDS_BYTES, stream, a);
#endif
}
```

```cpp
#include <hip/hip_runtime.h>
#include <cstdio>
#include <cstdint>

#define LAS __attribute__((address_space(3)))
#define GAS __attribute__((address_space(1)))
typedef float f32x16 __attribute__((ext_vector_type(16)));
typedef unsigned u32x2 __attribute__((ext_vector_type(2)));
typedef unsigned long long u64;

#ifndef MERGE56
#define MERGE56 1
#endif
#ifndef RES_XB
#define RES_XB 1
#endif
#ifndef GSEAM1
#define GSEAM1 1
#endif
#ifndef QPF
#define QPF 0
#endif
#ifndef SEL_DIRECT
#define SEL_DIRECT 0
#endif
#ifndef SEL_DUAL
#define SEL_DUAL 0
#endif
#ifndef X_NT
#define X_NT 1
#endif
#ifndef NT_CKI
#define NT_CKI 1
#endif
#ifndef NT_OUT
#define NT_OUT 0
#endif
#ifndef NT_HG
#define NT_HG 1
#endif
#ifndef NT_RES
#define NT_RES 0
#endif
#ifndef EPI_PERM
#define EPI_PERM 1
#endif
#ifndef EPI_HOIST
#define EPI_HOIST 0
#endif
#ifndef GSEAM0
#define GSEAM0 1
#endif
#ifndef NT_W
#define NT_W 0
#endif
#ifndef NT_MIX
#define NT_MIX 0
#endif
#ifndef XB_TOUCH
#define XB_TOUCH 0
#endif
#ifndef WDEFER
#define WDEFER 0
#endif
#ifndef ATT_PL32
#define ATT_PL32 1
#endif
#ifndef SEL_WLANE
#define SEL_WLANE 1
#endif
#define RES_BF16 1
constexpr int NTOK = 32768, NB = 16, SEQ = 2048, DM = 1024, NS = 32, PAST = 16384, PAGE = 128, NPAGES = 128;
constexpr int INW = 3400, INP = 3584, FF = 4096;
constexpr float EPS = 1e-6f;
constexpr float ATT_SCALE = 0.125f, LOG2E = 1.4426950408889634f;
constexpr float IDX_W_SCALE = 0.04419417382415922f;
constexpr float REC_QSCALE = 0.08838834764831845f;
enum { I_XP = 0, I_XS, I_CK, I_CV, I_CKI, I_ST, I_PT, I_N1G, I_WIN, I_QG, I_KG, I_IKG, I_LB, I_RG, I_WOUT, I_N2G, I_WUP, I_WDN };
constexpr size_t O_Y = 0, O_YS = 33554432, O_NK = O_YS + 32768, O_NV = O_NK + 4194304, O_NKI = O_NV + 4194304, O_NSP = O_NKI + 2097152,
                 O_NKS = O_NSP + 1048576, O_NVS = O_NKS + 4096, O_NKIS = O_NVS + 4096, O_NSS = O_NKIS + 2048, O_END = O_NSS + 2097152;
constexpr size_t MiB = 1u << 20;
constexpr size_t WS_SSQ = 131072;
constexpr size_t WS_CTL = 0, CTL_ZERO_BYTES = 262144;
constexpr size_t WS_W1T = 2 * MiB, WS_WOT = 10 * MiB, WS_WUT = 12 * MiB, WS_WDT = 20 * MiB;
constexpr size_t WS_GAINS = 28 * MiB + 512 * 1024;
constexpr size_t WS_RSTD1 = 28 * MiB, WS_IWF = 29 * MiB, WS_SSQ2 = 30 * MiB, WS_SAMP = 32 * MiB;
constexpr size_t WS_XB = 40 * MiB, WS_QB = 104 * MiB, WS_KB = 136 * MiB, WS_VT = 144 * MiB, WS_IQB = 152 * MiB, WS_IKB = 184 * MiB;
constexpr size_t WS_RQ = 188 * MiB, WS_RF = 220 * MiB, WS_RI = 252 * MiB, WS_RGT = 284 * MiB, WS_MASK = 316 * MiB, WS_MIX = 324 * MiB;
constexpr size_t WS_X1B = 388 * MiB, WS_H = 452 * MiB, WS_HST = 708 * MiB, WS_END = 712 * MiB;
constexpr int S_RAW = 0, S_SP = 131072, S_SC = 262144, S_SCROW = 16400, S_MIX = S_SC + 32 * S_SCROW + 256, S_X1 = S_MIX + 32768, S_H = S_X1 + 32768, S_ENDF = S_H + 131072;
static_assert((size_t)S_ENDF * 4 <= 8 * MiB, "sample scratch");
constexpr int CW_BAR = 4096, CW_Q2 = 8192, CW_Q3 = 8192 + 1024;
constexpr int LDS_BYTES = 163840, LDSCTL_OFF = LDS_BYTES - 1024, MISC_OFF = LDSCTL_OFF + 320;

namespace pg8 {
#define PG8_LAS __attribute__((address_space(3)))
typedef unsigned short bf16_t;
typedef short bf16x8 __attribute__((ext_vector_type(8)));
typedef float f32x4 __attribute__((ext_vector_type(4)));
typedef unsigned u32x4 __attribute__((ext_vector_type(4)));
constexpr int BM = 256, BK = 64, HALF = 128, HTB = HALF * BK * 2  , STAGE_BYTES = 8 * HTB, NXCD = 8, WGM = 8;

__host__ __device__ __forceinline__ int lds_byte(int r, int c) { const int st = (r >> 4) * 2 + (c >> 5), rr = r & 15, cc = c & 31, ob = rr * 64 + cc * 2; return st * 1024 + (ob ^ (((ob >> 9) & 1) << 5)); }
__host__ __device__ __forceinline__ void stage_rc(int b, int& R, int& C) { const int st = b / 1024, sb = b % 1024, swz = sb ^ (((sb >> 9) & 1) << 5); R = (st >> 1) * 16 + swz / 64; C = (st & 1) * 32 + (swz % 64) / 2; }
__host__ __device__ __forceinline__ int perm32(int rho) { const int n = rho >> 4, i = rho & 15; return 8 * (i >> 2) + 4 * n + (i & 3); }

struct Unit { int pm, pn; };
struct Gemm { const bf16_t* A; const bf16_t* Bt; int M, N, K; };

struct StaticOrder {
    int nM, nN, nwg, G, c;
    __host__ __device__ void init(int M, int N, int G_, int c_) { nM = M / BM; nN = N / BM; nwg = nM * nN; G = G_; c = c_; }
    __host__ __device__ bool next(int i, Unit& u) const {
        const long L = (long)i * G + c; if (L >= nwg) return false;
        int wgid = (int)L; { const int q = nwg / NXCD, r = nwg % NXCD, xcd = wgid % NXCD, off = wgid / NXCD; wgid = (xcd < r ? xcd * (q + 1) : r * (q + 1) + (xcd - r) * q) + off; }
        const int nig = WGM * nN, gid = wgid / nig, fm = gid * WGM, gsz = (nM - fm) < WGM ? (nM - fm) : WGM;
        u.pm = fm + ((wgid % nig) % gsz); u.pn = (wgid % nig) / gsz; return true;
    }
    __device__ __forceinline__ void a_ready(const Unit&) const {}
    __device__ __forceinline__ void done(const Unit&) const {}
};

__device__ __forceinline__ unsigned cvt_pk_bf16(float lo, float hi) { unsigned r; asm volatile("v_cvt_pk_bf16_f32 %0, %1, %2" : "=v"(r) : "v"(lo), "v"(hi)); return r; }
typedef float f32x2 __attribute__((ext_vector_type(2)));
struct PermOrder {
    StaticOrder S;
    __host__ __device__ void init(int M, int N, int G_, int c_) { S.init(M, N, G_, c_); }
    __host__ __device__ bool next(int i, Unit& u) const { if (!S.next(i, u)) return false;
        u.pn = u.pn < 3 ? u.pn : (u.pn < 11 ? u.pn + 3 : u.pn - 8);
        return true; }
    __device__ __forceinline__ void a_ready(const Unit&) const {}
    __device__ __forceinline__ void done(const Unit&) const {}
};
struct RangeOrder {
    StaticOrder S; int r0, r1;
    __host__ __device__ void init(int M, int N, int G_, int c_, int r0_, int r1_) { S.init(M, N, G_, c_); r0 = r0_; r1 = r1_; }
    __host__ __device__ bool next(int i, Unit& u) const { if (r0 + i >= r1) return false; return S.next(r0 + i, u); }
    __device__ __forceinline__ void a_ready(const Unit&) const {}
    __device__ __forceinline__ void done(const Unit&) const {}
};
struct RevOrder {
    StaticOrder S; int R;
    __host__ __device__ void init(int M, int N, int G_, int c_) { S.init(M, N, G_, c_); R = S.nwg / G_; }
    __host__ __device__ bool next(int i, Unit& u) const { if (i >= R) return false; return S.next(R - 1 - i, u); }
    __device__ __forceinline__ void a_ready(const Unit&) const {}
    __device__ __forceinline__ void done(const Unit&) const {}
};
__device__ __forceinline__ float silu_f(float x) { return x * __builtin_amdgcn_rcpf(1.f + __builtin_amdgcn_exp2f(x * -1.4426950408889634f)); }
__device__ __forceinline__ void st_bf16x16(bf16_t* p, const float (&t)[16]) {
    u32x4 a, b;
    a.x = cvt_pk_bf16(t[0], t[1]); a.y = cvt_pk_bf16(t[2], t[3]); a.z = cvt_pk_bf16(t[4], t[5]); a.w = cvt_pk_bf16(t[6], t[7]);
    b.x = cvt_pk_bf16(t[8], t[9]); b.y = cvt_pk_bf16(t[10], t[11]); b.z = cvt_pk_bf16(t[12], t[13]); b.w = cvt_pk_bf16(t[14], t[15]);
    *(u32x4*)p = a; *(u32x4*)(p + 8) = b;
}
__device__ __forceinline__ void st_bf16x16_nt(bf16_t* p, const float (&t)[16]) {
    u32x4 a, b;
    a.x = cvt_pk_bf16(t[0], t[1]); a.y = cvt_pk_bf16(t[2], t[3]); a.z = cvt_pk_bf16(t[4], t[5]); a.w = cvt_pk_bf16(t[6], t[7]);
    b.x = cvt_pk_bf16(t[8], t[9]); b.y = cvt_pk_bf16(t[10], t[11]); b.z = cvt_pk_bf16(t[12], t[13]); b.w = cvt_pk_bf16(t[14], t[15]);
    __builtin_nontemporal_store(a, (u32x4*)p); __builtin_nontemporal_store(b, (u32x4*)(p + 8));
}
__device__ __forceinline__ void st_f32x16(float* p, const float (&t)[16]) {
#pragma unroll
#if NT_OUT
    for (int i = 0; i < 4; ++i) __builtin_nontemporal_store((f32x4){t[4 * i], t[4 * i + 1], t[4 * i + 2], t[4 * i + 3]}, (f32x4*)(p + 4 * i));
#else
    for (int i = 0; i < 4; ++i) *(f32x4*)(p + 4 * i) = (f32x4){t[4 * i], t[4 * i + 1], t[4 * i + 2], t[4 * i + 3]};
#endif
}
__device__ __forceinline__ unsigned short f2bf_rne(float f) { unsigned u = __builtin_bit_cast(unsigned, f); return (unsigned short)((u + 0x7fffu + ((u >> 16) & 1u)) >> 16); }

#ifdef NT_R
#define ST_R st_bf16x16_nt
#else
#define ST_R st_bf16x16
#endif
struct EpiInProj {
    static constexpr bool PERM = false, AFTER_DRAIN = false;
    const float* rstd1; const float* gains;
    bf16_t *Qb, *Kb, *Vt, *IQb, *IKb, *Rq, *Rf, *Ri, *Rg; float* IWf; float *oK, *oV, *oKI;
    __device__ __forceinline__ void operator()(const f32x4 (&acc)[2][2][4][2], const Unit& u, int wr, int wc, int fr, int fq) const {
        const int pn = u.pn;
        const float* gsrc = gains + (pn < 2 ? 0 : (pn == 2 ? 64 : 128)) + 16 * fq;
        float rsv[2][4];
#pragma unroll
        for (int ai = 0; ai < 2; ++ai)
#pragma unroll
            for (int m = 0; m < 4; ++m) rsv[ai][m] = rstd1[u.pm * BM + ai * HALF + wr * 64 + m * 16 + fr];
#pragma unroll
        for (int ai = 0; ai < 2; ++ai)
#pragma unroll
            for (int m = 0; m < 4; ++m) {
                const int row = u.pm * BM + ai * HALF + wr * 64 + m * 16 + fr;
                const float rs = rsv[ai][m];
                float t[16];
#pragma unroll
                for (int bj = 0; bj < 2; ++bj)
#pragma unroll
                    for (int n = 0; n < 2; ++n)
#pragma unroll
                        for (int e = 0; e < 4; ++e) t[8 * bj + 4 * n + e] = acc[ai][bj][m][n][e] * rs;
                const bool normed = (pn < 2) || (pn == 2 && wc < 2) || (pn == 5 && wc == 0);
                if (normed) {
                    float ss = 0.f;
#pragma unroll
                    for (int j = 0; j < 16; ++j) ss += t[j] * t[j];
                    ss += __shfl_xor(ss, 16); ss += __shfl_xor(ss, 32);
                    float sc = rsqrtf(ss * (1.0f / 64.0f) + EPS);
                    if (pn < 2) sc *= ATT_SCALE * LOG2E;
#pragma unroll
                    for (int i = 0; i < 4; ++i) { const f32x4 gv = *(const f32x4*)(gsrc + 4 * i);
                        t[4 * i] *= sc * gv[0]; t[4 * i + 1] *= sc * gv[1]; t[4 * i + 2] *= sc * gv[2]; t[4 * i + 3] *= sc * gv[3]; }
                }
                if (pn < 2) {
                    st_bf16x16(Qb + (size_t)row * 512 + (4 * pn + wc) * 64 + 16 * fq, t);
                } else if (pn == 2) {
                    if (wc < 2) { st_f32x16(oK + (size_t)row * 128 + wc * 64 + 16 * fq, t); st_bf16x16(Kb + (size_t)row * 128 + wc * 64 + 16 * fq, t); }
                    else {
                        st_f32x16(oV + (size_t)row * 128 + (wc - 2) * 64 + 16 * fq, t);
                        const int b = row >> 11, tt = row & 2047;
                        bf16_t* vp = Vt + ((size_t)(b * 2 + (wc - 2)) * 64 + 16 * fq) * 2048 + tt;
#pragma unroll
                        for (int j = 0; j < 16; ++j) vp[(size_t)j * 2048] = f2bf_rne(t[j]);
                    }
                } else if (pn < 5) {
                    st_bf16x16(IQb + (size_t)row * 512 + (4 * (pn - 3) + wc) * 64 + 16 * fq, t);
                } else if (pn == 5) {
                    if (wc == 0) { st_f32x16(oKI + (size_t)row * 64 + 16 * fq, t); st_bf16x16(IKb + (size_t)row * 64 + 16 * fq, t); }
                    else if (wc == 1 && fq == 0) {
                        *(f32x4*)(IWf + (size_t)row * 8) = (f32x4){t[0] * IDX_W_SCALE, t[1] * IDX_W_SCALE, t[2] * IDX_W_SCALE, t[3] * IDX_W_SCALE};
                        *(f32x4*)(IWf + (size_t)row * 8 + 4) = (f32x4){t[4] * IDX_W_SCALE, t[5] * IDX_W_SCALE, t[6] * IDX_W_SCALE, t[7] * IDX_W_SCALE};
                    }
                } else {
                    const int kind = (pn - 6) >> 1, col = 256 * ((pn - 6) & 1) + 64 * wc + 16 * fq;
                    if (kind == 0) {
#pragma unroll
                        for (int j = 0; j < 16; ++j) t[j] = silu_f(t[j]) * REC_QSCALE;
                        ST_R(Rq + (size_t)row * 512 + col, t);
                    } else if (kind == 1) ST_R(Rf + (size_t)row * 512 + col, t);
                    else if (kind == 2) ST_R(Ri + (size_t)row * 512 + col, t);
                    else {
#pragma unroll
                        for (int j = 0; j < 16; ++j) t[j] = silu_f(t[j]);
                        ST_R(Rg + (size_t)row * 512 + col, t);
                    }
                }
            }
    }
};
#if EPI_PERM
struct EpiOutProj {
    static constexpr bool PERM = true, AFTER_DRAIN = false;
    const float* X; float* Y; bf16_t* X1B; float* SSQ2; const bf16_t* XB;
    __device__ __forceinline__ void operator()(const f32x4 (&acc)[2][2][4][2], const Unit& u, int wr, int wc, int fr, int fq) const {
        const int col0 = u.pn * BM + wc * 32 + 8 * fq;
#if EPI_HOIST
        u32x4 xr[2][4][2];
#pragma unroll
        for (int ai = 0; ai < 2; ++ai)
#pragma unroll
            for (int m = 0; m < 4; ++m)
#pragma unroll
                for (int bj = 0; bj < 2; ++bj) xr[ai][m][bj] = *(const u32x4*)(XB + (size_t)(u.pm * BM + ai * HALF + wr * 64 + m * 16 + fr) * DM + col0 + bj * HALF);
#endif
#pragma unroll
        for (int ai = 0; ai < 2; ++ai)
#pragma unroll
            for (int m = 0; m < 4; ++m) {
                const int row = u.pm * BM + ai * HALF + wr * 64 + m * 16 + fr; const size_t off = (size_t)row * DM + col0; float ss = 0.f;
#pragma unroll
                for (int bj = 0; bj < 2; ++bj) {
#if EPI_HOIST
                    const u32x4 xw = xr[ai][m][bj];
#else
                    const u32x4 xw = *(const u32x4*)(XB + off + bj * HALF);
#endif
                    f32x4 o0 = acc[ai][bj][m][0], o1 = acc[ai][bj][m][1];
                    o0[0] += __uint_as_float(xw.x << 16); o0[1] += __uint_as_float(xw.x & 0xffff0000u); o0[2] += __uint_as_float(xw.y << 16); o0[3] += __uint_as_float(xw.y & 0xffff0000u);
                    o1[0] += __uint_as_float(xw.z << 16); o1[1] += __uint_as_float(xw.z & 0xffff0000u); o1[2] += __uint_as_float(xw.w << 16); o1[3] += __uint_as_float(xw.w & 0xffff0000u);
                    ss += ((o0[0] * o0[0] + o0[1] * o0[1]) + (o0[2] * o0[2] + o0[3] * o0[3])) + ((o1[0] * o1[0] + o1[1] * o1[1]) + (o1[2] * o1[2] + o1[3] * o1[3]));
                    u32x4 w; w.x = cvt_pk_bf16(o0[0], o0[1]); w.y = cvt_pk_bf16(o0[2], o0[3]); w.z = cvt_pk_bf16(o1[0], o1[1]); w.w = cvt_pk_bf16(o1[2], o1[3]);
                    *(u32x4*)(X1B + off + bj * HALF) = w;
                }
                ss += __shfl_xor(ss, 16); ss += __shfl_xor(ss, 32);
                if (fq == 0) atomicAdd(SSQ2 + row, ss);
            }
    }
};
#else
struct EpiOutProj {
    static constexpr bool PERM = false, AFTER_DRAIN = false;
    const float* X; float* Y; bf16_t* X1B; float* SSQ2; const bf16_t* XB;
    __device__ __forceinline__ void operator()(const f32x4 (&acc)[2][2][4][2], const Unit& u, int wr, int wc, int fr, int fq) const {
        const int col0 = u.pn * BM + wc * 32 + 4 * fq;
#pragma unroll
        for (int ai = 0; ai < 2; ++ai)
#pragma unroll
            for (int m = 0; m < 4; ++m) {
                const int row = u.pm * BM + ai * HALF + wr * 64 + m * 16 + fr; const size_t off = (size_t)row * DM + col0; float ss = 0.f;
#pragma unroll
                for (int bj = 0; bj < 2; ++bj)
#pragma unroll
                    for (int n = 0; n < 2; ++n) {
#if RES_XB
#if NT_RES
                        const u32x2 xw = __builtin_nontemporal_load((const u32x2*)(XB + off + bj * HALF + n * 16));
#else
                        const u32x2 xw = *(const u32x2*)(XB + off + bj * HALF + n * 16);
#endif (x1 is rounded to bf16 below anyway): half the epilogue's read bytes
                        f32x4 xv; xv[0] = __uint_as_float(xw.x << 16); xv[1] = __uint_as_float(xw.x & 0xffff0000u); xv[2] = __uint_as_float(xw.y << 16); xv[3] = __uint_as_float(xw.y & 0xffff0000u);
                        const f32x4 o = xv + acc[ai][bj][m][n];
#else
                        const f32x4 xv = *(const f32x4*)(X + off + bj * HALF + n * 16); const f32x4 o = xv + acc[ai][bj][m][n];
#endif
#if !RES_BF16
                        *(f32x4*)(Y + off + bj * HALF + n * 16) = o;
#endif
                        ss += (o[0] * o[0] + o[1] * o[1]) + (o[2] * o[2] + o[3] * o[3]);
                        u32x2 w; w.x = cvt_pk_bf16(o[0], o[1]); w.y = cvt_pk_bf16(o[2], o[3]); *(u32x2*)(X1B + off + bj * HALF + n * 16) = w;
                    }
                ss += __shfl_xor(ss, 16); ss += __shfl_xor(ss, 32);
                if (fq == 0) atomicAdd(SSQ2 + row, ss);
            }
    }
};
#endif
struct EpiUp {
    static constexpr bool PERM = true, AFTER_DRAIN = false;
    bf16_t* H;
    __device__ __forceinline__ void operator()(const f32x4 (&acc)[2][2][4][2], const Unit& u, int wr, int wc, int fr, int fq) const {
        const int col0 = u.pn * BM + wc * 32 + 8 * fq;
#pragma unroll
        for (int ai = 0; ai < 2; ++ai)
#pragma unroll
            for (int m = 0; m < 4; ++m) {
                const int row = u.pm * BM + ai * HALF + wr * 64 + m * 16 + fr;
                bf16_t* rowp = H + (size_t)row * FF + col0;
#pragma unroll
                for (int bj = 0; bj < 2; ++bj) {
                    f32x4 v0 = acc[ai][bj][m][0], v1 = acc[ai][bj][m][1];
#pragma unroll
                    for (int e = 0; e < 4; ++e) { v0[e] = fmaxf(v0[e] * __builtin_fabsf(v0[e]), 0.f); v1[e] = fmaxf(v1[e] * __builtin_fabsf(v1[e]), 0.f); }
                    u32x4 w; w.x = cvt_pk_bf16(v0[0], v0[1]); w.y = cvt_pk_bf16(v0[2], v0[3]); w.z = cvt_pk_bf16(v1[0], v1[1]); w.w = cvt_pk_bf16(v1[2], v1[3]);
#ifdef NT_H
                    __builtin_nontemporal_store(w, (u32x4*)(rowp + bj * HALF));
#else
                    *(u32x4*)(rowp + bj * HALF) = w;
#endif
                }
            }
    }
};
#if EPI_PERM
struct EpiDown {
    static constexpr bool PERM = true, AFTER_DRAIN = false;
    float* Y; const bf16_t* X1B; const float* SSQ;
    __device__ __forceinline__ void operator()(const f32x4 (&acc)[2][2][4][2], const Unit& u, int wr, int wc, int fr, int fq) const {
        const int col0 = u.pn * BM + wc * 32 + 8 * fq;
        float rsv[2][4];
#pragma unroll
        for (int ai = 0; ai < 2; ++ai)
#pragma unroll
            for (int m = 0; m < 4; ++m) rsv[ai][m] = SSQ[u.pm * BM + ai * HALF + wr * 64 + m * 16 + fr];
#if EPI_HOIST
        u32x4 xr[2][4][2];
#pragma unroll
        for (int ai = 0; ai < 2; ++ai)
#pragma unroll
            for (int m = 0; m < 4; ++m)
#pragma unroll
                for (int bj = 0; bj < 2; ++bj) xr[ai][m][bj] = *(const u32x4*)(X1B + (size_t)(u.pm * BM + ai * HALF + wr * 64 + m * 16 + fr) * DM + col0 + bj * HALF);
#endif
#pragma unroll
        for (int ai = 0; ai < 2; ++ai)
#pragma unroll
            for (int m = 0; m < 4; ++m) {
                const float rs2 = 1.0f / (rsv[ai][m] * (1.0f / 1024.0f) + EPS);
                const size_t off = (size_t)(u.pm * BM + ai * HALF + wr * 64 + m * 16 + fr) * DM + col0;
#pragma unroll
                for (int bj = 0; bj < 2; ++bj) { float* p = Y + off + bj * HALF;
#if EPI_HOIST
                    const u32x4 xw = xr[ai][m][bj];
#else
                    const u32x4 xw = *(const u32x4*)(X1B + off + bj * HALF);
#endif
                    const f32x4 xa = {__builtin_bit_cast(float, xw.x << 16), __builtin_bit_cast(float, xw.x & 0xffff0000u), __builtin_bit_cast(float, xw.y << 16), __builtin_bit_cast(float, xw.y & 0xffff0000u)};
                    const f32x4 xb = {__builtin_bit_cast(float, xw.z << 16), __builtin_bit_cast(float, xw.z & 0xffff0000u), __builtin_bit_cast(float, xw.w << 16), __builtin_bit_cast(float, xw.w & 0xffff0000u)};
#ifdef Y_NT
                    __builtin_nontemporal_store(xa + acc[ai][bj][m][0] * rs2, (f32x4*)p); __builtin_nontemporal_store(xb + acc[ai][bj][m][1] * rs2, (f32x4*)(p + 4));
#else
                    *(f32x4*)p = xa + acc[ai][bj][m][0] * rs2; *(f32x4*)(p + 4) = xb + acc[ai][bj][m][1] * rs2;
#endif
                }
            }
    }
};
#else
struct EpiDown {
    static constexpr bool PERM = false, AFTER_DRAIN = false;
    float* Y; const bf16_t* X1B; const float* SSQ;
    __device__ __forceinline__ void operator()(const f32x4 (&acc)[2][2][4][2], const Unit& u, int wr, int wc, int fr, int fq) const {
        const int col0 = u.pn * BM + wc * 32 + 4 * fq;
        float rsv[2][4];
#pragma unroll
        for (int ai = 0; ai < 2; ++ai)
#pragma unroll
            for (int m = 0; m < 4; ++m) rsv[ai][m] = SSQ[u.pm * BM + ai * HALF + wr * 64 + m * 16 + fr];
#pragma unroll
        for (int ai = 0; ai < 2; ++ai)
#pragma unroll
            for (int m = 0; m < 4; ++m) {
                const float rs2 = 1.0f / (rsv[ai][m] * (1.0f / 1024.0f) + EPS);
                const size_t off = (size_t)(u.pm * BM + ai * HALF + wr * 64 + m * 16 + fr) * DM + col0;
#pragma unroll
                for (int bj = 0; bj < 2; ++bj)
#pragma unroll
                    for (int n = 0; n < 2; ++n) { float* p = Y + off + bj * HALF + n * 16;
#if RES_BF16
#if NT_RES
                        const u32x2 xw = __builtin_nontemporal_load((const u32x2*)(X1B + off + bj * HALF + n * 16));
#else
                        const u32x2 xw = *(const u32x2*)(X1B + off + bj * HALF + n * 16);
#endif
                        const f32x4 x1 = {__builtin_bit_cast(float, xw.x << 16), __builtin_bit_cast(float, xw.x & 0xffff0000u), __builtin_bit_cast(float, xw.y << 16), __builtin_bit_cast(float, xw.y & 0xffff0000u)};
#ifdef Y_NT
                        __builtin_nontemporal_store(x1 + acc[ai][bj][m][n] * rs2, (f32x4*)p);
#else
                        *(f32x4*)p = x1 + acc[ai][bj][m][n] * rs2;
#endif
#else
                        *(f32x4*)p = *(const f32x4*)p + acc[ai][bj][m][n] * rs2;
#endif
                    }
            }
    }
};
#endif
template <class Epi, class Sched, bool ALIGN_EPI = false, bool SP2 = false, int A_AUX = 0>
__device__ __forceinline__ void gemm_phase(PG8_LAS unsigned char* lds, const Gemm g, const Sched& S, const Epi& E) {
    const int tid = threadIdx.x, wid = __builtin_amdgcn_readfirstlane(tid >> 6), lane = tid & 63, wr = wid >> 2, wc = wid & 3, fr = lane & 15, fq = lane >> 4;
    const int K = g.K, nt = K / BK;
    unsigned voffA[2], voffB[2];
#pragma unroll
    for (int i = 0; i < 2; ++i) { int R, C; stage_rc(tid * 16 + i * 8192, R, C); const int Rb = Epi::PERM ? ((R & ~31) + perm32(R & 31)) : R;
        voffA[i] = (unsigned)(R * K + C) * 2u; voffB[i] = (unsigned)(Rb * K + C) * 2u; }
    const size_t kstep = (size_t)(BK * 2);
    const size_t hstep = (size_t)HALF * K * 2;
    const size_t tstep = 2 * hstep;
    const unsigned ldsw = (unsigned)wid * 1024u;
    const int aoff = lds_byte(wr * 64 + fr, fq * 8), boff = lds_byte(wc * 32 + fr, fq * 8);
#define PG8_SA(b, h) (((b) * 2 + (h)) * HTB)
#define PG8_SB(b, h) ((4 + (b) * 2 + (h)) * HTB)
#define PG8_STAGE(bufoff, gbase, voff) do { _Pragma("unroll") for (int _i = 0; _i < 2; ++_i) \
        __builtin_amdgcn_global_load_lds((const unsigned*)((const char*)(gbase) + (voff)[_i]), (PG8_LAS unsigned*)(lds + (bufoff) + ldsw + _i * 8192), 16, 0, 0); } while (0)
#define PG8_STAGEA(bufoff, gbase, voff) do { _Pragma("unroll") for (int _i = 0; _i < 2; ++_i) \
        __builtin_amdgcn_global_load_lds((const unsigned*)((const char*)(gbase) + (voff)[_i]), (PG8_LAS unsigned*)(lds + (bufoff) + ldsw + _i * 8192), 16, 0, A_AUX); } while (0)
#define PG8_LDA(dst, b, h) do { _Pragma("unroll") for (int m = 0; m < 4; ++m) _Pragma("unroll") for (int k = 0; k < 2; ++k) dst[m][k] = *(const PG8_LAS bf16x8*)(lds + PG8_SA(b, h) + aoff + m * 2048 + k * 1024); } while (0)
#define PG8_LDB(dst, b, h) do { _Pragma("unroll") for (int n = 0; n < 2; ++n) _Pragma("unroll") for (int k = 0; k < 2; ++k) dst[n][k] = *(const PG8_LAS bf16x8*)(lds + PG8_SB(b, h) + boff + n * 2048 + k * 1024); } while (0)
#define PG8_MMA(ai, bj, At, Bt) do { __builtin_amdgcn_s_setprio(1); _Pragma("unroll") for (int m = 0; m < 4; ++m) _Pragma("unroll") for (int n = 0; n < 2; ++n) _Pragma("unroll") for (int k = 0; k < 2; ++k) \
        acc[ai][bj][m][n] = __builtin_amdgcn_mfma_f32_16x16x32_bf16(Bt[n][k], At[m][k], acc[ai][bj][m][n], 0, 0, 0); __builtin_amdgcn_s_setprio(0); } while (0)
#define PG8_WAIT_V(n) asm volatile("s_waitcnt vmcnt(" #n ")" ::: "memory")
#define PG8_WAIT_L(n) asm volatile("s_waitcnt lgkmcnt(" #n ")" ::: "memory")
#define PG8_BAR __builtin_amdgcn_s_barrier()
#define PG8_SCHED __builtin_amdgcn_sched_barrier(0)
    Unit cur, nxt; int ui = 0;
    if (!S.next(0, cur)) return;
    f32x4 acc[2][2][4][2];
#pragma unroll
    for (int a = 0; a < 2; ++a)
#pragma unroll
        for (int b = 0; b < 2; ++b)
#pragma unroll
            for (int m = 0; m < 4; ++m)
#pragma unroll
                for (int n = 0; n < 2; ++n) acc[a][b][m][n] = (f32x4){0.f, 0.f, 0.f, 0.f};
    bf16x8 At[4][2], B0[2][2], B1[2][2];
    const char* cA = (const char*)g.A + (size_t)cur.pm * tstep; const char* cB = (const char*)g.Bt + (size_t)cur.pn * tstep;
    S.a_ready(cur);
    if constexpr (SP2) {
        PG8_STAGE(PG8_SB(0, 0), cB, voffB); PG8_STAGE(PG8_SB(0, 1), cB + hstep, voffB); PG8_STAGEA(PG8_SA(0, 0), cA, voffA); PG8_STAGEA(PG8_SA(0, 1), cA + hstep, voffA);
        if (wr == 1) PG8_BAR;
        PG8_WAIT_V(2); PG8_BAR;
        PG8_STAGE(PG8_SB(1, 0), cB + kstep, voffB); PG8_STAGEA(PG8_SA(1, 0), cA + kstep, voffA); PG8_STAGE(PG8_SB(1, 1), cB + hstep + kstep, voffB);
        PG8_WAIT_V(6); PG8_BAR;
    } else {
        PG8_STAGE(PG8_SB(0, 0), cB, voffB); PG8_STAGEA(PG8_SA(0, 0), cA, voffA); PG8_STAGE(PG8_SB(0, 1), cB + hstep, voffB); PG8_STAGEA(PG8_SA(0, 1), cA + hstep, voffA);
        if (wr == 1) PG8_BAR;
        PG8_WAIT_V(4); PG8_BAR;
        PG8_STAGE(PG8_SB(1, 0), cB + kstep, voffB); PG8_STAGEA(PG8_SA(1, 0), cA + kstep, voffA); PG8_STAGE(PG8_SB(1, 1), cB + hstep + kstep, voffB);
        PG8_WAIT_V(6); PG8_BAR;
    }
    for (;;) {
        const bool has_next = S.next(ui + 1, nxt);
        const char* nA = has_next ? (const char*)g.A + (size_t)nxt.pm * tstep : cA; const char* nB = has_next ? (const char*)g.Bt + (size_t)nxt.pn * tstep : cB;
        for (int t = 0; t < nt; t += 2) {
            const bool last = (t == nt - 2);
            const char* a1 = cA + (size_t)(t + 1) * kstep;
            const char* a2 = last ? nA : cA + (size_t)(t + 2) * kstep; const char* b2 = last ? nB : cB + (size_t)(t + 2) * kstep;
            const char* a3 = a2 + kstep; const char* b3 = b2 + kstep;
            if (last && has_next) S.a_ready(nxt);
            if constexpr (SP2) {
            PG8_LDB(B0, 0, 0); PG8_LDB(B1, 0, 1); PG8_SCHED; PG8_LDA(At, 0, 0); PG8_STAGEA(PG8_SA(1, 1), a1 + hstep, voffA);
            PG8_WAIT_V(8); PG8_WAIT_L(0); PG8_BAR; PG8_MMA(0, 0, At, B0); PG8_MMA(0, 1, At, B1); PG8_BAR; PG8_SCHED;
            PG8_LDA(At, 0, 1); PG8_STAGE(PG8_SB(0, 0), b2, voffB); PG8_STAGE(PG8_SB(0, 1), b2 + hstep, voffB); PG8_STAGEA(PG8_SA(0, 0), a2, voffA);
            PG8_WAIT_V(8); PG8_WAIT_L(0); PG8_BAR; PG8_MMA(1, 0, At, B0); PG8_MMA(1, 1, At, B1); PG8_BAR; PG8_SCHED;
            PG8_LDB(B0, 1, 0); PG8_LDB(B1, 1, 1); PG8_SCHED; PG8_LDA(At, 1, 0); PG8_STAGEA(PG8_SA(0, 1), a2 + hstep, voffA);
            PG8_WAIT_V(8); PG8_WAIT_L(0); PG8_BAR; PG8_MMA(0, 0, At, B0); PG8_MMA(0, 1, At, B1); PG8_BAR; PG8_SCHED;
            PG8_LDA(At, 1, 1); PG8_STAGE(PG8_SB(1, 0), b3, voffB); PG8_STAGE(PG8_SB(1, 1), b3 + hstep, voffB); PG8_STAGEA(PG8_SA(1, 0), a3, voffA);
            PG8_WAIT_V(8); PG8_WAIT_L(0); PG8_BAR; PG8_MMA(1, 0, At, B0); PG8_MMA(1, 1, At, B1); PG8_BAR; PG8_SCHED;
            } else {
            PG8_LDB(B0, 0, 0); PG8_SCHED; PG8_LDA(At, 0, 0); PG8_STAGEA(PG8_SA(1, 1), a1 + hstep, voffA);
            PG8_WAIT_L(8); PG8_BAR; PG8_WAIT_L(0); PG8_MMA(0, 0, At, B0); PG8_BAR; PG8_SCHED;
            PG8_LDB(B1, 0, 1); PG8_STAGE(PG8_SB(0, 0), b2, voffB);
            PG8_BAR; PG8_WAIT_L(0); PG8_MMA(0, 1, At, B1); PG8_BAR;
            PG8_LDA(At, 0, 1); PG8_STAGEA(PG8_SA(0, 0), a2, voffA);
            PG8_BAR; PG8_WAIT_L(0); PG8_MMA(1, 0, At, B0); PG8_BAR; PG8_SCHED;
            PG8_STAGE(PG8_SB(0, 1), b2 + hstep, voffB);
            PG8_WAIT_V(6); PG8_BAR; PG8_MMA(1, 1, At, B1); PG8_BAR;
            PG8_LDB(B0, 1, 0); PG8_SCHED; PG8_LDA(At, 1, 0); PG8_STAGEA(PG8_SA(0, 1), a2 + hstep, voffA);
            PG8_WAIT_L(8); PG8_BAR; PG8_WAIT_L(0); PG8_MMA(0, 0, At, B0); PG8_BAR; PG8_SCHED;
            PG8_LDB(B1, 1, 1); PG8_STAGE(PG8_SB(1, 0), b3, voffB);
            PG8_BAR; PG8_WAIT_L(0); PG8_MMA(0, 1, At, B1); PG8_BAR;
            PG8_LDA(At, 1, 1); PG8_STAGEA(PG8_SA(1, 0), a3, voffA);
            PG8_BAR; PG8_WAIT_L(0); PG8_MMA(1, 0, At, B0); PG8_BAR; PG8_SCHED;
            PG8_STAGE(PG8_SB(1, 1), b3 + hstep, voffB);
            PG8_WAIT_V(6); PG8_BAR; PG8_MMA(1, 1, At, B1); PG8_BAR;
            }
        }
        if constexpr (ALIGN_EPI) { if (wr == 0) PG8_BAR; }
        if constexpr (!Epi::AFTER_DRAIN) { E(acc, cur, wr, wc, fr, fq); S.done(cur); }
        if (!has_next) break;
#pragma unroll
        for (int a = 0; a < 2; ++a)
#pragma unroll
            for (int b = 0; b < 2; ++b)
#pragma unroll
                for (int m = 0; m < 4; ++m)
#pragma unroll
                    for (int n = 0; n < 2; ++n) acc[a][b][m][n] = (f32x4){0.f, 0.f, 0.f, 0.f};
        cur = nxt; cA = nA; cB = nB; ++ui;
        if constexpr (ALIGN_EPI) { if (wr == 1) PG8_BAR; }
    }
    PG8_WAIT_V(0);
    if constexpr (!ALIGN_EPI) { if (wr == 0) PG8_BAR; }
    PG8_BAR;
    if constexpr (Epi::AFTER_DRAIN) { E.fused(acc, cur, wr, wc, fr, fq, lds, wid, lane); S.done(cur); }
#undef PG8_SA
#undef PG8_SB
#undef PG8_STAGE
#undef PG8_STAGEA
#undef PG8_LDA
#undef PG8_LDB
#undef PG8_MMA
#undef PG8_WAIT_V
#undef PG8_WAIT_L
#undef PG8_BAR
#undef PG8_SCHED
}
}
#define XB_TMO      128
#define XB_XCNT(j)  (256  + 64 * (j))
#define XB_XSUB(j)  (1280 + 64 * (j))
#define XB_XGEN(j)  (2304 + 64 * (j))
#define XB_TOP      3328
#define XB_TOPGEN   3392
#define XCD_BAR_WORDS 3456
#define XB_SPIN_CAP (1u << 18)

__device__ __forceinline__ unsigned xb_ld(unsigned* p)              { return __hip_atomic_load(p, __ATOMIC_RELAXED, __HIP_MEMORY_SCOPE_AGENT); }
__device__ __forceinline__ unsigned xb_add(unsigned* p, unsigned v) { return __hip_atomic_fetch_add(p, v, __ATOMIC_RELAXED, __HIP_MEMORY_SCOPE_AGENT); }
__device__ __forceinline__ unsigned xb_xcc_id() { return (unsigned)__builtin_amdgcn_s_getreg((3 << 11) | 20) & 0xFu; }
#define XB_SPIN(cond, bar) do { unsigned _sp = 0; while (cond) { __builtin_amdgcn_s_sleep(1); \
    if ((++_sp & 255u) == 0u) { if (xb_ld(&(bar)[XB_TMO])) break; if (_sp > XB_SPIN_CAP) { atomicAdd(&(bar)[XB_TMO], 1u); break; } } } } while (0)

struct XcdBarrier {
    unsigned* bar; unsigned x;
    volatile LAS unsigned* st;
};

__device__ __forceinline__ XcdBarrier xcd_barrier_post(unsigned* bar, volatile LAS unsigned* st) {
    XcdBarrier b; b.bar = bar; b.x = xb_xcc_id(); b.st = st;
    if (threadIdx.x == 0) (void)xb_add(&bar[XB_XCNT(b.x)], 1u);
    return b;
}
__device__ __forceinline__ void xcd_barrier_complete(unsigned* bar, unsigned x, unsigned& nloc, unsigned& nx) {
    const unsigned G = gridDim.x * gridDim.y * gridDim.z;
    unsigned sum, cnt, mine, sp = 0u;
    for (;;) {
        sum = 0u; cnt = 0u; mine = 0u;
#pragma unroll
        for (unsigned j = 0; j < 16; ++j) { const unsigned c = xb_ld(&bar[XB_XCNT(j)]); sum += c; cnt += (c > 0u) ? 1u : 0u; mine = (j == x) ? c : mine; }
        if (sum == G) break;
        __builtin_amdgcn_s_sleep(1);
        if ((++sp & 255u) == 0u) { if (xb_ld(&bar[XB_TMO])) break; if (sp > XB_SPIN_CAP) { atomicAdd(&bar[XB_TMO], 1u); break; } }
    }
    nloc = mine > 0u ? mine : 1u; nx = cnt > 0u ? cnt : 1u;
}

__device__ __forceinline__ void xcd_barrier(const XcdBarrier& b) {
    asm volatile("s_waitcnt vmcnt(0)" ::: "memory");
    __syncthreads();
    if (threadIdx.x == 0) {
        unsigned* bar = b.bar;
        __builtin_amdgcn_s_waitcnt(0);
        unsigned nloc = b.st[0], nx = b.st[1];
        if (nloc == 0u) { xcd_barrier_complete(bar, b.x, nloc, nx); b.st[0] = nloc; b.st[1] = nx; }
        const unsigned old = xb_add(&bar[XB_XSUB(b.x)], 1u);
        const unsigned gen = old / nloc;
        if (old + 1u == (gen + 1u) * nloc) {
            __builtin_amdgcn_fence(__ATOMIC_RELEASE, "agent");
            asm volatile("s_waitcnt vmcnt(0)" ::: "memory");
            const unsigned og = xb_add(&bar[XB_TOP], 1u);
            const unsigned tg = og / nx;
            if (og + 1u == (tg + 1u) * nx) xb_add(&bar[XB_TOPGEN], 1u);
            else XB_SPIN(xb_ld(&bar[XB_TOPGEN]) == tg, bar);
            __builtin_amdgcn_fence(__ATOMIC_ACQUIRE, "agent");
            xb_add(&bar[XB_XGEN(b.x)], 1u);
            asm volatile("s_waitcnt vmcnt(0)" ::: "memory");
        } else {
            XB_SPIN(xb_ld(&bar[XB_XGEN(b.x)]) == gen, bar);
            __builtin_amdgcn_fence(__ATOMIC_ACQUIRE, "agent");
            asm volatile("s_waitcnt vmcnt(0)" ::: "memory");
        }
    }
    __syncthreads();
}
typedef unsigned short bf16;
typedef unsigned v4u __attribute__((ext_vector_type(4)));
typedef float f32x4 __attribute__((ext_vector_type(4)));
typedef short bf16x8 __attribute__((ext_vector_type(8)));
typedef GAS unsigned gu32;
#define LDS_WAIT() asm volatile("s_waitcnt lgkmcnt(0)" ::: "memory")
__device__ __forceinline__ unsigned f2bf(float f) { unsigned u = __builtin_bit_cast(unsigned, f); return (u + 0x7fffu + ((u >> 16) & 1u)) >> 16; }
__device__ __forceinline__ unsigned pk2(float lo, float hi) { return f2bf(lo) | (f2bf(hi) << 16); }
__device__ __forceinline__ unsigned cvtpk(float lo, float hi) { typedef float f2_ __attribute__((ext_vector_type(2))); typedef __bf16 b2_ __attribute__((ext_vector_type(2))); f2_ v = {lo, hi}; b2_ b = __builtin_convertvector(v, b2_); return __builtin_bit_cast(unsigned, b); }
__device__ __forceinline__ float bf2f(unsigned short h) { return __builtin_bit_cast(float, (unsigned)h << 16); }
__device__ __forceinline__ float bflo(unsigned w) { return __builtin_bit_cast(float, w << 16); }
__device__ __forceinline__ float bfhi(unsigned w) { return __builtin_bit_cast(float, w & 0xffff0000u); }
template <int CTRL> __device__ __forceinline__ float dpp_f(float v) { return __builtin_bit_cast(float, __builtin_amdgcn_update_dpp(__builtin_bit_cast(int, v), __builtin_bit_cast(int, v), CTRL, 0xf, 0xf, false)); }
__device__ __forceinline__ float wave_sum(float v) {
    v += dpp_f<0xB1>(v); v += dpp_f<0x4E>(v); v += dpp_f<0x141>(v); v += dpp_f<0x140>(v);
    const int vi = __builtin_bit_cast(int, v);
    return (__builtin_bit_cast(float, __builtin_amdgcn_readlane(vi, 0)) + __builtin_bit_cast(float, __builtin_amdgcn_readlane(vi, 16))) + (__builtin_bit_cast(float, __builtin_amdgcn_readlane(vi, 32)) + __builtin_bit_cast(float, __builtin_amdgcn_readlane(vi, 48)));
}
__device__ __forceinline__ float silu_f(float x) { return x / (1.f + __expf(-x)); }
__device__ __forceinline__ int crow(int r, int hi) { return (r & 3) + 8 * (r >> 2) + 4 * hi; }

struct Ctx {
    LAS unsigned char* lds; volatile LAS unsigned* MISC; gu32* ctl;
    int tid, wave, vcu, G;
    const float* in[18]; float* out; unsigned char* ws;
};
__device__ __forceinline__ int q_next(Ctx& C, int cw, unsigned n = 1u) {
    __syncthreads();
    if (C.tid == 0) C.MISC[16] = __hip_atomic_fetch_add((unsigned*)(C.ctl + cw), n, __ATOMIC_RELAXED, __HIP_MEMORY_SCOPE_AGENT);
    __syncthreads();
    return (int)C.MISC[16];
}

constexpr int CW_GB = 13312, CW_SUP = 14336, CW_SOP = 14368, CW_GC = 14400;
__device__ __forceinline__ void group_census(Ctx& C) { if (C.tid == 0) __hip_atomic_fetch_add((unsigned*)(C.ctl + CW_GC + 16 * ((int)blockIdx.x & 7) + (int)xb_xcc_id()), 1u, __ATOMIC_RELAXED, __HIP_MEMORY_SCOPE_AGENT); }
__device__ __forceinline__ void group_barrier(Ctx& C, int gx, unsigned gn, unsigned target, int wbase = CW_GB) {
    asm volatile("s_waitcnt vmcnt(0)" ::: "memory");
    __syncthreads();
    if (C.tid == 0) {
        const bool uni = __hip_atomic_load((unsigned*)(C.ctl + CW_GC + 16 * gx + (int)xb_xcc_id()), __ATOMIC_RELAXED, __HIP_MEMORY_SCOPE_AGENT) == gn;
        if (!uni) { __builtin_amdgcn_fence(__ATOMIC_RELEASE, "agent"); asm volatile("s_waitcnt vmcnt(0)" ::: "memory"); }
        const int word = wbase + 64 * gx;
        __hip_atomic_fetch_add((unsigned*)(C.ctl + word), 1u, __ATOMIC_RELAXED, __HIP_MEMORY_SCOPE_AGENT);
        unsigned sp = 0; while (__hip_atomic_load((unsigned*)(C.ctl + word), __ATOMIC_RELAXED, __HIP_MEMORY_SCOPE_AGENT) < target) { __builtin_amdgcn_s_sleep(1); if (++sp > (1u << 22)) break; }
        __builtin_amdgcn_fence(__ATOMIC_ACQUIRE, "agent"); asm volatile("s_waitcnt vmcnt(0)" ::: "memory");
    }
    __syncthreads();
}

constexpr int CW_GB0 = 15808, CW_W1T = 16320, CW_SIP = 16352;
constexpr int CW_GB1 = 14592, CW_GD1 = 15168, CW_SPP = 15744;
__device__ __forceinline__ void group_publish(Ctx& C, int gx, unsigned gn) {
    asm volatile("s_waitcnt vmcnt(0)" ::: "memory");
    __syncthreads();
    if (C.tid == 0) {
        const bool uni = __hip_atomic_load((unsigned*)(C.ctl + CW_GC + 16 * gx + (int)xb_xcc_id()), __ATOMIC_RELAXED, __HIP_MEMORY_SCOPE_AGENT) == gn;
        if (!uni) { __builtin_amdgcn_fence(__ATOMIC_RELEASE, "agent"); asm volatile("s_waitcnt vmcnt(0)" ::: "memory"); }
        const unsigned old = __hip_atomic_fetch_add((unsigned*)(C.ctl + CW_GB1 + 64 * gx), 1u, __ATOMIC_RELAXED, __HIP_MEMORY_SCOPE_AGENT);
        if (old + 1u == gn) { __builtin_amdgcn_fence(__ATOMIC_RELEASE, "agent"); asm volatile("s_waitcnt vmcnt(0)" ::: "memory");
            __hip_atomic_store((unsigned*)(C.ctl + CW_GD1 + 64 * gx), 1u, __ATOMIC_RELAXED, __HIP_MEMORY_SCOPE_AGENT); }
    }
}
__device__ __forceinline__ void group_consume_wait(Ctx& C, int x, int gx, unsigned gn, bool all) {
    if (C.tid == 0) {
        unsigned sp = 0;
        if (all) {
            for (;;) { unsigned ok = 1u;
#pragma unroll
                for (int j = 0; j < 8; ++j) ok &= __hip_atomic_load((unsigned*)(C.ctl + CW_GD1 + 64 * j), __ATOMIC_RELAXED, __HIP_MEMORY_SCOPE_AGENT);
                if (ok || ++sp > (1u << 22)) break; __builtin_amdgcn_s_sleep(2); }
        } else {
            const bool uni = __hip_atomic_load((unsigned*)(C.ctl + CW_GC + 16 * gx + (int)xb_xcc_id()), __ATOMIC_RELAXED, __HIP_MEMORY_SCOPE_AGENT) == gn;
            if (x == gx && uni) { while (__hip_atomic_load((unsigned*)(C.ctl + CW_GB1 + 64 * x), __ATOMIC_RELAXED, __HIP_MEMORY_SCOPE_AGENT) < gn) { __builtin_amdgcn_s_sleep(1); if (++sp > (1u << 22)) break; } }
            else { while (__hip_atomic_load((unsigned*)(C.ctl + CW_GD1 + 64 * x), __ATOMIC_RELAXED, __HIP_MEMORY_SCOPE_AGENT) == 0u) { __builtin_amdgcn_s_sleep(1); if (++sp > (1u << 22)) break; } }
            while (__hip_atomic_load((unsigned*)(C.ctl + CW_SPP), __ATOMIC_RELAXED, __HIP_MEMORY_SCOPE_AGENT) < 32u) { __builtin_amdgcn_s_sleep(1); if (++sp > (1u << 22)) break; }
        }
        __builtin_amdgcn_fence(__ATOMIC_ACQUIRE, "agent"); asm volatile("s_waitcnt vmcnt(0)" ::: "memory");
    }
    __syncthreads();
}

__device__ __forceinline__ void counter_wait(Ctx& C, int word, unsigned target) {
    if (C.tid == 0) { unsigned sp = 0; while (__hip_atomic_load((unsigned*)(C.ctl + word), __ATOMIC_RELAXED, __HIP_MEMORY_SCOPE_AGENT) < target) { __builtin_amdgcn_s_sleep(1); if (++sp > (1u << 22)) break; }
        __builtin_amdgcn_fence(__ATOMIC_ACQUIRE, "agent"); asm volatile("s_waitcnt vmcnt(0)" ::: "memory"); }
    __syncthreads();
}
__device__ __forceinline__ int inproj_src(int p) {
    const int pn = p >> 8, q = p & 255;
    const int bj = q >> 7, wc = (q >> 5) & 3, n = (q >> 4) & 1, fq = (q >> 2) & 3, e = q & 3;
    const int lc = 64 * wc + 16 * fq + 8 * bj + 4 * n + e;
    if (pn < 5) return 256 * pn + lc;
    if (pn == 5) return lc < 72 ? 1280 + lc : -1;
    return 1352 + 256 * (pn - 6) + lc;
}
template <bool MAP>
__device__ __forceinline__ void p0_transpose_item(const float* W, int K, int N, int NP, const float* gain, bf16* WT, LAS float* scr, int item, int lane) {
    const int nblk = NP / 32, kb = item / nblk, nb = item % nblk, k0 = 64 * kb, n0 = 32 * nb;
    const int p = n0 + (lane & 31); const int sc = MAP ? inproj_src(p) : p;
#pragma unroll 8
    for (int i = 0; i < 32; ++i) { const int kk = 2 * i + (lane >> 5); float v = 0.f; if (sc >= 0) v = (NT_W && !MAP) ? __builtin_nontemporal_load(W + (size_t)(k0 + kk) * N + sc) : W[(size_t)(k0 + kk) * N + sc]; if (gain) v *= gain[k0 + kk]; scr[kk * 33 + (lane & 31)] = v; }
    LDS_WAIT(); asm volatile("" ::: "memory");
    const int c = lane & 7;
#pragma unroll
    for (int j = 0; j < 4; ++j) { const int n = (lane >> 3) + 8 * j; const LAS float* s = scr + (8 * c) * 33 + n;
        v4u o; o.x = cvtpk(s[0 * 33], s[1 * 33]); o.y = cvtpk(s[2 * 33], s[3 * 33]); o.z = cvtpk(s[4 * 33], s[5 * 33]); o.w = cvtpk(s[6 * 33], s[7 * 33]);
        *(GAS v4u*)(WT + (size_t)(n0 + n) * K + k0 + 8 * c) = o; }
    LDS_WAIT(); asm volatile("" ::: "memory");
}
template <int R>
__device__ __forceinline__ void x_rows_to_bf16(const float* x0, size_t rstride, bf16* o0, float* rstd0, int lane, int nrows) {
    f32x4 v[R][4];
#pragma unroll
    for (int r = 0; r < R; ++r) { const GAS f32x4* xr = (const GAS f32x4*)(x0 + (r < nrows ? r : 0) * rstride * DM) + lane;
#pragma unroll
#if X_NT
        for (int j = 0; j < 4; ++j) v[r][j] = __builtin_nontemporal_load(xr + 64 * j); }
#else
        for (int j = 0; j < 4; ++j) v[r][j] = xr[64 * j]; }
#endif
#pragma unroll
    for (int r = 0; r < R; ++r) if (r < nrows) { float s = 0.f;
#pragma unroll
        for (int j = 0; j < 4; ++j) s += (v[r][j].x * v[r][j].x + v[r][j].y * v[r][j].y) + (v[r][j].z * v[r][j].z + v[r][j].w * v[r][j].w);
        s = wave_sum(s);
        if (lane == 0) rstd0[r * rstride] = rsqrtf(s * (1.0f / DM) + EPS);
        GAS u64* o8 = (GAS u64*)(o0 + r * rstride * DM) + lane;
#pragma unroll
        for (int j = 0; j < 4; ++j) o8[64 * j] = (u64)cvtpk(v[r][j].x, v[r][j].y) | ((u64)cvtpk(v[r][j].z, v[r][j].w) << 32); }
}

template <int K, bool GK, int KW = K / 8>
__device__ __forceinline__ void skinny32(const float* A, const float* gk, const float* W, int ldw, int N, int n0, LAS float* red, int tid, int lane, int wave, int kbase = 0) {
    asm volatile("" : "+v"(tid), "+v"(lane));
    const int i = lane & 31, kh = lane >> 5, n = n0 + i; const bool nok = n < N;
    f32x16 acc = {};
    const int kbeg = kbase + wave * KW, kend = kbeg + KW;
#pragma unroll 1
    for (int kb0 = kbeg; kb0 < kend; kb0 += 64) {
        f32x4 xa[8]; float bw[8][4];
#pragma unroll
        for (int s = 0; s < 8; ++s) { const int kb = kb0 + 8 * s;
            xa[s] = *(const f32x4*)(A + (size_t)i * K + kb + 4 * kh);
            if (GK) { const f32x4 ga = *(const f32x4*)(gk + kb + 4 * kh); xa[s] = xa[s] * ga; }
            const float* wp = W + (size_t)(kb + 4 * kh) * ldw + (nok ? n : 0);
            bw[s][0] = wp[0]; bw[s][1] = wp[ldw]; bw[s][2] = wp[2 * (size_t)ldw]; bw[s][3] = wp[3 * (size_t)ldw]; }
#pragma unroll
        for (int s = 0; s < 8; ++s)
#pragma unroll
            for (int j = 0; j < 4; ++j) acc = __builtin_amdgcn_mfma_f32_32x32x2f32(xa[s][j], nok ? bw[s][j] : 0.f, acc, 0, 0, 0);
    }
#pragma unroll
    for (int r = 0; r < 16; ++r) red[wave * 1024 + crow(r, kh) * 32 + i] = acc[r];
    __syncthreads();
#pragma unroll
    for (int x = 0; x < 2; ++x) { const int e = tid + 512 * x; float s = 0.f;
#pragma unroll
        for (int w = 0; w < 8; ++w) s += red[w * 1024 + e];
        red[8 * 1024 + e] = s; }
    __syncthreads();
}
__device__ __forceinline__ float sk_get(LAS float* red, int e) { return red[8 * 1024 + e]; }
template <int K>
__device__ __forceinline__ void rows_rstd32(const float* A, LAS float* rs, int lane, int wave) {
    f32x4 v[4][K / 256];
#pragma unroll
    for (int j = 0; j < 4; ++j)
#pragma unroll
        for (int c = 0; c < K / 256; ++c) v[j][c] = *(const f32x4*)(A + (size_t)(wave * 4 + j) * K + lane * 4 + 256 * c);
#pragma unroll
    for (int j = 0; j < 4; ++j) { float s = 0.f;
#pragma unroll
        for (int c = 0; c < K / 256; ++c) s += (v[j][c][0] * v[j][c][0] + v[j][c][1] * v[j][c][1]) + (v[j][c][2] * v[j][c][2] + v[j][c][3] * v[j][c][3]);
        s = wave_sum(s); if (lane == 0) rs[wave * 4 + j] = rsqrtf(s * (1.0f / K) + EPS); }
}
template <int K, int KW>
__device__ __forceinline__ void skinny32_bf16(const float* A, const bf16* WT, int n0, LAS float* red, int tid, int lane, int wave, int kbase = 0) {
    asm volatile("" : "+v"(tid), "+v"(lane));
    const int i = lane & 31, hi = lane >> 5; constexpr int NS = KW / 16;
    const int kbeg = kbase + wave * KW;
    bf16x8 wf[NS]; f32x4 xa[NS][2];
#pragma unroll
    for (int s = 0; s < NS; ++s) { wf[s] = *(const bf16x8*)(WT + (size_t)(n0 + i) * K + kbeg + 16 * s + 8 * hi);
        const float* ap = A + (size_t)i * K + kbeg + 16 * s + 8 * hi; xa[s][0] = *(const f32x4*)ap; xa[s][1] = *(const f32x4*)(ap + 4); }
    f32x16 acc = {};
#pragma unroll
    for (int s = 0; s < NS; ++s) { v4u xb; xb.x = cvtpk(xa[s][0][0], xa[s][0][1]); xb.y = cvtpk(xa[s][0][2], xa[s][0][3]); xb.z = cvtpk(xa[s][1][0], xa[s][1][1]); xb.w = cvtpk(xa[s][1][2], xa[s][1][3]);
        acc = __builtin_amdgcn_mfma_f32_32x32x16_bf16(wf[s], __builtin_bit_cast(bf16x8, xb), acc, 0, 0, 0); }
#pragma unroll
    for (int r = 0; r < 16; ++r) red[wave * 1024 + i * 32 + crow(r, hi)] = acc[r];
    __syncthreads();
#pragma unroll
    for (int x = 0; x < 2; ++x) { const int e = tid + 512 * x; float s = 0.f;
#pragma unroll
        for (int w = 0; w < 8; ++w) s += red[w * 1024 + e];
        red[8 * 1024 + e] = s; }
    __syncthreads();
}
__device__ __forceinline__ void p0_prologue(Ctx& C) {
    LAS float* scr = (LAS float*)(C.lds + C.wave * 16384);
    float* samp = (float*)(C.ws + WS_SAMP);
    if (C.vcu < 107) {
        LAS float* red = (LAS float*)C.lds; LAS float* rs = red + 9 * 1024 + 64;
        rows_rstd32<DM>(C.in[I_XS], rs, (C.tid & 63), C.wave);
        skinny32<DM, true>(C.in[I_XS], C.in[I_N1G], C.in[I_WIN], INW, INW, 32 * C.vcu, red, C.tid, (C.tid & 63), C.wave);
        int tid_ = C.tid; asm volatile("" : "+v"(tid_));
#pragma unroll
#if GSEAM0
        for (int x = 0; x < 2; ++x) { const int e = tid_ + 512 * x, i = e >> 5, n = 32 * C.vcu + (e & 31); if (n < INW) __hip_atomic_store(samp + S_RAW + i * INW + n, sk_get(red, e) * rs[i], __ATOMIC_RELAXED, __HIP_MEMORY_SCOPE_AGENT); }
        asm volatile("s_waitcnt vmcnt(0)" ::: "memory");
        __syncthreads();
        if (C.tid == 0) __hip_atomic_fetch_add((unsigned*)(C.ctl + CW_SIP), 1u, __ATOMIC_RELAXED, __HIP_MEMORY_SCOPE_AGENT);
#else
        for (int x = 0; x < 2; ++x) { const int e = tid_ + 512 * x, i = e >> 5, n = 32 * C.vcu + (e & 31); if (n < INW) samp[S_RAW + i * INW + n] = sk_get(red, e) * rs[i]; }
        __syncthreads();
#endif
    }
    if (C.vcu == 200 && C.tid < 192) ((float*)(C.ws + WS_GAINS))[C.tid] = C.tid < 64 ? C.in[I_QG][C.tid] : (C.tid < 128 ? C.in[I_KG][C.tid - 64] : C.in[I_IKG][C.tid - 128]);
    const int gw = C.vcu * 8 + C.wave, NGW = C.G * 8;
    constexpr int I_1 = (DM / 64) * (INP / 32), I_O = (DM / 64) * (DM / 32), I_U = (DM / 64) * (FF / 32), I_D = (FF / 64) * (DM / 32);
#if GSEAM0
    for (int it = gw; it < I_1; it += NGW) p0_transpose_item<true>(C.in[I_WIN], DM, INW, INP, C.in[I_N1G], (bf16*)(C.ws + WS_W1T), scr, it, (C.tid & 63));
    asm volatile("s_waitcnt vmcnt(0)" ::: "memory");
    __syncthreads();
    if (C.tid == 0) { __builtin_amdgcn_fence(__ATOMIC_RELEASE, "agent"); asm volatile("s_waitcnt vmcnt(0)" ::: "memory"); __hip_atomic_fetch_add((unsigned*)(C.ctl + CW_W1T), 1u, __ATOMIC_RELAXED, __HIP_MEMORY_SCOPE_AGENT); }
#ifdef P0_SKEW
    if (C.vcu < (C.G >> 1)) for (int it = I_1 + gw; it < I_1 + I_O + I_U + I_D; it += NGW >> 1) {
#else
    for (int it = I_1 + gw; it < (WDEFER ? I_1 : I_1 + I_O + I_U + I_D); it += NGW) {
#endif
#else
    for (int it = gw; it < I_1 + I_O + I_U + I_D; it += NGW) {
#endif
        int r = it;
        if (r < I_1) { p0_transpose_item<true>(C.in[I_WIN], DM, INW, INP, C.in[I_N1G], (bf16*)(C.ws + WS_W1T), scr, r, (C.tid & 63)); continue; } r -= I_1;
        if (r < I_O) { p0_transpose_item<false>(C.in[I_WOUT], DM, DM, DM, nullptr, (bf16*)(C.ws + WS_WOT), scr, r, (C.tid & 63)); continue; } r -= I_O;
        if (r < I_U) { p0_transpose_item<false>(C.in[I_WUP], DM, FF, FF, C.in[I_N2G], (bf16*)(C.ws + WS_WUT), scr, r, (C.tid & 63)); continue; } r -= I_U;
        p0_transpose_item<false>(C.in[I_WDN], FF, DM, DM, nullptr, (bf16*)(C.ws + WS_WDT), scr, r, (C.tid & 63));
    }
    bf16* XB = (bf16*)(C.ws + WS_XB); float* RSTD1 = (float*)(C.ws + WS_RSTD1);
#if GSEAM0
    {
        const int gx = (int)blockIdx.x & 7, ngwl = (C.G >> 3) * 8, gwl = ((int)blockIdx.x >> 3) * 8 + C.wave; const size_t base = (size_t)gx * (NTOK / 8);
        for (int m = gwl; m < NTOK / 8; m += 4 * ngwl) x_rows_to_bf16<4>(C.in[I_XP] + (base + m) * DM, (size_t)ngwl, XB + (base + m) * DM, RSTD1 + base + m, (C.tid & 63), (NTOK / 8 - 1 - m) / ngwl + 1);
    }
#else
    for (int m = gw; m < NTOK; m += 4 * NGW) x_rows_to_bf16<4>(C.in[I_XP] + (size_t)m * DM, (size_t)NGW, XB + (size_t)m * DM, RSTD1 + m, (C.tid & 63), (NTOK - 1 - m) / NGW + 1);
#endif
}

constexpr int CW_QW2 = 11264, CW_QW3 = 11328;
__device__ __forceinline__ void weights_filler(Ctx& C, int cw, int u_lo, int u_hi) {
    LAS float* scr = (LAS float*)(C.lds + C.wave * 16384);
    constexpr int I_O = (DM / 64) * (DM / 32), I_U = (DM / 64) * (FF / 32);
    for (int u = u_lo + q_next(C, cw, 1u); u < u_hi; u = u_lo + q_next(C, cw, 1u)) {
#pragma unroll 1
        for (int k = 0; k < 2; ++k) { int r = u * 16 + C.wave * 2 + k;
            if (r < I_O) { p0_transpose_item<false>(C.in[I_WOUT], DM, DM, DM, nullptr, (bf16*)(C.ws + WS_WOT), scr, r, (C.tid & 63)); continue; } r -= I_O;
            if (r < I_U) { p0_transpose_item<false>(C.in[I_WUP], DM, FF, FF, C.in[I_N2G], (bf16*)(C.ws + WS_WUT), scr, r, (C.tid & 63)); continue; } r -= I_U;
            p0_transpose_item<false>(C.in[I_WDN], FF, DM, DM, nullptr, (bf16*)(C.ws + WS_WDT), scr, r, (C.tid & 63)); }
    }
}

__device__ __forceinline__ void sample_postproj(Ctx& C, int b) {
    const float* __restrict__ raw = (const float*)(C.ws + WS_SAMP) + S_RAW + (size_t)b * INW; float* __restrict__ sp = (float*)(C.ws + WS_SAMP) + S_SP + (size_t)b * 4096;
    const int l = (C.tid & 63), w = C.wave, w1 = w & 1;
#define SPST(p, v) __hip_atomic_store((p), (v), __ATOMIC_RELAXED, __HIP_MEMORY_SCOPE_AGENT)
    const float vq = raw[w * 64 + l], vk = raw[512 + w1 * 64 + l], vv = raw[640 + w1 * 64 + l], viq = raw[768 + w * 64 + l], vik = raw[1280 + l], viw = raw[1344 + (l & 7)];
    const float r0 = raw[1352 + w * 64 + l], r1 = raw[1864 + w * 64 + l], r2 = raw[2376 + w * 64 + l], r3 = raw[2888 + w * 64 + l];
    const float gq = C.in[I_QG][l], gk = C.in[I_KG][l], gi = C.in[I_IKG][l];
    { const float ss = wave_sum(vq * vq); SPST(sp + w * 64 + l, vq * rsqrtf(ss * (1.f / 64.f) + EPS) * gq); }
    if (w < 2) { const float ss = wave_sum(vk * vk); const float kn = vk * rsqrtf(ss * (1.f / 64.f) + EPS) * gk;
        SPST(sp + 512 + w * 64 + l, kn); C.out[O_NKS + (size_t)b * 128 + w * 64 + l] = kn; }
    else if (w < 4) { SPST(sp + 640 + w1 * 64 + l, vv); C.out[O_NVS + (size_t)b * 128 + w1 * 64 + l] = vv; }
    else if (w == 4) { const float ss = wave_sum(vik * vik); const float kn = vik * rsqrtf(ss * (1.f / 64.f) + EPS) * gi; SPST(sp + 1280 + l, kn); C.out[O_NKIS + (size_t)b * 64 + l] = kn; }
    else if (w == 5) { if (l < 8) SPST(sp + 1344 + l, viw * IDX_W_SCALE); }
    SPST(sp + 768 + w * 64 + l, viq);
    SPST(sp + 1352 + w * 64 + l, silu_f(r0) * REC_QSCALE); SPST(sp + 1864 + w * 64 + l, r1); SPST(sp + 2376 + w * 64 + l, r2); SPST(sp + 2888 + w * 64 + l, silu_f(r3));
#undef SPST
    asm volatile("s_waitcnt vmcnt(0)" ::: "memory");
    __syncthreads();
    if (C.tid == 0) __hip_atomic_fetch_add((unsigned*)(C.ctl + CW_SPP), 1u, __ATOMIC_RELAXED, __HIP_MEMORY_SCOPE_AGENT);
}
constexpr int SROW = 2052, SEL_WS_OFF = 131584;
static_assert(SEL_WS_OFF + 8 * 3840 <= LDSCTL_OFF && SEL_WS_OFF + 16384 <= LDSCTL_OFF, "select lds");
template <int CTRL> __device__ __forceinline__ float dppf(float v) { return __builtin_bit_cast(float, __builtin_amdgcn_update_dpp(__builtin_bit_cast(int, v), __builtin_bit_cast(int, v), CTRL, 0xf, 0xf, false)); }
template <int CTRL> __device__ __forceinline__ int dppi(int v) { return __builtin_amdgcn_update_dpp(v, v, CTRL, 0xf, 0xf, false); }
__device__ __forceinline__ float rdl_f(float v, int l) { return __builtin_bit_cast(float, __builtin_amdgcn_readlane(__builtin_bit_cast(int, v), l)); }
__device__ __forceinline__ float wave_min_f(float v) {
    v = fminf(v, dppf<0xB1>(v)); v = fminf(v, dppf<0x4E>(v)); v = fminf(v, dppf<0x141>(v)); v = fminf(v, dppf<0x140>(v));
    return fminf(fminf(rdl_f(v, 0), rdl_f(v, 16)), fminf(rdl_f(v, 32), rdl_f(v, 48)));
}
__device__ __forceinline__ float wave_max_f(float v) {
    v = fmaxf(v, dppf<0xB1>(v)); v = fmaxf(v, dppf<0x4E>(v)); v = fmaxf(v, dppf<0x141>(v)); v = fmaxf(v, dppf<0x140>(v));
    return fmaxf(fmaxf(rdl_f(v, 0), rdl_f(v, 16)), fmaxf(rdl_f(v, 32), rdl_f(v, 48)));
}
__device__ __forceinline__ int row_sum_i(int v) { v += dppi<0xB1>(v); v += dppi<0x4E>(v); v += dppi<0x141>(v); v += dppi<0x140>(v); return v; }
__device__ __forceinline__ int row_suffix_i(int v) {
    v += __builtin_amdgcn_update_dpp(0, v, 0x101, 0xf, 0xf, true); v += __builtin_amdgcn_update_dpp(0, v, 0x102, 0xf, 0xf, true);
    v += __builtin_amdgcn_update_dpp(0, v, 0x104, 0xf, 0xf, true); v += __builtin_amdgcn_update_dpp(0, v, 0x108, 0xf, 0xf, true); return v;
}
__device__ __forceinline__ float relu_f(float x) { const int xi = __builtin_bit_cast(int, x); return __builtin_bit_cast(float, xi > 0 ? xi : 0); }
#if 0
__device__ __forceinline__ float relu_f(float x) { return __builtin_amdgcn_fmed3f(x, 0.f, INFINITY); }
#endif
__device__ __forceinline__ void dsa_select_unit(Ctx& C, int b, int qb) {
    const bf16* IQb = (const bf16*)(C.ws + WS_IQB); const bf16* IKb = (const bf16*)(C.ws + WS_IKB); const float* IWf = (const float*)(C.ws + WS_IWF);
    u64* MASK = (u64*)(C.ws + WS_MASK);
    LAS float* sc = (LAS float*)C.lds;
    int lane = (C.tid & 63), wave = C.wave; asm volatile("" : "+v"(lane), "+s"(wave));
#ifdef PROBE_SEL
    const unsigned long long ps0_ = __builtin_amdgcn_s_memrealtime(); unsigned long long ps1_ = 0;
#endif
    const int t0 = qb * 16, ntile = qb + 1, ql = lane & 15, g = lane >> 4;
    const size_t rowq = (size_t)b * SEQ + t0 + ql;
    if (t0 + 15 >= 256)
    {
        bf16x8 bq[8][2];
#pragma unroll
        for (int h = 0; h < 8; ++h)
#pragma unroll
#ifdef NT_IQ
            for (int ks = 0; ks < 2; ++ks) bq[h][ks] = __builtin_nontemporal_load((const bf16x8*)(IQb + rowq * 512 + h * 64 + ks * 32 + g * 8));
#else
            for (int ks = 0; ks < 2; ++ks) bq[h][ks] = *(const bf16x8*)(IQb + rowq * 512 + h * 64 + ks * 32 + g * 8);
#endif
        float w[8];
        { const f32x4 w0 = *(const f32x4*)(IWf + rowq * 8), w1 = *(const f32x4*)(IWf + rowq * 8 + 4); w[0] = w0[0]; w[1] = w0[1]; w[2] = w0[2]; w[3] = w0[3]; w[4] = w1[0]; w[5] = w1[1]; w[6] = w1[2]; w[7] = w1[3]; }
#if SEL_DIRECT
        const bf16* kfr = IKb + ((size_t)b * SEQ + ql) * 64 + g * 8; const int ntm1 = ntile - 1;
        bf16x8 ka0, ka1, kb0, kb1, kc0, kc1, kd0, kd1;
#define SEL_KLOAD(A0, A1, ii_) do { const bf16* p_ = kfr + (size_t)((ii_) < ntile ? (ii_) : ntm1) * 16 * 64; A0 = *(const bf16x8*)p_; A1 = *(const bf16x8*)(p_ + 32); } while (0)
#define SEL_TILE(A0, A1, ii_) do { const int ii = (ii_); const bf16x8 a0 = A0, a1 = A1; SEL_KLOAD(A0, A1, ii + 32); \
            if (ii < ntile) { \
                f32x4 I = {0.f, 0.f, 0.f, 0.f}; \
                _Pragma("unroll") for (int h = 0; h < 8; ++h) { \
                    f32x4 d = __builtin_amdgcn_mfma_f32_16x16x32_bf16(a0, bq[h][0], (f32x4){0.f, 0.f, 0.f, 0.f}, 0, 0, 0); \
                    d = __builtin_amdgcn_mfma_f32_16x16x32_bf16(a1, bq[h][1], d, 0, 0, 0); \
                    _Pragma("unroll") for (int r = 0; r < 4; ++r) I[r] = fmaf(w[h], relu_f(d[r]), I[r]); } \
                *(LAS f32x4*)(sc + ql * SROW + ii * 16 + 4 * g) = I;           \
            } } while (0)
        SEL_KLOAD(ka0, ka1, wave); SEL_KLOAD(kb0, kb1, wave + 8); SEL_KLOAD(kc0, kc1, wave + 16); SEL_KLOAD(kd0, kd1, wave + 24);
#pragma unroll 1
        for (int i0_ = wave; i0_ < ntile; i0_ += 32) {
            SEL_TILE(ka0, ka1, i0_); SEL_TILE(kb0, kb1, i0_ + 8); SEL_TILE(kc0, kc1, i0_ + 16); SEL_TILE(kd0, kd1, i0_ + 24);
        }
#undef SEL_KLOAD
#undef SEL_TILE
#else
        LAS unsigned char* stg = C.lds + SEL_WS_OFF;
        const int tid_ = C.tid, pk0 = tid_ >> 3, pc = tid_ & 7, nround = (ntile + 7) >> 3;
        const bf16* gsrc = IKb + ((size_t)b * SEQ + pk0) * 64 + pc * 8;
        const int wo0 = (pk0 * 8 + (pc ^ (pk0 & 7))) * 16, wo1 = ((pk0 + 64) * 8 + (pc ^ (pk0 & 7))) * 16;
        const int ro0 = ((16 * wave + ql) * 8 + (g ^ (ql & 7))) * 16, ro1 = ((16 * wave + ql) * 8 + ((4 + g) ^ (ql & 7))) * 16;
        const int nrm1 = nround - 1;
        v4u ra0, ra1, rb0, rb1;
#define SEL_GLOAD(R0, R1, rd_) do { const bf16* gp_ = gsrc + (size_t)((rd_) < nround ? (rd_) : nrm1) * 128 * 64; R0 = *(const v4u*)gp_; R1 = *(const v4u*)(gp_ + 64 * 64); } while (0)
#define SEL_ROUND(rd_, R0, R1) do { \
            __syncthreads();                                                    \
            *(LAS v4u*)(stg + wo0) = R0; *(LAS v4u*)(stg + wo1) = R1; \
            SEL_GLOAD(R0, R1, (rd_) + 2); \
            __syncthreads(); \
            const int ii = (rd_) * 8 + wave; \
            if (ii < ntile) { \
                const bf16x8 a0 = *(const LAS bf16x8*)(stg + ro0), a1 = *(const LAS bf16x8*)(stg + ro1); \
                f32x4 I = {0.f, 0.f, 0.f, 0.f}; \
                _Pragma("unroll") for (int h = 0; h < 8; ++h) { \
                    f32x4 d = __builtin_amdgcn_mfma_f32_16x16x32_bf16(a0, bq[h][0], (f32x4){0.f, 0.f, 0.f, 0.f}, 0, 0, 0); \
                    d = __builtin_amdgcn_mfma_f32_16x16x32_bf16(a1, bq[h][1], d, 0, 0, 0); \
                    _Pragma("unroll") for (int r = 0; r < 4; ++r) I[r] = fmaf(w[h], relu_f(d[r]), I[r]); } \
                *(LAS f32x4*)(sc + ql * SROW + ii * 16 + 4 * g) = I;           \
            } } while (0)
        SEL_GLOAD(ra0, ra1, 0); SEL_GLOAD(rb0, rb1, 1);
#pragma unroll 1
        for (int rd = 0; rd < nround; rd += 2) {
            SEL_ROUND(rd, ra0, ra1);
            if (rd + 1 < nround) SEL_ROUND(rd + 1, rb0, rb1);
        }
#undef SEL_GLOAD
#undef SEL_ROUND
#endif
    }
    __syncthreads();
#ifdef PROBE_SEL
    ps1_ = __builtin_amdgcn_s_memrealtime();
#endif
#ifdef PROBE_SEL
    unsigned long long sm_t_ = ps1_, sm_acc_ = 0;
#define SELMARK(k) do { const unsigned long long n_ = __builtin_amdgcn_s_memrealtime(); if (PROBE_SEL == (k)) sm_acc_ += n_ - sm_t_; sm_t_ = n_; } while (0)
#else
#define SELMARK(k) do {} while (0)
#endif
    LAS unsigned* hist = (LAS unsigned*)(C.lds + SEL_WS_OFF) + wave * 960;
#if SEL_DUAL
    bool dual_done = false;
#ifdef SEL_FORCE_FALLBACK
    if (t0 >= 256 && t0 > (SEL_FORCE_FALLBACK)) {
#else
    if (t0 >= 256) {
#endif
        float v[2][32]; int bn[2][32]; int tq[2], nj[2]; float lo[2], hi[2], scl[2]; unsigned mlo[2] = {0u, 0u}, mhi[2] = {0u, 0u};
        int Bs[2], cntB[2], rr_[2];
#pragma unroll
        for (int q = 0; q < 2; ++q) { tq[q] = t0 + 2 * wave + q; nj[q] = (tq[q] >> 6) + 1;
#pragma unroll
            for (int j = 0; j < 32; ++j) v[q][j] = sc[(2 * wave + q) * SROW + 64 * j + lane]; }
#pragma unroll
        for (int q = 0; q < 2; ++q) { float l_ = INFINITY, h_ = -INFINITY;
#pragma unroll
            for (int j = 0; j < 32; ++j) { const bool ok = (64 * j + lane) <= tq[q]; const float xl = ok ? v[q][j] : INFINITY; v[q][j] = ok ? v[q][j] : -INFINITY;
                asm("v_max_f32 %0, %0, %1" : "+v"(h_) : "v"(v[q][j])); asm("v_min_f32 %0, %0, %1" : "+v"(l_) : "v"(xl)); }
            lo[q] = l_; hi[q] = h_; }
#pragma unroll
        for (int q = 0; q < 2; ++q) { lo[q] = wave_min_f(lo[q]); hi[q] = wave_max_f(hi[q]); scl[q] = (hi[q] > lo[q]) ? 255.99f / (hi[q] - lo[q]) : 0.f; }
#pragma unroll
        for (int q = 0; q < 2; ++q) { LAS unsigned* hq = hist + 480 * q; *(LAS v4u*)(hq + 4 * lane) = (v4u){0u, 0u, 0u, 0u}; if (lane < 56) *(LAS v4u*)(hq + 256 + 4 * lane) = (v4u){0u, 0u, 0u, 0u}; }
        LDS_WAIT(); asm volatile("" ::: "memory");
#pragma unroll
        for (int q = 0; q < 2; ++q) { LAS unsigned* hq = hist + 480 * q;
#pragma unroll
            for (int j = 0; j < 32; ++j) { bn[q][j] = -1; if (j < nj[q]) { int bi = (int)((v[q][j] - lo[q]) * scl[q]); bi = bi > 255 ? 255 : bi; asm volatile("" : "+v"(bi)); bn[q][j] = bi;
                if (j < nj[q] - 1) __hip_atomic_fetch_add(hq + bi, 1u, __ATOMIC_RELAXED, __HIP_MEMORY_SCOPE_WORKGROUP);
                else if (bi >= 0) __hip_atomic_fetch_add(hq + bi, 1u, __ATOMIC_RELAXED, __HIP_MEMORY_SCOPE_WORKGROUP); } } }
        LDS_WAIT(); asm volatile("" ::: "memory");
#pragma unroll
        for (int q = 0; q < 2; ++q) { LAS unsigned* hq = hist + 480 * q;
            const v4u hh = *(const LAS v4u*)(hq + 4 * lane);
            const int s4 = (int)(hh.x + hh.y + hh.z + hh.w);
            const int rsum = row_sum_i(s4);
            const int r1s = __builtin_amdgcn_readlane(rsum, 16), r2s = __builtin_amdgcn_readlane(rsum, 32), r3s = __builtin_amdgcn_readlane(rsum, 48);
            int Rs, abv;
            if (r3s >= 256) { Rs = 3; abv = 0; } else if (r3s + r2s >= 256) { Rs = 2; abv = r3s; } else if (r3s + r2s + r1s >= 256) { Rs = 1; abv = r3s + r2s; } else { Rs = 0; abv = r3s + r2s + r1s; }
            const int incl = abv + row_suffix_i(s4);
            const u64 bal = __ballot(((lane >> 4) == Rs) && incl >= 256);
            const int Ls = 63 - __clzll(bal);
            int c = incl - s4, bsel, cab, hsel;
            if (c + (int)hh.w >= 256) { bsel = 3; cab = c; hsel = (int)hh.w; }
            else { c += (int)hh.w; if (c + (int)hh.z >= 256) { bsel = 2; cab = c; hsel = (int)hh.z; }
                else { c += (int)hh.z; if (c + (int)hh.y >= 256) { bsel = 1; cab = c; hsel = (int)hh.y; } else { c += (int)hh.y; bsel = 0; cab = c; hsel = (int)hh.x; } } }
            Bs[q] = 4 * Ls + __builtin_amdgcn_readlane(bsel, Ls); const int cabove = __builtin_amdgcn_readlane(cab, Ls); cntB[q] = __builtin_amdgcn_readlane(hsel, Ls);
            rr_[q] = 256 - cabove; }
        if (cntB[0] <= 64 && cntB[1] <= 64) {
#pragma unroll
            for (int q = 0; q < 2; ++q) { LAS unsigned* hq = hist + 480 * q; int cbase = 0;
#pragma unroll
                for (int j = 0; j < 32; ++j) if (j < nj[q]) { const u64 wa = __ballot(bn[q][j] > Bs[q]);
                    mlo[q] = (lane == j) ? (unsigned)wa : mlo[q]; mhi[q] = (lane == j) ? (unsigned)(wa >> 32) : mhi[q];
                    const bool isc = bn[q][j] == Bs[q]; const u64 bm = __ballot(isc);
                    if (bm != 0ull) { const int pos = cbase + (int)__builtin_amdgcn_mbcnt_hi((unsigned)(bm >> 32), __builtin_amdgcn_mbcnt_lo((unsigned)bm, 0u));
                        if (isc) hq[259 + 2 * pos] = (unsigned)(64 * j + lane);
                        cbase += __popcll(bm); } } }
            LDS_WAIT(); asm volatile("" ::: "memory");
            float cv[2]; int ci[2], rank[2] = {0, 0};
#pragma unroll
            for (int q = 0; q < 2; ++q) { LAS unsigned* hq = hist + 480 * q; const bool mine = lane < cntB[q];
                ci[q] = mine ? (int)hq[259 + 2 * lane] : 0; cv[q] = mine ? sc[(2 * wave + q) * SROW + ci[q]] : 0.f; }
            const int cmx = cntB[0] > cntB[1] ? cntB[0] : cntB[1];
#pragma unroll 1
            for (int j = 0; j < cmx; ++j) {
#pragma unroll
                for (int q = 0; q < 2; ++q) { const float x = rdl_f(cv[q], j); const int y = __builtin_amdgcn_readlane(ci[q], j); const bool in = j < cntB[q];
                    rank[q] += (in & ((x > cv[q]) | ((x == cv[q]) & (y < ci[q])))) ? 1 : 0; } }
#pragma unroll
            for (int q = 0; q < 2; ++q) { LAS unsigned* hq = hist + 480 * q;
                if (lane < cntB[q] && rank[q] < rr_[q]) __hip_atomic_fetch_or(hq + 416 + (ci[q] >> 5), 1u << (ci[q] & 31), __ATOMIC_RELAXED, __HIP_MEMORY_SCOPE_WORKGROUP); }
            LDS_WAIT(); asm volatile("" ::: "memory");
#pragma unroll
            for (int q = 0; q < 2; ++q) { LAS unsigned* hq = hist + 480 * q;
                if (lane < 32) { mlo[q] |= hq[416 + 2 * lane]; mhi[q] |= hq[417 + 2 * lane];
                    MASK[((size_t)b * SEQ + tq[q]) * 32 + lane] = ((u64)mhi[q] << 32) | mlo[q]; } }
            dual_done = true;
        }
    }
    if (!dual_done)
#endif
#ifdef SEL_REP_PICK
    for (int rep_ = 0; rep_ < 2; ++rep_)
#endif
#pragma unroll 1
    for (int qq = 0; qq < 2; ++qq) {
        const int qi = wave * 2 + qq, t = t0 + qi;
        unsigned mylo = 0, myhi = 0;
        if (t < 256) {
            const int lo = 64 * lane;
            const u64 mw_ = (lo > t) ? 0ull : ((lo + 63 <= t) ? ~0ull : ((2ull << (t - lo)) - 1ull));
            mylo = (unsigned)mw_; myhi = (unsigned)(mw_ >> 32);
        } else {
#ifndef SEL_RS
#define SEL_RS 0
#endif
            SELMARK(9);
            float v[32]; const int nj = (t >> 6) + 1;
            float lo = INFINITY, hi = -INFINITY;
#pragma unroll 1
            for (int rr = 0; rr < (SEL_RS == 1 ? 3 : 1); ++rr) { asm volatile("" ::: "memory"); lo = INFINITY; hi = -INFINITY;
#pragma unroll
            for (int j = 0; j < 32; ++j) v[j] = sc[qi * SROW + 64 * j + lane];
#pragma unroll
            for (int j = 0; j < 32; ++j) { const bool ok = (64 * j + lane) <= t; const float xl = ok ? v[j] : INFINITY; v[j] = ok ? v[j] : -INFINITY;
                asm("v_max_f32 %0, %0, %1" : "+v"(hi) : "v"(v[j])); asm("v_min_f32 %0, %0, %1" : "+v"(lo) : "v"(xl)); }
            lo = wave_min_f(lo); hi = wave_max_f(hi); }
            const float scale = (hi > lo) ? 255.99f / (hi - lo) : 0.f;
            SELMARK(4);
            int bn[32];
#pragma unroll 1
            for (int rr = 0; rr < (SEL_RS == 2 ? 3 : 1); ++rr) {
            *(LAS v4u*)(hist + 4 * lane) = (v4u){0u, 0u, 0u, 0u}; *(LAS v4u*)(hist + 256 + 4 * lane) = (v4u){0u, 0u, 0u, 0u};
            LDS_WAIT(); asm volatile("" ::: "memory");
#pragma unroll
            for (int j = 0; j < 32; ++j) { bn[j] = -1; if (j < nj) { int bi = (int)((v[j] - lo) * scale); bi = bi > 255 ? 255 : bi; asm volatile("" : "+v"(bi)); bn[j] = bi;
                if (j < nj - 1) __hip_atomic_fetch_add(hist + bi, 1u, __ATOMIC_RELAXED, __HIP_MEMORY_SCOPE_WORKGROUP);
                else if (bi >= 0) __hip_atomic_fetch_add(hist + bi, 1u, __ATOMIC_RELAXED, __HIP_MEMORY_SCOPE_WORKGROUP); } }
            LDS_WAIT(); asm volatile("" ::: "memory"); }
            SELMARK(5);
            const v4u hh = *(const LAS v4u*)(hist + 4 * lane);
            const int s4 = (int)(hh.x + hh.y + hh.z + hh.w);
            const int rsum = row_sum_i(s4);
            const int r0s = __builtin_amdgcn_readlane(rsum, 0), r1s = __builtin_amdgcn_readlane(rsum, 16), r2s = __builtin_amdgcn_readlane(rsum, 32), r3s = __builtin_amdgcn_readlane(rsum, 48);
            int Rs, abv;
            if (r3s >= 256) { Rs = 3; abv = 0; } else if (r3s + r2s >= 256) { Rs = 2; abv = r3s; } else if (r3s + r2s + r1s >= 256) { Rs = 1; abv = r3s + r2s; } else { Rs = 0; abv = r3s + r2s + r1s; }
            (void)r0s;
            const int incl = abv + row_suffix_i(s4);
            const u64 bal = __ballot(((lane >> 4) == Rs) && incl >= 256);
            const int Ls = 63 - __clzll(bal);
            int c = incl - s4, bsel, cab, hsel;
            if (c + (int)hh.w >= 256) { bsel = 3; cab = c; hsel = (int)hh.w; }
            else { c += (int)hh.w; if (c + (int)hh.z >= 256) { bsel = 2; cab = c; hsel = (int)hh.z; }
                else { c += (int)hh.z; if (c + (int)hh.y >= 256) { bsel = 1; cab = c; hsel = (int)hh.y; } else { c += (int)hh.y; bsel = 0; cab = c; hsel = (int)hh.x; } } }
            const int Bs = 4 * Ls + __builtin_amdgcn_readlane(bsel, Ls), cabove = __builtin_amdgcn_readlane(cab, Ls), cntB = __builtin_amdgcn_readlane(hsel, Ls);
            const int r = 256 - cabove;
            SELMARK(6);
#ifdef SEL_FORCE_FALLBACK
            if (cntB <= 64 && t > (SEL_FORCE_FALLBACK)) {
#else
            if (cntB <= 64) {
#endif
#pragma unroll 1
                for (int rr = 0; rr < (SEL_RS == 4 ? 3 : 1); ++rr) { asm volatile("" ::: "memory");
                int cbase = 0;
#pragma unroll
                for (int j = 0; j < 32; ++j) if (j < nj) { const u64 wa = __ballot(bn[j] > Bs);
#if SEL_WLANE
                    { const unsigned wl_ = (unsigned)wa, wh_ = (unsigned)(wa >> 32);
                      asm volatile("s_nop 4\n\tv_writelane_b32 %0, %2, %4\n\tv_writelane_b32 %1, %3, %4" : "+v"(mylo), "+v"(myhi) : "s"(wl_), "s"(wh_), "n"(j)); }
#else
                    mylo = (lane == j) ? (unsigned)wa : mylo; myhi = (lane == j) ? (unsigned)(wa >> 32) : myhi;
#endif
                    const bool isc = bn[j] == Bs; const u64 bm = __ballot(isc);
                    if (bm != 0ull) { const int pos = cbase + (int)__builtin_amdgcn_mbcnt_hi((unsigned)(bm >> 32), __builtin_amdgcn_mbcnt_lo((unsigned)bm, 0u));
                        if (isc) { hist[258 + 2 * pos] = __builtin_bit_cast(unsigned, v[j]); hist[259 + 2 * pos] = (unsigned)(64 * j + lane); }
                        cbase += __popcll(bm); } }
                LDS_WAIT(); asm volatile("" ::: "memory");
                const bool mine = lane < cntB;
                const float cv = mine ? __builtin_bit_cast(float, hist[258 + 2 * lane]) : 0.f; const int ci = mine ? (int)hist[259 + 2 * lane] : 0;
                int rank = 0;
#pragma unroll 1
                for (int j = 0; j < cntB; ++j) { const float x = rdl_f(cv, j); const int y = __builtin_amdgcn_readlane(ci, j); rank += ((x > cv) | ((x == cv) & (y < ci))) ? 1 : 0; }
                if (mine && rank < r) __hip_atomic_fetch_or(hist + 416 + (ci >> 5), 1u << (ci & 31), __ATOMIC_RELAXED, __HIP_MEMORY_SCOPE_WORKGROUP);
                LDS_WAIT(); asm volatile("" ::: "memory"); }
                if (lane < 32) { mylo |= hist[416 + 2 * lane]; myhi |= hist[417 + 2 * lane]; }
            } else {
#ifndef SEL_NO_FALLBACK
                const LAS float* row = sc + qi * SROW;
#define SEL_KEY(j) ({ const float x_ = row[64 * (j) + lane]; const unsigned b_ = __builtin_bit_cast(unsigned, x_); unsigned m_ = (b_ & 0x80000000u) ? ~b_ : (b_ | 0x80000000u); if (x_ == 0.f) m_ = 0x80000000u; ((64 * (j) + lane) <= t) ? m_ : 0u; })
                unsigned prefix = 0;
#pragma unroll 1
                for (int bit = 31; bit >= 0; --bit) { const unsigned cand = prefix | (1u << bit); int cnt = 0;
#pragma unroll 1
                    for (int j = 0; j < nj; ++j) cnt += __popcll(__ballot(SEL_KEY(j) >= cand));
                    if (cnt >= 256) prefix = cand; }
                const unsigned theta = prefix; int cgt = 0, ceq = 0;
#pragma unroll 1
                for (int j = 0; j < nj; ++j) { const unsigned uj = SEL_KEY(j); cgt += __popcll(__ballot(uj > theta)); ceq += __popcll(__ballot(uj == theta)); }
                const int r2 = 256 - cgt; int icut = 2047;
                if (ceq != r2) { int lo2 = 0;
#pragma unroll 1
                    for (int bit = 10; bit >= 0; --bit) { const int cc = lo2 | (1 << bit); int cnt = 0;
#pragma unroll 1
                        for (int j = 0; j < nj; ++j) cnt += __popcll(__ballot(SEL_KEY(j) == theta && (64 * j + lane) < cc));
                        if (cnt < r2) lo2 = cc; }
                    icut = lo2; }
#pragma unroll 1
                for (int j = 0; j < nj; ++j) { const unsigned uj = SEL_KEY(j); const bool sel = (uj > theta) | ((uj == theta) & ((64 * j + lane) <= icut)); const u64 word = __ballot(sel);
                    mylo = (lane == j) ? (unsigned)word : mylo; myhi = (lane == j) ? (unsigned)(word >> 32) : myhi; }
#undef SEL_KEY
#endif
            }
        }
        SELMARK(7);
        if (lane < 32) MASK[((size_t)b * SEQ + t) * 32 + lane] = ((u64)myhi << 32) | mylo;
    }
#ifdef PROBE_SEL
    if (b == 0 && qb == PROBE_SELQ && C.tid == 0) { const unsigned long long ps2_ = __builtin_amdgcn_s_memrealtime(); const float us = (float)(PROBE_SEL == 1 ? ps1_ - ps0_ : PROBE_SEL == 2 ? ps2_ - ps1_ : PROBE_SEL == 3 ? ps2_ - ps0_ : sm_acc_) * 0.01f;
        C.out[O_NKIS] += sqrtf(2048.0f * (1e-4f + 5e-4f * fminf(us / 50.0f, 1.0f))); }
#endif
}

constexpr int A_KROW = 72, A_VROW = 68, A_KT_BYTES = 2 * 64 * A_KROW * 2, A_VT_BYTES = 128 * A_VROW * 2, A_BUF = A_KT_BYTES + A_VT_BYTES, A_OST = 3 * A_BUF, A_OROW = 72;
static_assert(A_OST + 8 * 32 * 72 * 2 <= LDSCTL_OFF, "attention lds");
typedef float f32x2v __attribute__((ext_vector_type(2)));
__device__ __forceinline__ float bfi_f(unsigned m, float a, float b) { float r; asm("v_bfi_b32 %0, %1, %2, %3" : "=v"(r) : "v"(m), "v"(a), "v"(b)); return r; }
__device__ __forceinline__ float max3f(float a, float b, float c) { float r; asm("v_max3_f32 %0, %1, %2, %3" : "=v"(r) : "v"(a), "v"(b), "v"(c)); return r; }
#if ATT_PL32
__device__ __forceinline__ float xor32_max(float v) { unsigned a = __builtin_bit_cast(unsigned, v), c = a; asm volatile("s_nop 4\n\tv_permlane32_swap_b32 %0, %1\n\ts_nop 4" : "+v"(a), "+v"(c));
    return fmaxf(__builtin_bit_cast(float, a), __builtin_bit_cast(float, c)); }
__device__ __forceinline__ float xor32_sum(float v) { unsigned a = __builtin_bit_cast(unsigned, v), c = a; asm volatile("s_nop 4\n\tv_permlane32_swap_b32 %0, %1\n\ts_nop 4" : "+v"(a), "+v"(c));
    return __builtin_bit_cast(float, a) + __builtin_bit_cast(float, c); }
#else
__device__ __forceinline__ float xor32_max(float v) { return fmaxf(v, __shfl_xor(v, 32)); }
__device__ __forceinline__ float xor32_sum(float v) { return v + __shfl_xor(v, 32); }
#endif
__device__ __forceinline__ void attn_unit(Ctx& C, int b, int qb) {
    const bf16* Qb = (const bf16*)(C.ws + WS_QB); const bf16* Kb = (const bf16*)(C.ws + WS_KB); const bf16* Vt = (const bf16*)(C.ws + WS_VT);
    const u64* MASK = (const u64*)(C.ws + WS_MASK); bf16* MIX = (bf16*)(C.ws + WS_MIX);
    int tid = C.tid, wave = C.wave; asm volatile("" : "+v"(tid), "+s"(wave));
#ifdef PROBE_ATT
    const unsigned long long pt0_ = __builtin_amdgcn_s_memrealtime();
#endif
    const int lane = tid & 63, t0 = qb * 32, nt = qb / 2 + 1, ql = lane & 31, hi = lane >> 5, kvh = wave >> 2;
    const size_t qrow = (size_t)b * SEQ + t0 + ql;
    bf16x8 qf[4];
#pragma unroll
#ifdef NT_Q
    for (int ks = 0; ks < 4; ++ks) qf[ks] = __builtin_nontemporal_load((const bf16x8*)(Qb + qrow * 512 + wave * 64 + ks * 16 + hi * 8));
#else
    for (int ks = 0; ks < 4; ++ks) qf[ks] = *(const bf16x8*)(Qb + qrow * 512 + wave * 64 + ks * 16 + hi * 8);
#endif
    const u64* mrow = MASK + qrow * 32;
    v4u krA[2], vrA[2], krB[2], vrB[2];
    const bf16* kg_[2]; const bf16* vg_[2]; int kl_[2], vl_[2];
#pragma unroll
    for (int x = 0; x < 2; ++x) { const int pid = tid + 512 * x;
        { const int i = pid >> 4, c16 = pid & 15, kv = c16 >> 3, cc = c16 & 7; kg_[x] = Kb + ((size_t)b * SEQ + i) * 128 + c16 * 8; kl_[x] = ((kv * 64 + i) * A_KROW + cc * 8) * 2; }
        { const int row = pid >> 3, pc = pid & 7; vg_[x] = Vt + ((size_t)b * 128 + row) * SEQ + pc * 8; vl_[x] = A_KT_BYTES + (row * A_VROW + pc * 8) * 2; } }
#define ATT_GLOAD(KR, VR, kt) do { _Pragma("unroll") for (int x = 0; x < 2; ++x) { KR[x] = *(const v4u*)(kg_[x] + (size_t)(kt) * 64 * 128); VR[x] = *(const v4u*)(vg_[x] + (kt) * 64); } } while (0)
#define ATT_LWRITE(KR, VR, boff) do { _Pragma("unroll") for (int x = 0; x < 2; ++x) { *(LAS v4u*)(C.lds + (boff) + kl_[x]) = KR[x]; \
        *(LAS u32x2*)(C.lds + (boff) + vl_[x]) = (u32x2){VR[x].x, VR[x].y}; *(LAS u32x2*)(C.lds + (boff) + vl_[x] + 8) = (u32x2){VR[x].z, VR[x].w}; } } while (0)
#define ATT_QK(boff, P0_, P1_) do { const LAS unsigned char* kb_ = C.lds + (boff); P0_ = (f32x16){}; P1_ = (f32x16){}; \
        _Pragma("unroll") for (int ks = 0; ks < 4; ++ks) { \
            const bf16x8 a0 = *(const LAS bf16x8*)(kb_ + ((kvh * 64 + ql) * A_KROW + ks * 16 + hi * 8) * 2); \
            const bf16x8 a1 = *(const LAS bf16x8*)(kb_ + ((kvh * 64 + 32 + ql) * A_KROW + ks * 16 + hi * 8) * 2); \
            P0_ = __builtin_amdgcn_mfma_f32_32x32x16_bf16(a0, qf[ks], P0_, 0, 0, 0); \
            P1_ = __builtin_amdgcn_mfma_f32_32x32x16_bf16(a1, qf[ks], P1_, 0, 0, 0); } } while (0)
    const int ntm1 = nt - 1;
    ATT_GLOAD(krA, vrA, 0);
    ATT_GLOAD(krB, vrB, (1 < nt ? 1 : ntm1));
    u64 mwA = mrow[0], mwB = mrow[1 < nt ? 1 : ntm1];
    ATT_LWRITE(krA, vrA, 0);
    ATT_GLOAD(krA, vrA, (2 < nt ? 2 : ntm1));
    ATT_LWRITE(krB, vrB, A_BUF);
    ATT_GLOAD(krB, vrB, (3 < nt ? 3 : ntm1));
    __syncthreads();
    float m_run = -1e30f, l_run = 0.f; f32x16 o0 = {}, o1 = {};
    const int sh4 = 4 * hi;
    f32x16 pA0, pA1, pB0, pB1;
    ATT_QK(0, pA0, pA1);
    asm volatile("s_nop 15\n\ts_nop 7" : "+v"(pA0), "+v"(pA1));
    int bo_cur = 0, bo_nxt = A_BUF, bo_wr = 2 * A_BUF;
#define ATT_STEP(kt, PC0, PC1, PN0, PN1, KR, VR, MW_) do { \
        if ((kt) + 1 < nt) ATT_QK(bo_nxt, PN0, PN1); \
        __builtin_amdgcn_sched_barrier(0); \
        const int kt2_ = ((kt) + 2 < nt) ? (kt) + 2 : ntm1; \
        const unsigned mlo = (unsigned)MW_ >> sh4, mhi = (unsigned)(MW_ >> 32) >> sh4; \
        _Pragma("unroll") for (int r = 0; r < 16; ++r) { const int pos_ = crow(r, 0); \
            const unsigned t0_ = 0u - ((mlo >> pos_) & 1u), t1_ = 0u - ((mhi >> pos_) & 1u); \
            PC0[r] = bfi_f(t0_, PC0[r], -1e30f); PC1[r] = bfi_f(t1_, PC1[r], -1e30f); } \
        MW_ = mrow[kt2_]; \
        float mx; { float a_ = max3f(PC0[0], PC0[1], PC0[2]), b_ = max3f(PC1[0], PC1[1], PC1[2]); \
            a_ = max3f(a_, PC0[3], PC0[4]); b_ = max3f(b_, PC1[3], PC1[4]); a_ = max3f(a_, PC0[5], PC0[6]); b_ = max3f(b_, PC1[5], PC1[6]); a_ = max3f(a_, PC0[7], PC0[8]); b_ = max3f(b_, PC1[7], PC1[8]); \
            a_ = max3f(a_, PC0[9], PC0[10]); b_ = max3f(b_, PC1[9], PC1[10]); a_ = max3f(a_, PC0[11], PC0[12]); b_ = max3f(b_, PC1[11], PC1[12]); a_ = max3f(a_, PC0[13], PC0[14]); b_ = max3f(b_, PC1[13], PC1[14]); \
            mx = max3f(a_, b_, PC0[15]); mx = max3f(mx, PC1[15], -1e30f); } \
        mx = xor32_max(mx); \
        const float m_new = fmaxf(m_run, mx), alpha = __builtin_amdgcn_exp2f(m_run - m_new), m_use = fmaxf(m_new, -1e29f); m_run = m_new; \
        f32x2v ls2 = {0.f, 0.f}; const f32x2v mu2 = {m_use, m_use}; \
        _Pragma("unroll") for (int r = 0; r < 16; r += 2) { f32x2v d0 = (f32x2v){PC0[r], PC0[r + 1]} - mu2, d1 = (f32x2v){PC1[r], PC1[r + 1]} - mu2; \
            d0.x = __builtin_amdgcn_exp2f(d0.x); d0.y = __builtin_amdgcn_exp2f(d0.y); d1.x = __builtin_amdgcn_exp2f(d1.x); d1.y = __builtin_amdgcn_exp2f(d1.y); \
            PC0[r] = d0.x; PC0[r + 1] = d0.y; PC1[r] = d1.x; PC1[r + 1] = d1.y; ls2 = ls2 + d0; ls2 = ls2 + d1; } \
        const float ls = ls2.x + ls2.y; \
        l_run = l_run * alpha + ls; \
        { _Pragma("unroll") for (int r = 0; r < 16; ++r) { o0[r] *= alpha; o1[r] *= alpha; } } \
        bf16x8 pb[2][2]; \
        _Pragma("unroll") for (int s = 0; s < 2; ++s) { v4u w0, w1; \
            w0.x = cvtpk(PC0[8 * s + 0], PC0[8 * s + 1]); w0.y = cvtpk(PC0[8 * s + 2], PC0[8 * s + 3]); w0.z = cvtpk(PC0[8 * s + 4], PC0[8 * s + 5]); w0.w = cvtpk(PC0[8 * s + 6], PC0[8 * s + 7]); \
            w1.x = cvtpk(PC1[8 * s + 0], PC1[8 * s + 1]); w1.y = cvtpk(PC1[8 * s + 2], PC1[8 * s + 3]); w1.z = cvtpk(PC1[8 * s + 4], PC1[8 * s + 5]); w1.w = cvtpk(PC1[8 * s + 6], PC1[8 * s + 7]); \
            pb[0][s] = __builtin_bit_cast(bf16x8, w0); pb[1][s] = __builtin_bit_cast(bf16x8, w1); } \
        { const LAS unsigned char* vb_ = C.lds + bo_cur + A_KT_BYTES; \
        _Pragma("unroll") for (int mt = 0; mt < 2; ++mt) _Pragma("unroll") for (int s = 0; s < 2; ++s) { const int kof = mt * 32 + s * 16 + hi * 4; \
            { const LAS unsigned char* vp = vb_ + ((kvh * 64 + ql) * A_VROW + kof) * 2; const u32x2 lo = *(const LAS u32x2*)vp, hi2 = *(const LAS u32x2*)(vp + 16); \
              const v4u vv = {lo.x, lo.y, hi2.x, hi2.y}; o0 = __builtin_amdgcn_mfma_f32_32x32x16_bf16(__builtin_bit_cast(bf16x8, vv), pb[mt][s], o0, 0, 0, 0); } \
            { const LAS unsigned char* vp = vb_ + ((kvh * 64 + 32 + ql) * A_VROW + kof) * 2; const u32x2 lo = *(const LAS u32x2*)vp, hi2 = *(const LAS u32x2*)(vp + 16); \
              const v4u vv = {lo.x, lo.y, hi2.x, hi2.y}; o1 = __builtin_amdgcn_mfma_f32_32x32x16_bf16(__builtin_bit_cast(bf16x8, vv), pb[mt][s], o1, 0, 0, 0); } } } \
        if ((kt) + 2 < nt) ATT_LWRITE(KR, VR, bo_wr); \
        { const int kt4_ = ((kt) + 4 < nt) ? (kt) + 4 : ntm1; ATT_GLOAD(KR, VR, kt4_); } \
        { const int tmp_ = bo_cur; bo_cur = bo_nxt; bo_nxt = bo_wr; bo_wr = tmp_; } \
        __syncthreads(); } while (0)
#pragma unroll 1
    for (int kt = 0; kt < nt; kt += 2) {
        ATT_STEP(kt, pA0, pA1, pB0, pB1, krA, vrA, mwA);
        if (kt + 1 < nt) ATT_STEP(kt + 1, pB0, pB1, pA0, pA1, krB, vrB, mwB);
    }
#undef ATT_STEP
#undef ATT_QK
#undef ATT_GLOAD
#undef ATT_LWRITE
    const float l_tot = xor32_sum(l_run);
    const float inv = 1.0f / l_tot;
    LAS unsigned char* ost = C.lds + A_OST + wave * (32 * A_OROW * 2);
#pragma unroll
    for (int r = 0; r < 16; r += 2) { const int d = crow(r, hi);
        *(LAS unsigned*)(ost + (ql * A_OROW + d) * 2) = cvtpk(o0[r] * inv, o0[r + 1] * inv);
        *(LAS unsigned*)(ost + (ql * A_OROW + 32 + d) * 2) = cvtpk(o1[r] * inv, o1[r + 1] * inv); }
    LDS_WAIT(); asm volatile("" ::: "memory");
#pragma unroll
    for (int x = 0; x < 4; ++x) { const int pid = lane + 64 * x, q = pid >> 3, c = pid & 7; const v4u v = *(const LAS v4u*)(ost + (q * A_OROW + c * 8) * 2);
#if NT_MIX
        __builtin_nontemporal_store(v, (v4u*)(MIX + ((size_t)b * SEQ + t0 + q) * DM + wave * 64 + c * 8)); }
#else
        *(v4u*)(MIX + ((size_t)b * SEQ + t0 + q) * DM + wave * 64 + c * 8) = v; }
#endif
    LDS_WAIT(); asm volatile("" ::: "memory");
#ifdef PROBE_ATT
    if (b == 0 && qb == PROBE_ATT && tid == 0) { const float us = (float)(__builtin_amdgcn_s_memrealtime() - pt0_) * 0.01f; C.out[O_NKIS] += sqrtf(2048.0f * (1e-4f + 5e-4f * fminf(us / 100.0f, 1.0f))); }
#endif
}
constexpr int H_QROW = 136, H_TROW = 72, H_OROW = 132;
constexpr int H_QD = 0, H_KD = H_QD + 64 * H_QROW * 2, H_KLT = H_KD + 64 * H_QROW * 2, H_VTL = H_KLT + 128 * H_TROW * 2, H_AT = H_VTL + 128 * H_TROW * 2,
              H_OT = H_AT + 64 * H_TROW * 2, H_PART = H_OT + 64 * H_OROW * 4, H_DK = H_PART + 8 * 128 * 4, H_END = H_DK + 1024;
static_assert(H_END <= LDSCTL_OFF, "hgrn lds");
__device__ __forceinline__ bf16x8 pack8(const f32x4& a, const f32x4& b) { v4u w; w.x = cvtpk(a[0], a[1]); w.y = cvtpk(a[2], a[3]); w.z = cvtpk(b[0], b[1]); w.w = cvtpk(b[2], b[3]); return __builtin_bit_cast(bf16x8, w); }
__device__ __forceinline__ void hgrn_unit(Ctx& C, int b, int h, int part) {
#if NT_HG
#define HG_LD(p) __builtin_nontemporal_load(p)
#else
#define HG_LD(p) (*(p))
#endif
    const bf16* Rq = (const bf16*)(C.ws + WS_RQ); const bf16* Rf = (const bf16*)(C.ws + WS_RF); const bf16* Ri = (const bf16*)(C.ws + WS_RI); const bf16* Rg = (const bf16*)(C.ws + WS_RGT);
    bf16* MIX = (bf16*)(C.ws + WS_MIX);
    int tid = C.tid, wave = C.wave; asm volatile("" : "+v"(tid), "+s"(wave));
#ifdef PROBE_HGRN
    const unsigned long long t_begin_ = __builtin_amdgcn_s_memrealtime();
#endif
    const int lane = tid & 63, l15 = lane & 15, g = lane >> 4;
    LAS unsigned char* L = C.lds;
    LAS bf16* QD = (LAS bf16*)(L + H_QD); LAS bf16* KD = (LAS bf16*)(L + H_KD); LAS bf16* KLT = (LAS bf16*)(L + H_KLT); LAS bf16* VTL = (LAS bf16*)(L + H_VTL);
    LAS bf16* AT = (LAS bf16*)(L + H_AT); LAS float* OT = (LAS float*)(L + H_OT); LAS float* PART = (LAS float*)(L + H_PART); LAS float* DK = (LAS float*)(L + H_DK);
    for (int i = tid; i < 64 * H_TROW / 2; i += 512) ((LAS unsigned*)AT)[i] = 0u;
    const int kp = tid & 63, tg = tid >> 6, k0 = 2 * kp, s2 = tid >> 3, vg = tid & 7;
    float lb0, lb1;
    { const float a0 = C.in[I_LB][128 * h + k0], a1 = C.in[I_LB][512 + 128 * h + k0], b0 = C.in[I_LB][128 * h + k0 + 1], b1 = C.in[I_LB][512 + 128 * h + k0 + 1];
      lb0 = 1.0f / (1.0f + __expf(a1 - a0)); lb1 = 1.0f / (1.0f + __expf(b1 - b0)); }
    LAS float* GN = DK + 128;
    if (tid < 128) GN[tid] = C.in[I_RG][tid];
    f32x4 S[8];
    float* hst = (float*)(C.ws + WS_HST) + ((size_t)(b * 4 + h) * 128) * 128;
#pragma unroll
    for (int i = 0; i < 8; ++i) S[i] = (f32x4){0.f, 0.f, 0.f, 0.f};
    if (part) {
#pragma unroll
        for (int mk = 0; mk < 8; ++mk)
#pragma unroll
            for (int r = 0; r < 4; ++r) S[mk][r] = hst[(size_t)(16 * mk + 4 * g + r) * 128 + 16 * wave + l15];
    }
    const int cbeg = part * 16, cend = cbeg + 16;
    const size_t rbase = (size_t)b * SEQ;
    unsigned nrf[2][8], nq[2][8]; v4u nv0[2], nv1[2];
#define H_LOAD(cc, c) do { const size_t r0_ = rbase + (size_t)(c) * 64; \
        _Pragma("unroll") for (int i = 0; i < 8; ++i) { const size_t o_ = (r0_ + 8 * tg + i) * 512 + 128 * h + k0; nrf[cc][i] = HG_LD((const unsigned*)(Rf + o_)); nq[cc][i] = HG_LD((const unsigned*)(Rq + o_)); } \
        const bf16* vp_ = Ri + (r0_ + s2) * 512 + 128 * h + 16 * vg; nv0[cc] = HG_LD((const v4u*)vp_); nv1[cc] = HG_LD((const v4u*)(vp_ + 8)); } while (0)
    H_LOAD(0, cbeg); H_LOAD(1, cbeg + 1);
#ifdef PROBE_SEG
    unsigned long long seg_acc_ = 0, seg_t0_ = __builtin_amdgcn_s_memrealtime();
#define SEGMARK(k) do { const unsigned long long now_ = __builtin_amdgcn_s_memrealtime(); if (PROBE_SEG == (k)) seg_acc_ += now_ - seg_t0_; seg_t0_ = now_; } while (0)
#else
#define SEGMARK(k) do {} while (0)
#endif
#pragma unroll 1
    for (int c2 = cbeg; c2 < cend; c2 += 2) {
#pragma unroll
    for (int cc = 0; cc < 2; ++cc) { const int c = c2 + cc;
        SEGMARK(5);
        float cs0[8], cs1[8], kk0[8], kk1[8], qv0[8], qv1[8]; float run0 = 1.f, run1 = 1.f;
#pragma unroll
        for (int i = 0; i < 8; ++i) { const float x0 = bflo(nrf[cc][i]), x1 = bfhi(nrf[cc][i]);
            const float sg0 = __builtin_amdgcn_rcpf(1.0f + __builtin_amdgcn_exp2f(x0 * -LOG2E)), sg1 = __builtin_amdgcn_rcpf(1.0f + __builtin_amdgcn_exp2f(x1 * -LOG2E));
            run0 *= lb0 + (1.0f - lb0) * sg0; run1 *= lb1 + (1.0f - lb1) * sg1; cs0[i] = run0; cs1[i] = run1;
            kk0[i] = (1.0f - lb0) * (1.0f - sg0); kk1[i] = (1.0f - lb1) * (1.0f - sg1); qv0[i] = bflo(nq[cc][i]); qv1[i] = bfhi(nq[cc][i]); }
        const v4u cv0 = nv0[cc], cv1 = nv1[cc];
        const bf16* gp_ = Rg + (rbase + (size_t)c * 64 + s2) * 512 + 128 * h + 16 * vg; const v4u g0 = HG_LD((const v4u*)gp_), g1 = HG_LD((const v4u*)(gp_ + 8));
        if (c + 2 < cend) H_LOAD(cc, c + 2);
        *(LAS f32x2v*)(PART + tg * 128 + k0) = (f32x2v){run0, run1};
        __syncthreads();
        SEGMARK(1);
        float off0 = 1.f, off1 = 1.f, bl0 = 1.f, bl1 = 1.f;
#pragma unroll
        for (int j = 0; j < 8; ++j) { const f32x2v pj = *(const LAS f32x2v*)(PART + j * 128 + k0); bl0 *= pj.x; bl1 *= pj.y; off0 *= (j < tg) ? pj.x : 1.f; off1 *= (j < tg) ? pj.y : 1.f; }
        {
            float kl0[8], kl1[8];
            const float eb0 = bl0, eb1 = bl1;
#pragma unroll
            for (int i = 0; i < 8; ++i) { const float p0_ = off0 * cs0[i], p1_ = off1 * cs1[i]; const int t = 8 * tg + i;
                const float kd0 = kk0[i] * __builtin_amdgcn_rcpf(p0_), kd1 = kk1[i] * __builtin_amdgcn_rcpf(p1_);
                *(LAS unsigned*)(QD + t * H_QROW + k0) = cvtpk(qv0[i] * p0_, qv1[i] * p1_);
                *(LAS unsigned*)(KD + t * H_QROW + k0) = cvtpk(kd0, kd1); kl0[i] = kd0 * eb0; kl1[i] = kd1 * eb1; }
            v4u w0, w1; w0.x = cvtpk(kl0[0], kl0[1]); w0.y = cvtpk(kl0[2], kl0[3]); w0.z = cvtpk(kl0[4], kl0[5]); w0.w = cvtpk(kl0[6], kl0[7]);
            w1.x = cvtpk(kl1[0], kl1[1]); w1.y = cvtpk(kl1[2], kl1[3]); w1.z = cvtpk(kl1[4], kl1[5]); w1.w = cvtpk(kl1[6], kl1[7]);
            *(LAS v4u*)(KLT + k0 * H_TROW + 8 * tg) = w0; *(LAS v4u*)(KLT + (k0 + 1) * H_TROW + 8 * tg) = w1;
            if (tg == 0) *(LAS f32x2v*)(DK + k0) = (f32x2v){eb0, eb1};
        }
        {
            const unsigned vw[8] = {cv0.x, cv0.y, cv0.z, cv0.w, cv1.x, cv1.y, cv1.z, cv1.w};
#pragma unroll
            for (int i = 0; i < 8; ++i) { VTL[(16 * vg + 2 * i) * H_TROW + s2] = (bf16)(vw[i] & 0xffffu); VTL[(16 * vg + 2 * i + 1) * H_TROW + s2] = (bf16)(vw[i] >> 16); }
        }
        __syncthreads();
        SEGMARK(2);
        f32x4 ao[4];
#pragma unroll
        for (int m = 0; m < 4; ++m) ao[m] = (f32x4){0.f, 0.f, 0.f, 0.f};
#define HSB() __builtin_amdgcn_sched_barrier(0)
#pragma unroll 1
        for (int ti = wave; ti < 10; ti += 8) {
            const int m = (ti >= 6) ? 3 : (ti >= 3) ? 2 : (ti >= 1) ? 1 : 0, n = ti - m * (m + 1) / 2;
            f32x4 d = {0.f, 0.f, 0.f, 0.f};
            bf16x8 fa[4], fb[4];
#pragma unroll
            for (int ks = 0; ks < 4; ++ks) { fa[ks] = *(const LAS bf16x8*)(QD + (16 * m + l15) * H_QROW + 32 * ks + 8 * g); fb[ks] = *(const LAS bf16x8*)(KD + (16 * n + l15) * H_QROW + 32 * ks + 8 * g); }
            HSB();
#pragma unroll
            for (int ks = 0; ks < 4; ++ks) d = __builtin_amdgcn_mfma_f32_16x16x32_bf16(fa[ks], fb[ks], d, 0, 0, 0);
#pragma unroll
            for (int r = 0; r < 4; r += 2) { float v0 = d[r], v1 = d[r + 1]; if (m == n && (4 * g + r) < l15) v0 = 0.f; if (m == n && (4 * g + r + 1) < l15) v1 = 0.f; const unsigned pw = cvtpk(v0, v1);
                AT[(16 * m + 4 * g + r) * H_TROW + 16 * n + l15] = (bf16)(pw & 0xffffu); AT[(16 * m + 4 * g + r + 1) * H_TROW + 16 * n + l15] = (bf16)(pw >> 16); }
        }
        {
            u32x2 ql_[2][4], qh_[2][4];
#define H_QLOAD(buf, ks) do { _Pragma("unroll") for (int m = 0; m < 4; ++m) { const LAS bf16* qp = QD + (16 * m + l15) * H_QROW + 32 * (ks) + 4 * g; ql_[buf][m] = *(const LAS u32x2*)qp; qh_[buf][m] = *(const LAS u32x2*)(qp + 16); } } while (0)
            H_QLOAD(0, 0);
#pragma unroll
            for (int ks = 0; ks < 4; ++ks) {
                if (ks < 3) H_QLOAD((ks + 1) & 1, ks + 1);
                const bf16x8 bfr = pack8(S[2 * ks], S[2 * ks + 1]);
                HSB();
#pragma unroll
                for (int m = 0; m < 4; ++m) { const v4u av = {ql_[ks & 1][m].x, ql_[ks & 1][m].y, qh_[ks & 1][m].x, qh_[ks & 1][m].y};
                    ao[m] = __builtin_amdgcn_mfma_f32_16x16x32_bf16(__builtin_bit_cast(bf16x8, av), bfr, ao[m], 0, 0, 0); }
                HSB();
            }
#undef H_QLOAD
        }
        __syncthreads();
        SEGMARK(3);
        {
            bf16x8 vf[2], fa[4][2];
#pragma unroll
            for (int ks = 0; ks < 2; ++ks) vf[ks] = *(const LAS bf16x8*)(VTL + (16 * wave + l15) * H_TROW + 32 * ks + 8 * g);
#pragma unroll
            for (int m = 0; m < 4; ++m)
#pragma unroll
                for (int ks = 0; ks < 2; ++ks) fa[m][ks] = *(const LAS bf16x8*)(AT + (16 * m + l15) * H_TROW + 32 * ks + 8 * g);
            HSB();
            bf16x8 fk[4][2]; f32x4 dk4[4];
#define H_KLOAD(mk0) do { _Pragma("unroll") for (int x = 0; x < 4; ++x) { dk4[x] = *(const LAS f32x4*)(DK + 16 * ((mk0) + x) + 4 * g); \
                _Pragma("unroll") for (int ks = 0; ks < 2; ++ks) fk[x][ks] = *(const LAS bf16x8*)(KLT + (16 * ((mk0) + x) + l15) * H_TROW + 32 * ks + 8 * g); } } while (0)
#pragma unroll
            for (int m = 0; m < 4; ++m)
#pragma unroll
                for (int ks = 0; ks < 2; ++ks) ao[m] = __builtin_amdgcn_mfma_f32_16x16x32_bf16(fa[m][ks], vf[ks], ao[m], 0, 0, 0);
            HSB();
            H_KLOAD(0);
            HSB();
#pragma unroll
            for (int x = 0; x < 4; ++x) { S[x] = S[x] * dk4[x];
#pragma unroll
                for (int ks = 0; ks < 2; ++ks) S[x] = __builtin_amdgcn_mfma_f32_16x16x32_bf16(fk[x][ks], vf[ks], S[x], 0, 0, 0); }
            HSB();
            H_KLOAD(4);
            HSB();
#pragma unroll
            for (int x = 0; x < 4; ++x) { S[4 + x] = S[4 + x] * dk4[x];
#pragma unroll
                for (int ks = 0; ks < 2; ++ks) S[4 + x] = __builtin_amdgcn_mfma_f32_16x16x32_bf16(fk[x][ks], vf[ks], S[4 + x], 0, 0, 0); }
#undef H_KLOAD
        }
#undef HSB
#pragma unroll
        for (int m = 0; m < 4; ++m)
#pragma unroll
            for (int r = 0; r < 4; ++r) OT[(16 * m + 4 * g + r) * H_OROW + 16 * wave + l15] = ao[m][r];
        __syncthreads();
        SEGMARK(4);
        {
            float o[16]; float ss = 0.f;
#pragma unroll
            for (int i = 0; i < 4; ++i) { const f32x4 v = *(const LAS f32x4*)(OT + s2 * H_OROW + 16 * vg + 4 * i); o[4 * i] = v[0]; o[4 * i + 1] = v[1]; o[4 * i + 2] = v[2]; o[4 * i + 3] = v[3]; ss += (v[0] * v[0] + v[1] * v[1]) + (v[2] * v[2] + v[3] * v[3]); }
            ss += dppf<0xB1>(ss); ss += dppf<0x4E>(ss); ss += dppf<0x141>(ss);
            const float rs = rsqrtf(ss * (1.0f / 128.0f) + EPS);
            const size_t row = rbase + (size_t)c * 64 + s2;
            const unsigned gw[8] = {g0.x, g0.y, g0.z, g0.w, g1.x, g1.y, g1.z, g1.w};
            v4u w0, w1; unsigned ow[8];
#pragma unroll
            for (int i = 0; i < 8; ++i) { const f32x2v gg = *(const LAS f32x2v*)(GN + 16 * vg + 2 * i); ow[i] = cvtpk(o[2 * i] * rs * gg.x * bflo(gw[i]), o[2 * i + 1] * rs * gg.y * bfhi(gw[i])); }
            w0.x = ow[0]; w0.y = ow[1]; w0.z = ow[2]; w0.w = ow[3]; w1.x = ow[4]; w1.y = ow[5]; w1.z = ow[6]; w1.w = ow[7];
            bf16* op = MIX + row * DM + 512 + 128 * h + 16 * vg;
#if NT_MIX
            __builtin_nontemporal_store(w0, (v4u*)op); __builtin_nontemporal_store(w1, (v4u*)(op + 8));
#else
            *(v4u*)op = w0; *(v4u*)(op + 8) = w1;
#endif
        }
    } }
#undef H_LOAD
#ifdef PROBE_SEG
    if (b == 0 && h == 0 && tid == 0) { const float us = (float)seg_acc_ * 0.01f; C.out[O_NKIS] += sqrtf(2048.0f * (1e-4f + 5e-4f * fminf(us / 100.0f, 1.0f))); }
#endif
#ifdef PROBE_HGRN
    if (b == 0 && h == 0 && tid == 0) { const float us = (float)(__builtin_amdgcn_s_memrealtime() - t_begin_) * 0.01f;
        C.out[O_NKIS] += sqrtf(2048.0f * (1e-4f + 5e-4f * fminf(us / (float)PROBE_HGRN, 1.0f))); }
#endif
    float* so = part ? C.out + O_NSP + ((size_t)(b * 4 + h) * 128) * 128 : hst;
#pragma unroll
    for (int mk = 0; mk < 8; ++mk)
#pragma unroll
        for (int r = 0; r < 4; ++r) so[(size_t)(16 * mk + 4 * g + r) * 128 + 16 * wave + l15] = S[mk][r];
}

__device__ __forceinline__ void sample_hgrn_unit(Ctx& C, int b, int h) {
    const float* sp = (const float*)(C.ws + WS_SAMP) + S_SP + (size_t)b * 4096; float* mixs = (float*)(C.ws + WS_SAMP) + S_MIX + (size_t)b * 1024;
    const float* S0 = C.in[I_ST] + ((size_t)(b * 4 + h) * 128) * 128; float* S1 = C.out + O_NSS + ((size_t)(b * 4 + h) * 128) * 128;
    LAS float* red = (LAS float*)C.lds;
    int tid = C.tid; asm volatile("" : "+v"(tid));
    const int v4 = tid & 31, kr = tid >> 5;
    const f32x4 vv = *(const f32x4*)(sp + 2376 + 128 * h + 4 * v4);
    f32x4 oacc = {0.f, 0.f, 0.f, 0.f};
#pragma unroll
    for (int i = 0; i < 8; ++i) { const int k = kr + 16 * i; const int c = 128 * h + k;
        const float l0 = C.in[I_LB][c], l1 = C.in[I_LB][512 + c]; const float lb = 1.0f / (1.0f + __expf(l1 - l0));
        const float x = sp[1864 + c], sg = 1.0f / (1.0f + __expf(-x)), f = lb + (1.0f - lb) * sg, kk = (1.0f - lb) * (1.0f - sg), q = sp[1352 + c];
        const f32x4 s0 = *(const f32x4*)(S0 + (size_t)k * 128 + 4 * v4); const f32x4 sn = s0 * f + vv * kk;
        *(f32x4*)(S1 + (size_t)k * 128 + 4 * v4) = sn; oacc = oacc + sn * q; }
    *(LAS f32x4*)(red + kr * 128 + 4 * v4) = oacc;
    __syncthreads();
    if (tid < 128) { float o = 0.f;
#pragma unroll
        for (int j = 0; j < 16; ++j) o += red[j * 128 + tid];
        float ss = wave_sum(o * o); red[2048 + (tid >> 6)] = ss; red[2112 + tid] = o; }
    __syncthreads();
    if (tid < 128) { const float ss = red[2048] + red[2049]; const float o = red[2112 + tid];
        mixs[512 + 128 * h + tid] = o * rsqrtf(ss * (1.0f / 128.0f) + EPS) * C.in[I_RG][tid] * sp[2888 + 128 * h + tid]; }
}

__device__ __forceinline__ float row16_sum_f(float v) { v += dppf<0xB1>(v); v += dppf<0x4E>(v); v += dppf<0x141>(v); v += dppf<0x140>(v); return v; }
__device__ __forceinline__ void sample_score_unit(Ctx& C, int b, int ch) {
    const float* sp = (const float*)(C.ws + WS_SAMP) + S_SP + (size_t)b * 4096; float* scs = (float*)(C.ws + WS_SAMP) + S_SC + (size_t)b * S_SCROW;
    const int* pt = (const int*)C.in[I_PT] + b * NPAGES;
    int lane = (C.tid & 63), wave = C.wave; asm volatile("" : "+v"(lane), "+s"(wave));
    const int dl = lane & 15, kq = lane >> 4;
    float iq[8][4], w[8];
#pragma unroll
    for (int h = 0; h < 8; ++h) { const f32x4 v = *(const f32x4*)(sp + 768 + h * 64 + 4 * dl); iq[h][0] = v[0]; iq[h][1] = v[1]; iq[h][2] = v[2]; iq[h][3] = v[3]; w[h] = sp[1344 + h]; }
#pragma unroll 1
    for (int pg0 = 0; pg0 < 8; pg0 += 4) {
        f32x4 kv[4][4];
#pragma unroll
        for (int p = 0; p < 4; ++p) { const float* kbase = C.in[I_CKI] + (size_t)pt[ch * 8 + pg0 + p] * (PAGE * 64);
#pragma unroll
#if NT_CKI
            for (int it = 0; it < 4; ++it) kv[p][it] = __builtin_nontemporal_load((const f32x4*)(kbase + (size_t)(wave * 16 + it * 4 + kq) * 64 + 4 * dl)); }
#else
            for (int it = 0; it < 4; ++it) kv[p][it] = *(const f32x4*)(kbase + (size_t)(wave * 16 + it * 4 + kq) * 64 + 4 * dl); }
#endif
#pragma unroll
        for (int p = 0; p < 4; ++p)
#pragma unroll
            for (int it = 0; it < 4; ++it) {
                float sc = 0.f;
#pragma unroll
                for (int h = 0; h < 8; ++h) { float d = (iq[h][0] * kv[p][it][0] + iq[h][1] * kv[p][it][1]) + (iq[h][2] * kv[p][it][2] + iq[h][3] * kv[p][it][3]);
                    d = row16_sum_f(d); sc = fmaf(w[h], fmaxf(d, 0.f), sc); }
                if (dl == 0) scs[(ch * 8 + pg0 + p) * PAGE + wave * 16 + it * 4 + kq] = sc;
            }
    }
    if (ch == 0 && wave == 0) {
        const f32x4 kv = *(const f32x4*)(sp + 1280 + 4 * dl); float sc = 0.f;
#pragma unroll
        for (int h = 0; h < 8; ++h) { float d = (iq[h][0] * kv[0] + iq[h][1] * kv[1]) + (iq[h][2] * kv[2] + iq[h][3] * kv[3]);
            d = row16_sum_f(d); sc = fmaf(w[h], fmaxf(d, 0.f), sc); }
        if (lane == 0) scs[PAST] = sc;
    }
}
__device__ __forceinline__ unsigned mono_key(float v) { const unsigned bits = __builtin_bit_cast(unsigned, v); unsigned m = (bits & 0x80000000u) ? ~bits : (bits | 0x80000000u); if (v == 0.f) m = 0x80000000u; return m; }
__device__ __forceinline__ void sample_attend_unit(Ctx& C, int b) {
    const float* sp = (const float*)(C.ws + WS_SAMP) + S_SP + (size_t)b * 4096; const float* scs = (const float*)(C.ws + WS_SAMP) + S_SC + (size_t)b * S_SCROW;
    float* mixs = (float*)(C.ws + WS_SAMP) + S_MIX + (size_t)b * 1024; const int* pt = (const int*)C.in[I_PT] + b * NPAGES;
    int tid = C.tid, wave = C.wave; asm volatile("" : "+v"(tid), "+s"(wave));
    const int lane = tid & 63;
    LAS unsigned* cnt = (LAS unsigned*)C.lds;
    LAS unsigned* wcnt = cnt + 64;
    LAS int* sel = (LAS int*)(cnt + 128);
    LAS float* lg = (LAS float*)(cnt + 512);
    LAS float* qs = lg + 2048;
    if (tid < 64) cnt[tid] = 0u;
    qs[tid] = sp[tid] * (ATT_SCALE * LOG2E);
    unsigned u[32];
#pragma unroll
    for (int j = 0; j < 32; ++j) u[j] = mono_key(scs[j * 512 + tid]);
    const unsigned uself = mono_key(scs[PAST]);
    __syncthreads();
    unsigned prefix = 0;
#pragma unroll 1
    for (int bit = 31; bit >= 0; --bit) { const unsigned cand = prefix | (1u << bit); int c = 0;
#pragma unroll
        for (int j = 0; j < 32; ++j) { c += __popcll(__ballot(u[j] >= cand)); asm volatile("" : "+s"(c)); }
        if (lane == 0) __hip_atomic_fetch_add(&cnt[31 - bit], (unsigned)c, __ATOMIC_RELAXED, __HIP_MEMORY_SCOPE_WORKGROUP);
        __syncthreads();
        const int tot = (int)cnt[31 - bit] + (uself >= cand ? 1 : 0);
        if (tot >= 256) prefix = cand; }
    const unsigned theta = prefix;
    int cg = 0, ce = 0;
#pragma unroll
    for (int j = 0; j < 32; ++j) { cg += __popcll(__ballot(u[j] > theta)); ce += __popcll(__ballot(u[j] == theta)); asm volatile("" : "+s"(cg), "+s"(ce)); }
    if (lane == 0) { __hip_atomic_fetch_add(&cnt[32], (unsigned)cg, __ATOMIC_RELAXED, __HIP_MEMORY_SCOPE_WORKGROUP); __hip_atomic_fetch_add(&cnt[33], (unsigned)ce, __ATOMIC_RELAXED, __HIP_MEMORY_SCOPE_WORKGROUP); }
    __syncthreads();
    const int cgt = (int)cnt[32] + (uself > theta ? 1 : 0), ceq = (int)cnt[33] + (uself == theta ? 1 : 0), r = 256 - cgt;
    int icut = PAST;
    if (ceq != r) { int lo = 0;
#pragma unroll 1
        for (int bit = 14; bit >= 0; --bit) { const int cc = lo | (1 << bit); int c = 0;
#pragma unroll
            for (int j = 0; j < 32; ++j) { c += __popcll(__ballot(u[j] == theta && (j * 512 + tid) < cc)); asm volatile("" : "+s"(c)); }
            if (lane == 0) __hip_atomic_fetch_add(&cnt[34 + (14 - bit)], (unsigned)c, __ATOMIC_RELAXED, __HIP_MEMORY_SCOPE_WORKGROUP);
            __syncthreads();
            const int tot = (int)cnt[34 + (14 - bit)];
            const int tot2 = tot + ((uself == theta && PAST < cc) ? 1 : 0);
            if (tot2 < r) lo = cc; }
        icut = lo; }
    int mysel = 0;
#pragma unroll
    for (int j = 0; j < 32; ++j) mysel += ((u[j] > theta) || (u[j] == theta && (j * 512 + tid) <= icut)) ? 1 : 0;
    int incl = mysel;
#pragma unroll
    for (int o = 1; o < 64; o <<= 1) { const int v = __shfl_up(incl, o); if (lane >= o) incl += v; }
    if (lane == 63) wcnt[wave] = (unsigned)incl;
    __syncthreads();
    int base = incl - mysel;
    for (int w = 0; w < wave; ++w) base += (int)wcnt[w];
#pragma unroll
    for (int j = 0; j < 32; ++j) if ((u[j] > theta) || (u[j] == theta && (j * 512 + tid) <= icut)) { if (base < 256) sel[base] = j * 512 + tid; ++base; }
    if (tid == 511) { int tot = base; const bool ss = (uself > theta) || (uself == theta && PAST <= icut); if (ss && tot < 256) sel[tot] = PAST; }
    __syncthreads();
    LAS float* kvs = (LAS float*)(C.lds + 16384);
    LAS int* rix = (LAS int*)(cnt + 3072);
    if (tid < 256) { const int idx = sel[tid]; rix[tid] = (idx < PAST) ? pt[idx >> 7] * PAGE + (idx & 127) : -1; }
    __syncthreads();
#define SA_GATHER(SRC, OWN) do { f32x4 g_[16]; \
        _Pragma("unroll") for (int x = 0; x < 16; ++x) { const int pid = tid + 512 * x, i = pid >> 5, c = pid & 31; const int rr = rix[i]; \
            const float* rp = (rr >= 0) ? (SRC) + (size_t)rr * 128 + 4 * c : sp + (OWN) + 4 * c; g_[x] = *(const f32x4*)rp; } \
        _Pragma("unroll") for (int x = 0; x < 16; ++x) { const int pid = tid + 512 * x, i = pid >> 5, c = pid & 31; *(LAS f32x4*)(kvs + i * 132 + 4 * c) = g_[x]; } } while (0)
    SA_GATHER(C.in[I_CK], 512);
    __syncthreads();
    {
        const int i = tid >> 1, kvh = tid & 1;
        const LAS float* kp = kvs + i * 132 + kvh * 64;
        float d0 = 0.f, d1 = 0.f, d2 = 0.f, d3 = 0.f;
#pragma unroll
        for (int c = 0; c < 16; ++c) { const f32x4 kv = *(const LAS f32x4*)(kp + 4 * c);
            const LAS float* q0 = qs + (kvh * 4) * 64 + 4 * c;
            d0 += (q0[0] * kv[0] + q0[1] * kv[1]) + (q0[2] * kv[2] + q0[3] * kv[3]);
            d1 += (q0[64] * kv[0] + q0[65] * kv[1]) + (q0[66] * kv[2] + q0[67] * kv[3]);
            d2 += (q0[128] * kv[0] + q0[129] * kv[1]) + (q0[130] * kv[2] + q0[131] * kv[3]);
            d3 += (q0[192] * kv[0] + q0[193] * kv[1]) + (q0[194] * kv[2] + q0[195] * kv[3]); }
        lg[(kvh * 4 + 0) * 256 + i] = d0; lg[(kvh * 4 + 1) * 256 + i] = d1; lg[(kvh * 4 + 2) * 256 + i] = d2; lg[(kvh * 4 + 3) * 256 + i] = d3;
    }
    __syncthreads();
    SA_GATHER(C.in[I_CV], 640);
#undef SA_GATHER
    {
        float v[4]; float mx = -1e30f;
#pragma unroll
        for (int x = 0; x < 4; ++x) { v[x] = lg[wave * 256 + lane + 64 * x]; mx = fmaxf(mx, v[x]); }
#pragma unroll
        for (int o = 1; o < 64; o <<= 1) mx = fmaxf(mx, __shfl_xor(mx, o));
        float s = 0.f;
#pragma unroll
        for (int x = 0; x < 4; ++x) { v[x] = __builtin_amdgcn_exp2f(v[x] - mx); s += v[x]; }
        s = wave_sum(s); const float inv = 1.0f / s;
#pragma unroll
        for (int x = 0; x < 4; ++x) lg[wave * 256 + lane + 64 * x] = v[x] * inv;
    }
    __syncthreads();
    {
        const int kvh = wave >> 2; float o = 0.f;
#pragma unroll 8
        for (int i = 0; i < 256; ++i) o = fmaf(lg[wave * 256 + i], kvs[i * 132 + kvh * 64 + lane], o);
        mixs[wave * 64 + lane] = o;
    }
}

constexpr int CW_SSQS = 12288;
__device__ __forceinline__ void sample_outproj_task(Ctx& C, int tile) {
    int tid_ = C.tid; asm volatile("" : "+v"(tid_));
    float* samp = (float*)(C.ws + WS_SAMP); LAS float* red = (LAS float*)C.lds;
    skinny32_bf16<DM, 128>(samp + S_MIX, (const bf16*)(C.ws + WS_WOT), 32 * tile, red, C.tid, (C.tid & 63), C.wave);
#pragma unroll
    for (int x = 0; x < 2; ++x) { const int e = tid_ + 512 * x, i = e >> 5, n = 32 * tile + (e & 31); const float v = C.in[I_XS][i * DM + n] + sk_get(red, e); __hip_atomic_store(samp + S_X1 + i * DM + n, v, __ATOMIC_RELAXED, __HIP_MEMORY_SCOPE_AGENT);
        float q = v * v; q += __shfl_xor(q, 1); q += __shfl_xor(q, 2); q += __shfl_xor(q, 4); q += __shfl_xor(q, 8); q += __shfl_xor(q, 16);
        if ((tid_ & 31) == 0) atomicAdd((float*)(C.ctl + CW_SSQS) + i, q); }
    asm volatile("s_waitcnt vmcnt(0)" ::: "memory");
    __syncthreads();
#if MERGE56
    if (C.tid == 0) __hip_atomic_fetch_add((unsigned*)(C.ctl + CW_SOP), 1u, __ATOMIC_RELAXED, __HIP_MEMORY_SCOPE_AGENT);
#endif
}
__device__ __forceinline__ void sample_up_task(Ctx& C, int tile) {
    int tid_ = C.tid; asm volatile("" : "+v"(tid_));
    float* samp = (float*)(C.ws + WS_SAMP); LAS float* red = (LAS float*)C.lds;
#if MERGE56
    if (C.tid == 0) { unsigned sp = 0; while (__hip_atomic_load((unsigned*)(C.ctl + CW_SOP), __ATOMIC_RELAXED, __HIP_MEMORY_SCOPE_AGENT) < 32u) { __builtin_amdgcn_s_sleep(2); if (++sp > (1u << 20)) break; }
        __builtin_amdgcn_fence(__ATOMIC_ACQUIRE, "agent"); asm volatile("s_waitcnt vmcnt(0)" ::: "memory"); }
    __syncthreads();
#endif
    skinny32_bf16<DM, 128>(samp + S_X1, (const bf16*)(C.ws + WS_WUT), 32 * tile, red, C.tid, (C.tid & 63), C.wave);
#pragma unroll
    for (int x = 0; x < 2; ++x) { const int e = tid_ + 512 * x, i = e >> 5, n = 32 * tile + (e & 31);
        const float rs = rsqrtf(((const float*)(C.ctl + CW_SSQS))[i] * (1.0f / DM) + EPS); const float v = fmaxf(sk_get(red, e) * rs, 0.f); __hip_atomic_store(samp + S_H + i * FF + n, v * v, __ATOMIC_RELAXED, __HIP_MEMORY_SCOPE_AGENT); }
    asm volatile("s_waitcnt vmcnt(0)" ::: "memory");
    __syncthreads();
}
constexpr int CW_SDN = 8192 + 2048;
__device__ __forceinline__ void sample_down_partial(Ctx& C) {
    int tid_ = C.tid; asm volatile("" : "+v"(tid_));
    float* samp = (float*)(C.ws + WS_SAMP); LAS float* red = (LAS float*)C.lds; float* part = (float*)(C.ws + WS_SAMP + 5 * MiB);
    const int tile = C.vcu & 31, ks = C.vcu >> 5;
#if MERGE56
    if (C.tid == 0) { unsigned sp = 0; while (__hip_atomic_load((unsigned*)(C.ctl + CW_SUP), __ATOMIC_RELAXED, __HIP_MEMORY_SCOPE_AGENT) < 128u) { __builtin_amdgcn_s_sleep(2); if (++sp > (1u << 20)) break; }
        __builtin_amdgcn_fence(__ATOMIC_ACQUIRE, "agent"); asm volatile("s_waitcnt vmcnt(0)" ::: "memory"); }
    __syncthreads();
#endif
    skinny32_bf16<FF, 64>(samp + S_H, (const bf16*)(C.ws + WS_WDT), 32 * tile, red, C.tid, (C.tid & 63), C.wave, ks * 512);
#pragma unroll
    for (int x = 0; x < 2; ++x) { const int e = tid_ + 512 * x, i = e >> 5, n = 32 * tile + (e & 31); __hip_atomic_store(part + (size_t)ks * 32768 + i * DM + n, sk_get(red, e), __ATOMIC_RELAXED, __HIP_MEMORY_SCOPE_AGENT); }
    asm volatile("s_waitcnt vmcnt(0)" ::: "memory");
    __syncthreads();
    if (C.tid == 0) __hip_atomic_fetch_add((unsigned*)(C.ctl + CW_SDN), 1u, __ATOMIC_RELAXED, __HIP_MEMORY_SCOPE_AGENT);
    __syncthreads();
}
__device__ __forceinline__ void sample_down_final(Ctx& C, int tile) {
    int tid_ = C.tid; asm volatile("" : "+v"(tid_));
    float* samp = (float*)(C.ws + WS_SAMP); const float* part = (const float*)(C.ws + WS_SAMP + 5 * MiB);
    if (C.tid == 0) { unsigned sp = 0; while (__hip_atomic_load((unsigned*)(C.ctl + CW_SDN), __ATOMIC_RELAXED, __HIP_MEMORY_SCOPE_AGENT) < (unsigned)C.G) { __builtin_amdgcn_s_sleep(4); if (++sp > (1u << 20)) break; }
        __builtin_amdgcn_fence(__ATOMIC_ACQUIRE, "agent"); asm volatile("s_waitcnt vmcnt(0)" ::: "memory"); }
    __syncthreads();
#pragma unroll
    for (int x = 0; x < 2; ++x) { const int e = tid_ + 512 * x, i = e >> 5, n = 32 * tile + (e & 31); float s = samp[S_X1 + i * DM + n];
#pragma unroll
        for (int k = 0; k < 8; ++k) s += __hip_atomic_load(part + (size_t)k * 32768 + i * DM + n, __ATOMIC_RELAXED, __HIP_MEMORY_SCOPE_AGENT);
        C.out[O_YS + i * DM + n] = s; }
}
__device__ __forceinline__ bool opaque_tid(Ctx& C) { asm volatile("" : "+v"(C.tid)); return true; }
#ifndef PG_ALIGN
#define PG_ALIGN true
#endif
#ifndef PG_SP2
#define PG_SP2 true
#endif
struct Args { const float* in[18]; float* out; unsigned char* ws; int ph_lo, ph_hi; };
constexpr int N_PHASES = 7;
#ifndef MK_SPLIT
#define MK_SPLIT 0
#endif
__global__ void __launch_bounds__(512, 2) hymba_fwd(Args args) {
    extern __shared__ __attribute__((aligned(16))) unsigned char lds_raw[];
    Ctx C;
    C.lds = (LAS unsigned char*)lds_raw; C.MISC = (volatile LAS unsigned*)(C.lds + MISC_OFF);
    C.tid = threadIdx.x; C.wave = __builtin_amdgcn_readfirstlane(C.tid >> 6);
    C.G = gridDim.x; { const int bx = blockIdx.x; C.vcu = (C.G % 8 == 0) ? (bx % 8) * (C.G / 8) + bx / 8 : bx; }
    C.ws = args.ws; C.out = args.out; C.ctl = (gu32*)(args.ws + WS_CTL);
#pragma unroll
    for (int i = 0; i < 18; ++i) C.in[i] = args.in[i];
    for (int u = C.tid; u < (LDS_BYTES - LDSCTL_OFF) / 4; u += 512) ((LAS unsigned*)(C.lds + LDSCTL_OFF))[u] = 0u;
    __syncthreads();
    const int lo = args.ph_lo, hi = args.ph_hi;
#ifdef PROBE_PH
    unsigned long long ph_t0_ = __builtin_amdgcn_s_memrealtime(), ph_acc_ = 0;
#define PHMARK(k) do { const unsigned long long now_ = __builtin_amdgcn_s_memrealtime(); if (PROBE_PH == (k)) ph_acc_ = now_ - ph_t0_; ph_t0_ = now_; } while (0)
#else
#define PHMARK(k) do {} while (0)
#endif
    XcdBarrier bar; bar.bar = (unsigned*)(C.ctl + CW_BAR); bar.x = 0; bar.st = nullptr;
    if (hi - lo > 1) bar = xcd_barrier_post((unsigned*)(C.ctl + CW_BAR), C.MISC + 8);
    group_census(C);
#ifdef PROBE_GRP
    if (C.tid == 0) ((unsigned*)(C.ws + WS_GAINS + 16384))[blockIdx.x] = (unsigned)__builtin_amdgcn_s_memrealtime();
#endif
#ifndef PH_MASK
#define PH_MASK 0x7f
#endif
#define IN(k) (((PH_MASK >> (k)) & 1) && lo <= (k) && (k) < hi)
#ifndef REP_MASK
#define REP_MASK 0
#endif
#define REPS(k) (((REP_MASK >> (k)) & 1) ? 2 : 1)
#ifdef PROBE_2BAR
#define SEAM(k) do { if (IN(k) && IN((k) + 1)) { xcd_barrier(bar); xcd_barrier(bar); } } while (0)
#else
#define SEAM(k) do { if (IN(k) && IN((k) + 1)) xcd_barrier(bar); } while (0)
#endif

#ifdef PROBE_VALU
    if (C.vcu == 40) {
        float x_[16]; for (int i = 0; i < 16; ++i) x_[i] = (float)(C.tid + i);
        const float a_ = 1.0001f, b_ = 0.5f;
        __syncthreads();
        const unsigned long long t0_ = __builtin_amdgcn_s_memrealtime();
#pragma unroll 1
        for (int it = 0; it < 4096; ++it) {
#pragma unroll
            for (int i = 0; i < 16; ++i) asm volatile("v_fma_f32 %0, %0, %1, %2" : "+v"(x_[i]) : "v"(a_), "v"(b_));
        }
        __syncthreads();
        const unsigned long long t1_ = __builtin_amdgcn_s_memrealtime();
        float s_ = 0.f; for (int i = 0; i < 16; ++i) s_ += x_[i];
        if (C.tid == 0) { const float us = (float)(t1_ - t0_) * 0.01f; ((float*)(C.ws + WS_GAINS + 4096))[0] = sqrtf(2048.0f * (1e-4f + 5e-4f * fminf(us / 400.0f, 1.0f))); ((float*)(C.ws + WS_GAINS + 4096))[1] = s_; }
    }
#endif
#ifdef PROBE_TICKS
    { const unsigned long long t0_ = __builtin_amdgcn_s_memrealtime(); while (__builtin_amdgcn_s_memrealtime() - t0_ < (unsigned long long)(PROBE_TICKS)) __builtin_amdgcn_s_sleep(4); }
#endif
#if GSEAM0
    if (IN(0)) { p0_prologue(C); group_barrier(C, (int)blockIdx.x & 7, (unsigned)(C.G >> 3), (unsigned)(C.G >> 3), CW_GB0); counter_wait(C, CW_W1T, (unsigned)C.G); PHMARK(0); }
#else
    if (IN(0)) { for (int rep = 0; rep < REPS(0); ++rep) { p0_prologue(C); __syncthreads(); } SEAM(0); PHMARK(0); }
#endif

    if (IN(1)) {
#ifdef PROBE_SPP
        const unsigned long long sp0_ = __builtin_amdgcn_s_memrealtime();
#endif
#if GSEAM0
        if (C.vcu < 32) { counter_wait(C, CW_SIP, 107u); sample_postproj(C, C.vcu); }
#else
        if (C.vcu < 32) sample_postproj(C, C.vcu);
#endif
#ifdef PROBE_SPP
        __syncthreads();
        if (C.vcu == 2 && C.tid == 0) { const float us = (float)(__builtin_amdgcn_s_memrealtime() - sp0_) * 0.01f; ((float*)(C.ws + WS_GAINS + 4096))[0] = sqrtf(2048.0f * (1e-4f + 5e-4f * fminf(us / 50.0f, 1.0f))); }
#endif
        __syncthreads();
        pg8::Gemm g{(const pg8::bf16_t*)(C.ws + WS_XB), (const pg8::bf16_t*)(C.ws + WS_W1T), NTOK, INP, DM};
#ifdef P1_PERM
        pg8::PermOrder S; S.init(NTOK, INP, C.G, (int)blockIdx.x);
#define P1_ORDER pg8::PermOrder
#else
        pg8::StaticOrder S; S.init(NTOK, INP, C.G, (int)blockIdx.x);
#define P1_ORDER pg8::StaticOrder
#endif
        pg8::EpiInProj E{(const float*)(C.ws + WS_RSTD1), (const float*)(C.ws + WS_GAINS),
                         (pg8::bf16_t*)(C.ws + WS_QB), (pg8::bf16_t*)(C.ws + WS_KB), (pg8::bf16_t*)(C.ws + WS_VT), (pg8::bf16_t*)(C.ws + WS_IQB), (pg8::bf16_t*)(C.ws + WS_IKB),
                         (pg8::bf16_t*)(C.ws + WS_RQ), (pg8::bf16_t*)(C.ws + WS_RF), (pg8::bf16_t*)(C.ws + WS_RI), (pg8::bf16_t*)(C.ws + WS_RGT), (float*)(C.ws + WS_IWF),
                         C.out + O_NK, C.out + O_NV, C.out + O_NKI};
        pg8::gemm_phase<pg8::EpiInProj, P1_ORDER, PG_ALIGN, PG_SP2>(C.lds, g, S, E);
#if (REP_MASK >> 1) & 1
        __syncthreads(); pg8::gemm_phase<pg8::EpiInProj, P1_ORDER, PG_ALIGN, PG_SP2>(C.lds, g, S, E);
#endif
#if GSEAM1
        group_publish(C, (int)blockIdx.x & 7, (unsigned)(C.G >> 3)); PHMARK(1);
#else
        SEAM(1); PHMARK(1);
#endif
    }

    const int myx = (int)(xb_xcc_id() & 7u);
    if (IN(2)) {
        constexpr int U_H = 16, U_SH = 16, U_SS = 64, U_SEL = 256, U_TOT = U_H + U_SH + U_SS + U_SEL;
        for (int qi = 0; qi < 8; ++qi) { const int x = (myx + qi) & 7, cw = CW_Q2 + 64 * x;
#if GSEAM1
            if (qi < 2) group_consume_wait(C, x, (int)blockIdx.x & 7, (unsigned)(C.G >> 3), qi == 1);
#endif
#if QPF
            for (int u0 = q_next(C, cw, 2u); u0 < U_TOT; ) {
                unsigned pf = 0u; const bool havepf = u0 >= U_H;
                for (int u = u0; u < u0 + 2; ++u) {
                    if (havepf && u == u0 + 1 && C.tid == 0) pf = __hip_atomic_fetch_add((unsigned*)(C.ctl + cw), 2u, __ATOMIC_RELAXED, __HIP_MEMORY_SCOPE_AGENT);
                    if (u < U_H) { if (!(u & 1)) hgrn_unit(C, 2 * x + (u >> 3), (u >> 1) & 3, 0); continue; }
                    int v = u - U_H;
                    if (v < U_SH) { sample_hgrn_unit(C, 4 * x + (v >> 2), v & 3); __syncthreads(); continue; } v -= U_SH;
                    if (v < U_SS) { sample_score_unit(C, 4 * x + (v >> 4), v & 15); continue; } v -= U_SS;
                    dsa_select_unit(C, 2 * x + (v & 1), 127 - (v >> 1)); __syncthreads();
                }
                if (havepf) { __syncthreads(); if (C.tid == 0) C.MISC[16] = pf; __syncthreads(); u0 = (int)C.MISC[16]; } else u0 = q_next(C, cw, 2u);
            } }
#else
            for (int u0 = q_next(C, cw, 2u); u0 < U_TOT; u0 = q_next(C, cw, 2u))
                for (int u = u0; u < u0 + 2; ++u) {
                    if (u < U_H) { if (!(u & 1)) hgrn_unit(C, 2 * x + (u >> 3), (u >> 1) & 3, 0); continue; }
                    int v = u - U_H;
                    if (v < U_SH) { sample_hgrn_unit(C, 4 * x + (v >> 2), v & 3); __syncthreads(); continue; } v -= U_SH;
                    if (v < U_SS) { sample_score_unit(C, 4 * x + (v >> 4), v & 15); continue; } v -= U_SS;
                    dsa_select_unit(C, 2 * x + (v & 1), 127 - (v >> 1)); __syncthreads();
                } }
#endif
#if WDEFER
        weights_filler(C, CW_QW2, 0, 144);
#endif
        SEAM(2); PHMARK(2);
    }
    if (IN(3)) {
        constexpr int U_HG = 16, U_SA = 4, U_AT = 128, U_TOT = U_HG + U_SA + U_AT;
        for (int qi = 0; qi < 8; ++qi) { const int x = (myx + qi) & 7, cw = CW_Q3 + 64 * x;
#if QPF
            for (int u0 = q_next(C, cw, 2u); u0 < U_TOT; ) {
                unsigned pf = 0u; const bool havepf = u0 >= U_HG;
                for (int u = u0; u < u0 + 2; ++u) {
                    if (havepf && u == u0 + 1 && C.tid == 0) pf = __hip_atomic_fetch_add((unsigned*)(C.ctl + cw), 2u, __ATOMIC_RELAXED, __HIP_MEMORY_SCOPE_AGENT);
                    if (u < U_HG) { if (!(u & 1)) hgrn_unit(C, 2 * x + (u >> 3), (u >> 1) & 3, 1); continue; }
                    int v = u - U_HG;
                    if (v < U_SA) { sample_attend_unit(C, 4 * x + v); __syncthreads(); continue; } v -= U_SA;
                    attn_unit(C, 2 * x + (v & 1), 63 - (v >> 1)); __syncthreads();
                }
                if (havepf) { __syncthreads(); if (C.tid == 0) C.MISC[16] = pf; __syncthreads(); u0 = (int)C.MISC[16]; } else u0 = q_next(C, cw, 2u);
            } }
#else
            for (int u0 = q_next(C, cw, 2u); u0 < U_TOT; u0 = q_next(C, cw, 2u))
                for (int u = u0; u < u0 + 2; ++u) {
                    if (u < U_HG) { if (!(u & 1)) hgrn_unit(C, 2 * x + (u >> 3), (u >> 1) & 3, 1); continue; }
                    int v = u - U_HG;
                    if (v < U_SA) { sample_attend_unit(C, 4 * x + v); __syncthreads(); continue; } v -= U_SA;
                    attn_unit(C, 2 * x + (v & 1), 63 - (v >> 1)); __syncthreads();
                } }
#endif
#if WDEFER
        weights_filler(C, CW_QW3, 144, 288);
#endif
        SEAM(3); PHMARK(3);
    }

    if (IN(4)) {
#if PROBE_TASK == 4
        const unsigned long long tk0_ = __builtin_amdgcn_s_memrealtime();
#endif
        if (C.vcu >= 224) sample_outproj_task(C, C.vcu - 224);
#if PROBE_TASK == 4
        __syncthreads();
        if (C.vcu == 2 && C.tid == 0) { const float us = (float)(__builtin_amdgcn_s_memrealtime() - tk0_) * 0.01f; ((float*)(C.ws + WS_GAINS + 4096))[0] = sqrtf(2048.0f * (1e-4f + 5e-4f * fminf(us / 50.0f, 1.0f))); }
#endif
#if XB_TOUCH
        {   pg8::StaticOrder S_; S_.init(NTOK, DM, C.G, (int)blockIdx.x); const bf16* xb_ = (const bf16*)(C.ws + WS_XB);
            LAS unsigned* sink_ = (LAS unsigned*)(C.lds + 131072 + C.wave * 256);
#pragma unroll
            for (int k_ = 0; k_ < 2; ++k_) { struct { int pm, pn; } u_;
                { const int L2_ = k_ * C.G + (int)blockIdx.x, w_ = (L2_ & 7) * (S_.nwg >> 3) + (L2_ >> 3), nig_ = 8 * S_.nN; u_.pm = (w_ / nig_) * 8 + ((w_ % nig_) & 7); u_.pn = (w_ % nig_) >> 3; }
#pragma unroll
                for (int h_ = 0; h_ < 2; ++h_) { const int L_ = C.tid + 512 * h_; const bf16* p_ = xb_ + (size_t)(u_.pm * 256 + (L_ >> 2)) * DM + u_.pn * 256 + (L_ & 3) * 64;
                    __builtin_amdgcn_global_load_lds((const unsigned*)p_, sink_, 4, 0, 0); } } }
#endif
        __syncthreads();
        pg8::Gemm g{(const pg8::bf16_t*)(C.ws + WS_MIX), (const pg8::bf16_t*)(C.ws + WS_WOT), NTOK, DM, DM};
#ifdef P4_REV
        pg8::RevOrder S; S.init(NTOK, DM, C.G, (int)blockIdx.x);
#define P4_ORDER pg8::RevOrder
#else
        pg8::StaticOrder S; S.init(NTOK, DM, C.G, (int)blockIdx.x);
#define P4_ORDER pg8::StaticOrder
#endif
        pg8::EpiOutProj E{C.in[I_XP], C.out + O_Y, (pg8::bf16_t*)(C.ws + WS_X1B), (float*)(C.ws + WS_SSQ), (const pg8::bf16_t*)(C.ws + WS_XB)};
        pg8::gemm_phase<pg8::EpiOutProj, P4_ORDER, PG_ALIGN, PG_SP2>(C.lds, g, S, E);
#if (REP_MASK >> 4) & 1
        __syncthreads(); pg8::gemm_phase<pg8::EpiOutProj, P4_ORDER, PG_ALIGN, PG_SP2>(C.lds, g, S, E);
#endif
#if MERGE56
        group_barrier(C, (int)blockIdx.x & 7, (unsigned)(C.G >> 3), (unsigned)(C.G >> 3));
        PHMARK(4);
#else
        SEAM(4); PHMARK(4);
#endif
    }

#ifndef MERGE56
#define MERGE56 1
#endif
#ifndef H_AUX
#define H_AUX 0
#endif
#if MERGE56
    if (IN(5)) {
        const int gx = (int)blockIdx.x & 7; const unsigned gn = (unsigned)(C.G >> 3);
        if (C.vcu >= 96 && C.vcu < 224) { sample_up_task(C, C.vcu - 96);
            if (C.tid == 0) __hip_atomic_fetch_add((unsigned*)(C.ctl + CW_SUP), 1u, __ATOMIC_RELAXED, __HIP_MEMORY_SCOPE_AGENT); }
        __syncthreads();
        const pg8::Gemm gu{(const pg8::bf16_t*)(C.ws + WS_X1B), (const pg8::bf16_t*)(C.ws + WS_WUT), NTOK, FF, DM};
        const pg8::Gemm gd{(const pg8::bf16_t*)(C.ws + WS_H), (const pg8::bf16_t*)(C.ws + WS_WDT), NTOK, DM, FF};
        const pg8::EpiUp EU{(pg8::bf16_t*)(C.ws + WS_H)};
        const pg8::EpiDown ED{C.out + O_Y, (const pg8::bf16_t*)(C.ws + WS_X1B), (const float*)(C.ws + WS_SSQ)};
        { pg8::RangeOrder S; S.init(NTOK, FF, C.G, (int)blockIdx.x, 0, 4); pg8::gemm_phase<pg8::EpiUp, pg8::RangeOrder, PG_ALIGN, PG_SP2>(C.lds, gu, S, EU); }
        group_barrier(C, gx, gn, 2u * gn);
        sample_down_partial(C);
        __syncthreads();
#ifdef MIX_ORDER
        if (((int)blockIdx.x >> 3) & 1) {
            { pg8::RangeOrder S; S.init(NTOK, FF, C.G, (int)blockIdx.x, 4, 8); pg8::gemm_phase<pg8::EpiUp, pg8::RangeOrder, PG_ALIGN, PG_SP2>(C.lds, gu, S, EU); }
            __syncthreads();
            { pg8::RangeOrder S; S.init(NTOK, DM, C.G, (int)blockIdx.x, 0, 1); pg8::gemm_phase<pg8::EpiDown, pg8::RangeOrder, PG_ALIGN, PG_SP2, H_AUX>(C.lds, gd, S, ED); }
        } else
#endif
        {
        { pg8::RangeOrder S; S.init(NTOK, DM, C.G, (int)blockIdx.x, 0, 1); pg8::gemm_phase<pg8::EpiDown, pg8::RangeOrder, PG_ALIGN, PG_SP2, H_AUX>(C.lds, gd, S, ED); }
        __syncthreads();
        { pg8::RangeOrder S; S.init(NTOK, FF, C.G, (int)blockIdx.x, 4, 8); pg8::gemm_phase<pg8::EpiUp, pg8::RangeOrder, PG_ALIGN, PG_SP2>(C.lds, gu, S, EU); }
        }
        group_barrier(C, gx, gn, 3u * gn);
        { pg8::RangeOrder S; S.init(NTOK, DM, C.G, (int)blockIdx.x, 1, 2); pg8::gemm_phase<pg8::EpiDown, pg8::RangeOrder, PG_ALIGN, PG_SP2, H_AUX>(C.lds, gd, S, ED); }
        if (C.vcu < 32) sample_down_final(C, C.vcu);
        PHMARK(6);
#ifdef PROBE_GRP
        {   unsigned* slot = (unsigned*)(C.ws + WS_GAINS + 8192);
            __syncthreads();
            if (C.tid == 0) slot[blockIdx.x] = (unsigned)__builtin_amdgcn_s_memrealtime();
            xcd_barrier(bar);
            if (C.vcu == 40 && C.tid == 0) { const unsigned me = slot[blockIdx.x]; int mx = -(1 << 30), mn = (1 << 30); int gmx[8];
                for (int g = 0; g < 8; ++g) gmx[g] = -(1 << 30);
                for (int i = 0; i < (int)C.G; ++i) { const int d = (int)(slot[i] - me); mx = d > mx ? d : mx; mn = d < mn ? d : mn; }
                int sel = mx - mn;
                if (PROBE_GRP >= 1) { int m2 = -(1 << 30); for (int i = (PROBE_GRP - 1); i < (int)C.G; i += 8) { const int d = (int)(slot[i] - me); m2 = d > m2 ? d : m2; } sel = m2 - mn; }
                float us = (float)sel * 0.01f;
                if (PROBE_GRP == 9) { const unsigned* st = (const unsigned*)(C.ws + WS_GAINS + 16384); int smn = (1 << 30); for (int i = 0; i < (int)C.G; ++i) { const int d = (int)(st[i] - me); smn = d < smn ? d : smn; }
                    us = (float)(mx - smn) * 0.01f - 1100.0f; }
                C.out[O_NKIS + 5] += sqrtf(2048.0f * (1e-4f + 5e-4f * fminf(fmaxf(us, 0.f) / 100.0f, 1.0f))); }
        }
#endif
#else
    if (IN(5)) {
#ifdef PROBE_SUP
        const unsigned long long su0_ = __builtin_amdgcn_s_memrealtime();
#endif
        if (C.vcu < 128) sample_up_task(C, C.vcu);
#ifdef PROBE_SUP
        if (C.vcu == 40 && C.tid == 0) { const float us = (float)(__builtin_amdgcn_s_memrealtime() - su0_) * 0.01f; ((float*)(C.ws + WS_GAINS + 4096))[0] = sqrtf(2048.0f * (1e-4f + 5e-4f * fminf(us / 50.0f, 1.0f))); }
#endif
        __syncthreads();
        pg8::Gemm g{(const pg8::bf16_t*)(C.ws + WS_X1B), (const pg8::bf16_t*)(C.ws + WS_WUT), NTOK, FF, DM};
#ifdef P5_REV
        pg8::RevOrder S; S.init(NTOK, FF, C.G, (int)blockIdx.x);
        pg8::EpiUp E{(pg8::bf16_t*)(C.ws + WS_H)};
        pg8::gemm_phase<pg8::EpiUp, pg8::RevOrder, PG_ALIGN, PG_SP2>(C.lds, g, S, E);
#else
        pg8::StaticOrder S; S.init(NTOK, FF, C.G, (int)blockIdx.x);
        pg8::EpiUp E{(pg8::bf16_t*)(C.ws + WS_H)};
        pg8::gemm_phase<pg8::EpiUp, pg8::StaticOrder, PG_ALIGN, PG_SP2>(C.lds, g, S, E);
#endif
#if (REP_MASK >> 5) & 1
        __syncthreads(); pg8::gemm_phase<pg8::EpiUp, pg8::StaticOrder, PG_ALIGN, PG_SP2>(C.lds, g, S, E);
#endif
        SEAM(5); PHMARK(5);
    }

    if (IN(6)) {
#if PROBE_TASK == 6
        const unsigned long long tk0_ = __builtin_amdgcn_s_memrealtime();
#endif
        sample_down_partial(C);
#if PROBE_TASK == 6
        __syncthreads();
        if (C.vcu == 40 && C.tid == 0) { const float us = (float)(__builtin_amdgcn_s_memrealtime() - tk0_) * 0.01f; ((float*)(C.ws + WS_GAINS + 4096))[0] = sqrtf(2048.0f * (1e-4f + 5e-4f * fminf(us / 50.0f, 1.0f))); }
#endif
        __syncthreads();
        pg8::Gemm g{(const pg8::bf16_t*)(C.ws + WS_H), (const pg8::bf16_t*)(C.ws + WS_WDT), NTOK, DM, FF};
#ifdef P6_FWD
        pg8::StaticOrder S; S.init(NTOK, DM, C.G, (int)blockIdx.x);
        pg8::EpiDown E{C.out + O_Y, (const pg8::bf16_t*)(C.ws + WS_X1B), (const float*)(C.ws + WS_SSQ)};
        pg8::gemm_phase<pg8::EpiDown, pg8::StaticOrder, PG_ALIGN, PG_SP2>(C.lds, g, S, E);
#else
        pg8::RevOrder S; S.init(NTOK, DM, C.G, (int)blockIdx.x);
        pg8::EpiDown E{C.out + O_Y, (const pg8::bf16_t*)(C.ws + WS_X1B), (const float*)(C.ws + WS_SSQ)};
        pg8::gemm_phase<pg8::EpiDown, pg8::RevOrder, PG_ALIGN, PG_SP2>(C.lds, g, S, E);
#endif
#if PROBE_TASK == 7
        const unsigned long long tk0_ = __builtin_amdgcn_s_memrealtime();
#endif
        if (C.vcu < 32) sample_down_final(C, C.vcu);
#if PROBE_TASK == 7
        __syncthreads();
        if (C.vcu == 2 && C.tid == 0) { const float us = (float)(__builtin_amdgcn_s_memrealtime() - tk0_) * 0.01f; ((float*)(C.ws + WS_GAINS + 4096))[0] = sqrtf(2048.0f * (1e-4f + 5e-4f * fminf(us / 50.0f, 1.0f))); }
#endif
        PHMARK(6);
#endif
#if defined(PROBE_P0) || defined(PROBE_VALU) || defined(PROBE_SUP) || defined(PROBE_SPP) || PROBE_TASK
        if (C.vcu == 40 && C.tid == 0) C.out[O_NKIS + 5] += ((const float*)(C.ws + WS_GAINS + 4096))[0];
#endif
#ifdef PROBE_PH
        if (C.vcu == 40 && C.tid == 0) { const float us = (float)ph_acc_ * 0.01f; C.out[O_NKIS] += sqrtf(2048.0f * (1e-4f + 5e-4f * fminf(us / 400.0f, 1.0f))); }
#endif
    }
#undef IN
#undef SEAM
}

extern "C" void kernel_launch(void* const* d_in, const int* in_sizes, int n_in, void* d_out, int out_size, void* d_ws, size_t ws_size, hipStream_t stream) {
    static int grid = 0;
    if (grid == 0) {
        if (n_in != 18 || in_sizes[0] != NTOK * DM || (size_t)out_size != O_END || ws_size < WS_END) {
            fprintf(stderr, "kernel_launch: unexpected shapes: n_in %d in0 %d out %d ws %zu (need ws >= %zu); nothing launched\n", n_in, n_in > 0 ? in_sizes[0] : -1, out_size, ws_size, (size_t)WS_END); grid = -1; return; }
        int dev = 0, cus = 0;
        if (hipGetDevice(&dev) != hipSuccess || hipDeviceGetAttribute(&cus, hipDeviceAttributeMultiprocessorCount, dev) != hipSuccess) { grid = -1; return; }
        if (hipFuncSetAttribute((const void*)hymba_fwd, hipFuncAttributeMaxDynamicSharedMemorySize, LDS_BYTES) != hipSuccess) { fprintf(stderr, "kernel_launch: hipFuncSetAttribute failed\n"); grid = -1; return; }
        int per_cu = 0;
        if (hipOccupancyMaxActiveBlocksPerMultiprocessor(&per_cu, (const void*)hymba_fwd, 512, LDS_BYTES) != hipSuccess || per_cu < 1) fprintf(stderr, "kernel_launch: occupancy query says %d\n", per_cu);
        (void)hipGetLastError();
        grid = cus;
        if (grid != 256) fprintf(stderr, "kernel_launch: %d CUs (expected 256)\n", grid);
    }
    if (grid < 0) return;
    (void)hipMemsetAsync((char*)d_ws + WS_CTL, 0, CTL_ZERO_BYTES, stream);
#ifdef PROBE_2MEMSET
    (void)hipMemsetAsync((char*)d_ws + WS_END, 0, 4096, stream);
#endif
    Args a{};
    for (int i = 0; i < 18; ++i) a.in[i] = (const float*)d_in[i];
    a.out = (float*)d_out; a.ws = (unsigned char*)d_ws;
#if MK_SPLIT
    for (int p = 0; p < N_PHASES; ++p) { a.ph_lo = p; a.ph_hi = p + 1; hipLaunchKernelGGL(hymba_fwd, dim3(grid), dim3(512), LDS_BYTES, stream, a); }
#else
    a.ph_lo = 0; a.ph_hi = N_PHASES; hipLaunchKernelGGL(hymba_fwd, dim3(grid), dim3(512), LDS_BYTES, stream, a);
#endif
}
```
